# Optimizing an MI355X kernel written in HIP

```python
import jax, jax.numpy as jnp
from jax import lax
import numpy as np

D_MODEL = 1024
BATCH = 4
SEQ = 4096
DEPTH = 1
DEC_BATCH = 16
DEC_SEQ = 16
PAST_LEN = 1024

CHUNK = 64
MIX_WIDTH = D_MODEL
RET_HEADS = 4
RET_DK = 128
RET_DV = 128
RET_QK = RET_HEADS * RET_DK
RET_WIDTH = RET_HEADS * RET_DV
HG_HEADS = 4
HG_EXPAND = 128
HG_DV = 128
HG_FDIM = HG_HEADS * HG_EXPAND
HG_WIDTH = HG_HEADS * HG_DV
D_FF = 2816
CONV_W = 3
EPS = 1e-6
ROPE_BASE = 10000.0
IN_SIZES = (RET_QK, RET_QK, RET_WIDTH, RET_WIDTH, HG_FDIM, HG_FDIM, HG_WIDTH, HG_WIDTH)
IN_COLS = sum(IN_SIZES)
IN_OFFSETS = tuple(int(o) for o in np.cumsum(IN_SIZES)[:-1])

kernel_name = "retention_hgrn2_convffn_stream_step"


def rmsnorm(x, g):
    x32 = x.astype(jnp.float32)
    y = x32 * lax.rsqrt(jnp.mean(x32 * x32, axis=-1, keepdims=True) + EPS)
    return (y * g.astype(jnp.float32)).astype(x.dtype)


def rope(t, pos):
    half = t.shape[-1] // 2
    inv = 1.0 / (ROPE_BASE ** (jnp.arange(half, dtype=jnp.float32) / half))
    ang = pos.astype(jnp.float32)[:, None] * inv[None, :]
    cos, sin = jnp.cos(ang), jnp.sin(ang)
    t1, t2 = t[..., :half], t[..., half:]
    return jnp.concatenate([t1 * cos - t2 * sin, t1 * sin + t2 * cos], axis=-1)


def to_chunks(t, c):
    b, h, l, d = t.shape
    return t.reshape(b, h, l // c, c, d).transpose(2, 0, 1, 3, 4)


def from_chunks(t):
    n, b, h, c, d = t.shape
    return t.transpose(1, 2, 0, 3, 4).reshape(b, h, n * c, d)


def retention_chunkwise(q, k, v, state):
    L = q.shape[2]
    c = min(L, CHUNK)
    log_g = jnp.log(1.0 - 2.0 ** (-5.0 - jnp.arange(RET_HEADS, dtype=jnp.float32)))
    idx = jnp.arange(c)
    rel = idx[:, None] - idx[None, :]
    dmat = jnp.where(rel >= 0, jnp.exp(log_g[:, None, None] * jnp.maximum(rel, 0)), 0.0)
    q_decay = jnp.exp(log_g[:, None] * (idx + 1))[..., None]
    k_decay = jnp.exp(log_g[:, None] * (c - 1 - idx))[..., None]
    chunk_decay = jnp.exp(log_g * c)[:, None, None]

    def step(s, inp):
        qc, kc, vc = inp
        attn = jnp.einsum('bhid,bhjd->bhij', qc, kc) * dmat
        o = jnp.einsum('bhij,bhjv->bhiv', attn, vc) + jnp.einsum('bhid,bhdv->bhiv', qc * q_decay, s)
        s_new = s * chunk_decay + jnp.einsum('bhjd,bhjv->bhdv', kc * k_decay, vc)
        return s_new, o

    s_fin, o = lax.scan(step, state, (to_chunks(q, c), to_chunks(k, c), to_chunks(v, c)))
    return from_chunks(o), s_fin


def gated_chunkwise(q, k, v, g, state):
    L = q.shape[2]
    c = min(L, CHUNK)
    causal = (jnp.arange(c)[:, None] >= jnp.arange(c)[None, :])[:, :, None]

    def step(s, inp):
        qc, kc, vc, gc = inp
        b = jnp.cumsum(gc, axis=2)
        diff = b[:, :, :, None, :] - b[:, :, None, :, :]
        decay = jnp.exp(jnp.where(causal, diff, -jnp.inf))
        attn = jnp.einsum('bhik,bhjk,bhijk->bhij', qc, kc, decay)
        o = jnp.einsum('bhij,bhjv->bhiv', attn, vc) + jnp.einsum('bhik,bhkv->bhiv', qc * jnp.exp(b), s)
        b_last = b[:, :, -1]
        s_new = s * jnp.exp(b_last)[..., None] + jnp.einsum(
            'bhjk,bhjv->bhkv', kc * jnp.exp(b_last[:, :, None, :] - b), vc)
        return s_new, o

    s_fin, o = lax.scan(step, state, (to_chunks(q, c), to_chunks(k, c), to_chunks(v, c), to_chunks(g, c)))
    return from_chunks(o), s_fin


def hybrid_mixer(h, pos, s_ret, s_hg, w_in, ret_norm_g, hg_norm_g, lb, w_out):
    B, L, _ = h.shape
    proj = jnp.einsum('bld,dc->blc', h, w_in)
    rq, rk, rv, rg, hq, hf, hi, hgate = jnp.split(proj, IN_OFFSETS, axis=-1)

    def heads(t, n):
        return t.astype(jnp.float32).reshape(B, L, n, -1).transpose(0, 2, 1, 3)

    q_r = rope(heads(rq, RET_HEADS), pos)
    k_r = rope(heads(rk, RET_HEADS), pos) * (RET_DK ** -0.5)
    o_r, s_ret_new = retention_chunkwise(q_r, k_r, heads(rv, RET_HEADS), s_ret.astype(jnp.float32))
    o_r = o_r.transpose(0, 2, 1, 3)
    o_r = o_r * lax.rsqrt(jnp.mean(o_r * o_r, axis=-1, keepdims=True) + EPS)
    o_r = o_r.reshape(B, L, RET_WIDTH) * ret_norm_g.astype(jnp.float32)
    o_r = o_r * jax.nn.silu(rg.astype(jnp.float32))

    f = lb + (1.0 - lb) * jax.nn.sigmoid(hf.astype(jnp.float32))
    o_h, s_hg_new = gated_chunkwise(heads(hq, HG_HEADS), heads(1.0 - f, HG_HEADS),
                                    heads(hi, HG_HEADS), heads(jnp.log(f), HG_HEADS),
                                    s_hg.astype(jnp.float32))
    o_h = o_h.transpose(0, 2, 1, 3).reshape(B, L, HG_WIDTH)
    o_h = rmsnorm(o_h, hg_norm_g) * jax.nn.silu(hgate.astype(jnp.float32))

    merged = jnp.concatenate([o_r, o_h], axis=-1).astype(h.dtype)
    out = jnp.einsum('blc,cd->bld', merged, w_out)
    return out, s_ret_new.astype(h.dtype), s_hg_new.astype(h.dtype)


def conv_ffn(h, conv_state, w_up, conv_k, conv_b, w_down):
    L = h.shape[1]
    u = jnp.einsum('bld,df->blf', h, w_up)
    a, b = jnp.split(u, 2, axis=-1)
    a_ext = jnp.concatenate([conv_state.astype(a.dtype), a], axis=1)
    conv = conv_b
    for w in range(CONV_W):
        conv = conv + a_ext[:, w:w + L] * conv_k[w]
    y = jnp.einsum('blf,fd->bld', jax.nn.silu(conv) * b, w_down)
    return y, a_ext[:, -(CONV_W - 1):]


def trunk(x, pos, s_ret, s_hg, s_conv, w_in, ret_norm_g, hg_norm_g, lb_all, w_out,
          norm_mix, norm_ffn, w_up, conv_k, conv_b, w_down, norm_final):
    new_ret, new_hg, new_conv = [], [], []
    for l in range(DEPTH):
        h = rmsnorm(x, norm_mix[l])
        m, sr, sh = hybrid_mixer(h, pos, s_ret[l], s_hg[l], w_in[l], ret_norm_g[l],
                                 hg_norm_g[l], lb_all[l], w_out[l])
        x = x + m
        h = rmsnorm(x, norm_ffn[l])
        f, sc = conv_ffn(h, s_conv[l], w_up[l], conv_k[l], conv_b[l], w_down[l])
        x = x + f
        new_ret.append(sr)
        new_hg.append(sh)
        new_conv.append(sc)
    y = rmsnorm(x, norm_final)
    return y, jnp.stack(new_ret), jnp.stack(new_hg), jnp.stack(new_conv)


def setup_inputs(seed: int = 0) -> dict:
    key = jax.random.key(seed)
    ks = jax.random.split(key, 20)
    f32 = jnp.float32
    nrm = lambda k, shape, s: jax.random.normal(k, shape, f32) * s
    return {
        "x_prompt": nrm(ks[0], (BATCH, SEQ, D_MODEL), 1.0),
        "x_sample": nrm(ks[1], (DEC_BATCH, DEC_SEQ, D_MODEL), 1.0),
        "state_ret": nrm(ks[2], (DEPTH, DEC_BATCH, RET_HEADS, RET_DK, RET_DV), 0.3),
        "state_hgrn": nrm(ks[3], (DEPTH, DEC_BATCH, HG_HEADS, HG_EXPAND, HG_DV), 0.3),
        "cache_ffn_conv": nrm(ks[4], (DEPTH, DEC_BATCH, CONV_W - 1, D_FF), 1.0),
        "w_in": nrm(ks[5], (DEPTH, D_MODEL, IN_COLS), D_MODEL ** -0.5),
        "ret_norm_g": 1.0 + nrm(ks[6], (DEPTH, RET_WIDTH), 0.01),
        "hg_norm_g": 1.0 + nrm(ks[7], (DEPTH, HG_WIDTH), 0.01),
        "hg_lb_logits": nrm(ks[8], (DEPTH + 1, HG_FDIM), 0.1),
        "w_out": nrm(ks[9], (DEPTH, MIX_WIDTH, D_MODEL), MIX_WIDTH ** -0.5),
        "norm_mix": 1.0 + nrm(ks[10], (DEPTH, D_MODEL), 0.01),
        "norm_ffn": 1.0 + nrm(ks[11], (DEPTH, D_MODEL), 0.01),
        "w_up": nrm(ks[12], (DEPTH, D_MODEL, 2 * D_FF), D_MODEL ** -0.5),
        "conv_k": nrm(ks[13], (DEPTH, CONV_W, D_FF), CONV_W ** -0.5),
        "conv_b": nrm(ks[14], (DEPTH, D_FF), 0.01),
        "w_down": nrm(ks[15], (DEPTH, D_FF, D_MODEL), D_FF ** -0.5),
        "norm_final": 1.0 + nrm(ks[16], (D_MODEL,), 0.01),
    }


def reference(x_prompt, x_sample, state_ret, state_hgrn, cache_ffn_conv, w_in, ret_norm_g,
              hg_norm_g, hg_lb_logits, w_out, norm_mix, norm_ffn, w_up, conv_k, conv_b,
              w_down, norm_final):
    lb_all = jnp.cumsum(jax.nn.softmax(hg_lb_logits.astype(jnp.float32), axis=0), axis=0)[:DEPTH]
    weights = (w_in, ret_norm_g, hg_norm_g, lb_all, w_out, norm_mix, norm_ffn,
               w_up, conv_k, conv_b, w_down, norm_final)

    pos_p = jnp.arange(SEQ, dtype=jnp.int32)
    zr = jnp.zeros((DEPTH, BATCH, RET_HEADS, RET_DK, RET_DV), jnp.float32)
    zh = jnp.zeros((DEPTH, BATCH, HG_HEADS, HG_EXPAND, HG_DV), jnp.float32)
    zc = jnp.zeros((DEPTH, BATCH, CONV_W - 1, D_FF), x_prompt.dtype)
    y_prompt, ret_p, hg_p, conv_p = trunk(x_prompt, pos_p, zr, zh, zc, *weights)

    pos_s = PAST_LEN + jnp.arange(x_sample.shape[1], dtype=jnp.int32)
    y_sample, ret_s, hg_s, conv_s = trunk(x_sample, pos_s, state_ret, state_hgrn,
                                          cache_ffn_conv, *weights)
    return (y_prompt, y_sample, ret_p, hg_p, conv_p, ret_s, hg_s, conv_s)
```

```cpp
#include <hip/hip_runtime.h>
#include <cstdio>
#include <cstdint>

#ifndef N_LAUNCHES
#define N_LAUNCHES 8
#endif

#define LAS __attribute__((address_space(3)))
typedef unsigned short bf16_t;
typedef short bf16x8 __attribute__((ext_vector_type(8)));
typedef float f32x4 __attribute__((ext_vector_type(4)));
typedef float f32x2 __attribute__((ext_vector_type(2)));
typedef unsigned u32x4 __attribute__((ext_vector_type(4)));
typedef unsigned u32x2 __attribute__((ext_vector_type(2)));

constexpr int DM = 1024, TP = 16384, TS = 256, TT = TP + TS, SEQ = 4096;
constexpr int DFF = 2816, UPC = 5632, INC = 4096, HW = 512;
constexpr float EPS = 1e-6f;
constexpr int NTHREADS = 512, NWAVES = 8;
constexpr int LDS_BYTES = 147456;
constexpr int RING_BYTES = 131072;
constexpr int MISC_OFF = RING_BYTES;

constexpr size_t O_Y = 0, O_RETP = 17039360, O_HGP = 17301504, O_CCP = 17563648, O_RETS = 17586176, O_HGS = 18634752, O_CCS = 19683328;

constexpr size_t WS_CTL = 0;
constexpr size_t WS_WIN = 65536;
constexpr size_t WS_WOUT = WS_WIN + (size_t)INC * DM * 2;
constexpr size_t WS_WUP = WS_WOUT + (size_t)DM * DM * 2;
constexpr size_t WS_WD = WS_WUP + (size_t)UPC * DM * 2;
constexpr size_t WS_ROPE = WS_WD + (size_t)DM * DFF * 2;
constexpr size_t WS_LB = WS_ROPE + (size_t)SEQ * 64 * 8;
constexpr size_t WS_SS2 = WS_LB + 4096;
constexpr size_t WS_SS3 = WS_SS2 + (size_t)TT * 16 * 4;
constexpr size_t WS_XB = WS_SS3 + (size_t)TT * 16 * 4;
constexpr size_t WS_PROJ = WS_XB + (size_t)TT * DM * 2;
constexpr size_t PSZ = (size_t)TT * HW * 2;
constexpr size_t WS_QR = WS_PROJ, WS_KR = WS_PROJ + PSZ, WS_VR = WS_PROJ + 2 * PSZ, WS_GR = WS_PROJ + 3 * PSZ, WS_HQ = WS_PROJ + 4 * PSZ,
                 WS_HI = WS_PROJ + 5 * PSZ, WS_HGT = WS_PROJ + 6 * PSZ, WS_HGF = WS_PROJ + 7 * PSZ;
constexpr size_t WS_PROJ_END = WS_HGF + (size_t)TT * HW * 4;
constexpr int X1B_ROWS = 16896;
constexpr size_t WS_X1B = WS_PROJ;
constexpr size_t WS_ACT = WS_X1B + (size_t)X1B_ROWS * DM * 2;
constexpr size_t WS_ACT_END = WS_ACT + (size_t)TT * DFF * 2;
static_assert(WS_ACT_END <= WS_PROJ_END, "overlay");
constexpr size_t WS_END = WS_PROJ_END;
static_assert(WS_END <= (size_t)256 * 1024 * 1024, "workspace");

__device__ __forceinline__ unsigned cvt_pk_bf16(float lo, float hi) { unsigned r; asm volatile("v_cvt_pk_bf16_f32 %0, %1, %2" : "=v"(r) : "v"(lo), "v"(hi)); return r; }
__device__ __forceinline__ float bf2f(unsigned short b) { return __uint_as_float(((unsigned)b) << 16); }
__device__ __forceinline__ float silu_f(float x) { return x / (1.0f + __expf(-x)); }

#define XB_TMO      128
#define XB_XCNT(j)  (256  + 64 * (j))
#define XB_XSUB(j)  (1280 + 64 * (j))
#define XB_XGEN(j)  (2304 + 64 * (j))
#define XB_TOP      3328
#define XB_TOPGEN   3392
#define XCD_BAR_WORDS 3456
#define XB_SPIN_CAP (1u << 18)
__device__ __forceinline__ unsigned xb_ld(unsigned* p)              { return __hip_atomic_load(p, __ATOMIC_RELAXED, __HIP_MEMORY_SCOPE_AGENT); }
__device__ __forceinline__ unsigned xb_add(unsigned* p, unsigned v) { return __hip_atomic_fetch_add(p, v, __ATOMIC_RELAXED, __HIP_MEMORY_SCOPE_AGENT); }
__device__ __forceinline__ unsigned xb_xcc_id() { return (unsigned)__builtin_amdgcn_s_getreg((3 << 11) | 20) & 0xFu; }
#define XB_SPIN(cond, bar) do { unsigned _sp = 0; while (cond) { __builtin_amdgcn_s_sleep(1); \
    if ((++_sp & 255u) == 0u) { if (xb_ld(&(bar)[XB_TMO])) break; if (_sp > XB_SPIN_CAP) { atomicAdd(&(bar)[XB_TMO], 1u); break; } } } } while (0)
struct XcdBarrier { unsigned* bar; unsigned x; volatile LAS unsigned* st; };
__device__ __forceinline__ XcdBarrier xcd_barrier_post(unsigned* bar, volatile LAS unsigned* st) {
    XcdBarrier b; b.bar = bar; b.x = xb_xcc_id(); b.st = st;
    if (threadIdx.x == 0) (void)xb_add(&bar[XB_XCNT(b.x)], 1u);
    return b;
}
__device__ __forceinline__ void xcd_barrier_complete(unsigned* bar, unsigned x, unsigned& nloc, unsigned& nx) {
    const unsigned G = gridDim.x * gridDim.y * gridDim.z;
    unsigned sum, cnt, mine, sp = 0u;
    for (;;) {
        sum = 0u; cnt = 0u; mine = 0u;
#pragma unroll
        for (unsigned j = 0; j < 16; ++j) { const unsigned c = xb_ld(&bar[XB_XCNT(j)]); sum += c; cnt += (c > 0u) ? 1u : 0u; mine = (j == x) ? c : mine; }
        if (sum == G) break;
        __builtin_amdgcn_s_sleep(1);
        if ((++sp & 255u) == 0u) { if (xb_ld(&bar[XB_TMO])) break; if (sp > XB_SPIN_CAP) { atomicAdd(&bar[XB_TMO], 1u); break; } }
    }
    nloc = mine > 0u ? mine : 1u; nx = cnt > 0u ? cnt : 1u;
}
__device__ __forceinline__ void xcd_barrier(const XcdBarrier& b) {
    asm volatile("s_waitcnt vmcnt(0)" ::: "memory");
    __syncthreads();
    if (threadIdx.x == 0) {
        unsigned* bar = b.bar;
        __builtin_amdgcn_s_waitcnt(0);
        unsigned nloc = b.st[0], nx = b.st[1];
        if (nloc == 0u) { xcd_barrier_complete(bar, b.x, nloc, nx); b.st[0] = nloc; b.st[1] = nx; }
        const unsigned old = xb_add(&bar[XB_XSUB(b.x)], 1u);
        const unsigned gen = old / nloc;
        if (old + 1u == (gen + 1u) * nloc) {
            __builtin_amdgcn_fence(__ATOMIC_RELEASE, "agent");
            asm volatile("s_waitcnt vmcnt(0)" ::: "memory");
            const unsigned og = xb_add(&bar[XB_TOP], 1u);
            const unsigned tg = og / nx;
            if (og + 1u == (tg + 1u) * nx) xb_add(&bar[XB_TOPGEN], 1u);
            else XB_SPIN(xb_ld(&bar[XB_TOPGEN]) == tg, bar);
            __builtin_amdgcn_fence(__ATOMIC_ACQUIRE, "agent");
            xb_add(&bar[XB_XGEN(b.x)], 1u);
            asm volatile("s_waitcnt vmcnt(0)" ::: "memory");
        } else {
            XB_SPIN(xb_ld(&bar[XB_XGEN(b.x)]) == gen, bar);
            __builtin_amdgcn_fence(__ATOMIC_ACQUIRE, "agent");
            asm volatile("s_waitcnt vmcnt(0)" ::: "memory");
        }
    }
    __syncthreads();
}

namespace pg8 {
constexpr int BM = 256, BK = 64, HALF = 128, HTB = HALF * BK * 2, NXCD = 8, WGM = 8;
__host__ __device__ __forceinline__ int lds_byte(int r, int c) { const int st = (r >> 4) * 2 + (c >> 5), rr = r & 15, cc = c & 31, ob = rr * 64 + cc * 2; return st * 1024 + (ob ^ (((ob >> 9) & 1) << 5)); }
__host__ __device__ __forceinline__ void stage_rc(int b, int& R, int& C) { const int st = b / 1024, sb = b % 1024, swz = sb ^ (((sb >> 9) & 1) << 5); R = (st >> 1) * 16 + swz / 64; C = (st & 1) * 32 + (swz % 64) / 2; }
__host__ __device__ __forceinline__ int perm32(int rho) { const int n = rho >> 4, i = rho & 15; return 8 * (i >> 2) + 4 * n + (i & 3); }

struct Unit { int pm, pn; };
struct Gemm { const bf16_t* A; const bf16_t* Bt; int K; };

struct StaticOrder {
    int nM, nN, nwg, G, c;
    __device__ void init(int nM_, int nN_, int G_, int c_) { nM = nM_; nN = nN_; nwg = nM * nN; G = G_; c = c_; }
    __device__ bool next(int i, Unit& u) const {
        const long L = (long)i * G + c; if (L >= nwg) return false;
        int wgid = (int)L; { const int q = nwg / NXCD, r = nwg % NXCD, xcd = wgid % NXCD, off = wgid / NXCD; wgid = (xcd < r ? xcd * (q + 1) : r * (q + 1) + (xcd - r) * q) + off; }
        const int nig = WGM * nN, gid = wgid / nig, fm = gid * WGM, gsz = (nM - fm) < WGM ? (nM - fm) : WGM;
        u.pm = fm + ((wgid % nig) % gsz); u.pn = (wgid % nig) / gsz; return true;
    }
};

struct AInfo { const char* base; size_t hstep; unsigned v0, v1; };
template <bool UPMAP>
__device__ __forceinline__ AInfo a_info(const Gemm& g, const Unit& u, int tid) {
    AInfo a; const int K = g.K;
    int R0, C0, R1, C1; stage_rc(tid * 16, R0, C0); stage_rc(tid * 16 + 8192, R1, C1);
    if constexpr (!UPMAP) {
        a.base = (const char*)g.A + (size_t)u.pm * 256 * K * 2; a.hstep = (size_t)HALF * K * 2;
        a.v0 = (unsigned)(R0 * K + C0) * 2u; a.v1 = (unsigned)(R1 * K + C1) * 2u;
    } else {
        if (u.pm < 68) {
            const int b = u.pm / 17, j = u.pm % 17;
            a.base = (const char*)g.A + (size_t)(4098 * b + 248 * j) * K * 2; a.hstep = (size_t)124 * K * 2;
            a.v0 = (unsigned)((R0 - 2 * (R0 >> 6)) * K + C0) * 2u; a.v1 = (unsigned)((R1 - 2 * (R1 >> 6)) * K + C1) * 2u;
        } else {
            a.base = (const char*)g.A + (size_t)16394 * K * 2; a.hstep = (size_t)HALF * K * 2;
            a.v0 = (unsigned)(R0 * K + C0) * 2u; a.v1 = (unsigned)(R1 * K + C1) * 2u;
        }
    }
    return a;
}

template <class Epi, bool UPMAP>
__device__ __forceinline__ void gemm_phase(LAS unsigned char* lds, const Gemm g, const StaticOrder& S, const Epi& E) {
    const int tid = threadIdx.x, wid = __builtin_amdgcn_readfirstlane(tid >> 6), lane = tid & 63, wr = wid >> 2, wc = wid & 3, fr = lane & 15, fq = lane >> 4;
    const int K = g.K, nt = K / BK;
    unsigned voffB[2];
#pragma unroll
    for (int i = 0; i < 2; ++i) { int R, C; stage_rc(tid * 16 + i * 8192, R, C); const int Rb = (R & ~31) + perm32(R & 31); voffB[i] = (unsigned)(Rb * K + C) * 2u; }
    const size_t kstep = (size_t)(BK * 2);
    const size_t hstepB = (size_t)HALF * K * 2;
    const size_t tstepB = 2 * hstepB;
    const unsigned ldsw = (unsigned)wid * 1024u;
    const int aoff = lds_byte(wr * 64 + fr, fq * 8), boff = lds_byte(wc * 32 + fr, fq * 8);
#define PG8_SA(b, h) (((b) * 2 + (h)) * HTB)
#define PG8_SB(b, h) ((4 + (b) * 2 + (h)) * HTB)
#define PG8_STAGEB(bufoff, gbase) do { _Pragma("unroll") for (int _i = 0; _i < 2; ++_i) \
        __builtin_amdgcn_global_load_lds((const unsigned*)((const char*)(gbase) + voffB[_i]), (LAS unsigned*)(lds + (bufoff) + ldsw + _i * 8192), 16, 0, 0); } while (0)
#define PG8_STAGEA(bufoff, gbase, va0, va1) do { \
        __builtin_amdgcn_global_load_lds((const unsigned*)((const char*)(gbase) + (va0)), (LAS unsigned*)(lds + (bufoff) + ldsw), 16, 0, 0); \
        __builtin_amdgcn_global_load_lds((const unsigned*)((const char*)(gbase) + (va1)), (LAS unsigned*)(lds + (bufoff) + ldsw + 8192), 16, 0, 0); } while (0)
#define PG8_LDA(dst, b, h) do { _Pragma("unroll") for (int m = 0; m < 4; ++m) _Pragma("unroll") for (int k = 0; k < 2; ++k) dst[m][k] = *(const LAS bf16x8*)(lds + PG8_SA(b, h) + aoff + m * 2048 + k * 1024); } while (0)
#define PG8_LDB(dst, b, h) do { _Pragma("unroll") for (int n = 0; n < 2; ++n) _Pragma("unroll") for (int k = 0; k < 2; ++k) dst[n][k] = *(const LAS bf16x8*)(lds + PG8_SB(b, h) + boff + n * 2048 + k * 1024); } while (0)
#define PG8_MMA(ai, bj, At, Bt) do { __builtin_amdgcn_s_setprio(1); _Pragma("unroll") for (int m = 0; m < 4; ++m) _Pragma("unroll") for (int n = 0; n < 2; ++n) _Pragma("unroll") for (int k = 0; k < 2; ++k) \
        acc[ai][bj][m][n] = __builtin_amdgcn_mfma_f32_16x16x32_bf16(Bt[n][k], At[m][k], acc[ai][bj][m][n], 0, 0, 0); __builtin_amdgcn_s_setprio(0); } while (0)
#define PG8_WAIT_V(n) asm volatile("s_waitcnt vmcnt(" #n ")" ::: "memory")
#define PG8_WAIT_L(n) asm volatile("s_waitcnt lgkmcnt(" #n ")" ::: "memory")
#define PG8_BAR __builtin_amdgcn_s_barrier()
#define PG8_SCHED __builtin_amdgcn_sched_barrier(0)
    Unit cur, nxt; int ui = 0;
    if (!S.next(0, cur)) return;
    f32x4 acc[2][2][4][2];
#pragma unroll
    for (int a = 0; a < 2; ++a)
#pragma unroll
        for (int b = 0; b < 2; ++b)
#pragma unroll
            for (int m = 0; m < 4; ++m)
#pragma unroll
                for (int n = 0; n < 2; ++n) acc[a][b][m][n] = (f32x4){0.f, 0.f, 0.f, 0.f};
    bf16x8 At[4][2], B0[2][2], B1[2][2];
    AInfo ca = a_info<UPMAP>(g, cur, tid);
    const char* cA = ca.base; const char* cB = (const char*)g.Bt + (size_t)cur.pn * tstepB;
    PG8_STAGEB(PG8_SB(0, 0), cB); PG8_STAGEB(PG8_SB(0, 1), cB + hstepB); PG8_STAGEA(PG8_SA(0, 0), cA, ca.v0, ca.v1); PG8_STAGEA(PG8_SA(0, 1), cA + ca.hstep, ca.v0, ca.v1);
    if (wr == 1) PG8_BAR;
    PG8_WAIT_V(2); PG8_BAR;
    PG8_STAGEB(PG8_SB(1, 0), cB + kstep); PG8_STAGEA(PG8_SA(1, 0), cA + kstep, ca.v0, ca.v1); PG8_STAGEB(PG8_SB(1, 1), cB + hstepB + kstep);
    PG8_WAIT_V(6); PG8_BAR;
    for (;;) {
        const bool has_next = S.next(ui + 1, nxt);
        AInfo na = ca; if (has_next) na = a_info<UPMAP>(g, nxt, tid);
        const char* nA = na.base; const char* nB = has_next ? (const char*)g.Bt + (size_t)nxt.pn * tstepB : cB;
        for (int t = 0; t < nt; t += 2) {
            const bool last = (t == nt - 2);
            const char* a1 = cA + (size_t)(t + 1) * kstep;
            const char* a2 = last ? nA : cA + (size_t)(t + 2) * kstep; const char* b2 = last ? nB : cB + (size_t)(t + 2) * kstep;
            const char* a3 = a2 + kstep; const char* b3 = b2 + kstep;
            const size_t h2 = last ? na.hstep : ca.hstep; const unsigned w0 = last ? na.v0 : ca.v0, w1 = last ? na.v1 : ca.v1;
            PG8_LDB(B0, 0, 0); PG8_LDB(B1, 0, 1); PG8_SCHED; PG8_LDA(At, 0, 0); PG8_STAGEA(PG8_SA(1, 1), a1 + ca.hstep, ca.v0, ca.v1);
            PG8_WAIT_V(8); PG8_WAIT_L(0); PG8_BAR; PG8_MMA(0, 0, At, B0); PG8_MMA(0, 1, At, B1); PG8_BAR; PG8_SCHED;
            PG8_LDA(At, 0, 1); PG8_STAGEB(PG8_SB(0, 0), b2); PG8_STAGEB(PG8_SB(0, 1), b2 + hstepB); PG8_STAGEA(PG8_SA(0, 0), a2, w0, w1);
            PG8_WAIT_V(8); PG8_WAIT_L(0); PG8_BAR; PG8_MMA(1, 0, At, B0); PG8_MMA(1, 1, At, B1); PG8_BAR; PG8_SCHED;
            PG8_LDB(B0, 1, 0); PG8_LDB(B1, 1, 1); PG8_SCHED; PG8_LDA(At, 1, 0); PG8_STAGEA(PG8_SA(0, 1), a2 + h2, w0, w1);
            PG8_WAIT_V(8); PG8_WAIT_L(0); PG8_BAR; PG8_MMA(0, 0, At, B0); PG8_MMA(0, 1, At, B1); PG8_BAR; PG8_SCHED;
            PG8_LDA(At, 1, 1); PG8_STAGEB(PG8_SB(1, 0), b3); PG8_STAGEB(PG8_SB(1, 1), b3 + hstepB); PG8_STAGEA(PG8_SA(1, 0), a3, w0, w1);
            PG8_WAIT_V(8); PG8_WAIT_L(0); PG8_BAR; PG8_MMA(1, 0, At, B0); PG8_MMA(1, 1, At, B1); PG8_BAR; PG8_SCHED;
        }
        if (wr == 0) PG8_BAR;
        E(acc, cur, wr, wc, fr, fq);
        if (!has_next) break;
#pragma unroll
        for (int a = 0; a < 2; ++a)
#pragma unroll
            for (int b = 0; b < 2; ++b)
#pragma unroll
                for (int m = 0; m < 4; ++m)
#pragma unroll
                    for (int n = 0; n < 2; ++n) acc[a][b][m][n] = (f32x4){0.f, 0.f, 0.f, 0.f};
        cur = nxt; ca = na; cA = nA; cB = nB; ++ui;
        if (wr == 1) PG8_BAR;
    }
    PG8_WAIT_V(0);
    PG8_BAR;
#undef PG8_SA
#undef PG8_SB
#undef PG8_STAGEA
#undef PG8_STAGEB
#undef PG8_LDA
#undef PG8_LDB
#undef PG8_MMA
#undef PG8_WAIT_V
#undef PG8_WAIT_L
#undef PG8_BAR
#undef PG8_SCHED
}
}
using pg8::Unit;

struct EpiIn {
    bf16_t *dQR, *dKR, *dVR, *dGR, *dHQ, *dHI, *dHGT; float* HGF; const f32x4* rope; const float* lb;
    __device__ __forceinline__ void operator()(const f32x4 (&acc)[2][2][4][2], const Unit& u, int wr, int wc, int fr_, int fq_) const {
        int fr = fr_, fq = fq_; asm volatile("" : "+v"(fr), "+v"(fq));
        const int type = u.pn >> 1;
        const int dd0 = 32 * (wc & 1) + 8 * fq;
        const int col0 = ((u.pn & 1) * 2 + (wc >> 1)) * 128 + dd0;
        const int rowb = u.pm * 256 + wr * 64 + fr;
        if (type <= 1) {
            bf16_t* D = type == 0 ? dQR : dKR;
            const float sc = type == 0 ? 1.0f : 0.08838834764831845f;
#pragma unroll
            for (int ai = 0; ai < 2; ++ai)
#pragma unroll
                for (int m = 0; m < 4; ++m) {
                    const int r = rowb + ai * 128 + m * 16;
                    const int pos = r < TP ? (r & 4095) : (1024 + (r & 15));
                    const f32x4* cs = rope + (size_t)pos * 32 + (dd0 >> 1);
                    const f32x4 c0 = cs[0], c1 = cs[1], c2 = cs[2], c3 = cs[3];
                    const f32x4 lo0 = acc[ai][0][m][0], lo1 = acc[ai][0][m][1], hi0 = acc[ai][1][m][0], hi1 = acc[ai][1][m][1];
                    float ol[8], oh[8];
                    ol[0] = lo0[0] * c0[0] - hi0[0] * c0[1]; oh[0] = lo0[0] * c0[1] + hi0[0] * c0[0];
                    ol[1] = lo0[1] * c0[2] - hi0[1] * c0[3]; oh[1] = lo0[1] * c0[3] + hi0[1] * c0[2];
                    ol[2] = lo0[2] * c1[0] - hi0[2] * c1[1]; oh[2] = lo0[2] * c1[1] + hi0[2] * c1[0];
                    ol[3] = lo0[3] * c1[2] - hi0[3] * c1[3]; oh[3] = lo0[3] * c1[3] + hi0[3] * c1[2];
                    ol[4] = lo1[0] * c2[0] - hi1[0] * c2[1]; oh[4] = lo1[0] * c2[1] + hi1[0] * c2[0];
                    ol[5] = lo1[1] * c2[2] - hi1[1] * c2[3]; oh[5] = lo1[1] * c2[3] + hi1[1] * c2[2];
                    ol[6] = lo1[2] * c3[0] - hi1[2] * c3[1]; oh[6] = lo1[2] * c3[1] + hi1[2] * c3[0];
                    ol[7] = lo1[3] * c3[2] - hi1[3] * c3[3]; oh[7] = lo1[3] * c3[3] + hi1[3] * c3[2];
                    u32x4 wl, wh;
                    wl.x = cvt_pk_bf16(ol[0] * sc, ol[1] * sc); wl.y = cvt_pk_bf16(ol[2] * sc, ol[3] * sc); wl.z = cvt_pk_bf16(ol[4] * sc, ol[5] * sc); wl.w = cvt_pk_bf16(ol[6] * sc, ol[7] * sc);
                    wh.x = cvt_pk_bf16(oh[0] * sc, oh[1] * sc); wh.y = cvt_pk_bf16(oh[2] * sc, oh[3] * sc); wh.z = cvt_pk_bf16(oh[4] * sc, oh[5] * sc); wh.w = cvt_pk_bf16(oh[6] * sc, oh[7] * sc);
                    bf16_t* rp = D + (size_t)r * HW + col0;
                    *(u32x4*)rp = wl; *(u32x4*)(rp + 64) = wh;
                }
        } else if (type == 5) {
            f32x4 lbv[2][2];
#pragma unroll
            for (int bj = 0; bj < 2; ++bj)
#pragma unroll
                for (int n = 0; n < 2; ++n) lbv[bj][n] = *(const f32x4*)(lb + col0 + 64 * bj + 4 * n);
#pragma unroll
            for (int ai = 0; ai < 2; ++ai)
#pragma unroll
                for (int m = 0; m < 4; ++m) {
                    const int r = rowb + ai * 128 + m * 16;
                    float* rp = HGF + (size_t)r * HW + col0;
#pragma unroll
                    for (int bj = 0; bj < 2; ++bj)
#pragma unroll
                        for (int n = 0; n < 2; ++n) {
                            const f32x4 v = acc[ai][bj][m][n]; const f32x4 l = lbv[bj][n]; f32x4 o;
#pragma unroll
                            for (int j = 0; j < 4; ++j) { const float sg = 1.0f / (1.0f + __expf(-v[j])); o[j] = __logf(l[j] + (1.0f - l[j]) * sg); }
                            *(f32x4*)(rp + 64 * bj + 4 * n) = o;
                        }
                }
        } else {
            bf16_t* D = type == 2 ? dVR : type == 3 ? dGR : type == 4 ? dHQ : type == 6 ? dHI : dHGT;
            const bool act = (type == 3) || (type == 7);
#pragma unroll
            for (int ai = 0; ai < 2; ++ai)
#pragma unroll
                for (int m = 0; m < 4; ++m) {
                    const int r = rowb + ai * 128 + m * 16;
                    bf16_t* rp = D + (size_t)r * HW + col0;
#pragma unroll
                    for (int bj = 0; bj < 2; ++bj) {
                        f32x4 v0 = acc[ai][bj][m][0], v1 = acc[ai][bj][m][1];
                        if (act) {
#pragma unroll
                            for (int j = 0; j < 4; ++j) { v0[j] = silu_f(v0[j]); v1[j] = silu_f(v1[j]); }
                        }
                        u32x4 w; w.x = cvt_pk_bf16(v0[0], v0[1]); w.y = cvt_pk_bf16(v0[2], v0[3]); w.z = cvt_pk_bf16(v1[0], v1[1]); w.w = cvt_pk_bf16(v1[2], v1[3]);
                        *(u32x4*)(rp + 64 * bj) = w;
                    }
                }
        }
    }
};

struct EpiOut {
    const float* xp; const float* xs; float* X1F; bf16_t* X1B; float* SS2;
    __device__ __forceinline__ void operator()(const f32x4 (&acc)[2][2][4][2], const Unit& u, int wr, int wc, int fr_, int fq_) const {
        int fr = fr_, fq = fq_; asm volatile("" : "+v"(fr), "+v"(fq));
        const int col0 = u.pn * 256 + wc * 32 + 8 * fq;
#pragma unroll
        for (int ai = 0; ai < 2; ++ai)
#pragma unroll
            for (int m = 0; m < 4; ++m) {
                const int r = u.pm * 256 + ai * 128 + wr * 64 + m * 16 + fr;
                const float* xr = (r < TP ? xp + (size_t)r * DM : xs + (size_t)(r - TP) * DM) + col0;
                const int rb = r < TP ? (4098 * (r >> 12) + 2 + (r & 4095)) : (16394 + (r - TP));
                float* o32 = X1F + (size_t)r * DM + col0; bf16_t* o16 = X1B + (size_t)rb * DM + col0;
                float ss = 0.f;
#pragma unroll
                for (int bj = 0; bj < 2; ++bj) {
                    const f32x4 x0 = *(const f32x4*)(xr + 128 * bj), x1 = *(const f32x4*)(xr + 128 * bj + 4);
                    const f32x4 v0 = acc[ai][bj][m][0] + x0, v1 = acc[ai][bj][m][1] + x1;
                    *(f32x4*)(o32 + 128 * bj) = v0; *(f32x4*)(o32 + 128 * bj + 4) = v1;
                    u32x4 w; w.x = cvt_pk_bf16(v0[0], v0[1]); w.y = cvt_pk_bf16(v0[2], v0[3]); w.z = cvt_pk_bf16(v1[0], v1[1]); w.w = cvt_pk_bf16(v1[2], v1[3]);
                    *(u32x4*)(o16 + 128 * bj) = w;
                    ss += (v0[0] * v0[0] + v0[1] * v0[1]) + (v0[2] * v0[2] + v0[3] * v0[3]) + (v1[0] * v1[0] + v1[1] * v1[1]) + (v1[2] * v1[2] + v1[3] * v1[3]);
                }
                ss += __shfl_xor(ss, 16); ss += __shfl_xor(ss, 32);
                if (fq == 0) SS2[(size_t)r * 16 + u.pn * 4 + wc] = ss;
            }
    }
};

struct EpiUp {
    const float* SS2; const float* ck; const float* cb; const float* cache_in; bf16_t* ACT; float* ccp; float* ccs;
    __device__ __forceinline__ void operator()(f32x4 (&acc)[2][2][4][2], const Unit& u, int wr, int wc, int fr_, int fq_) const {
        int fr = fr_, fq = fq_; asm volatile("" : "+v"(fr), "+v"(fq));
        const int lane = fq * 16 + fr;
        const int f0 = u.pn * 128 + wc * 32 + 8 * fq;
        const bool samp = (u.pm == 68);
        const int sb = samp ? 0 : u.pm / 17, sj = samp ? 0 : u.pm % 17;
        f32x4 k0[2], k1[2], k2[2], bb[2];
#pragma unroll
        for (int n = 0; n < 2; ++n) { k0[n] = *(const f32x4*)(ck + f0 + 4 * n); k1[n] = *(const f32x4*)(ck + DFF + f0 + 4 * n); k2[n] = *(const f32x4*)(ck + 2 * DFF + f0 + 4 * n); bb[n] = *(const f32x4*)(cb + f0 + 4 * n); }
        const int src1 = (lane & 48) | ((fr + 15) & 15), src2 = (lane & 48) | ((fr + 14) & 15);
#pragma unroll
        for (int ai = 0; ai < 2; ++ai) {
            f32x4 prev[2] = {(f32x4){0.f, 0.f, 0.f, 0.f}, (f32x4){0.f, 0.f, 0.f, 0.f}};
#pragma unroll
            for (int m = 0; m < 4; ++m) {
                int gr; bool valid; int t = 0;
                if (samp) { gr = TP + ai * 128 + wr * 64 + m * 16 + fr; valid = true; }
                else { t = 248 * sj + 62 * (2 * ai + wr) + 16 * m + fr - 2; gr = sb * SEQ + t; valid = (t >= 0) && (t < SEQ); }
                float ssq = 0.f;
                if (valid) { const f32x4 p = *(const f32x4*)(SS2 + (size_t)gr * 16 + 4 * fq); ssq = (p[0] + p[1]) + (p[2] + p[3]); }
                ssq += __shfl_xor(ssq, 16); ssq += __shfl_xor(ssq, 32);
                const float rs = valid ? __frsqrt_rn(ssq * (1.0f / DM) + EPS) : 0.f;
                f32x4 a[2], b[2];
#pragma unroll
                for (int n = 0; n < 2; ++n) { a[n] = acc[ai][0][m][n] * rs; b[n] = acc[ai][1][m][n] * rs; }
                if (samp) {
                    const int s = ai * 8 + wr * 4 + m;
                    if (fr >= 14) {
#pragma unroll
                        for (int n = 0; n < 2; ++n) prev[n] = *(const f32x4*)(cache_in + ((size_t)s * 2 + (fr - 14)) * DFF + f0 + 4 * n);
                    }
                }
                f32x4 o[2];
#pragma unroll
                for (int n = 0; n < 2; ++n)
#pragma unroll
                    for (int j = 0; j < 4; ++j) {
                        const float v1 = (fr == 15) ? prev[n][j] : a[n][j];
                        const float v2 = (fr >= 14) ? prev[n][j] : a[n][j];
                        const float s1 = __shfl(v1, src1), s2 = __shfl(v2, src2);
                        const float cv = bb[n][j] + k0[n][j] * s2 + k1[n][j] * s1 + k2[n][j] * a[n][j];
                        o[n][j] = silu_f(cv) * b[n][j];
                    }
                const bool store = samp ? true : (valid && (16 * m + fr >= 2));
                if (store) {
                    u32x4 w; w.x = cvt_pk_bf16(o[0][0], o[0][1]); w.y = cvt_pk_bf16(o[0][2], o[0][3]); w.z = cvt_pk_bf16(o[1][0], o[1][1]); w.w = cvt_pk_bf16(o[1][2], o[1][3]);
                    *(u32x4*)(ACT + (size_t)gr * DFF + f0) = w;
                    if (samp) { if (fr >= 14) { float* cp = ccs + ((size_t)(ai * 8 + wr * 4 + m) * 2 + (fr - 14)) * DFF + f0; *(f32x4*)cp = a[0]; *(f32x4*)(cp + 4) = a[1]; } }
                    else if (t >= SEQ - 2) { float* cp = ccp + ((size_t)sb * 2 + (t - (SEQ - 2))) * DFF + f0; *(f32x4*)cp = a[0]; *(f32x4*)(cp + 4) = a[1]; }
                }
                prev[0] = a[0]; prev[1] = a[1];
            }
        }
    }
};

struct EpiDown {
    float* X; float* SS3;
    __device__ __forceinline__ void operator()(const f32x4 (&acc)[2][2][4][2], const Unit& u, int wr, int wc, int fr_, int fq_) const {
        int fr = fr_, fq = fq_; asm volatile("" : "+v"(fr), "+v"(fq));
        const int col0 = u.pn * 256 + wc * 32 + 8 * fq;
#pragma unroll
        for (int ai = 0; ai < 2; ++ai)
#pragma unroll
            for (int m = 0; m < 4; ++m) {
                const int r = u.pm * 256 + ai * 128 + wr * 64 + m * 16 + fr;
                float* xr = X + (size_t)r * DM + col0;
                float ss = 0.f;
#pragma unroll
                for (int bj = 0; bj < 2; ++bj) {
                    const f32x4 x0 = *(const f32x4*)(xr + 128 * bj), x1 = *(const f32x4*)(xr + 128 * bj + 4);
                    const f32x4 v0 = acc[ai][bj][m][0] + x0, v1 = acc[ai][bj][m][1] + x1;
                    *(f32x4*)(xr + 128 * bj) = v0; *(f32x4*)(xr + 128 * bj + 4) = v1;
                    ss += (v0[0] * v0[0] + v0[1] * v0[1]) + (v0[2] * v0[2] + v0[3] * v0[3]) + (v1[0] * v1[0] + v1[1] * v1[1]) + (v1[2] * v1[2] + v1[3] * v1[3]);
                }
                ss += __shfl_xor(ss, 16); ss += __shfl_xor(ss, 32);
                if (fq == 0) SS3[(size_t)r * 16 + u.pn * 4 + wc] = ss;
            }
    }
};

struct Args { const float* in[17]; float* out; unsigned char* ws; int ph_lo, ph_hi; };

__device__ __forceinline__ float wave_sum(float v) {
#pragma unroll
    for (int o = 1; o < 64; o <<= 1) v += __shfl_xor(v, o);
    return v;
}

__device__ __forceinline__ void transpose_item(const float* W, int K, int N, bf16_t* WT, const float* gain, LAS float* scr, int k0, int p0, int s0, int lane) {
#pragma unroll 8
    for (int i = 0; i < 32; ++i) { const int kk = 2 * i + (lane >> 5); const float gsc = gain ? gain[k0 + kk] : 1.0f; scr[kk * 33 + (lane & 31)] = W[(size_t)(k0 + kk) * N + s0 + (lane & 31)] * gsc; }
    asm volatile("s_waitcnt lgkmcnt(0)" ::: "memory");
    const int c = lane & 7;
#pragma unroll
    for (int j = 0; j < 4; ++j) { const int n = (lane >> 3) + 8 * j; const LAS float* s = scr + (8 * c) * 33 + n;
        u32x4 o; o.x = cvt_pk_bf16(s[0 * 33], s[1 * 33]); o.y = cvt_pk_bf16(s[2 * 33], s[3 * 33]); o.z = cvt_pk_bf16(s[4 * 33], s[5 * 33]); o.w = cvt_pk_bf16(s[6 * 33], s[7 * 33]);
        *(u32x4*)(WT + (size_t)(p0 + n) * K + k0 + 8 * c) = o; }
    asm volatile("s_waitcnt lgkmcnt(0)" ::: "memory");
}
__device__ __forceinline__ int colmap_in(int p) {
    const int type = p >> 9, pl = p & 511, pn1 = pl >> 8, plc = pl & 255, bj = plc >> 7, q = plc & 127, hl = q >> 6, dd = q & 63;
    return type * 512 + (pn1 * 2 + hl) * 128 + bj * 64 + dd;
}
__device__ __forceinline__ int colmap_up(int p) { const int pn = p >> 8, pl = p & 255, bj = pl >> 7, q = pl & 127; return bj * DFF + 128 * pn + q; }

__device__ __forceinline__ void phase_prep(const Args& A, LAS unsigned char* lds, int wave, int lane) {
    unsigned char* ws = A.ws;
    const int G = gridDim.x, gw = blockIdx.x * NWAVES + wave, NGW = G * NWAVES;
    LAS float* scr = (LAS float*)(lds + wave * 8704);
    bf16_t* WinT = (bf16_t*)(ws + WS_WIN); bf16_t* WoutT = (bf16_t*)(ws + WS_WOUT); bf16_t* WupT = (bf16_t*)(ws + WS_WUP); bf16_t* WdT = (bf16_t*)(ws + WS_WD);
    constexpr int I_IN = 16 * 128, I_OUT = 16 * 32, I_UP = 16 * 176, I_DN = 44 * 32, NITEMS = I_IN + I_OUT + I_UP + I_DN;
    for (int it = gw; it < NITEMS; it += NGW) {
        int r = it;
        if (r < I_IN) { const int kb = r / 128, pb = r % 128; transpose_item(A.in[5], DM, INC, WinT, A.in[10], scr, 64 * kb, 32 * pb, colmap_in(32 * pb), lane); continue; } r -= I_IN;
        if (r < I_OUT) { const int kb = r / 32, pb = r % 32; transpose_item(A.in[9], DM, DM, WoutT, nullptr, scr, 64 * kb, 32 * pb, 32 * pb, lane); continue; } r -= I_OUT;
        if (r < I_UP) { const int kb = r / 176, pb = r % 176; transpose_item(A.in[12], DM, UPC, WupT, A.in[11], scr, 64 * kb, 32 * pb, colmap_up(32 * pb), lane); continue; } r -= I_UP;
        { const int kb = r / 32, pb = r % 32; transpose_item(A.in[15], DFF, DM, WdT, nullptr, scr, 64 * kb, 32 * pb, 32 * pb, lane); }
    }
    bf16_t* XB = (bf16_t*)(ws + WS_XB);
    for (int m = gw; m < TT; m += NGW) {
        const float* xrow = m < TP ? A.in[0] + (size_t)m * DM : A.in[1] + (size_t)(m - TP) * DM;
        const f32x4* xr = (const f32x4*)xrow + lane;
        f32x4 v[4]; float s = 0.f;
#pragma unroll
        for (int j = 0; j < 4; ++j) { v[j] = xr[64 * j]; s += (v[j][0] * v[j][0] + v[j][1] * v[j][1]) + (v[j][2] * v[j][2] + v[j][3] * v[j][3]); }
        const float rs = 1.0f / sqrtf(wave_sum(s) * (1.0f / DM) + EPS);
        u32x2* o8 = (u32x2*)(XB + (size_t)m * DM) + lane;
#pragma unroll
        for (int j = 0; j < 4; ++j) { u32x2 w; w.x = cvt_pk_bf16(v[j][0] * rs, v[j][1] * rs); w.y = cvt_pk_bf16(v[j][2] * rs, v[j][3] * rs); o8[64 * j] = w; }
    }
    f32x2* rope = (f32x2*)(ws + WS_ROPE);
    const int gt = blockIdx.x * NTHREADS + threadIdx.x, NGT = G * NTHREADS;
    for (int i = gt; i < SEQ * 64; i += NGT) {
        const int pos = i >> 6, d = i & 63;
        const float inv = 1.0f / powf(10000.0f, (float)d * (1.0f / 64.0f));
        const float ang = (float)pos * inv;
        float sn, cs; sn = sinf(ang); cs = cosf(ang);
        rope[i] = (f32x2){cs, sn};
    }
    if (gt < HW) { const float l0 = A.in[8][gt], l1 = A.in[8][HW + gt]; ((float*)(ws + WS_LB))[gt] = 1.0f / (1.0f + __expf(l1 - l0)); }
    bf16_t* X1B = (bf16_t*)(ws + WS_X1B); (void)X1B;
}

template <bool HG>
__device__ __forceinline__ void mixer_item(const bf16_t* Q, const bf16_t* Kx, const float* Gf, const bf16_t* V, float* O, int row0, int nsteps, int head, int dv0,
                                           const float* state_in, float* state_out, float gamma) {
    const int tid = threadIdx.x, part = tid & 15, dv = dv0 + (tid >> 4);
    float S[8];
#pragma unroll
    for (int i = 0; i < 8; ++i) S[i] = state_in ? state_in[(size_t)(part * 8 + i) * 128 + dv] : 0.f;
    const int ck = head * 128 + part * 8, cv = head * 128 + dv;
    constexpr int U = 4;
    for (int t0 = 0; t0 < nsteps; t0 += U) {
        u32x4 q8[U]; u32x4 k8[U]; f32x4 g0[U], g1[U]; unsigned short vv[U];
#pragma unroll
        for (int u = 0; u < U; ++u) {
            const size_t r = (size_t)(row0 + t0 + u) * HW;
            q8[u] = *(const u32x4*)(Q + r + ck);
            if (HG) { g0[u] = *(const f32x4*)(Gf + r + ck); g1[u] = *(const f32x4*)(Gf + r + ck + 4); } else k8[u] = *(const u32x4*)(Kx + r + ck);
            vv[u] = V[r + cv];
        }
#pragma unroll
        for (int u = 0; u < U; ++u) {
            const float v = bf2f(vv[u]);
            float qf[8], kf[8], df[8];
            const unsigned qa[4] = {q8[u].x, q8[u].y, q8[u].z, q8[u].w};
#pragma unroll
            for (int i = 0; i < 4; ++i) { qf[2 * i] = __uint_as_float(qa[i] << 16); qf[2 * i + 1] = __uint_as_float(qa[i] & 0xffff0000u); }
            if (HG) {
#pragma unroll
                for (int i = 0; i < 4; ++i) { df[i] = __expf(g0[u][i]); df[4 + i] = __expf(g1[u][i]); }
#pragma unroll
                for (int i = 0; i < 8; ++i) kf[i] = 1.0f - df[i];
            } else {
                const unsigned ka[4] = {k8[u].x, k8[u].y, k8[u].z, k8[u].w};
#pragma unroll
                for (int i = 0; i < 4; ++i) { kf[2 * i] = __uint_as_float(ka[i] << 16); kf[2 * i + 1] = __uint_as_float(ka[i] & 0xffff0000u); }
#pragma unroll
                for (int i = 0; i < 8; ++i) df[i] = gamma;
            }
            float p = 0.f;
#pragma unroll
            for (int i = 0; i < 8; ++i) { S[i] = df[i] * S[i] + kf[i] * v; p += qf[i] * S[i]; }
            p += __shfl_xor(p, 1); p += __shfl_xor(p, 2); p += __shfl_xor(p, 4); p += __shfl_xor(p, 8);
            if (part == 0) O[(size_t)(row0 + t0 + u) * DM + (HG ? HW : 0) + cv] = p;
        }
    }
#pragma unroll
    for (int i = 0; i < 8; ++i) state_out[(size_t)(part * 8 + i) * 128 + dv] = S[i];
}
__device__ __forceinline__ void phase_mixer(const Args& A) {
    unsigned char* ws = A.ws;
    const bf16_t* QR = (const bf16_t*)(ws + WS_QR); const bf16_t* KR = (const bf16_t*)(ws + WS_KR); const bf16_t* VR = (const bf16_t*)(ws + WS_VR);
    const bf16_t* HQ = (const bf16_t*)(ws + WS_HQ); const bf16_t* HI = (const bf16_t*)(ws + WS_HI); const float* HGF = (const float*)(ws + WS_HGF);
    float* O = A.out + O_Y;
    const int G = gridDim.x;
    for (int it = blockIdx.x; it < 128 + 512; it += G) {
        const bool longit = it < 128; const int id = longit ? it : it - 128;
        int mixer, seq, head, slice, row0, nsteps; const float* sin_; float* sout;
        if (longit) { mixer = id >> 6; seq = (id >> 4) & 3; head = (id >> 2) & 3; slice = id & 3; row0 = seq * SEQ; nsteps = SEQ; sin_ = nullptr;
            sout = A.out + (mixer ? O_HGP : O_RETP) + (size_t)(seq * 4 + head) * 16384; }
        else { mixer = id >> 8; seq = (id >> 4) & 15; head = (id >> 2) & 3; slice = id & 3; row0 = TP + seq * 16; nsteps = 16; sin_ = A.in[mixer ? 3 : 2] + (size_t)(seq * 4 + head) * 16384;
            sout = A.out + (mixer ? O_HGS : O_RETS) + (size_t)(seq * 4 + head) * 16384; }
        const float gamma = 1.0f - exp2f(-5.0f - (float)head);
        if (mixer) mixer_item<true>(HQ, nullptr, HGF, HI, O, row0, nsteps, head, slice * 32, sin_, sout, gamma);
        else mixer_item<false>(QR, KR, nullptr, VR, O, row0, nsteps, head, slice * 32, sin_, sout, gamma);
    }
}
__device__ __forceinline__ void phase_normgate(const Args& A, int wave, int lane) {
    unsigned char* ws = A.ws;
    const float* O = A.out + O_Y;
    const bf16_t* GR = (const bf16_t*)(ws + WS_GR); const bf16_t* HGT = (const bf16_t*)(ws + WS_HGT);
    bf16_t* MG = (bf16_t*)(ws + WS_XB);
    const int gw = blockIdx.x * NWAVES + wave, NGW = gridDim.x * NWAVES;
    const bool hg = lane >= 32; const int c0 = lane * 16;
    const float* gain = hg ? A.in[7] + (c0 - HW) : A.in[6] + c0;
    f32x4 gn[4];
#pragma unroll
    for (int j = 0; j < 4; ++j) gn[j] = *(const f32x4*)(gain + 4 * j);
    for (int m = gw; m < TT; m += NGW) {
        const f32x4* orow = (const f32x4*)(O + (size_t)m * DM + c0);
        f32x4 v[4]; float s = 0.f;
#pragma unroll
        for (int j = 0; j < 4; ++j) { v[j] = orow[j]; s += (v[j][0] * v[j][0] + v[j][1] * v[j][1]) + (v[j][2] * v[j][2] + v[j][3] * v[j][3]); }
        s += __shfl_xor(s, 1); s += __shfl_xor(s, 2); s += __shfl_xor(s, 4);
        float s2 = s; s2 += __shfl_xor(s2, 8); s2 += __shfl_xor(s2, 16);
        const float rs = hg ? 1.0f / sqrtf(s2 * (1.0f / 512.0f) + EPS) : 1.0f / sqrtf(s * (1.0f / 128.0f) + EPS);
        const bf16_t* gp = (hg ? HGT + (size_t)m * HW + (c0 - HW) : GR + (size_t)m * HW + c0);
        const u32x4 ga = *(const u32x4*)gp, gb = *(const u32x4*)(gp + 8);
        const unsigned gw_[8] = {ga.x, ga.y, ga.z, ga.w, gb.x, gb.y, gb.z, gb.w};
        float o[16];
#pragma unroll
        for (int i = 0; i < 8; ++i) { const float g0 = __uint_as_float(gw_[i] << 16), g1 = __uint_as_float(gw_[i] & 0xffff0000u);
            o[2 * i] = v[(2 * i) >> 2][(2 * i) & 3] * rs * gn[(2 * i) >> 2][(2 * i) & 3] * g0; o[2 * i + 1] = v[(2 * i + 1) >> 2][(2 * i + 1) & 3] * rs * gn[(2 * i + 1) >> 2][(2 * i + 1) & 3] * g1; }
        u32x4 w0, w1;
        w0.x = cvt_pk_bf16(o[0], o[1]); w0.y = cvt_pk_bf16(o[2], o[3]); w0.z = cvt_pk_bf16(o[4], o[5]); w0.w = cvt_pk_bf16(o[6], o[7]);
        w1.x = cvt_pk_bf16(o[8], o[9]); w1.y = cvt_pk_bf16(o[10], o[11]); w1.z = cvt_pk_bf16(o[12], o[13]); w1.w = cvt_pk_bf16(o[14], o[15]);
        bf16_t* mp = MG + (size_t)m * DM + c0;
        *(u32x4*)mp = w0; *(u32x4*)(mp + 8) = w1;
    }
}
__device__ __forceinline__ void phase_final(const Args& A, int wave, int lane) {
    const float* SS3 = (const float*)(A.ws + WS_SS3);
    const int gw = blockIdx.x * NWAVES + wave, NGW = gridDim.x * NWAVES;
    f32x4 gn[4];
#pragma unroll
    for (int j = 0; j < 4; ++j) gn[j] = ((const f32x4*)A.in[16])[lane + 64 * j];
    for (int m = gw; m < TT; m += NGW) {
        float p = lane < 16 ? SS3[(size_t)m * 16 + lane] : 0.f;
        p = wave_sum(p);
        const float rs = 1.0f / sqrtf(p * (1.0f / DM) + EPS);
        f32x4* xr = (f32x4*)(A.out + O_Y + (size_t)m * DM) + lane;
#pragma unroll
        for (int j = 0; j < 4; ++j) { f32x4 v = xr[64 * j]; v = v * rs * gn[j]; xr[64 * j] = v; }
    }
}

__global__ void __launch_bounds__(NTHREADS, 2) fwd_kernel(Args args) {
    extern __shared__ __attribute__((aligned(16))) unsigned char lds_raw[];
    LAS unsigned char* lds = (LAS unsigned char*)lds_raw;
    const int tid = threadIdx.x, lane = tid & 63, wave = __builtin_amdgcn_readfirstlane(tid >> 6);
    volatile LAS unsigned* MISC = (volatile LAS unsigned*)(lds + MISC_OFF);
    if (tid < 64) MISC[tid] = 0u;
    __syncthreads();
    unsigned char* ws = args.ws;
    XcdBarrier bar; bar.bar = (unsigned*)(ws + WS_CTL); bar.x = 0; bar.st = nullptr;
    if (N_LAUNCHES == 1) bar = xcd_barrier_post((unsigned*)(ws + WS_CTL), MISC + 8);
    const int lo = args.ph_lo, hi = args.ph_hi;
#define IN(k) (lo <= (k) && (k) < hi)
#define SEAM(k) do { if (IN(k) && IN((k) + 1)) xcd_barrier(bar); } while (0)
    const int G = gridDim.x, c = blockIdx.x;

    if (IN(0)) { phase_prep(args, lds, wave, lane); } SEAM(0);
    if (IN(1)) {
        pg8::Gemm g{(const bf16_t*)(ws + WS_XB), (const bf16_t*)(ws + WS_WIN), DM}; pg8::StaticOrder S; S.init(65, 16, G, c);
        EpiIn E{(bf16_t*)(ws + WS_QR), (bf16_t*)(ws + WS_KR), (bf16_t*)(ws + WS_VR), (bf16_t*)(ws + WS_GR), (bf16_t*)(ws + WS_HQ), (bf16_t*)(ws + WS_HI), (bf16_t*)(ws + WS_HGT),
                (float*)(ws + WS_HGF), (const f32x4*)(ws + WS_ROPE), (const float*)(ws + WS_LB)};
        pg8::gemm_phase<EpiIn, false>(lds, g, S, E);
    } SEAM(1);
    if (IN(2)) { phase_mixer(args); } SEAM(2);
    if (IN(3)) {
        phase_normgate(args, wave, lane);
    } SEAM(3);
    if (IN(4)) {
        { bf16_t* X1B = (bf16_t*)(ws + WS_X1B); const int gt = c * NTHREADS + tid;
          if (gt < 4 * 256) { const int b = gt >> 8, w = gt & 255; ((u32x4*)(X1B + (size_t)(4098 * b) * DM))[w] = (u32x4){0u, 0u, 0u, 0u}; } }
        pg8::Gemm g{(const bf16_t*)(ws + WS_XB), (const bf16_t*)(ws + WS_WOUT), DM}; pg8::StaticOrder S; S.init(65, 4, G, c);
        EpiOut E{args.in[0], args.in[1], args.out + O_Y, (bf16_t*)(ws + WS_X1B), (float*)(ws + WS_SS2)};
        pg8::gemm_phase<EpiOut, false>(lds, g, S, E);
    } SEAM(4);
    if (IN(5)) {
        pg8::Gemm g{(const bf16_t*)(ws + WS_X1B), (const bf16_t*)(ws + WS_WUP), DM}; pg8::StaticOrder S; S.init(69, 22, G, c);
        EpiUp E{(const float*)(ws + WS_SS2), args.in[13], args.in[14], args.in[4], (bf16_t*)(ws + WS_ACT), args.out + O_CCP, args.out + O_CCS};
        pg8::gemm_phase<EpiUp, true>(lds, g, S, E);
    } SEAM(5);
    if (IN(6)) {
        pg8::Gemm g{(const bf16_t*)(ws + WS_ACT), (const bf16_t*)(ws + WS_WD), DFF}; pg8::StaticOrder S; S.init(65, 4, G, c);
        EpiDown E{args.out + O_Y, (float*)(ws + WS_SS3)};
        pg8::gemm_phase<EpiDown, false>(lds, g, S, E);
    } SEAM(6);
    if (IN(7)) { phase_final(args, wave, lane); }
#undef IN
#undef SEAM
}

extern "C" void kernel_launch(void* const* d_in, const int* in_sizes, int n_in, void* d_out, int out_size, void* d_ws, size_t ws_size, hipStream_t stream) {
    static int grid = 0;
    if (grid == 0) {
        if (n_in != 17 || ws_size < WS_END) { fprintf(stderr, "kernel_launch: unexpected n_in %d or ws_size %zu (need %zu)\n", n_in, ws_size, (size_t)WS_END); grid = -1; return; }
        int dev = 0, cus = 0, per_cu = 0;
        hipGetDevice(&dev); hipDeviceGetAttribute(&cus, hipDeviceAttributeMultiprocessorCount, dev);
        hipFuncSetAttribute((const void*)fwd_kernel, hipFuncAttributeMaxDynamicSharedMemorySize, LDS_BYTES);
        hipOccupancyMaxActiveBlocksPerMultiprocessor(&per_cu, (const void*)fwd_kernel, NTHREADS, LDS_BYTES);
        if (per_cu < 1) { fprintf(stderr, "kernel_launch: occupancy query says %d blocks per CU\n", per_cu); per_cu = 1; }
        (void)hipGetLastError();
        grid = cus;
        if (grid > 256) grid = 256;
        fprintf(stderr, "kernel_launch: cus %d per_cu %d grid %d ws %zu\n", cus, per_cu, grid, ws_size);
    }
    if (grid < 0) return;
    hipMemsetAsync((char*)d_ws + WS_CTL, 0, 65536, stream);
    Args a{};
    for (int i = 0; i < 17; ++i) a.in[i] = (const float*)d_in[i];
    a.out = (float*)d_out; a.ws = (unsigned char*)d_ws;
    if (N_LAUNCHES == 1) {
        a.ph_lo = 0; a.ph_hi = 8;
        void* kargs[] = {&a};
        hipError_t e = hipLaunchCooperativeKernel((const void*)fwd_kernel, dim3(grid), dim3(NTHREADS), kargs, LDS_BYTES, stream);
        if (e != hipSuccess) fprintf(stderr, "cooperative launch failed: %s (grid %d)\n", hipGetErrorString(e), grid);
    } else {
        for (int p = 0; p < 8; ++p) { a.ph_lo = p; a.ph_hi = p + 1; hipLaunchKernelGGL(fwd_kernel, dim3(grid), dim3(NTHREADS), LDS_BYTES, stream, a); }
    }
}
```

```cpp
#include <hip/hip_runtime.h>
#include <cstdio>
#include <cstdint>

#ifndef PROBE
#define PROBE 0
#endif
#ifndef N_LAUNCHES
#define N_LAUNCHES 1
#endif

#define LAS __attribute__((address_space(3)))
typedef unsigned short bf16_t;
typedef short bf16x8 __attribute__((ext_vector_type(8)));
typedef float f32x4 __attribute__((ext_vector_type(4)));
typedef float f32x2 __attribute__((ext_vector_type(2)));
typedef unsigned u32x4 __attribute__((ext_vector_type(4)));
typedef unsigned u32x2 __attribute__((ext_vector_type(2)));

constexpr int DM = 1024, TP = 16384, TS = 256, TT = TP + TS, SEQ = 4096;
constexpr int DFF = 2816, UPC = 5632, INC = 4096, HW = 512;
constexpr float EPS = 1e-6f;
constexpr int NTHREADS = 512, NWAVES = 8;
constexpr int LDS_BYTES = 163840;
constexpr int RING_BYTES = 131072;
constexpr int MISC_OFF = LDS_BYTES - 256;

constexpr size_t O_Y = 0, O_RETP = 17039360, O_HGP = 17301504, O_CCP = 17563648, O_RETS = 17586176, O_HGS = 18634752, O_CCS = 19683328;

constexpr size_t WS_CTL = 0;
constexpr size_t WS_WIN = 65536;
constexpr size_t WS_WOUT = WS_WIN + (size_t)INC * DM * 2;
constexpr size_t WS_WUP = WS_WOUT + (size_t)DM * DM * 2;
constexpr size_t WS_WD = WS_WUP + (size_t)UPC * DM * 2;
constexpr size_t WS_ROPE = WS_WD + (size_t)DM * DFF * 2;
constexpr size_t WS_LB = WS_ROPE + (size_t)SEQ * 64 * 8;
constexpr size_t WS_SS2 = WS_LB + 4096;
constexpr size_t WS_SS3 = WS_SS2 + (size_t)TT * 16 * 4;
constexpr size_t WS_XB = WS_SS3 + (size_t)TT * 16 * 4;
constexpr size_t WS_PROJ = WS_XB + (size_t)TT * DM * 2;
constexpr size_t PSZ = (size_t)TT * HW * 2;
constexpr size_t WS_QR = WS_PROJ, WS_KR = WS_PROJ + PSZ, WS_VR = WS_PROJ + 2 * PSZ, WS_GR = WS_PROJ + 3 * PSZ, WS_HQ = WS_PROJ + 4 * PSZ,
                 WS_HK = WS_PROJ + 5 * PSZ, WS_HI = WS_PROJ + 6 * PSZ, WS_HGT = WS_PROJ + 7 * PSZ;
constexpr size_t WS_DEC = WS_PROJ + 8 * PSZ;
constexpr size_t WS_HGFS = WS_DEC + (size_t)256 * HW * 4;
constexpr size_t WS_PROJ_END = WS_HGFS + (size_t)TS * HW * 4;
constexpr int X1B_ROWS = 16896;
constexpr size_t WS_X1B = WS_PROJ;
constexpr size_t WS_ACT = WS_X1B + (size_t)X1B_ROWS * DM * 2;
constexpr size_t WS_ACT_END = WS_ACT + (size_t)TT * DFF * 2;
static_assert(WS_ACT_END <= WS_PROJ_END, "overlay");
constexpr size_t WS_END = WS_PROJ_END;
static_assert(WS_END <= (size_t)256 * 1024 * 1024, "workspace");

__device__ __forceinline__ size_t kofs(int nrows, size_t row, int k) { return ((size_t)(k >> 6) * nrows + row) * 64 + (k & 63); }
__device__ __forceinline__ size_t pofs(int head, size_t row) { return ((size_t)head * TT + row) * 128; }
__device__ __forceinline__ unsigned cvt_pk_bf16(float lo, float hi) { unsigned r; asm volatile("v_cvt_pk_bf16_f32 %0, %1, %2" : "=v"(r) : "v"(lo), "v"(hi)); return r; }
__device__ __forceinline__ int fresh_lane() { int l; asm volatile("v_mbcnt_lo_u32_b32 %0, -1, 0\n\tv_mbcnt_hi_u32_b32 %0, -1, %0" : "=v"(l)); return l; }
__device__ __forceinline__ float bf2f(unsigned short b) { return __uint_as_float(((unsigned)b) << 16); }
__device__ __forceinline__ float sigmoid_f(float x) { return __builtin_amdgcn_rcpf(1.0f + __builtin_amdgcn_exp2f(x * -1.4426950408889634f)); }
__device__ __forceinline__ float silu_f(float x) { return x * sigmoid_f(x); }
#ifndef WT_STORES
#define WT_STORES 0
#endif
__device__ __forceinline__ void st16(void* p, u32x4 v) {
#if WT_STORES == 1
    asm volatile("global_store_dwordx4 %0, %1, off sc1\n\ts_nop 1" :: "v"(p), "v"(v) : "memory");
#elif WT_STORES == 2
    __builtin_nontemporal_store(v, (u32x4*)p);
#else
    *(u32x4*)p = v;
#endif
}
__device__ __forceinline__ void st8(void* p, u32x2 v) {
#if WT_STORES == 1
    asm volatile("global_store_dwordx2 %0, %1, off sc1\n\ts_nop 1" :: "v"(p), "v"(v) : "memory");
#elif WT_STORES == 2
    __builtin_nontemporal_store(v, (u32x2*)p);
#else
    *(u32x2*)p = v;
#endif
}
template <int CTRL> __device__ __forceinline__ float dpp_z(float src) {
    return __builtin_bit_cast(float, __builtin_amdgcn_update_dpp(0, __builtin_bit_cast(int, src), CTRL, 0xF, 0xF, true)); }
template <int CTRL> __device__ __forceinline__ float dpp_f(float oldv, float src) {
    return __builtin_bit_cast(float, __builtin_amdgcn_update_dpp(__builtin_bit_cast(int, oldv), __builtin_bit_cast(int, src), CTRL, 0xF, 0xF, false)); }

#define XB_TMO      128
#define XB_XCNT(j)  (256  + 64 * (j))
#define XB_XSUB(j)  (1280 + 64 * (j))
#define XB_XGEN(j)  (2304 + 64 * (j))
#define XB_TOP      3328
#define XB_TOPGEN   3392
#define XCD_BAR_WORDS 3456
#define XB_SPIN_CAP (1u << 18)
__device__ __forceinline__ unsigned xb_ld(unsigned* p)              { return __hip_atomic_load(p, __ATOMIC_RELAXED, __HIP_MEMORY_SCOPE_AGENT); }
__device__ __forceinline__ unsigned xb_add(unsigned* p, unsigned v) { return __hip_atomic_fetch_add(p, v, __ATOMIC_RELAXED, __HIP_MEMORY_SCOPE_AGENT); }
__device__ __forceinline__ unsigned xb_xcc_id() { return (unsigned)__builtin_amdgcn_s_getreg((3 << 11) | 20) & 0xFu; }
#define XB_SPIN(cond, bar) do { unsigned _sp = 0; while (cond) { __builtin_amdgcn_s_sleep(1); \
    if ((++_sp & 255u) == 0u) { if (xb_ld(&(bar)[XB_TMO])) break; if (_sp > XB_SPIN_CAP) { atomicAdd(&(bar)[XB_TMO], 1u); break; } } } } while (0)
struct XcdBarrier { unsigned* bar; unsigned x; volatile LAS unsigned* st; };
__device__ __forceinline__ XcdBarrier xcd_barrier_post(unsigned* bar, volatile LAS unsigned* st) {
    XcdBarrier b; b.bar = bar; b.x = xb_xcc_id(); b.st = st;
    if (threadIdx.x == 0) (void)xb_add(&bar[XB_XCNT(b.x)], 1u);
    return b;
}
__device__ __forceinline__ void xcd_barrier_complete(unsigned* bar, unsigned x, unsigned& nloc, unsigned& nx) {
    const unsigned G = gridDim.x * gridDim.y * gridDim.z;
    unsigned sum, cnt, mine, sp = 0u;
    for (;;) {
        sum = 0u; cnt = 0u; mine = 0u;
#pragma unroll
        for (unsigned j = 0; j < 16; ++j) { const unsigned c = xb_ld(&bar[XB_XCNT(j)]); sum += c; cnt += (c > 0u) ? 1u : 0u; mine = (j == x) ? c : mine; }
        if (sum == G) break;
        __builtin_amdgcn_s_sleep(1);
        if ((++sp & 255u) == 0u) { if (xb_ld(&bar[XB_TMO])) break; if (sp > XB_SPIN_CAP) { atomicAdd(&bar[XB_TMO], 1u); break; } }
    }
    nloc = mine > 0u ? mine : 1u; nx = cnt > 0u ? cnt : 1u;
}
__device__ __forceinline__ void xcd_barrier(const XcdBarrier& b) {
    asm volatile("s_waitcnt vmcnt(0)" ::: "memory");
    __syncthreads();
    if (threadIdx.x == 0) {
        unsigned* bar = b.bar;
        __builtin_amdgcn_s_waitcnt(0);
        unsigned nloc = b.st[0], nx = b.st[1];
        if (nloc == 0u) { xcd_barrier_complete(bar, b.x, nloc, nx); b.st[0] = nloc; b.st[1] = nx; }
        const unsigned old = xb_add(&bar[XB_XSUB(b.x)], 1u);
        const unsigned gen = old / nloc;
        if (old + 1u == (gen + 1u) * nloc) {
            __builtin_amdgcn_fence(__ATOMIC_RELEASE, "agent");
            asm volatile("s_waitcnt vmcnt(0)" ::: "memory");
            const unsigned og = xb_add(&bar[XB_TOP], 1u);
            const unsigned tg = og / nx;
            if (og + 1u == (tg + 1u) * nx) xb_add(&bar[XB_TOPGEN], 1u);
            else XB_SPIN(xb_ld(&bar[XB_TOPGEN]) == tg, bar);
            __builtin_amdgcn_fence(__ATOMIC_ACQUIRE, "agent");
            xb_add(&bar[XB_XGEN(b.x)], 1u);
            asm volatile("s_waitcnt vmcnt(0)" ::: "memory");
        } else {
            XB_SPIN(xb_ld(&bar[XB_XGEN(b.x)]) == gen, bar);
            __builtin_amdgcn_fence(__ATOMIC_ACQUIRE, "agent");
            asm volatile("s_waitcnt vmcnt(0)" ::: "memory");
        }
    }
    __syncthreads();
}

namespace pg8 {
constexpr int BM = 256, BK = 64, HALF = 128, HTB = HALF * BK * 2, NXCD = 8, WGM = 8;
__host__ __device__ __forceinline__ int lds_byte(int r, int c) { const int st = (r >> 4) * 2 + (c >> 5), rr = r & 15, cc = c & 31, ob = rr * 64 + cc * 2; return st * 1024 + (ob ^ (((ob >> 9) & 1) << 5)); }
__host__ __device__ __forceinline__ void stage_rc(int b, int& R, int& C) { const int st = b / 1024, sb = b % 1024, swz = sb ^ (((sb >> 9) & 1) << 5); R = (st >> 1) * 16 + swz / 64; C = (st & 1) * 32 + (swz % 64) / 2; }
__host__ __device__ __forceinline__ int perm32(int rho) { const int n = rho >> 4, i = rho & 15; return 8 * (i >> 2) + 4 * n + (i & 3); }

struct Unit { int pm, pn; };
struct Gemm { const bf16_t* A; const bf16_t* Bt; int K; int nrowsA; };

struct StaticOrder {
    int nM, nN, nwg, G, c;
    __device__ void init(int nM_, int nN_, int G_, int c_) { nM = nM_; nN = nN_; nwg = nM * nN; G = G_; c = c_; }
    __device__ bool next(int i, Unit& u) const {
        const long L = (long)i * G + c; if (L >= nwg) return false;
        int wgid = (int)L; { const int q = nwg / NXCD, r = nwg % NXCD, xcd = wgid % NXCD, off = wgid / NXCD; wgid = (xcd < r ? xcd * (q + 1) : r * (q + 1) + (xcd - r) * q) + off; }
        const int nig = WGM * nN, gid = wgid / nig, fm = gid * WGM, gsz = (nM - fm) < WGM ? (nM - fm) : WGM;
        u.pm = fm + ((wgid % nig) % gsz); u.pn = (wgid % nig) / gsz; return true;
    }
};

struct AInfo { const char* base; size_t hstep; unsigned v0, v1; };
template <bool UPMAP>
__device__ __forceinline__ AInfo a_info(const Gemm& g, const Unit& u, int tid) {
    AInfo a;
    int R0, C0, R1, C1; stage_rc(tid * 16, R0, C0); stage_rc(tid * 16 + 8192, R1, C1);
    if constexpr (!UPMAP) {
        a.base = (const char*)g.A + (size_t)u.pm * 256 * 128; a.hstep = (size_t)HALF * 128;
        a.v0 = (unsigned)(R0 * 64 + C0) * 2u; a.v1 = (unsigned)(R1 * 64 + C1) * 2u;
    } else {
        if (u.pm < 68) {
            const int b = u.pm / 17, j = u.pm % 17;
            a.base = (const char*)g.A + (size_t)(4098 * b + 248 * j) * 128; a.hstep = (size_t)124 * 128;
            a.v0 = (unsigned)((R0 - 2 * (R0 >> 6)) * 64 + C0) * 2u; a.v1 = (unsigned)((R1 - 2 * (R1 >> 6)) * 64 + C1) * 2u;
        } else {
            a.base = (const char*)g.A + (size_t)16394 * 128; a.hstep = (size_t)HALF * 128;
            a.v0 = (unsigned)(R0 * 64 + C0) * 2u; a.v1 = (unsigned)(R1 * 64 + C1) * 2u;
        }
    }
    return a;
}

template <class Epi, bool UPMAP>
__device__ __forceinline__ void gemm_phase(LAS unsigned char* lds, const Gemm g, const StaticOrder& S, const Epi& E) {
    const int tid = threadIdx.x, wid = __builtin_amdgcn_readfirstlane(tid >> 6), lane = tid & 63, wr = wid >> 2, wc = wid & 3, fr = lane & 15, fq = lane >> 4;
    const int K = g.K, nt = K / BK;
    unsigned voffB[2];
#pragma unroll
    for (int i = 0; i < 2; ++i) { int R, C; stage_rc(tid * 16 + i * 8192, R, C); const int Rb = (R & ~31) + perm32(R & 31); voffB[i] = (unsigned)(Rb * K + C) * 2u; }
    const size_t kstep = (size_t)(BK * 2);
    const size_t kstepA = (size_t)g.nrowsA * 128;
    const size_t hstepB = (size_t)HALF * K * 2;
    const size_t tstepB = 2 * hstepB;
    const unsigned ldsw = (unsigned)wid * 1024u;
    const int aoff = lds_byte(wr * 64 + fr, fq * 8), boff = lds_byte(wc * 32 + fr, fq * 8);
#define PG8_SA(b, h) (((b) * 2 + (h)) * HTB)
#define PG8_SB(b, h) ((4 + (b) * 2 + (h)) * HTB)
#define PG8_STAGEB(bufoff, gbase) do { _Pragma("unroll") for (int _i = 0; _i < 2; ++_i) \
        __builtin_amdgcn_global_load_lds((const unsigned*)((const char*)(gbase) + voffB[_i]), (LAS unsigned*)(lds + (bufoff) + ldsw + _i * 8192), 16, 0, 0); } while (0)
#define PG8_STAGEA(bufoff, gbase, va0, va1) do { \
        __builtin_amdgcn_global_load_lds((const unsigned*)((const char*)(gbase) + (va0)), (LAS unsigned*)(lds + (bufoff) + ldsw), 16, 0, 0); \
        __builtin_amdgcn_global_load_lds((const unsigned*)((const char*)(gbase) + (va1)), (LAS unsigned*)(lds + (bufoff) + ldsw + 8192), 16, 0, 0); } while (0)
#define PG8_LDA(dst, b, h) do { _Pragma("unroll") for (int m = 0; m < 4; ++m) _Pragma("unroll") for (int k = 0; k < 2; ++k) dst[m][k] = *(const LAS bf16x8*)(lds + PG8_SA(b, h) + aoff + m * 2048 + k * 1024); } while (0)
#define PG8_LDB(dst, b, h) do { _Pragma("unroll") for (int n = 0; n < 2; ++n) _Pragma("unroll") for (int k = 0; k < 2; ++k) dst[n][k] = *(const LAS bf16x8*)(lds + PG8_SB(b, h) + boff + n * 2048 + k * 1024); } while (0)
#define PG8_MMA(ai, bj, At, Bt) do { __builtin_amdgcn_s_setprio(1); _Pragma("unroll") for (int m = 0; m < 4; ++m) _Pragma("unroll") for (int n = 0; n < 2; ++n) _Pragma("unroll") for (int k = 0; k < 2; ++k) \
        acc[ai][bj][m][n] = __builtin_amdgcn_mfma_f32_16x16x32_bf16(Bt[n][k], At[m][k], acc[ai][bj][m][n], 0, 0, 0); __builtin_amdgcn_s_setprio(0); } while (0)
#define PG8_WAIT_V(n) asm volatile("s_waitcnt vmcnt(" #n ")" ::: "memory")
#define PG8_WAIT_L(n) asm volatile("s_waitcnt lgkmcnt(" #n ")" ::: "memory")
#define PG8_BAR __builtin_amdgcn_s_barrier()
#define PG8_SCHED __builtin_amdgcn_sched_barrier(0)
    Unit cur, nxt; int ui = 0;
    if (!S.next(0, cur)) return;
    f32x4 acc[2][2][4][2];
#pragma unroll
    for (int a = 0; a < 2; ++a)
#pragma unroll
        for (int b = 0; b < 2; ++b)
#pragma unroll
            for (int m = 0; m < 4; ++m)
#pragma unroll
                for (int n = 0; n < 2; ++n) acc[a][b][m][n] = (f32x4){0.f, 0.f, 0.f, 0.f};
    bf16x8 At[4][2], B0[2][2], B1[2][2];
    AInfo ca = a_info<UPMAP>(g, cur, tid);
    const char* cA = ca.base; const char* cB = (const char*)g.Bt + (size_t)cur.pn * tstepB;
    PG8_STAGEB(PG8_SB(0, 0), cB); PG8_STAGEB(PG8_SB(0, 1), cB + hstepB); PG8_STAGEA(PG8_SA(0, 0), cA, ca.v0, ca.v1); PG8_STAGEA(PG8_SA(0, 1), cA + ca.hstep, ca.v0, ca.v1);
    if (wr == 1) PG8_BAR;
    PG8_WAIT_V(2); PG8_BAR;
    PG8_STAGEB(PG8_SB(1, 0), cB + kstep); PG8_STAGEA(PG8_SA(1, 0), cA + kstepA, ca.v0, ca.v1); PG8_STAGEB(PG8_SB(1, 1), cB + hstepB + kstep);
    PG8_WAIT_V(6); PG8_BAR;
    for (;;) {
        const bool has_next = S.next(ui + 1, nxt);
        AInfo na = ca; if (has_next) na = a_info<UPMAP>(g, nxt, tid);
        const char* nA = na.base; const char* nB = has_next ? (const char*)g.Bt + (size_t)nxt.pn * tstepB : cB;
        for (int t = 0; t < nt; t += 2) {
            const bool last = (t == nt - 2);
            const char* a1 = cA + (size_t)(t + 1) * kstepA;
            const char* a2 = last ? nA : cA + (size_t)(t + 2) * kstepA; const char* b2 = last ? nB : cB + (size_t)(t + 2) * kstep;
            const char* a3 = a2 + kstepA; const char* b3 = b2 + kstep;
            const size_t h2 = last ? na.hstep : ca.hstep; const unsigned w0 = last ? na.v0 : ca.v0, w1 = last ? na.v1 : ca.v1;
            PG8_LDB(B0, 0, 0); PG8_LDB(B1, 0, 1); PG8_SCHED; PG8_LDA(At, 0, 0); PG8_STAGEA(PG8_SA(1, 1), a1 + ca.hstep, ca.v0, ca.v1);
            PG8_WAIT_V(8); PG8_WAIT_L(0); PG8_BAR; PG8_MMA(0, 0, At, B0); PG8_MMA(0, 1, At, B1); PG8_BAR; PG8_SCHED;
            PG8_LDA(At, 0, 1); PG8_STAGEB(PG8_SB(0, 0), b2); PG8_STAGEB(PG8_SB(0, 1), b2 + hstepB); PG8_STAGEA(PG8_SA(0, 0), a2, w0, w1);
            PG8_WAIT_V(8); PG8_WAIT_L(0); PG8_BAR; PG8_MMA(1, 0, At, B0); PG8_MMA(1, 1, At, B1); PG8_BAR; PG8_SCHED;
            PG8_LDB(B0, 1, 0); PG8_LDB(B1, 1, 1); PG8_SCHED; PG8_LDA(At, 1, 0); PG8_STAGEA(PG8_SA(0, 1), a2 + h2, w0, w1);
            PG8_WAIT_V(8); PG8_WAIT_L(0); PG8_BAR; PG8_MMA(0, 0, At, B0); PG8_MMA(0, 1, At, B1); PG8_BAR; PG8_SCHED;
            PG8_LDA(At, 1, 1); PG8_STAGEB(PG8_SB(1, 0), b3); PG8_STAGEB(PG8_SB(1, 1), b3 + hstepB); PG8_STAGEA(PG8_SA(1, 0), a3, w0, w1);
            PG8_WAIT_V(8); PG8_WAIT_L(0); PG8_BAR; PG8_MMA(1, 0, At, B0); PG8_MMA(1, 1, At, B1); PG8_BAR; PG8_SCHED;
        }
        if (wr == 0) PG8_BAR;
        E(acc, cur, wr, wc, fr, fq);
        if constexpr ((PROBE & 512) && Epi::IDEM) E(acc, cur, wr, wc, fr, fq);
        if (!has_next) break;
#pragma unroll
        for (int a = 0; a < 2; ++a)
#pragma unroll
            for (int b = 0; b < 2; ++b)
#pragma unroll
                for (int m = 0; m < 4; ++m)
#pragma unroll
                    for (int n = 0; n < 2; ++n) acc[a][b][m][n] = (f32x4){0.f, 0.f, 0.f, 0.f};
        cur = nxt; ca = na; cA = nA; cB = nB; ++ui;
        if (wr == 1) PG8_BAR;
    }
    PG8_WAIT_V(0);
    PG8_BAR;
#undef PG8_SA
#undef PG8_SB
#undef PG8_STAGEA
#undef PG8_STAGEB
#undef PG8_LDA
#undef PG8_LDB
#undef PG8_MMA
#undef PG8_WAIT_V
#undef PG8_WAIT_L
#undef PG8_BAR
#undef PG8_SCHED
}

template <class Epi>
__device__ __forceinline__ void sample_gemm(LAS unsigned char* lds, const bf16_t* Abase, const int nrowsA, const int arow0, const bf16_t* Bt, const int K, const int nN, const int pm_unit, const Epi& E, const int job0, const int jstride, const int jend = 1 << 30) {
    const int tid = threadIdx.x, w = __builtin_amdgcn_readfirstlane(tid >> 6);
    int lane = tid & 63; asm volatile("" : "+v"(lane));
    const int fr = lane & 15, fq = lane >> 4;
    const int per = K / 256;
#pragma unroll 1
    for (int job = job0; job < nN * 16 && job < jend; job += jstride) {
        const int pn = job >> 4, jai = (job >> 3) & 1, jwr = (job >> 2) & 1, jwc = job & 3;
        f32x4 h[2][4][2];
#pragma unroll
        for (int b = 0; b < 2; ++b)
#pragma unroll
            for (int m = 0; m < 4; ++m)
#pragma unroll
                for (int n = 0; n < 2; ++n) h[b][m][n] = (f32x4){0.f, 0.f, 0.f, 0.f};
        const bf16_t* ap = Abase + (size_t)(arow0 + jai * 128 + jwr * 64 + fr) * 64 + 8 * fq;
        const bf16_t* bp = Bt + (size_t)(pn * 256 + jwc * 32 + 8 * (fr >> 2) + (fr & 3)) * K + 8 * fq + (w * per) * 32;
#pragma unroll 1
        for (int ks0 = 0; ks0 < per; ks0 += 4) {
            bf16x8 af[4][4], bfr[4][2][2];
#pragma unroll
            for (int kl = 0; kl < 4; ++kl) {
                const int ks = (ks0 + kl < per) ? ks0 + kl : per - 1;
#pragma unroll
                for (int m = 0; m < 4; ++m) { const int kk = w * per + ks; af[kl][m] = *(const bf16x8*)(ap + (size_t)(16 * m) * 64 + (size_t)(kk >> 1) * nrowsA * 64 + (kk & 1) * 32); }
#pragma unroll
                for (int bj = 0; bj < 2; ++bj)
#pragma unroll
                    for (int n = 0; n < 2; ++n) bfr[kl][bj][n] = *(const bf16x8*)(bp + (size_t)(bj * 128 + 4 * n) * K + 32 * ks);
            }
#pragma unroll
            for (int kl = 0; kl < 4; ++kl)
                if (ks0 + kl < per) {
#pragma unroll
                    for (int bj = 0; bj < 2; ++bj)
#pragma unroll
                        for (int m = 0; m < 4; ++m)
#pragma unroll
                            for (int n = 0; n < 2; ++n) h[bj][m][n] = __builtin_amdgcn_mfma_f32_16x16x32_bf16(bfr[kl][bj][n], af[kl][m], h[bj][m][n], 0, 0, 0);
                }
        }
        __syncthreads();
#pragma unroll
        for (int bj = 0; bj < 2; ++bj)
#pragma unroll
            for (int m = 0; m < 4; ++m)
#pragma unroll
                for (int n = 0; n < 2; ++n) *(LAS f32x4*)(lds + ((w * 16 + (bj * 4 + m) * 2 + n) * 64 + lane) * 16) = h[bj][m][n];
        __syncthreads();
#pragma unroll
        for (int q = 0; q < 2; ++q) {
            LAS unsigned char* sp = lds + ((2 * w + q) * 64 + lane) * 16;
            f32x4 sum = *(const LAS f32x4*)sp;
#pragma unroll
            for (int ww = 1; ww < 8; ++ww) sum += *(const LAS f32x4*)(sp + ww * 16384);
            *(LAS f32x4*)sp = sum;
        }
        __syncthreads();
        if (w < 4) {
            f32x4 acc[2][2][4][2];
#pragma unroll
            for (int ai = 0; ai < 2; ++ai)
#pragma unroll
                for (int bj = 0; bj < 2; ++bj)
#pragma unroll
                    for (int m = 0; m < 4; ++m)
#pragma unroll
                        for (int n = 0; n < 2; ++n) acc[ai][bj][m][n] = *(const LAS f32x4*)(lds + (((bj * 4 + m) * 2 + n) * 64 + lane) * 16);
            Unit u; u.pm = pm_unit; u.pn = pn;
            E(acc, u, jwr, jwc, fr, fq, 1u << (4 * jai + w));
        }
        if constexpr (Epi::POST) E.post(lds, 2 * jai + jwr, w, lane, 16u);
    }
    __syncthreads();
}

template <class Epi>
__device__ __forceinline__ void sample_gemm16(LAS unsigned char* lds, const bf16_t* Abase, const int nrowsA, const int arow0, const bf16_t* Bt, const int K, const int nN, const int pm_unit, const Epi& E, const int job0, const int jstride) {
    const int tid = threadIdx.x, w = __builtin_amdgcn_readfirstlane(tid >> 6);
    int lane = tid & 63; asm volatile("" : "+v"(lane));
    const int fr = lane & 15, fq = lane >> 4;
    const int per = K / 256;
#pragma unroll 1
    for (int job = job0; job < nN * 64; job += jstride) {
        const int pn = job >> 6, jai = (job >> 5) & 1, jwr = (job >> 4) & 1, jm = (job >> 2) & 3, jwc = job & 3;
        f32x4 h[2][2];
#pragma unroll
        for (int b = 0; b < 2; ++b)
#pragma unroll
            for (int n = 0; n < 2; ++n) h[b][n] = (f32x4){0.f, 0.f, 0.f, 0.f};
        const bf16_t* ap = Abase + (size_t)(arow0 + jai * 128 + jwr * 64 + 16 * jm + fr) * 64 + 8 * fq;
        const bf16_t* bp = Bt + (size_t)(pn * 256 + jwc * 32 + 8 * (fr >> 2) + (fr & 3)) * K + 8 * fq + (w * per) * 32;
#pragma unroll 1
        for (int ks0 = 0; ks0 < per; ks0 += 6) {
            bf16x8 af[6], bfr[6][2][2];
#pragma unroll
            for (int kl = 0; kl < 6; ++kl) {
                const int ks = (ks0 + kl < per) ? ks0 + kl : per - 1;
                { const int kk = w * per + ks; af[kl] = *(const bf16x8*)(ap + (size_t)(kk >> 1) * nrowsA * 64 + (kk & 1) * 32); }
#pragma unroll
                for (int bj = 0; bj < 2; ++bj)
#pragma unroll
                    for (int n = 0; n < 2; ++n) bfr[kl][bj][n] = *(const bf16x8*)(bp + (size_t)(bj * 128 + 4 * n) * K + 32 * ks);
            }
#pragma unroll
            for (int kl = 0; kl < 6; ++kl)
                if (ks0 + kl < per) {
#pragma unroll
                    for (int bj = 0; bj < 2; ++bj)
#pragma unroll
                        for (int n = 0; n < 2; ++n) h[bj][n] = __builtin_amdgcn_mfma_f32_16x16x32_bf16(bfr[kl][bj][n], af[kl], h[bj][n], 0, 0, 0);
                }
        }
        __syncthreads();
#pragma unroll
        for (int bj = 0; bj < 2; ++bj)
#pragma unroll
            for (int n = 0; n < 2; ++n) *(LAS f32x4*)(lds + ((w * 4 + bj * 2 + n) * 64 + lane) * 16) = h[bj][n];
        __syncthreads();
        if (w < 4) {
            LAS unsigned char* sp = lds + (w * 64 + lane) * 16;
            f32x4 sum = *(const LAS f32x4*)sp;
#pragma unroll
            for (int ww = 1; ww < 8; ++ww) sum += *(const LAS f32x4*)(sp + ww * 4096);
            *(LAS f32x4*)sp = sum;
        }
        __syncthreads();
        if (w == 0) {
            f32x4 acc[2][2][4][2];
#pragma unroll
            for (int ai = 0; ai < 2; ++ai)
#pragma unroll
                for (int bj = 0; bj < 2; ++bj)
#pragma unroll
                    for (int m = 0; m < 4; ++m)
#pragma unroll
                        for (int n = 0; n < 2; ++n) acc[ai][bj][m][n] = *(const LAS f32x4*)(lds + ((bj * 2 + n) * 64 + lane) * 16);
            Unit u; u.pm = pm_unit; u.pn = pn;
            E(acc, u, jwr, jwc, fr, fq, 1u << (4 * jai + jm));
        }
        if constexpr (Epi::POST) E.post(lds, 2 * jai + jwr, w, lane, 64u);
    }
    __syncthreads();
}
}
using pg8::Unit;

struct EpiIn {
    static constexpr bool IDEM = true, POST = false;
    unsigned char* proj; float* DEC; float* HGFS; const f32x4* rope; const float* lb;
    __device__ __forceinline__ void operator()(const f32x4 (&acc)[2][2][4][2], const Unit& u, int wr, int wc, int fr_, int fq_, const unsigned mask = 0xffu) const {
        int fr = fr_, fq = fq_; asm volatile("" : "+v"(fr), "+v"(fq));
        const int pn = u.pn; const bool samp = (u.pm == 64);
        const int dd0 = 32 * (wc & 1) + 8 * fq;
        const int col0 = ((pn & 1) * 2 + (wc >> 1)) * 128 + dd0;
        const int rowb = u.pm * 256 + wr * 64 + fr;
        if (pn < 4) {
            const int type = pn >> 1;
            bf16_t* D = (bf16_t*)(proj + (size_t)type * PSZ);
            const int head = (pn & 1) * 2 + (wc >> 1);
            const float lg = __log2f(1.0f - exp2f(-5.0f - (float)head));
            const float base = type == 0 ? 1.0f : 0.08838834764831845f;
#pragma unroll
            for (int ai = 0; ai < 2; ++ai)
#pragma unroll
                for (int m = 0; m < 4; ++m) if ((mask >> (4 * ai + m)) & 1u) {
                    const int r = rowb + ai * 128 + m * 16;
                    const int pos = r < TP ? (r & 4095) : (1024 + (r & 15));
                    const float e = (float)((r & 63) + 1) * lg;
                    const float sc = samp ? base : base * exp2f(type == 0 ? e : -e);
                    const f32x4* cs = rope + (size_t)pos * 32 + (dd0 >> 1);
                    const f32x4 c0 = cs[0], c1 = cs[1], c2 = cs[2], c3 = cs[3];
                    const f32x4 lo0 = acc[ai][0][m][0], lo1 = acc[ai][0][m][1], hi0 = acc[ai][1][m][0], hi1 = acc[ai][1][m][1];
                    float ol[8], oh[8];
                    ol[0] = lo0[0] * c0[0] - hi0[0] * c0[1]; oh[0] = lo0[0] * c0[1] + hi0[0] * c0[0];
                    ol[1] = lo0[1] * c0[2] - hi0[1] * c0[3]; oh[1] = lo0[1] * c0[3] + hi0[1] * c0[2];
                    ol[2] = lo0[2] * c1[0] - hi0[2] * c1[1]; oh[2] = lo0[2] * c1[1] + hi0[2] * c1[0];
                    ol[3] = lo0[3] * c1[2] - hi0[3] * c1[3]; oh[3] = lo0[3] * c1[3] + hi0[3] * c1[2];
                    ol[4] = lo1[0] * c2[0] - hi1[0] * c2[1]; oh[4] = lo1[0] * c2[1] + hi1[0] * c2[0];
                    ol[5] = lo1[1] * c2[2] - hi1[1] * c2[3]; oh[5] = lo1[1] * c2[3] + hi1[1] * c2[2];
                    ol[6] = lo1[2] * c3[0] - hi1[2] * c3[1]; oh[6] = lo1[2] * c3[1] + hi1[2] * c3[0];
                    ol[7] = lo1[3] * c3[2] - hi1[3] * c3[3]; oh[7] = lo1[3] * c3[3] + hi1[3] * c3[2];
                    u32x4 wl, wh;
                    wl.x = cvt_pk_bf16(ol[0] * sc, ol[1] * sc); wl.y = cvt_pk_bf16(ol[2] * sc, ol[3] * sc); wl.z = cvt_pk_bf16(ol[4] * sc, ol[5] * sc); wl.w = cvt_pk_bf16(ol[6] * sc, ol[7] * sc);
                    wh.x = cvt_pk_bf16(oh[0] * sc, oh[1] * sc); wh.y = cvt_pk_bf16(oh[2] * sc, oh[3] * sc); wh.z = cvt_pk_bf16(oh[4] * sc, oh[5] * sc); wh.w = cvt_pk_bf16(oh[6] * sc, oh[7] * sc);
                    bf16_t* rp = D + pofs(head, r) + dd0;
                    st16(rp, wl); st16(rp + 64, wh);
                }
        } else if (pn >= 8 && pn < 12) {
            const int lane = fq * 16 + fr;
            const int colh = (pn - 8) * 128 + 32 * wc + 8 * fq;
            bf16_t* dHQ = (bf16_t*)(proj + 4 * PSZ); bf16_t* dHK = (bf16_t*)(proj + 5 * PSZ);
            f32x4 lbv[2];
#pragma unroll
            for (int n = 0; n < 2; ++n) lbv[n] = *(const f32x4*)(lb + colh + 4 * n);
            const int srcl = (lane & 48) | 15;
#pragma unroll
            for (int ai = 0; ai < 2; ++ai) {
                const int rbase = u.pm * 256 + ai * 128 + wr * 64;
#pragma unroll
                for (int n = 0; n < 2; ++n) if ((mask >> (4 * ai)) & 0xfu) {
                    const int cn = colh + 4 * n;
                    f32x4 gg[4], kk[4];
#pragma unroll
                    for (int m = 0; m < 4; ++m)
#pragma unroll
                        for (int j = 0; j < 4; ++j) {
                            const float x = acc[ai][1][m][n][j]; const float sg = sigmoid_f(x); const float l = lbv[n][j];
                            gg[m][j] = __builtin_amdgcn_logf(l + (1.0f - l) * sg); kk[m][j] = (1.0f - l) * (1.0f - sg);
                        }
                    if (samp) {
#pragma unroll
                        for (int m = 0; m < 4; ++m) if ((mask >> (4 * ai + m)) & 1u) {
                            const int r = rbase + 16 * m + fr;
                            const f32x4 q0 = acc[ai][0][m][n];
                            u32x2 w; w.x = cvt_pk_bf16(q0[0], q0[1]); w.y = cvt_pk_bf16(q0[2], q0[3]);
                            *(u32x2*)(dHQ + pofs(pn - 8, r) + (cn & 127)) = w;
                            *(f32x4*)(HGFS + (size_t)(r - TP) * HW + cn) = gg[m] * 0.6931471805599453f;
                        }
                    } else {
                        f32x4 carry = (f32x4){0.f, 0.f, 0.f, 0.f};
#pragma unroll
                        for (int m = 0; m < 4; ++m)
#pragma unroll
                            for (int j = 0; j < 4; ++j) {
                                float v = gg[m][j];
                                v += dpp_z<0x111>(v); v += dpp_z<0x112>(v); v += dpp_z<0x114>(v); v += dpp_z<0x118>(v);
                                v += carry[j];
                                gg[m][j] = v;
                                carry[j] = __shfl(v, srcl);
                            }
#pragma unroll
                        for (int m = 0; m < 4; ++m) {
                            const int r = rbase + 16 * m + fr;
                            float qo[4], ko[4];
#pragma unroll
                            for (int j = 0; j < 4; ++j) { const float b = gg[m][j]; qo[j] = acc[ai][0][m][n][j] * __builtin_amdgcn_exp2f(b); ko[j] = kk[m][j] * __builtin_amdgcn_exp2f(-b); }
                            u32x2 wq, wk;
                            wq.x = cvt_pk_bf16(qo[0], qo[1]); wq.y = cvt_pk_bf16(qo[2], qo[3]);
                            wk.x = cvt_pk_bf16(ko[0], ko[1]); wk.y = cvt_pk_bf16(ko[2], ko[3]);
                            st8(dHQ + pofs(pn - 8, r) + (cn & 127), wq); st8(dHK + pofs(pn - 8, r) + (cn & 127), wk);
                        }
                        if (fr == 15) {
                            f32x4 d0;
#pragma unroll
                            for (int j = 0; j < 4; ++j) d0[j] = __builtin_amdgcn_exp2f(carry[j]);
                            *(f32x4*)(DEC + (size_t)(4 * u.pm + 2 * ai + wr) * HW + cn) = d0;
                        }
                    }
                }
            }
        } else {
            bf16_t* D = (bf16_t*)(proj + (size_t)(pn >> 1) * PSZ);
            const bool act = false;
#pragma unroll
            for (int ai = 0; ai < 2; ++ai)
#pragma unroll
                for (int m = 0; m < 4; ++m) if ((mask >> (4 * ai + m)) & 1u) {
                    const int r = rowb + ai * 128 + m * 16;
                    bf16_t* rp = D + pofs((pn & 1) * 2 + (wc >> 1), r) + dd0;
#pragma unroll
                    for (int bj = 0; bj < 2; ++bj) {
                        f32x4 v0 = acc[ai][bj][m][0], v1 = acc[ai][bj][m][1];
                        if (act) {
#pragma unroll
                            for (int j = 0; j < 4; ++j) { v0[j] = silu_f(v0[j]); v1[j] = silu_f(v1[j]); }
                        }
                        u32x4 w; w.x = cvt_pk_bf16(v0[0], v0[1]); w.y = cvt_pk_bf16(v0[2], v0[3]); w.z = cvt_pk_bf16(v1[0], v1[1]); w.w = cvt_pk_bf16(v1[2], v1[3]);
                        st16(rp + 64 * bj, w);
                    }
                }
        }
    }
};

struct EpiOut {
    static constexpr bool IDEM = true, POST = false;
    const float* xp; const float* xs; float* X1F; bf16_t* X1B; float* SS2;
    __device__ __forceinline__ void operator()(const f32x4 (&acc)[2][2][4][2], const Unit& u, int wr, int wc, int fr_, int fq_, const unsigned mask = 0xffu) const {
        int fr = fr_, fq = fq_; asm volatile("" : "+v"(fr), "+v"(fq));
        const int col0 = u.pn * 256 + wc * 32 + 8 * fq;
#pragma unroll
        for (int ai = 0; ai < 2; ++ai)
#pragma unroll
            for (int m = 0; m < 4; ++m) if ((mask >> (4 * ai + m)) & 1u) {
                const int r = u.pm * 256 + ai * 128 + wr * 64 + m * 16 + fr;
                const float* xr = (r < TP ? xp + (size_t)r * DM : xs + (size_t)(r - TP) * DM) + col0;
                const int rb = r < TP ? (4098 * (r >> 12) + 2 + (r & 4095)) : (16394 + (r - TP));

                float ss = 0.f;
#pragma unroll
                for (int bj = 0; bj < 2; ++bj) {
                    const f32x4 x0 = __builtin_nontemporal_load((const f32x4*)(xr + 128 * bj)), x1 = __builtin_nontemporal_load((const f32x4*)(xr + 128 * bj + 4));
                    const f32x4 v0 = acc[ai][bj][m][0] + x0, v1 = acc[ai][bj][m][1] + x1;
                    u32x4 w; w.x = cvt_pk_bf16(v0[0], v0[1]); w.y = cvt_pk_bf16(v0[2], v0[3]); w.z = cvt_pk_bf16(v1[0], v1[1]); w.w = cvt_pk_bf16(v1[2], v1[3]);
                    st16(X1B + kofs(X1B_ROWS, rb, col0 + 128 * bj), w);
                    ss += (v0[0] * v0[0] + v0[1] * v0[1]) + (v0[2] * v0[2] + v0[3] * v0[3]) + (v1[0] * v1[0] + v1[1] * v1[1]) + (v1[2] * v1[2] + v1[3] * v1[3]);
                }
                ss += __shfl_xor(ss, 16); ss += __shfl_xor(ss, 32);
                if (fq == 0) SS2[(size_t)r * 16 + u.pn * 4 + wc] = ss;
            }
    }
};

struct EpiUp {
    static constexpr bool IDEM = true, POST = false;
    const float* SS2; const float* ck; const float* cb; const float* cache_in; bf16_t* ACT; float* ccp; float* ccs;
    __device__ __forceinline__ void operator()(f32x4 (&acc)[2][2][4][2], const Unit& u, int wr, int wc, int fr_, int fq_, const unsigned mask = 0xffu) const {
        int fr = fr_, fq = fq_; asm volatile("" : "+v"(fr), "+v"(fq));
        const int lane = fq * 16 + fr;
        const int f0 = u.pn * 128 + wc * 32 + 8 * fq;
        const bool samp = (u.pm == 68);
        const int sb = samp ? 0 : u.pm / 17, sj = samp ? 0 : u.pm % 17;
        f32x4 k0[2], k1[2], k2[2], bb[2];
#pragma unroll
        for (int n = 0; n < 2; ++n) { k0[n] = *(const f32x4*)(ck + f0 + 4 * n); k1[n] = *(const f32x4*)(ck + DFF + f0 + 4 * n); k2[n] = *(const f32x4*)(ck + 2 * DFF + f0 + 4 * n); bb[n] = *(const f32x4*)(cb + f0 + 4 * n); }
#pragma unroll
        for (int ai = 0; ai < 2; ++ai) {
            f32x4 prev[2] = {(f32x4){0.f, 0.f, 0.f, 0.f}, (f32x4){0.f, 0.f, 0.f, 0.f}};
#pragma unroll
            for (int m = 0; m < 4; ++m) if ((mask >> (4 * ai + m)) & 1u) {
                int gr; bool valid; int t = 0;
                if (samp) { gr = TP + ai * 128 + wr * 64 + m * 16 + fr; valid = true; }
                else { t = 248 * sj + 62 * (2 * ai + wr) + 16 * m + fr - 2; gr = sb * SEQ + t; valid = (t >= 0) && (t < SEQ); }
                float ssq = 0.f;
                if (valid) { const f32x4 p = *(const f32x4*)(SS2 + (size_t)gr * 16 + 4 * fq); ssq = (p[0] + p[1]) + (p[2] + p[3]); }
                ssq += __shfl_xor(ssq, 16); ssq += __shfl_xor(ssq, 32);
                const float rs = valid ? __frsqrt_rn(ssq * (1.0f / DM) + EPS) : 0.f;
                f32x4 a[2], b[2];
#pragma unroll
                for (int n = 0; n < 2; ++n) { a[n] = acc[ai][0][m][n] * rs; b[n] = acc[ai][1][m][n] * rs; }
                if (samp) {
                    const int s = ai * 8 + wr * 4 + m;
                    if (fr >= 14) {
#pragma unroll
                        for (int n = 0; n < 2; ++n) prev[n] = *(const f32x4*)(cache_in + ((size_t)s * 2 + (fr - 14)) * DFF + f0 + 4 * n);
                    }
                }
                f32x4 o[2];
#pragma unroll
                for (int n = 0; n < 2; ++n)
#pragma unroll
                    for (int j = 0; j < 4; ++j) {
                        const float s1 = dpp_f<0x111>(dpp_f<0x121>(0.f, prev[n][j]), a[n][j]);
                        const float s2 = dpp_f<0x112>(dpp_f<0x122>(0.f, prev[n][j]), a[n][j]);
                        const float cv = bb[n][j] + k0[n][j] * s2 + k1[n][j] * s1 + k2[n][j] * a[n][j];
                        o[n][j] = silu_f(cv) * b[n][j];
                    }
                const bool store = samp ? true : (valid && (16 * m + fr >= 2));
                if (store) {
                    u32x4 w; w.x = cvt_pk_bf16(o[0][0], o[0][1]); w.y = cvt_pk_bf16(o[0][2], o[0][3]); w.z = cvt_pk_bf16(o[1][0], o[1][1]); w.w = cvt_pk_bf16(o[1][2], o[1][3]);
                    st16(ACT + kofs(TT, gr, f0), w);
                    if (samp) { if (fr >= 14) { float* cp = ccs + ((size_t)(ai * 8 + wr * 4 + m) * 2 + (fr - 14)) * DFF + f0; *(f32x4*)cp = a[0]; *(f32x4*)(cp + 4) = a[1]; } }
                    else if (t >= SEQ - 2) { float* cp = ccp + ((size_t)sb * 2 + (t - (SEQ - 2))) * DFF + f0; *(f32x4*)cp = a[0]; *(f32x4*)(cp + 4) = a[1]; }
                }
                prev[0] = a[0]; prev[1] = a[1];
            }
        }
    }
};

template <bool FUSED>
struct EpiDownT {
    static constexpr bool IDEM = false, POST = !FUSED;
    float* X; const bf16_t* X1B; float* SS3; const float* gfin; float* XS; unsigned* cnt; LAS unsigned char* ldsx;
    static __device__ __forceinline__ void ld8(const bf16_t* p, f32x4& a, f32x4& b) { const u32x4 w = *(const u32x4*)p;
        a[0] = __uint_as_float(w.x << 16); a[1] = __uint_as_float(w.x & 0xffff0000u); a[2] = __uint_as_float(w.y << 16); a[3] = __uint_as_float(w.y & 0xffff0000u);
        b[0] = __uint_as_float(w.z << 16); b[1] = __uint_as_float(w.z & 0xffff0000u); b[2] = __uint_as_float(w.w << 16); b[3] = __uint_as_float(w.w & 0xffff0000u); }
    __device__ __forceinline__ void post(LAS unsigned char* lds, int rb, int w, int lane, const unsigned nexp) const {
        asm volatile("s_waitcnt vmcnt(0)" ::: "memory");
        __syncthreads();
        LAS unsigned* flag = (LAS unsigned*)(lds + RING_BYTES + 8192);
        if (threadIdx.x == 0) {
            __builtin_amdgcn_fence(__ATOMIC_RELEASE, "agent");
            asm volatile("s_waitcnt vmcnt(0)" ::: "memory");
            const unsigned old = __hip_atomic_fetch_add(cnt + 64 * (64 + rb), 1u, __ATOMIC_RELAXED, __HIP_MEMORY_SCOPE_AGENT);
            const unsigned last = (old == nexp - 1u) ? 1u : 0u;
            if (last) { __builtin_amdgcn_fence(__ATOMIC_ACQUIRE, "agent"); asm volatile("s_waitcnt vmcnt(0)" ::: "memory"); }
            *flag = last;
        }
        __syncthreads();
        if (*flag) {
            f32x4 gn[4];
#pragma unroll
            for (int j = 0; j < 4; ++j) gn[j] = ((const f32x4*)gfin)[lane + 64 * j];
            for (int q = w; q < 64; q += NWAVES) {
                const int m = TP + 64 * rb + q;
                float p = lane < 16 ? SS3[(size_t)m * 16 + lane] : 0.f;
#pragma unroll
                for (int o = 1; o < 64; o <<= 1) p += __shfl_xor(p, o);
                const float rs = 1.0f / sqrtf(p * (1.0f / DM) + EPS);
                f32x4* xr = (f32x4*)(X + (size_t)m * DM) + lane;
#pragma unroll
                for (int j = 0; j < 4; ++j) { f32x4 v = xr[64 * j]; v = v * rs * gn[j]; xr[64 * j] = v; }
            }
        }
        __syncthreads();
    }
    __device__ __forceinline__ void operator()(f32x4 (&acc)[2][2][4][2], const Unit& u, int wr, int wc, int fr_, int fq_, const unsigned mask = 0xffu) const {
        int fr = fr_, fq = fq_; asm volatile("" : "+v"(fr), "+v"(fq));
        const int col0 = u.pn * 256 + wc * 32 + 8 * fq;
        if constexpr (!FUSED) {
#pragma unroll
            for (int ai = 0; ai < 2; ++ai)
#pragma unroll
                for (int m = 0; m < 4; ++m) if ((mask >> (4 * ai + m)) & 1u) {
                    const int r = u.pm * 256 + ai * 128 + wr * 64 + m * 16 + fr;
                    float* xr = X + (size_t)r * DM + col0;
                    const int rb = r < TP ? (4098 * (r >> 12) + 2 + (r & 4095)) : (16394 + (r - TP));
                    float ss = 0.f;
#pragma unroll
                    for (int bj = 0; bj < 2; ++bj) {
                        f32x4 x0, x1; ld8(X1B + kofs(X1B_ROWS, rb, col0 + 128 * bj), x0, x1);
                        const f32x4 v0 = acc[ai][bj][m][0] + x0, v1 = acc[ai][bj][m][1] + x1;
                        *(f32x4*)(xr + 128 * bj) = v0; *(f32x4*)(xr + 128 * bj + 4) = v1;
                        ss += (v0[0] * v0[0] + v0[1] * v0[1]) + (v0[2] * v0[2] + v0[3] * v0[3]) + (v1[0] * v1[0] + v1[1] * v1[1]) + (v1[2] * v1[2] + v1[3] * v1[3]);
                    }
                    ss += __shfl_xor(ss, 16); ss += __shfl_xor(ss, 32);
                    if (fq == 0) SS3[(size_t)r * 16 + u.pn * 4 + wc] = ss;
                }
        } else {
            const int tid = threadIdx.x, wid = __builtin_amdgcn_readfirstlane(tid >> 6);
            LAS float* P = (LAS float*)ldsx;
            LAS float* S = (LAS float*)(ldsx + 4096);
#pragma unroll
            for (int ai = 0; ai < 2; ++ai)
#pragma unroll
                for (int m = 0; m < 4; ++m) {
                    const int rl = ai * 128 + wr * 64 + m * 16 + fr;
                    const int r = u.pm * 256 + rl;
                    const int rbf = 4098 * (r >> 12) + 2 + (r & 4095);
                    float ss = 0.f;
#pragma unroll
                    for (int bj = 0; bj < 2; ++bj) {
                        f32x4 x0, x1; ld8(X1B + kofs(X1B_ROWS, rbf, col0 + 128 * bj), x0, x1);
                        const f32x4 v0 = acc[ai][bj][m][0] + x0, v1 = acc[ai][bj][m][1] + x1;
                        acc[ai][bj][m][0] = v0; acc[ai][bj][m][1] = v1;
                        ss += (v0[0] * v0[0] + v0[1] * v0[1]) + (v0[2] * v0[2] + v0[3] * v0[3]) + (v1[0] * v1[0] + v1[1] * v1[1]) + (v1[2] * v1[2] + v1[3] * v1[3]);
                    }
                    ss += __shfl_xor(ss, 16); ss += __shfl_xor(ss, 32);
                    if (fq == 0) P[rl * 4 + wc] = ss;
                    if (m & 1) asm volatile("" ::: "memory");
                }
            asm volatile("s_waitcnt lgkmcnt(0)" ::: "memory"); __builtin_amdgcn_s_barrier(); asm volatile("" ::: "memory");
            if (tid < 256) {
                const f32x4 p = *(const LAS f32x4*)(P + tid * 4);
                __hip_atomic_store(XS + ((size_t)u.pm * 256 + tid) * 4 + u.pn, (p[0] + p[1]) + (p[2] + p[3]), __ATOMIC_RELAXED, __HIP_MEMORY_SCOPE_AGENT);
            }
            asm volatile("s_waitcnt vmcnt(0)" ::: "memory");
            if (tid < 256 && (tid & 63) == 0) __hip_atomic_fetch_add(cnt + 64 * u.pm, 1u, __ATOMIC_RELAXED, __HIP_MEMORY_SCOPE_AGENT);
            if (wid == 0) {
                unsigned sp = 0;
                while ((unsigned)__builtin_amdgcn_readfirstlane(__hip_atomic_load(cnt + 64 * u.pm, __ATOMIC_RELAXED, __HIP_MEMORY_SCOPE_AGENT)) < 16u) {
                    __builtin_amdgcn_s_sleep(2);
                    if (++sp > (1u << 20)) break;
                }
                __builtin_amdgcn_fence(__ATOMIC_ACQUIRE, "agent");
            }
            asm volatile("s_waitcnt vmcnt(0) lgkmcnt(0)" ::: "memory"); __builtin_amdgcn_s_barrier(); asm volatile("" ::: "memory");
            if (tid < 256) {
                const float* sl = XS + ((size_t)u.pm * 256 + tid) * 4;
                float t = 0.f;
#pragma unroll
                for (int k = 0; k < 4; ++k) t += __hip_atomic_load(sl + k, __ATOMIC_RELAXED, __HIP_MEMORY_SCOPE_AGENT);
                S[tid] = 1.0f / sqrtf(t * (1.0f / DM) + EPS);
            }
            asm volatile("s_waitcnt vmcnt(0) lgkmcnt(0)" ::: "memory"); __builtin_amdgcn_s_barrier(); asm volatile("" ::: "memory");
            f32x4 gv[2][2];
#pragma unroll
            for (int bj = 0; bj < 2; ++bj)
#pragma unroll
                for (int n = 0; n < 2; ++n) gv[bj][n] = *(const f32x4*)(gfin + col0 + 128 * bj + 4 * n);
#pragma unroll
            for (int ai = 0; ai < 2; ++ai)
#pragma unroll
                for (int m = 0; m < 4; ++m) {
                    const int rl = ai * 128 + wr * 64 + m * 16 + fr;
                    const float rs = S[rl];
                    float* xr = X + (size_t)(u.pm * 256 + rl) * DM + col0;
#pragma unroll
                    for (int bj = 0; bj < 2; ++bj) {
                        *(f32x4*)(xr + 128 * bj) = acc[ai][bj][m][0] * rs * gv[bj][0];
                        *(f32x4*)(xr + 128 * bj + 4) = acc[ai][bj][m][1] * rs * gv[bj][1];
                    }
                }
        }
    }
};

struct EpiNull {
    static constexpr bool IDEM = false, POST = false;
    __device__ __forceinline__ void operator()(f32x4 (&acc)[2][2][4][2], const Unit& u, int wr, int wc, int fr_, int fq_, const unsigned mask = 0xffu) const {
#pragma unroll
        for (int a = 0; a < 2; ++a)
#pragma unroll
            for (int b = 0; b < 2; ++b)
#pragma unroll
                for (int m = 0; m < 4; ++m)
#pragma unroll
                    for (int n = 0; n < 2; ++n) asm volatile("" :: "v"(acc[a][b][m][n]));
    }
};
struct Args { const float* in[17]; float* out; unsigned char* ws; int ph_lo, ph_hi; };

__device__ __forceinline__ float wave_sum(float v) {
#pragma unroll
    for (int o = 1; o < 64; o <<= 1) v += __shfl_xor(v, o);
    return v;
}

__device__ __forceinline__ void transpose_item(const float* W, int K, int N, bf16_t* WT, const float* gain, LAS float* scr, int k0, int p0, int s0, int lane) {
    float tv[32];
#pragma unroll
    for (int i = 0; i < 32; ++i) { const int kk = 2 * i + (lane >> 5); tv[i] = __builtin_nontemporal_load(W + (size_t)(k0 + kk) * N + s0 + (lane & 31)); }
    if (gain) {
#pragma unroll
        for (int i = 0; i < 32; ++i) tv[i] *= gain[k0 + 2 * i + (lane >> 5)];
    }
#pragma unroll
    for (int i = 0; i < 32; ++i) scr[(2 * i + (lane >> 5)) * 33 + (lane & 31)] = tv[i];
    asm volatile("s_waitcnt lgkmcnt(0)" ::: "memory");
    const int c = lane & 7;
#pragma unroll
    for (int j = 0; j < 4; ++j) { const int n = (lane >> 3) + 8 * j; const LAS float* s = scr + (8 * c) * 33 + n;
        u32x4 o; o.x = cvt_pk_bf16(s[0 * 33], s[1 * 33]); o.y = cvt_pk_bf16(s[2 * 33], s[3 * 33]); o.z = cvt_pk_bf16(s[4 * 33], s[5 * 33]); o.w = cvt_pk_bf16(s[6 * 33], s[7 * 33]);
        *(u32x4*)(WT + (size_t)(p0 + n) * K + k0 + 8 * c) = o; }
    asm volatile("s_waitcnt lgkmcnt(0)" ::: "memory");
}
__device__ __forceinline__ int colmap_in(int p) {
    const int pn = p >> 8, pl = p & 255, bj = pl >> 7, q = pl & 127;
    if (pn >= 8 && pn < 12) return (bj ? 2560 : 2048) + (pn - 8) * 128 + q;
    const int type = pn >> 1;
    return type * 512 + ((pn & 1) * 2 + (q >> 6)) * 128 + bj * 64 + (q & 63);
}
__device__ __forceinline__ int colmap_up(int p) { const int pn = p >> 8, pl = p & 255, bj = pl >> 7, q = pl & 127; return bj * DFF + 128 * pn + q; }

__device__ __forceinline__ void phase_prep(const Args& A, LAS unsigned char* lds, int wave, int lane) {
    unsigned char* ws = A.ws;
    const int G = gridDim.x, gw = blockIdx.x * NWAVES + wave, NGW = G * NWAVES;
    LAS float* scr = (LAS float*)(lds + wave * 8704);
    bf16_t* WinT = (bf16_t*)(ws + WS_WIN); bf16_t* WoutT = (bf16_t*)(ws + WS_WOUT); bf16_t* WupT = (bf16_t*)(ws + WS_WUP); bf16_t* WdT = (bf16_t*)(ws + WS_WD);
    constexpr int I_IN = 16 * 128, I_OUT = 16 * 32, I_UP = 16 * 176, I_DN = 44 * 32, NITEMS = I_IN + I_OUT + I_UP + I_DN;
    for (int it = gw; it < NITEMS; it += NGW) {
        int r = it;
        if (r < I_IN) { const int kb = r / 128, pb = r % 128; transpose_item(A.in[5], DM, INC, WinT, A.in[10], scr, 64 * kb, 32 * pb, colmap_in(32 * pb), lane); continue; } r -= I_IN;
        if (r < I_OUT) { const int kb = r / 32, pb = r % 32; transpose_item(A.in[9], DM, DM, WoutT, nullptr, scr, 64 * kb, 32 * pb, 32 * pb, lane); continue; } r -= I_OUT;
        if (r < I_UP) { const int kb = r / 176, pb = r % 176; transpose_item(A.in[12], DM, UPC, WupT, A.in[11], scr, 64 * kb, 32 * pb, colmap_up(32 * pb), lane); continue; } r -= I_UP;
        { const int kb = r / 32, pb = r % 32; transpose_item(A.in[15], DFF, DM, WdT, nullptr, scr, 64 * kb, 32 * pb, 32 * pb, lane); }
    }
    bf16_t* XB = (bf16_t*)(ws + WS_XB);
    for (int m0 = gw; m0 < TT; m0 += 4 * NGW) {
        f32x4 v[4][4];
#pragma unroll
        for (int q = 0; q < 4; ++q) {
            const int m = m0 + q * NGW;
            if (m < TT) {
                const float* xrow = m < TP ? A.in[0] + (size_t)m * DM : A.in[1] + (size_t)(m - TP) * DM;
                const f32x4* xr = (const f32x4*)xrow + lane;
#pragma unroll
                for (int j = 0; j < 4; ++j) v[q][j] = __builtin_nontemporal_load(xr + 64 * j);
            }
        }
#pragma unroll
        for (int q = 0; q < 4; ++q) {
            const int m = m0 + q * NGW;
            if (m < TT) {
                float s = 0.f;
#pragma unroll
                for (int j = 0; j < 4; ++j) s += (v[q][j][0] * v[q][j][0] + v[q][j][1] * v[q][j][1]) + (v[q][j][2] * v[q][j][2] + v[q][j][3] * v[q][j][3]);
                const float rs = 1.0f / sqrtf(wave_sum(s) * (1.0f / DM) + EPS);
#pragma unroll
                for (int j = 0; j < 4; ++j) { u32x2 w; w.x = cvt_pk_bf16(v[q][j][0] * rs, v[q][j][1] * rs); w.y = cvt_pk_bf16(v[q][j][2] * rs, v[q][j][3] * rs); *(u32x2*)(XB + kofs(TT, m, 4 * lane + 256 * j)) = w; }
            }
        }
    }
    f32x2* rope = (f32x2*)(ws + WS_ROPE);
    const int gt = blockIdx.x * NTHREADS + threadIdx.x, NGT = G * NTHREADS;
    for (int i = gt; i < SEQ * 64; i += NGT) {
        const int pos = i >> 6, d = i & 63;
        const float inv = 1.0f / powf(10000.0f, (float)d * (1.0f / 64.0f));
        const float ang = (float)pos * inv;
        float sn, cs; sn = sinf(ang); cs = cosf(ang);
        rope[i] = (f32x2){cs, sn};
    }
    if (gt < HW) { const float l0 = A.in[8][gt], l1 = A.in[8][HW + gt]; ((float*)(ws + WS_LB))[gt] = 1.0f / (1.0f + __expf(l1 - l0)); }
    bf16_t* X1B = (bf16_t*)(ws + WS_X1B); (void)X1B;
}

template <bool HG>
__device__ __forceinline__ void sample_mixer_pair(const bf16_t* Q, const bf16_t* Kx, const float* Gf, const bf16_t* V, float* O, const float* st_in, float* st_out, int id0, int id1) {
    const int tid = threadIdx.x, part = tid & 15, dvl = tid >> 4;
    float S[2][8]; int ck[2], cv[2], row0[2]; float gamma[2]; float* so[2]; size_t hb[2]; int dvi[2]; const int pk8 = part * 8;
#pragma unroll
    for (int e = 0; e < 2; ++e) {
        const int id = e ? id1 : id0, seq = (id >> 4) & 15, head = (id >> 2) & 3, slice = id & 3;
        const int dv = slice * 32 + dvl;
        const float* si = st_in + (size_t)(seq * 4 + head) * 16384; so[e] = st_out + (size_t)(seq * 4 + head) * 16384 + dv;
#pragma unroll
        for (int i = 0; i < 8; ++i) S[e][i] = si[(size_t)(part * 8 + i) * 128 + dv];
        ck[e] = head * 128 + part * 8; cv[e] = head * 128 + dv; row0[e] = TP + seq * 16; gamma[e] = 1.0f - exp2f(-5.0f - (float)head); hb[e] = (size_t)head * TT * 128; dvi[e] = dv;
    }
    constexpr int U = 2;
    u32x4 q8[2][2][U], k8[2][2][U]; f32x4 g0[2][2][U], g1[2][2][U]; unsigned short vv[2][2][U];
#define SM_LOAD(set, t0_) do { _Pragma("unroll") for (int e = 0; e < 2; ++e) _Pragma("unroll") for (int u = 0; u < U; ++u) { \
        const size_t r = (size_t)(row0[e] + (t0_) + u) * HW; const size_t rp_ = hb[e] + (size_t)(row0[e] + (t0_) + u) * 128; q8[set][e][u] = *(const u32x4*)(Q + rp_ + pk8); \
        if (HG) { g0[set][e][u] = *(const f32x4*)(Gf + r + ck[e]); g1[set][e][u] = *(const f32x4*)(Gf + r + ck[e] + 4); } else k8[set][e][u] = *(const u32x4*)(Kx + rp_ + pk8); \
        vv[set][e][u] = V[rp_ + dvi[e]]; } } while (0)
    SM_LOAD(0, 0);
#pragma unroll 1
    for (int t0 = 0; t0 < 16; t0 += 2 * U) {
#pragma unroll
        for (int set = 0; set < 2; ++set) {
            const int tb = t0 + set * U;
            { const int tn = (tb + U < 16) ? tb + U : 16 - U; if (set == 0) SM_LOAD(1, tn); else SM_LOAD(0, tn); }
#pragma unroll
            for (int u = 0; u < U; ++u)
#pragma unroll
                for (int e = 0; e < 2; ++e) {
                    const float v = bf2f(vv[set][e][u]);
                    float qf[8], kf[8], df[8];
                    const unsigned qa[4] = {q8[set][e][u].x, q8[set][e][u].y, q8[set][e][u].z, q8[set][e][u].w};
#pragma unroll
                    for (int i = 0; i < 4; ++i) { qf[2 * i] = __uint_as_float(qa[i] << 16); qf[2 * i + 1] = __uint_as_float(qa[i] & 0xffff0000u); }
                    if (HG) {
#pragma unroll
                        for (int i = 0; i < 4; ++i) { df[i] = __expf(g0[set][e][u][i]); df[4 + i] = __expf(g1[set][e][u][i]); }
#pragma unroll
                        for (int i = 0; i < 8; ++i) kf[i] = 1.0f - df[i];
                    } else {
                        const unsigned ka[4] = {k8[set][e][u].x, k8[set][e][u].y, k8[set][e][u].z, k8[set][e][u].w};
#pragma unroll
                        for (int i = 0; i < 4; ++i) { kf[2 * i] = __uint_as_float(ka[i] << 16); kf[2 * i + 1] = __uint_as_float(ka[i] & 0xffff0000u); }
#pragma unroll
                        for (int i = 0; i < 8; ++i) df[i] = gamma[e];
                    }
                    float p = 0.f;
#pragma unroll
                    for (int i = 0; i < 8; ++i) { S[e][i] = df[i] * S[e][i] + kf[i] * v; p += qf[i] * S[e][i]; }
                    p += dpp_f<0x128>(0.f, p); p += dpp_f<0x124>(0.f, p); p += dpp_f<0x122>(0.f, p); p += dpp_f<0x121>(0.f, p);
                    if (part == 0) O[(size_t)(row0[e] + tb + u) * DM + (HG ? HW : 0) + cv[e]] = p;
                }
        }
    }
#undef SM_LOAD
#pragma unroll
    for (int e = 0; e < 2; ++e)
#pragma unroll
        for (int i = 0; i < 8; ++i) so[e][(size_t)(part * 8 + i) * 128] = S[e][i];
}
__device__ __forceinline__ void phase_mixer_sample(const Args& A) {
    unsigned char* ws = A.ws;
    const bf16_t* QR = (const bf16_t*)(ws + WS_QR); const bf16_t* KR = (const bf16_t*)(ws + WS_KR); const bf16_t* VR = (const bf16_t*)(ws + WS_VR);
    const bf16_t* HQ = (const bf16_t*)(ws + WS_HQ); const bf16_t* HI = (const bf16_t*)(ws + WS_HI);
    const float* HGFv = (const float*)(ws + WS_HGFS) - (size_t)TP * HW;
    float* O = A.out + O_Y;
    const int G = gridDim.x;
    for (int pr = blockIdx.x; pr < 256; pr += G) {
        const int mixer = pr >> 7, j = pr & 127;
        if (mixer) sample_mixer_pair<true>(HQ, nullptr, HGFv, HI, O, A.in[3], A.out + O_HGS, j, j + 128);
        else sample_mixer_pair<false>(QR, KR, nullptr, VR, O, A.in[2], A.out + O_RETS, j, j + 128);
    }
}

typedef short s16x4 __attribute__((ext_vector_type(4)));
__device__ __forceinline__ bf16x8 tr2(LAS unsigned char* p0, LAS unsigned char* p1) {
    const s16x4 a = __builtin_amdgcn_ds_read_tr16_b64_v4i16((LAS s16x4*)p0);
    const s16x4 b = __builtin_amdgcn_ds_read_tr16_b64_v4i16((LAS s16x4*)p1);
    return __builtin_shufflevector(a, b, 0, 1, 2, 3, 4, 5, 6, 7);
}
#define MFMA16(a, b, c) __builtin_amdgcn_mfma_f32_16x16x32_bf16((a), (b), (c), 0, 0, 0)

constexpr int M1_KSTR = 144, M1_VSTR = 72, M1_KSZ = 64 * M1_KSTR, M1_CH = M1_KSZ + 64 * M1_VSTR, M1_BUF = 2 * M1_CH;
__device__ __forceinline__ void m1_item(const bf16_t* Kt, const bf16_t* V, const float* DECp, bf16_t* ST, float* state_out, int seq, int head, int slice, float gamma64,
                                        LAS unsigned char* lds, int w, int lane, const int pmode = 0) {
    const int tid = threadIdx.x, fr = lane & 15, g = lane >> 4, r4 = fr >> 2, c4 = fr & 3;
    const int dkh = slice >> 2, dvq = slice & 3, tk = w >> 1, tv = w & 1;
    const size_t rbase = (size_t)seq * SEQ;
    const int cb = head * 128;
    const bool vld = tid < 256;
    const bf16_t* kp = Kt + pofs(head, rbase + (tid >> 3)) + dkh * 64 + (tid & 7) * 8;
    const bf16_t* vp = V + pofs(head, rbase + (tid >> 2)) + dvq * 32 + (tid & 3) * 8;
    const int kwo = (tid >> 3) * M1_KSTR + (tid & 7) * 16, vwo = M1_KSZ + (tid >> 2) * M1_VSTR + (tid & 3) * 16;
    const int dv = dvq * 32 + tv * 16 + fr, dk0 = dkh * 64 + 16 * tk + 4 * g;
    const float* dp = DECp ? DECp + (size_t)(seq * 64) * HW + cb + dk0 : nullptr;
    u32x4 rk0[8], rv[8]; f32x4 rd[8];
#define M1_LOAD(slot, n_) do { const size_t o_ = (size_t)(n_) * 64 * 128; rk0[slot] = *(const u32x4*)(kp + o_); \
        rv[slot] = vld ? *(const u32x4*)(vp + o_) : (u32x4){0u, 0u, 0u, 0u}; rd[slot] = dp ? *(const f32x4*)(dp + (size_t)(n_) * HW) : (f32x4){gamma64, gamma64, gamma64, gamma64}; } while (0)
#define M1_WRITE(slot, off_) do { LAS unsigned char* nb_ = lds + (off_); *(LAS u32x4*)(nb_ + kwo) = rk0[slot]; \
        if (vld) { *(LAS u32x2*)(nb_ + vwo) = (u32x2){rv[slot].x, rv[slot].y}; *(LAS u32x2*)(nb_ + vwo + 8) = (u32x2){rv[slot].z, rv[slot].w}; } } while (0)
    M1_LOAD(0, 0); M1_LOAD(1, 1); M1_LOAD(2, 2); M1_LOAD(3, 3); M1_LOAD(4, 4); M1_LOAD(5, 5); M1_LOAD(6, 6); M1_LOAD(7, 7);
    M1_WRITE(0, 0); M1_WRITE(1, M1_CH);
    __syncthreads();
    f32x4 acc = (f32x4){0.f, 0.f, 0.f, 0.f};
    for (int s0 = 0; s0 < 32; s0 += 4) {
#pragma unroll
        for (int u = 0; u < 4; ++u) {
            const int n = 2 * (s0 + u);
            LAS unsigned char* buf = lds + (u & 1) * M1_BUF;
            const f32x4 dec0 = rd[2 * u], dec1 = rd[2 * u + 1];
            { const int na = (n + 8 < 64) ? n + 8 : 62; M1_LOAD(2 * u, na); M1_LOAD(2 * u + 1, na + 1); }
#pragma unroll
            for (int h = 0; h < 2; ++h) {
                if (!(pmode & 1)) { u32x2 sv; sv.x = cvt_pk_bf16(acc[0], acc[1]); sv.y = cvt_pk_bf16(acc[2], acc[3]);
                  st8(ST + ((size_t)((seq * 64 + n + h) * 4 + head) * 128 + dv) * 128 + dk0, sv); }
#pragma unroll
                for (int ks = 0; ks < 2; ++ks) if (!(pmode & 2)) {
                    LAS unsigned char* ka = buf + h * M1_CH + (32 * ks + 8 * g + r4) * M1_KSTR + 32 * tk + 8 * c4;
                    LAS unsigned char* va = buf + h * M1_CH + M1_KSZ + (32 * ks + 8 * g + r4) * M1_VSTR + 32 * tv + 8 * c4;
                    const bf16x8 af = tr2(ka, ka + 4 * M1_KSTR), bfv = tr2(va, va + 4 * M1_VSTR);
                    acc = MFMA16(af, bfv, acc);
                }
                acc = acc * (h ? dec1 : dec0);
            }
            M1_WRITE(2 * ((u + 1) & 3), ((u + 1) & 1) * M1_BUF); M1_WRITE(2 * ((u + 1) & 3) + 1, ((u + 1) & 1) * M1_BUF + M1_CH);
            __syncthreads();
        }
    }
#undef M1_LOAD
#undef M1_WRITE
    if (!pmode) {
#pragma unroll
        for (int j = 0; j < 4; ++j) state_out[(size_t)(dk0 + j) * 128 + dv] = acc[j];
    } else asm volatile("" :: "v"(acc));
}
__device__ __forceinline__ void phase_m1(const Args& A, LAS unsigned char* lds, int w, int lane, const bool dup = false) {
    unsigned char* ws = A.ws;
    bf16_t* STb = (bf16_t*)(A.out + O_Y);
    const int G = gridDim.x;
    const int vcu = (G % 8 == 0) ? (int)(blockIdx.x % 8) * (G / 8) + (int)(blockIdx.x / 8) : (int)blockIdx.x;
    for (int it = vcu; it < 256 && !((PROBE & 4096) && dup); it += G) {
        const int mixer = it >> 7, seq = (it >> 5) & 3, head = (it >> 3) & 3, slice = it & 7;
        const float gam = 1.0f - exp2f(-5.0f - (float)head);
        const float g64 = exp2f(64.0f * __log2f(gam));
        float* sout = A.out + (mixer ? O_HGP : O_RETP) + (size_t)(seq * 4 + head) * 16384;
        bf16_t* ST = STb + (size_t)mixer * 256 * 4 * 16384;
        const int pm_ = dup ? ((PROBE >> 14) & 3) : 0;
        if (mixer) m1_item((const bf16_t*)(ws + WS_HK), (const bf16_t*)(ws + WS_HI), (const float*)(ws + WS_DEC), ST, sout, seq, head, slice, 0.f, lds, w, lane, pm_);
        else m1_item((const bf16_t*)(ws + WS_KR), (const bf16_t*)(ws + WS_VR), nullptr, ST, sout, seq, head, slice, g64, lds, w, lane, pm_);
        __syncthreads();
    }
    if (!(PROBE & 8192) || !dup) phase_mixer_sample(A);
}

constexpr int M2_VSTR = 272, M2_VBUF = 64 * M2_VSTR, M2_EXCH = 8 * M2_VBUF;
__device__ __forceinline__ void m2_item(const Args& A, int seq, int n, LAS unsigned char* lds, int w, int lane) {
    unsigned char* ws = A.ws;
    int fr = lane & 15, g = lane >> 4; asm volatile("" : "+v"(fr), "+v"(g));
    const int r4 = fr >> 2, c4 = fr & 3;
    const int mixer = w >> 2, head = w & 3, cb = head * 128;
    const bf16_t* Q = (const bf16_t*)(ws + (mixer ? WS_HQ : WS_QR)); const bf16_t* K = (const bf16_t*)(ws + (mixer ? WS_HK : WS_KR));
    const bf16_t* V = (const bf16_t*)(ws + (mixer ? WS_HI : WS_VR)); const bf16_t* GT = (const bf16_t*)(ws + (mixer ? WS_HGT : WS_GR));
    const float* gain = A.in[mixer ? 7 : 6] + cb;
    const size_t r0 = (size_t)seq * SEQ + 64 * n;
    const bf16_t* ST = (const bf16_t*)(A.out + O_Y) + ((size_t)(mixer * 256 + seq * 64 + n) * 4 + head) * 16384;
    bf16_t* MG = (bf16_t*)(ws + WS_XB);
    LAS unsigned char* vb = lds + w * M2_VBUF;
    const bf16_t* qp = Q + pofs(head, r0 + fr) + 8 * g; const bf16_t* kp = K + pofs(head, r0 + fr) + 8 * g;
    u32x4 vr[16];
#pragma unroll
    for (int i = 0; i < 16; ++i) vr[i] = __builtin_nontemporal_load((const u32x4*)(V + pofs(head, r0 + 4 * i + g) + fr * 8));
    bf16x8 qf[4][4], kf[4][4];
#pragma unroll
    for (int ks = 0; ks < 4; ++ks)
#pragma unroll
        for (int t = 0; t < 4; ++t) { qf[ks][t] = *(const bf16x8*)(qp + (size_t)(16 * t) * 128 + 32 * ks); kf[ks][t] = *(const bf16x8*)(kp + (size_t)(16 * t) * 128 + 32 * ks); }
#pragma unroll
    for (int i = 0; i < 16; ++i) *(LAS u32x4*)(vb + (4 * i + g) * M2_VSTR + fr * 16) = vr[i];
    f32x4 X[4][4];
#pragma unroll
    for (int a = 0; a < 4; ++a)
#pragma unroll
        for (int b = 0; b < 4; ++b) X[a][b] = (f32x4){0.f, 0.f, 0.f, 0.f};
#pragma unroll
    for (int ks = 0; ks < 4; ++ks)
#pragma unroll
        for (int jt = 0; jt < 4; ++jt)
#pragma unroll
            for (int it = jt; it < 4; ++it) X[jt][it] = MFMA16(kf[ks][jt], qf[ks][it], X[jt][it]);
    bf16x8 PB[4][2];
#pragma unroll
    for (int it = 0; it < 4; ++it)
#pragma unroll
        for (int s2 = 0; s2 < 2; ++s2) {
            float v[8];
#pragma unroll
            for (int e = 0; e < 8; ++e) {
                const int jt = 2 * s2 + (e >> 2);
                float x = 0.f;
                if (jt < it) x = X[jt][it][e & 3];
                else if (jt == it) x = (fr >= 4 * g + (e & 3)) ? X[jt][it][e & 3] : 0.f;
                v[e] = x;
            }
            u32x4 wv; wv.x = cvt_pk_bf16(v[0], v[1]); wv.y = cvt_pk_bf16(v[2], v[3]); wv.z = cvt_pk_bf16(v[4], v[5]); wv.w = cvt_pk_bf16(v[6], v[7]);
            PB[it][s2] = __builtin_bit_cast(bf16x8, wv);
        }
    const bf16_t* sp = ST + (size_t)fr * 128 + 8 * g;
    bf16x8 sa0[2][4];
#pragma unroll
    for (int k2 = 0; k2 < 2; ++k2)
#pragma unroll
        for (int d = 0; d < 4; ++d) sa0[k2][d] = *(const bf16x8*)(sp + (size_t)(16 * d) * 128 + 32 * k2);
    f32x4 O[8][4];
#pragma unroll
    for (int a = 0; a < 8; ++a)
#pragma unroll
        for (int b = 0; b < 4; ++b) O[a][b] = (f32x4){0.f, 0.f, 0.f, 0.f};
#pragma unroll
    for (int s2 = 0; s2 < 2; ++s2)
#pragma unroll
        for (int dh = 0; dh < 2; ++dh) {
            bf16x8 vt[4];
#pragma unroll
            for (int d = 0; d < 4; ++d) { LAS unsigned char* pa = vb + (32 * s2 + 4 * g + r4) * M2_VSTR + 32 * (4 * dh + d) + 8 * c4; vt[d] = tr2(pa, pa + 16 * M2_VSTR); }
#pragma unroll
            for (int it = 2 * s2; it < 4; ++it)
#pragma unroll
                for (int d = 0; d < 4; ++d) O[4 * dh + d][it] = MFMA16(vt[d], PB[it][s2], O[4 * dh + d][it]);
            asm volatile("" ::: "memory");
        }
#pragma unroll
    for (int dh = 0; dh < 2; ++dh)
#pragma unroll
        for (int kp2 = 0; kp2 < 2; ++kp2) {
            bf16x8 qg[2][4], sa[2][4];
#pragma unroll
            for (int k2 = 0; k2 < 2; ++k2) {
#pragma unroll
                for (int t = 0; t < 4; ++t) qg[k2][t] = *(const bf16x8*)(qp + (size_t)(16 * t) * 128 + 32 * (2 * kp2 + k2));
#pragma unroll
                for (int d = 0; d < 4; ++d) sa[k2][d] = (dh == 0 && kp2 == 0) ? sa0[k2][d] : *(const bf16x8*)(sp + (size_t)(16 * (4 * dh + d)) * 128 + 32 * (2 * kp2 + k2));
            }
#pragma unroll
            for (int k2 = 0; k2 < 2; ++k2)
#pragma unroll
                for (int d = 0; d < 4; ++d)
#pragma unroll
                    for (int it = 0; it < 4; ++it) O[4 * dh + d][it] = MFMA16(sa[k2][d], qg[k2][it], O[4 * dh + d][it]);
            asm volatile("" ::: "memory");
        }
    u32x2 gtr[4][8];
#pragma unroll
    for (int it = 0; it < 4; ++it)
#pragma unroll
        for (int d = 0; d < 8; ++d) gtr[it][d] = *(const u32x2*)(GT + pofs(head, r0 + 16 * it + fr) + 4 * g + 16 * d);
    float rs[4];
    LAS float* exch = (LAS float*)(lds + M2_EXCH);
#pragma unroll
    for (int it = 0; it < 4; ++it) {
        float ss = 0.f;
#pragma unroll
        for (int d = 0; d < 8; ++d) ss += (O[d][it][0] * O[d][it][0] + O[d][it][1] * O[d][it][1]) + (O[d][it][2] * O[d][it][2] + O[d][it][3] * O[d][it][3]);
        ss += __shfl_xor(ss, 16); ss += __shfl_xor(ss, 32);
        rs[it] = ss;
        if (mixer && g == 0) exch[(16 * it + fr) * 4 + head] = ss;
    }
    __syncthreads();
#pragma unroll
    for (int it = 0; it < 4; ++it) {
        if (mixer) { const f32x4 e = *(LAS f32x4*)(exch + (16 * it + fr) * 4); rs[it] = 1.0f / sqrtf(((e[0] + e[1]) + (e[2] + e[3])) * (1.0f / 512.0f) + EPS); }
        else rs[it] = 1.0f / sqrtf(rs[it] * (1.0f / 128.0f) + EPS);
    }
#pragma unroll
    for (int it = 0; it < 4; ++it) {
        int rowi = 16 * it + fr; asm volatile("" : "+v"(rowi));
        const size_t row = r0 + rowi;
        bf16_t* mrow = MG + ((size_t)(mixer * 8 + head * 2) * TT + row) * 64 + 4 * g;
        const float rsi = rs[it];
#pragma unroll
        for (int d = 0; d < 8; ++d) {
            const f32x4 gn = *(const f32x4*)(gain + 16 * d + 4 * g);
            const u32x2 gt = gtr[it][d];
            const float g0 = silu_f(__uint_as_float(gt.x << 16)), g1 = silu_f(__uint_as_float(gt.x & 0xffff0000u)), g2 = silu_f(__uint_as_float(gt.y << 16)), g3 = silu_f(__uint_as_float(gt.y & 0xffff0000u));
            const f32x4 o = O[d][it] * rsi * gn;
            u32x2 wv; wv.x = cvt_pk_bf16(o[0] * g0, o[1] * g1); wv.y = cvt_pk_bf16(o[2] * g2, o[3] * g3);
            st8(mrow + (size_t)(d >> 2) * TT * 64 + 16 * (d & 3), wv);
        }
    }
}
__device__ __forceinline__ void phase_normgate_sample(const Args& A, int wave, int lane) {
    unsigned char* ws = A.ws;
    const float* O = A.out + O_Y;
    const bf16_t* GR = (const bf16_t*)(ws + WS_GR); const bf16_t* HGT = (const bf16_t*)(ws + WS_HGT);
    bf16_t* MG = (bf16_t*)(ws + WS_XB);
    const int gw = blockIdx.x * NWAVES + wave, NGW = gridDim.x * NWAVES;
    const bool hg = lane >= 32; const int c0 = lane * 16;
    const float* gain = hg ? A.in[7] + (c0 - HW) : A.in[6] + c0;
    f32x4 gn[4];
#pragma unroll
    for (int j = 0; j < 4; ++j) gn[j] = *(const f32x4*)(gain + 4 * j);
    for (int m = TP + gw; m < TT; m += NGW) {
        const f32x4* orow = (const f32x4*)(O + (size_t)m * DM + c0);
        f32x4 v[4]; float s = 0.f;
#pragma unroll
        for (int j = 0; j < 4; ++j) { v[j] = orow[j]; s += (v[j][0] * v[j][0] + v[j][1] * v[j][1]) + (v[j][2] * v[j][2] + v[j][3] * v[j][3]); }
        s += __shfl_xor(s, 1); s += __shfl_xor(s, 2); s += __shfl_xor(s, 4);
        float s2 = s; s2 += __shfl_xor(s2, 8); s2 += __shfl_xor(s2, 16);
        const float rs = hg ? 1.0f / sqrtf(s2 * (1.0f / 512.0f) + EPS) : 1.0f / sqrtf(s * (1.0f / 128.0f) + EPS);
        const bf16_t* gp = (hg ? HGT + pofs((c0 - HW) >> 7, m) + ((c0 - HW) & 127) : GR + pofs(c0 >> 7, m) + (c0 & 127));
        const u32x4 ga = *(const u32x4*)gp, gb = *(const u32x4*)(gp + 8);
        const unsigned gw_[8] = {ga.x, ga.y, ga.z, ga.w, gb.x, gb.y, gb.z, gb.w};
        float o[16];
#pragma unroll
        for (int i = 0; i < 8; ++i) { const float g0 = silu_f(__uint_as_float(gw_[i] << 16)), g1 = silu_f(__uint_as_float(gw_[i] & 0xffff0000u));
            o[2 * i] = v[(2 * i) >> 2][(2 * i) & 3] * rs * gn[(2 * i) >> 2][(2 * i) & 3] * g0; o[2 * i + 1] = v[(2 * i + 1) >> 2][(2 * i + 1) & 3] * rs * gn[(2 * i + 1) >> 2][(2 * i + 1) & 3] * g1; }
        u32x4 w0, w1;
        w0.x = cvt_pk_bf16(o[0], o[1]); w0.y = cvt_pk_bf16(o[2], o[3]); w0.z = cvt_pk_bf16(o[4], o[5]); w0.w = cvt_pk_bf16(o[6], o[7]);
        w1.x = cvt_pk_bf16(o[8], o[9]); w1.y = cvt_pk_bf16(o[10], o[11]); w1.z = cvt_pk_bf16(o[12], o[13]); w1.w = cvt_pk_bf16(o[14], o[15]);
        bf16_t* mp = MG + kofs(TT, m, c0);
        *(u32x4*)mp = w0; *(u32x4*)(mp + 8) = w1;
    }
}
__device__ __forceinline__ void phase_m2(const Args& A, LAS unsigned char* lds, int w, int lane) {
    const int G = gridDim.x;
    for (int it = blockIdx.x; it < 256; it += G) { m2_item(A, it >> 6, it & 63, lds, w, lane); __syncthreads(); }
    phase_normgate_sample(A, w, lane);
}
__device__ __forceinline__ void phase_final(const Args& A, int wave, int lane) {
    const float* SS3 = (const float*)(A.ws + WS_SS3);
    const int gw = blockIdx.x * NWAVES + wave, NGW = gridDim.x * NWAVES;
    f32x4 gn[4];
#pragma unroll
    for (int j = 0; j < 4; ++j) gn[j] = ((const f32x4*)A.in[16])[lane + 64 * j];
    for (int m = gw; m < TP; m += NGW) {
        float p = lane < 16 ? SS3[(size_t)m * 16 + lane] : 0.f;
        p = wave_sum(p);
        const float rs = 1.0f / sqrtf(p * (1.0f / DM) + EPS);
        f32x4* xr = (f32x4*)(A.out + O_Y + (size_t)m * DM) + lane;
#pragma unroll
        for (int j = 0; j < 4; ++j) { f32x4 v = xr[64 * j]; v = v * rs * gn[j]; xr[64 * j] = v; }
    }
}

__global__ void __launch_bounds__(NTHREADS, 2) fwd_kernel(Args args) {
    extern __shared__ __attribute__((aligned(16))) unsigned char lds_raw[];
    LAS unsigned char* lds = (LAS unsigned char*)lds_raw;
    const int tid = threadIdx.x, wave = __builtin_amdgcn_readfirstlane(tid >> 6);
    volatile LAS unsigned* MISC = (volatile LAS unsigned*)(lds + MISC_OFF);
    if (tid < 64) MISC[tid] = 0u;
    __syncthreads();
    unsigned char* ws = args.ws;
    XcdBarrier bar; bar.bar = (unsigned*)(ws + WS_CTL); bar.x = 0; bar.st = nullptr;
    if (N_LAUNCHES == 1) bar = xcd_barrier_post((unsigned*)(ws + WS_CTL), MISC + 8);
    const int lo = args.ph_lo, hi = args.ph_hi;
#define IN(k) (lo <= (k) && (k) < hi)
#define SEAM(k) do { if (IN(k) && IN((k) + 1)) { xcd_barrier(bar); if (PROBE & 256) xcd_barrier(bar); } } while (0)
    const int G = gridDim.x, c = blockIdx.x;

    if (IN(0)) { phase_prep(args, lds, wave, fresh_lane()); if (PROBE & 64) { __syncthreads(); phase_prep(args, lds, wave, fresh_lane()); } } SEAM(0);
    if (IN(1)) {
        pg8::Gemm g{(const bf16_t*)(ws + WS_XB), (const bf16_t*)(ws + WS_WIN), DM, TT}; pg8::StaticOrder S; S.init(64, 16, G, c);
        EpiIn E{ws + WS_PROJ, (float*)(ws + WS_DEC), (float*)(ws + WS_HGFS), (const f32x4*)(ws + WS_ROPE), (const float*)(ws + WS_LB)};
        pg8::gemm_phase<EpiIn, false>(lds, g, S, E);
        pg8::sample_gemm<EpiIn>(lds, g.A, TT, TP, g.Bt, DM, 16, 64, E, c, G);
        if (PROBE & 2) { pg8::gemm_phase<EpiIn, false>(lds, g, S, E); }
    } SEAM(1);
    if (IN(2)) { phase_m1(args, lds, wave, fresh_lane()); if (PROBE & (16 | 4096 | 8192)) { __syncthreads(); phase_m1(args, lds, wave, fresh_lane(), true); } } SEAM(2);
    if (IN(3)) { phase_m2(args, lds, wave, fresh_lane()); if (PROBE & 32) { __syncthreads(); phase_m2(args, lds, wave, fresh_lane()); } } SEAM(3);
    if (IN(4)) {
        { bf16_t* X1B = (bf16_t*)(ws + WS_X1B); const int gt = c * NTHREADS + tid;
          if (gt < 4 * 256) { const int b = gt >> 8, w = gt & 255; *(u32x4*)(X1B + kofs(X1B_ROWS, 4098 * b + (w >> 7), (w & 127) * 8)) = (u32x4){0u, 0u, 0u, 0u}; } }
        pg8::Gemm g{(const bf16_t*)(ws + WS_XB), (const bf16_t*)(ws + WS_WOUT), DM, TT}; pg8::StaticOrder S; S.init(64, 4, G, c);
        EpiOut E{args.in[0], args.in[1], args.out + O_Y, (bf16_t*)(ws + WS_X1B), (float*)(ws + WS_SS2)};
        pg8::gemm_phase<EpiOut, false>(lds, g, S, E);
        pg8::sample_gemm16<EpiOut>(lds, g.A, TT, TP, g.Bt, DM, 4, 64, E, c, G);
        if (PROBE & 4) { pg8::gemm_phase<EpiOut, false>(lds, g, S, E); }
    } SEAM(4);
    if (IN(5)) {
        pg8::Gemm g{(const bf16_t*)(ws + WS_X1B), (const bf16_t*)(ws + WS_WUP), DM, X1B_ROWS}; pg8::StaticOrder S; S.init(68, 22, G, c);
        EpiUp E{(const float*)(ws + WS_SS2), args.in[13], args.in[14], args.in[4], (bf16_t*)(ws + WS_ACT), args.out + O_CCP, args.out + O_CCS};
        pg8::gemm_phase<EpiUp, true>(lds, g, S, E);
        {
            const int njobs = 22 * 16, rem = (68 * 22) % G, nidle = rem ? G - rem : 0, pre = (nidle >= 32 && 3 * nidle < njobs) ? 3 * nidle : 0;
            if (pre && c >= rem) pg8::sample_gemm<EpiUp>(lds, g.A, X1B_ROWS, 16394, g.Bt, DM, 22, 68, E, c - rem, nidle, pre);
            pg8::sample_gemm<EpiUp>(lds, g.A, X1B_ROWS, 16394, g.Bt, DM, 22, 68, E, pre + c, G, njobs);
        }
        if (PROBE & 8) { pg8::gemm_phase<EpiUp, true>(lds, g, S, E); }
    } SEAM(5);
    if (IN(6)) {
        pg8::Gemm g{(const bf16_t*)(ws + WS_ACT), (const bf16_t*)(ws + WS_WD), DFF, TT}; pg8::StaticOrder S; S.init(64, 4, G, c);
        EpiDownT<true> E{args.out + O_Y, (const bf16_t*)(ws + WS_X1B), (float*)(ws + WS_SS3), args.in[16], (float*)(ws + WS_SS3), (unsigned*)(ws + WS_CTL + 32768), lds + RING_BYTES};
        EpiDownT<false> Es{args.out + O_Y, (const bf16_t*)(ws + WS_X1B), (float*)(ws + WS_SS3), args.in[16], nullptr, (unsigned*)(ws + WS_CTL + 32768), lds};
        if (PROBE & 2048) { EpiNull En; pg8::gemm_phase<EpiNull, false>(lds, g, S, En); }
        if (G == 256) pg8::gemm_phase<EpiDownT<true>, false>(lds, g, S, E);
        else pg8::gemm_phase<EpiDownT<false>, false>(lds, g, S, Es);
        pg8::sample_gemm16<EpiDownT<false>>(lds, g.A, TT, TP, g.Bt, DFF, 4, 64, Es, c, G);
    }
    if (G != 256) {
        SEAM(6);
        if (IN(7)) { phase_final(args, wave, fresh_lane()); }
    }
#undef IN
#undef SEAM
}

extern "C" void kernel_launch(void* const* d_in, const int* in_sizes, int n_in, void* d_out, int out_size, void* d_ws, size_t ws_size, hipStream_t stream) {
    static int grid = 0;
    if (grid == 0) {
        if (n_in != 17 || ws_size < WS_END) { fprintf(stderr, "kernel_launch: unexpected n_in %d or ws_size %zu (need %zu)\n", n_in, ws_size, (size_t)WS_END); grid = -1; return; }
        int dev = 0, cus = 0, per_cu = 0;
        hipGetDevice(&dev); hipDeviceGetAttribute(&cus, hipDeviceAttributeMultiprocessorCount, dev);
        hipFuncSetAttribute((const void*)fwd_kernel, hipFuncAttributeMaxDynamicSharedMemorySize, LDS_BYTES);
        hipOccupancyMaxActiveBlocksPerMultiprocessor(&per_cu, (const void*)fwd_kernel, NTHREADS, LDS_BYTES);
        if (per_cu < 1) { fprintf(stderr, "kernel_launch: occupancy query says %d blocks per CU\n", per_cu); per_cu = 1; }
        (void)hipGetLastError();
        grid = cus;
        if (grid > 256) grid = 256;
        fprintf(stderr, "kernel_launch: cus %d per_cu %d grid %d ws %zu\n", cus, per_cu, grid, ws_size);
    }
    if (grid < 0) return;
    hipMemsetAsync((char*)d_ws + WS_CTL, 0, 65536, stream);
    Args a{};
    for (int i = 0; i < 17; ++i) a.in[i] = (const float*)d_in[i];
    a.out = (float*)d_out; a.ws = (unsigned char*)d_ws;
    if (N_LAUNCHES == 1) {
        a.ph_lo = 0; a.ph_hi = 8;
        void* kargs[] = {&a};
#if PROBE & 1024
        hipLaunchKernelGGL(fwd_kernel, dim3(grid), dim3(NTHREADS), LDS_BYTES, stream, a); hipError_t e = hipSuccess; (void)kargs;
#else
        hipError_t e = hipLaunchCooperativeKernel((const void*)fwd_kernel, dim3(grid), dim3(NTHREADS), kargs, LDS_BYTES, stream);
#endif
        if (e != hipSuccess) fprintf(stderr, "cooperative launch failed: %s (grid %d)\n", hipGetErrorString(e), grid);
    } else {
        for (int p = 0; p < 8; ++p) { a.ph_lo = p; a.ph_hi = p + 1; hipLaunchKernelGGL(fwd_kernel, dim3(grid), dim3(NTHREADS), LDS_BYTES, stream, a); }
    }
}
```

```cpp
#include <hip/hip_runtime.h>
#include <cstdio>
#include <cstdint>

#ifndef PROBE
#define PROBE 0
#endif
#ifndef N_LAUNCHES
#define N_LAUNCHES 1
#endif

#define LAS __attribute__((address_space(3)))
typedef unsigned short bf16_t;
typedef short bf16x8 __attribute__((ext_vector_type(8)));
typedef float f32x4 __attribute__((ext_vector_type(4)));
typedef float f32x2 __attribute__((ext_vector_type(2)));
typedef unsigned u32x4 __attribute__((ext_vector_type(4)));
typedef unsigned u32x2 __attribute__((ext_vector_type(2)));

constexpr int DM = 1024, TP = 16384, TS = 256, TT = TP + TS, SEQ = 4096;
constexpr int DFF = 2816, UPC = 5632, INC = 4096, HW = 512;
constexpr float EPS = 1e-6f;
constexpr int NTHREADS = 512, NWAVES = 8;
constexpr int LDS_BYTES = 163840;
constexpr int RING_BYTES = 131072;
constexpr int MISC_OFF = LDS_BYTES - 256;

constexpr size_t O_Y = 0, O_RETP = 17039360, O_HGP = 17301504, O_CCP = 17563648, O_RETS = 17586176, O_HGS = 18634752, O_CCS = 19683328;

constexpr size_t WS_CTL = 0;
constexpr size_t WS_WIN = 65536;
constexpr size_t WS_WOUT = WS_WIN + (size_t)INC * DM * 2;
constexpr size_t WS_WUP = WS_WOUT + (size_t)DM * DM * 2;
constexpr size_t WS_WD = WS_WUP + (size_t)UPC * DM * 2;
constexpr size_t WS_ROPE = WS_WD + (size_t)DM * DFF * 2;
constexpr size_t WS_LB = WS_ROPE + (size_t)SEQ * 64 * 8;
constexpr size_t WS_SS2 = WS_LB + 4096;
constexpr size_t WS_SS3 = WS_SS2 + (size_t)TT * 16 * 4;
constexpr size_t WS_XB = WS_SS3 + (size_t)TT * 16 * 4;
constexpr size_t WS_PROJ = WS_XB + (size_t)TT * DM * 2;
constexpr size_t PSZ = (size_t)TT * HW * 2;
constexpr size_t WS_QR = WS_PROJ, WS_KR = WS_PROJ + PSZ, WS_VR = WS_PROJ + 2 * PSZ, WS_GR = WS_PROJ + 3 * PSZ, WS_HQ = WS_PROJ + 4 * PSZ,
                 WS_HK = WS_PROJ + 5 * PSZ, WS_HI = WS_PROJ + 6 * PSZ, WS_HGT = WS_PROJ + 7 * PSZ;
constexpr size_t WS_DEC = WS_PROJ + 8 * PSZ;
constexpr size_t WS_HGFS = WS_DEC + (size_t)256 * HW * 4;
constexpr size_t WS_PROJ_END = WS_HGFS + (size_t)TS * HW * 4;
constexpr int X1B_ROWS = 16896;
constexpr size_t WS_X1B = WS_PROJ;
constexpr size_t WS_ACT = WS_X1B + (size_t)X1B_ROWS * DM * 2;
constexpr size_t WS_ACT_END = WS_ACT + (size_t)TT * DFF * 2;
static_assert(WS_ACT_END <= WS_PROJ_END, "overlay");
constexpr size_t WS_END = WS_PROJ_END;
static_assert(WS_END <= (size_t)256 * 1024 * 1024, "workspace");

__device__ __forceinline__ size_t pofs(int head, size_t row) { return ((size_t)head * TT + row) * 128; }
__device__ __forceinline__ unsigned cvt_pk_bf16(float lo, float hi) { unsigned r; asm volatile("v_cvt_pk_bf16_f32 %0, %1, %2" : "=v"(r) : "v"(lo), "v"(hi)); return r; }
__device__ __forceinline__ int fresh_lane() { int l; asm volatile("v_mbcnt_lo_u32_b32 %0, -1, 0\n\tv_mbcnt_hi_u32_b32 %0, -1, %0" : "=v"(l)); return l; }
__device__ __forceinline__ float bf2f(unsigned short b) { return __uint_as_float(((unsigned)b) << 16); }
__device__ __forceinline__ float sigmoid_f(float x) { return __builtin_amdgcn_rcpf(1.0f + __builtin_amdgcn_exp2f(x * -1.4426950408889634f)); }
__device__ __forceinline__ float silu_f(float x) { return x * sigmoid_f(x); }
#ifndef WT_STORES
#define WT_STORES 0
#endif
__device__ __forceinline__ void st16(void* p, u32x4 v) {
#if WT_STORES == 1
    asm volatile("global_store_dwordx4 %0, %1, off sc1\n\ts_nop 1" :: "v"(p), "v"(v) : "memory");
#elif WT_STORES == 2
    __builtin_nontemporal_store(v, (u32x4*)p);
#else
    *(u32x4*)p = v;
#endif
}
__device__ __forceinline__ void st8(void* p, u32x2 v) {
#if WT_STORES == 1
    asm volatile("global_store_dwordx2 %0, %1, off sc1\n\ts_nop 1" :: "v"(p), "v"(v) : "memory");
#elif WT_STORES == 2
    __builtin_nontemporal_store(v, (u32x2*)p);
#else
    *(u32x2*)p = v;
#endif
}
template <int CTRL> __device__ __forceinline__ float dpp_z(float src) {
    return __builtin_bit_cast(float, __builtin_amdgcn_update_dpp(0, __builtin_bit_cast(int, src), CTRL, 0xF, 0xF, true)); }
template <int CTRL> __device__ __forceinline__ float dpp_f(float oldv, float src) {
    return __builtin_bit_cast(float, __builtin_amdgcn_update_dpp(__builtin_bit_cast(int, oldv), __builtin_bit_cast(int, src), CTRL, 0xF, 0xF, false)); }

#define XB_TMO      128
#define XB_XCNT(j)  (256  + 64 * (j))
#define XB_XSUB(j)  (1280 + 64 * (j))
#define XB_XGEN(j)  (2304 + 64 * (j))
#define XB_TOP      3328
#define XB_TOPGEN   3392
#define XCD_BAR_WORDS 3456
#define XB_SPIN_CAP (1u << 18)
__device__ __forceinline__ unsigned xb_ld(unsigned* p)              { return __hip_atomic_load(p, __ATOMIC_RELAXED, __HIP_MEMORY_SCOPE_AGENT); }
__device__ __forceinline__ unsigned xb_add(unsigned* p, unsigned v) { return __hip_atomic_fetch_add(p, v, __ATOMIC_RELAXED, __HIP_MEMORY_SCOPE_AGENT); }
__device__ __forceinline__ unsigned xb_xcc_id() { return (unsigned)__builtin_amdgcn_s_getreg((3 << 11) | 20) & 0xFu; }
#define XB_SPIN(cond, bar) do { unsigned _sp = 0; while (cond) { __builtin_amdgcn_s_sleep(1); \
    if ((++_sp & 255u) == 0u) { if (xb_ld(&(bar)[XB_TMO])) break; if (_sp > XB_SPIN_CAP) { atomicAdd(&(bar)[XB_TMO], 1u); break; } } } } while (0)
struct XcdBarrier { unsigned* bar; unsigned x; volatile LAS unsigned* st; };
__device__ __forceinline__ XcdBarrier xcd_barrier_post(unsigned* bar, volatile LAS unsigned* st) {
    XcdBarrier b; b.bar = bar; b.x = xb_xcc_id(); b.st = st;
    if (threadIdx.x == 0) (void)xb_add(&bar[XB_XCNT(b.x)], 1u);
    return b;
}
__device__ __forceinline__ void xcd_barrier_complete(unsigned* bar, unsigned x, unsigned& nloc, unsigned& nx) {
    const unsigned G = gridDim.x * gridDim.y * gridDim.z;
    unsigned sum, cnt, mine, sp = 0u;
    for (;;) {
        sum = 0u; cnt = 0u; mine = 0u;
#pragma unroll
        for (unsigned j = 0; j < 16; ++j) { const unsigned c = xb_ld(&bar[XB_XCNT(j)]); sum += c; cnt += (c > 0u) ? 1u : 0u; mine = (j == x) ? c : mine; }
        if (sum == G) break;
        __builtin_amdgcn_s_sleep(1);
        if ((++sp & 255u) == 0u) { if (xb_ld(&bar[XB_TMO])) break; if (sp > XB_SPIN_CAP) { atomicAdd(&bar[XB_TMO], 1u); break; } }
    }
    nloc = mine > 0u ? mine : 1u; nx = cnt > 0u ? cnt : 1u;
}
__device__ __forceinline__ void xcd_barrier(const XcdBarrier& b) {
    asm volatile("s_waitcnt vmcnt(0)" ::: "memory");
    __syncthreads();
    if (threadIdx.x == 0) {
        unsigned* bar = b.bar;
        __builtin_amdgcn_s_waitcnt(0);
        unsigned nloc = b.st[0], nx = b.st[1];
        if (nloc == 0u) { xcd_barrier_complete(bar, b.x, nloc, nx); b.st[0] = nloc; b.st[1] = nx; }
        const unsigned old = xb_add(&bar[XB_XSUB(b.x)], 1u);
        const unsigned gen = old / nloc;
        if (old + 1u == (gen + 1u) * nloc) {
            __builtin_amdgcn_fence(__ATOMIC_RELEASE, "agent");
            asm volatile("s_waitcnt vmcnt(0)" ::: "memory");
            const unsigned og = xb_add(&bar[XB_TOP], 1u);
            const unsigned tg = og / nx;
            if (og + 1u == (tg + 1u) * nx) xb_add(&bar[XB_TOPGEN], 1u);
            else XB_SPIN(xb_ld(&bar[XB_TOPGEN]) == tg, bar);
            __builtin_amdgcn_fence(__ATOMIC_ACQUIRE, "agent");
            xb_add(&bar[XB_XGEN(b.x)], 1u);
            asm volatile("s_waitcnt vmcnt(0)" ::: "memory");
        } else {
            XB_SPIN(xb_ld(&bar[XB_XGEN(b.x)]) == gen, bar);
            __builtin_amdgcn_fence(__ATOMIC_ACQUIRE, "agent");
            asm volatile("s_waitcnt vmcnt(0)" ::: "memory");
        }
    }
    __syncthreads();
}

namespace pg8 {
constexpr int BM = 256, BK = 64, HALF = 128, HTB = HALF * BK * 2, NXCD = 8, WGM = 8;
__host__ __device__ __forceinline__ int lds_byte(int r, int c) { const int st = (r >> 4) * 2 + (c >> 5), rr = r & 15, cc = c & 31, ob = rr * 64 + cc * 2; return st * 1024 + (ob ^ (((ob >> 9) & 1) << 5)); }
__host__ __device__ __forceinline__ void stage_rc(int b, int& R, int& C) { const int st = b / 1024, sb = b % 1024, swz = sb ^ (((sb >> 9) & 1) << 5); R = (st >> 1) * 16 + swz / 64; C = (st & 1) * 32 + (swz % 64) / 2; }
__host__ __device__ __forceinline__ int perm32(int rho) { const int n = rho >> 4, i = rho & 15; return 8 * (i >> 2) + 4 * n + (i & 3); }

struct Unit { int pm, pn; };
struct Gemm { const bf16_t* A; const bf16_t* Bt; int K; };

struct StaticOrder {
    int nM, nN, nwg, G, c;
    __device__ void init(int nM_, int nN_, int G_, int c_) { nM = nM_; nN = nN_; nwg = nM * nN; G = G_; c = c_; }
    __device__ bool next(int i, Unit& u) const {
        const long L = (long)i * G + c; if (L >= nwg) return false;
        int wgid = (int)L; { const int q = nwg / NXCD, r = nwg % NXCD, xcd = wgid % NXCD, off = wgid / NXCD; wgid = (xcd < r ? xcd * (q + 1) : r * (q + 1) + (xcd - r) * q) + off; }
        const int nig = WGM * nN, gid = wgid / nig, fm = gid * WGM, gsz = (nM - fm) < WGM ? (nM - fm) : WGM;
        u.pm = fm + ((wgid % nig) % gsz); u.pn = (wgid % nig) / gsz; return true;
    }
};

struct AInfo { const char* base; size_t hstep; unsigned v0, v1; };
template <bool UPMAP>
__device__ __forceinline__ AInfo a_info(const Gemm& g, const Unit& u, int tid) {
    AInfo a; const int K = g.K;
    int R0, C0, R1, C1; stage_rc(tid * 16, R0, C0); stage_rc(tid * 16 + 8192, R1, C1);
    if constexpr (!UPMAP) {
        a.base = (const char*)g.A + (size_t)u.pm * 256 * K * 2; a.hstep = (size_t)HALF * K * 2;
        a.v0 = (unsigned)(R0 * K + C0) * 2u; a.v1 = (unsigned)(R1 * K + C1) * 2u;
    } else {
        if (u.pm < 68) {
            const int b = u.pm / 17, j = u.pm % 17;
            a.base = (const char*)g.A + (size_t)(4098 * b + 248 * j) * K * 2; a.hstep = (size_t)124 * K * 2;
            a.v0 = (unsigned)((R0 - 2 * (R0 >> 6)) * K + C0) * 2u; a.v1 = (unsigned)((R1 - 2 * (R1 >> 6)) * K + C1) * 2u;
        } else {
            a.base = (const char*)g.A + (size_t)16394 * K * 2; a.hstep = (size_t)HALF * K * 2;
            a.v0 = (unsigned)(R0 * K + C0) * 2u; a.v1 = (unsigned)(R1 * K + C1) * 2u;
        }
    }
    return a;
}

template <class Epi, bool UPMAP>
__device__ __forceinline__ void gemm_phase(LAS unsigned char* lds, const Gemm g, const StaticOrder& S, const Epi& E) {
    const int tid = threadIdx.x, wid = __builtin_amdgcn_readfirstlane(tid >> 6), lane = tid & 63, wr = wid >> 2, wc = wid & 3, fr = lane & 15, fq = lane >> 4;
    const int K = g.K, nt = K / BK;
    unsigned voffB[2];
#pragma unroll
    for (int i = 0; i < 2; ++i) { int R, C; stage_rc(tid * 16 + i * 8192, R, C); const int Rb = (R & ~31) + perm32(R & 31); voffB[i] = (unsigned)(Rb * K + C) * 2u; }
    const size_t kstep = (size_t)(BK * 2);
    const size_t hstepB = (size_t)HALF * K * 2;
    const size_t tstepB = 2 * hstepB;
    const unsigned ldsw = (unsigned)wid * 1024u;
    const int aoff = lds_byte(wr * 64 + fr, fq * 8), boff = lds_byte(wc * 32 + fr, fq * 8);
#define PG8_SA(b, h) (((b) * 2 + (h)) * HTB)
#define PG8_SB(b, h) ((4 + (b) * 2 + (h)) * HTB)
#define PG8_STAGEB(bufoff, gbase) do { _Pragma("unroll") for (int _i = 0; _i < 2; ++_i) \
        __builtin_amdgcn_global_load_lds((const unsigned*)((const char*)(gbase) + voffB[_i]), (LAS unsigned*)(lds + (bufoff) + ldsw + _i * 8192), 16, 0, 0); } while (0)
#define PG8_STAGEA(bufoff, gbase, va0, va1) do { \
        __builtin_amdgcn_global_load_lds((const unsigned*)((const char*)(gbase) + (va0)), (LAS unsigned*)(lds + (bufoff) + ldsw), 16, 0, 0); \
        __builtin_amdgcn_global_load_lds((const unsigned*)((const char*)(gbase) + (va1)), (LAS unsigned*)(lds + (bufoff) + ldsw + 8192), 16, 0, 0); } while (0)
#define PG8_LDA(dst, b, h) do { _Pragma("unroll") for (int m = 0; m < 4; ++m) _Pragma("unroll") for (int k = 0; k < 2; ++k) dst[m][k] = *(const LAS bf16x8*)(lds + PG8_SA(b, h) + aoff + m * 2048 + k * 1024); } while (0)
#define PG8_LDB(dst, b, h) do { _Pragma("unroll") for (int n = 0; n < 2; ++n) _Pragma("unroll") for (int k = 0; k < 2; ++k) dst[n][k] = *(const LAS bf16x8*)(lds + PG8_SB(b, h) + boff + n * 2048 + k * 1024); } while (0)
#define PG8_MMA(ai, bj, At, Bt) do { __builtin_amdgcn_s_setprio(1); _Pragma("unroll") for (int m = 0; m < 4; ++m) _Pragma("unroll") for (int n = 0; n < 2; ++n) _Pragma("unroll") for (int k = 0; k < 2; ++k) \
        acc[ai][bj][m][n] = __builtin_amdgcn_mfma_f32_16x16x32_bf16(Bt[n][k], At[m][k], acc[ai][bj][m][n], 0, 0, 0); __builtin_amdgcn_s_setprio(0); } while (0)
#define PG8_WAIT_V(n) asm volatile("s_waitcnt vmcnt(" #n ")" ::: "memory")
#define PG8_WAIT_L(n) asm volatile("s_waitcnt lgkmcnt(" #n ")" ::: "memory")
#define PG8_BAR __builtin_amdgcn_s_barrier()
#define PG8_SCHED __builtin_amdgcn_sched_barrier(0)
    Unit cur, nxt; int ui = 0;
    if (!S.next(0, cur)) return;
    f32x4 acc[2][2][4][2];
#pragma unroll
    for (int a = 0; a < 2; ++a)
#pragma unroll
        for (int b = 0; b < 2; ++b)
#pragma unroll
            for (int m = 0; m < 4; ++m)
#pragma unroll
                for (int n = 0; n < 2; ++n) acc[a][b][m][n] = (f32x4){0.f, 0.f, 0.f, 0.f};
    bf16x8 At[4][2], B0[2][2], B1[2][2];
    AInfo ca = a_info<UPMAP>(g, cur, tid);
    const char* cA = ca.base; const char* cB = (const char*)g.Bt + (size_t)cur.pn * tstepB;
    PG8_STAGEB(PG8_SB(0, 0), cB); PG8_STAGEB(PG8_SB(0, 1), cB + hstepB); PG8_STAGEA(PG8_SA(0, 0), cA, ca.v0, ca.v1); PG8_STAGEA(PG8_SA(0, 1), cA + ca.hstep, ca.v0, ca.v1);
    if (wr == 1) PG8_BAR;
    PG8_WAIT_V(2); PG8_BAR;
    PG8_STAGEB(PG8_SB(1, 0), cB + kstep); PG8_STAGEA(PG8_SA(1, 0), cA + kstep, ca.v0, ca.v1); PG8_STAGEB(PG8_SB(1, 1), cB + hstepB + kstep);
    PG8_WAIT_V(6); PG8_BAR;
    for (;;) {
        const bool has_next = S.next(ui + 1, nxt);
        AInfo na = ca; if (has_next) na = a_info<UPMAP>(g, nxt, tid);
        const char* nA = na.base; const char* nB = has_next ? (const char*)g.Bt + (size_t)nxt.pn * tstepB : cB;
        for (int t = 0; t < nt; t += 2) {
            const bool last = (t == nt - 2);
            const char* a1 = cA + (size_t)(t + 1) * kstep;
            const char* a2 = last ? nA : cA + (size_t)(t + 2) * kstep; const char* b2 = last ? nB : cB + (size_t)(t + 2) * kstep;
            const char* a3 = a2 + kstep; const char* b3 = b2 + kstep;
            const size_t h2 = last ? na.hstep : ca.hstep; const unsigned w0 = last ? na.v0 : ca.v0, w1 = last ? na.v1 : ca.v1;
            PG8_LDB(B0, 0, 0); PG8_LDB(B1, 0, 1); PG8_SCHED; PG8_LDA(At, 0, 0); PG8_STAGEA(PG8_SA(1, 1), a1 + ca.hstep, ca.v0, ca.v1);
            PG8_WAIT_V(8); PG8_WAIT_L(0); PG8_BAR; PG8_MMA(0, 0, At, B0); PG8_MMA(0, 1, At, B1); PG8_BAR; PG8_SCHED;
            PG8_LDA(At, 0, 1); PG8_STAGEB(PG8_SB(0, 0), b2); PG8_STAGEB(PG8_SB(0, 1), b2 + hstepB); PG8_STAGEA(PG8_SA(0, 0), a2, w0, w1);
            PG8_WAIT_V(8); PG8_WAIT_L(0); PG8_BAR; PG8_MMA(1, 0, At, B0); PG8_MMA(1, 1, At, B1); PG8_BAR; PG8_SCHED;
            PG8_LDB(B0, 1, 0); PG8_LDB(B1, 1, 1); PG8_SCHED; PG8_LDA(At, 1, 0); PG8_STAGEA(PG8_SA(0, 1), a2 + h2, w0, w1);
            PG8_WAIT_V(8); PG8_WAIT_L(0); PG8_BAR; PG8_MMA(0, 0, At, B0); PG8_MMA(0, 1, At, B1); PG8_BAR; PG8_SCHED;
            PG8_LDA(At, 1, 1); PG8_STAGEB(PG8_SB(1, 0), b3); PG8_STAGEB(PG8_SB(1, 1), b3 + hstepB); PG8_STAGEA(PG8_SA(1, 0), a3, w0, w1);
            PG8_WAIT_V(8); PG8_WAIT_L(0); PG8_BAR; PG8_MMA(1, 0, At, B0); PG8_MMA(1, 1, At, B1); PG8_BAR; PG8_SCHED;
        }
        if (wr == 0) PG8_BAR;
        E(acc, cur, wr, wc, fr, fq);
        if constexpr ((PROBE & 512) && Epi::IDEM) E(acc, cur, wr, wc, fr, fq);
        if (!has_next) break;
#pragma unroll
        for (int a = 0; a < 2; ++a)
#pragma unroll
            for (int b = 0; b < 2; ++b)
#pragma unroll
                for (int m = 0; m < 4; ++m)
#pragma unroll
                    for (int n = 0; n < 2; ++n) acc[a][b][m][n] = (f32x4){0.f, 0.f, 0.f, 0.f};
        cur = nxt; ca = na; cA = nA; cB = nB; ++ui;
        if (wr == 1) PG8_BAR;
    }
    PG8_WAIT_V(0);
    PG8_BAR;
#undef PG8_SA
#undef PG8_SB
#undef PG8_STAGEA
#undef PG8_STAGEB
#undef PG8_LDA
#undef PG8_LDB
#undef PG8_MMA
#undef PG8_WAIT_V
#undef PG8_WAIT_L
#undef PG8_BAR
#undef PG8_SCHED
}

template <class Epi>
__device__ __forceinline__ void sample_gemm(LAS unsigned char* lds, const bf16_t* Arows, const bf16_t* Bt, const int K, const int nN, const int pm_unit, const Epi& E, const int job0, const int jstride, const int jend = 1 << 30) {
    const int tid = threadIdx.x, w = __builtin_amdgcn_readfirstlane(tid >> 6);
    int lane = tid & 63; asm volatile("" : "+v"(lane));
    const int fr = lane & 15, fq = lane >> 4;
    const int per = K / 256;
#pragma unroll 1
    for (int job = job0; job < nN * 16 && job < jend; job += jstride) {
        const int pn = job >> 4, jai = (job >> 3) & 1, jwr = (job >> 2) & 1, jwc = job & 3;
        f32x4 h[2][4][2];
#pragma unroll
        for (int b = 0; b < 2; ++b)
#pragma unroll
            for (int m = 0; m < 4; ++m)
#pragma unroll
                for (int n = 0; n < 2; ++n) h[b][m][n] = (f32x4){0.f, 0.f, 0.f, 0.f};
        const bf16_t* ap = Arows + (size_t)(jai * 128 + jwr * 64 + fr) * K + 8 * fq + (w * per) * 32;
        const bf16_t* bp = Bt + (size_t)(pn * 256 + jwc * 32 + 8 * (fr >> 2) + (fr & 3)) * K + 8 * fq + (w * per) * 32;
#pragma unroll 1
        for (int ks0 = 0; ks0 < per; ks0 += 4) {
            bf16x8 af[4][4], bfr[4][2][2];
#pragma unroll
            for (int kl = 0; kl < 4; ++kl) {
                const int ks = (ks0 + kl < per) ? ks0 + kl : per - 1;
#pragma unroll
                for (int m = 0; m < 4; ++m) af[kl][m] = *(const bf16x8*)(ap + (size_t)(16 * m) * K + 32 * ks);
#pragma unroll
                for (int bj = 0; bj < 2; ++bj)
#pragma unroll
                    for (int n = 0; n < 2; ++n) bfr[kl][bj][n] = *(const bf16x8*)(bp + (size_t)(bj * 128 + 4 * n) * K + 32 * ks);
            }
#pragma unroll
            for (int kl = 0; kl < 4; ++kl)
                if (ks0 + kl < per) {
#pragma unroll
                    for (int bj = 0; bj < 2; ++bj)
#pragma unroll
                        for (int m = 0; m < 4; ++m)
#pragma unroll
                            for (int n = 0; n < 2; ++n) h[bj][m][n] = __builtin_amdgcn_mfma_f32_16x16x32_bf16(bfr[kl][bj][n], af[kl][m], h[bj][m][n], 0, 0, 0);
                }
        }
        __syncthreads();
#pragma unroll
        for (int bj = 0; bj < 2; ++bj)
#pragma unroll
            for (int m = 0; m < 4; ++m)
#pragma unroll
                for (int n = 0; n < 2; ++n) *(LAS f32x4*)(lds + ((w * 16 + (bj * 4 + m) * 2 + n) * 64 + lane) * 16) = h[bj][m][n];
        __syncthreads();
#pragma unroll
        for (int q = 0; q < 2; ++q) {
            LAS unsigned char* sp = lds + ((2 * w + q) * 64 + lane) * 16;
            f32x4 sum = *(const LAS f32x4*)sp;
#pragma unroll
            for (int ww = 1; ww < 8; ++ww) sum += *(const LAS f32x4*)(sp + ww * 16384);
            *(LAS f32x4*)sp = sum;
        }
        __syncthreads();
        if (w < 4) {
            f32x4 acc[2][2][4][2];
#pragma unroll
            for (int ai = 0; ai < 2; ++ai)
#pragma unroll
                for (int bj = 0; bj < 2; ++bj)
#pragma unroll
                    for (int m = 0; m < 4; ++m)
#pragma unroll
                        for (int n = 0; n < 2; ++n) acc[ai][bj][m][n] = *(const LAS f32x4*)(lds + (((bj * 4 + m) * 2 + n) * 64 + lane) * 16);
            Unit u; u.pm = pm_unit; u.pn = pn;
            E(acc, u, jwr, jwc, fr, fq, 1u << (4 * jai + w));
        }
        if constexpr (Epi::POST) E.post(lds, 2 * jai + jwr, w, lane, 16u);
    }
    __syncthreads();
}

template <class Epi>
__device__ __forceinline__ void sample_gemm16(LAS unsigned char* lds, const bf16_t* Arows, const bf16_t* Bt, const int K, const int nN, const int pm_unit, const Epi& E, const int job0, const int jstride) {
    const int tid = threadIdx.x, w = __builtin_amdgcn_readfirstlane(tid >> 6);
    int lane = tid & 63; asm volatile("" : "+v"(lane));
    const int fr = lane & 15, fq = lane >> 4;
    const int per = K / 256;
#pragma unroll 1
    for (int job = job0; job < nN * 64; job += jstride) {
        const int pn = job >> 6, jai = (job >> 5) & 1, jwr = (job >> 4) & 1, jm = (job >> 2) & 3, jwc = job & 3;
        f32x4 h[2][2];
#pragma unroll
        for (int b = 0; b < 2; ++b)
#pragma unroll
            for (int n = 0; n < 2; ++n) h[b][n] = (f32x4){0.f, 0.f, 0.f, 0.f};
        const bf16_t* ap = Arows + (size_t)(jai * 128 + jwr * 64 + 16 * jm + fr) * K + 8 * fq + (w * per) * 32;
        const bf16_t* bp = Bt + (size_t)(pn * 256 + jwc * 32 + 8 * (fr >> 2) + (fr & 3)) * K + 8 * fq + (w * per) * 32;
#pragma unroll 1
        for (int ks0 = 0; ks0 < per; ks0 += 6) {
            bf16x8 af[6], bfr[6][2][2];
#pragma unroll
            for (int kl = 0; kl < 6; ++kl) {
                const int ks = (ks0 + kl < per) ? ks0 + kl : per - 1;
                af[kl] = *(const bf16x8*)(ap + 32 * ks);
#pragma unroll
                for (int bj = 0; bj < 2; ++bj)
#pragma unroll
                    for (int n = 0; n < 2; ++n) bfr[kl][bj][n] = *(const bf16x8*)(bp + (size_t)(bj * 128 + 4 * n) * K + 32 * ks);
            }
#pragma unroll
            for (int kl = 0; kl < 6; ++kl)
                if (ks0 + kl < per) {
#pragma unroll
                    for (int bj = 0; bj < 2; ++bj)
#pragma unroll
                        for (int n = 0; n < 2; ++n) h[bj][n] = __builtin_amdgcn_mfma_f32_16x16x32_bf16(bfr[kl][bj][n], af[kl], h[bj][n], 0, 0, 0);
                }
        }
        __syncthreads();
#pragma unroll
        for (int bj = 0; bj < 2; ++bj)
#pragma unroll
            for (int n = 0; n < 2; ++n) *(LAS f32x4*)(lds + ((w * 4 + bj * 2 + n) * 64 + lane) * 16) = h[bj][n];
        __syncthreads();
        if (w < 4) {
            LAS unsigned char* sp = lds + (w * 64 + lane) * 16;
            f32x4 sum = *(const LAS f32x4*)sp;
#pragma unroll
            for (int ww = 1; ww < 8; ++ww) sum += *(const LAS f32x4*)(sp + ww * 4096);
            *(LAS f32x4*)sp = sum;
        }
        __syncthreads();
        if (w == 0) {
            f32x4 acc[2][2][4][2];
#pragma unroll
            for (int ai = 0; ai < 2; ++ai)
#pragma unroll
                for (int bj = 0; bj < 2; ++bj)
#pragma unroll
                    for (int m = 0; m < 4; ++m)
#pragma unroll
                        for (int n = 0; n < 2; ++n) acc[ai][bj][m][n] = *(const LAS f32x4*)(lds + ((bj * 2 + n) * 64 + lane) * 16);
            Unit u; u.pm = pm_unit; u.pn = pn;
            E(acc, u, jwr, jwc, fr, fq, 1u << (4 * jai + jm));
        }
        if constexpr (Epi::POST) E.post(lds, 2 * jai + jwr, w, lane, 64u);
    }
    __syncthreads();
}
}
using pg8::Unit;

struct EpiIn {
    static constexpr bool IDEM = true, POST = false;
    unsigned char* proj; float* DEC; float* HGFS; const f32x4* rope; const float* lb;
    __device__ __forceinline__ void operator()(const f32x4 (&acc)[2][2][4][2], const Unit& u, int wr, int wc, int fr_, int fq_, const unsigned mask = 0xffu) const {
        int fr = fr_, fq = fq_; asm volatile("" : "+v"(fr), "+v"(fq));
        const int pn = u.pn; const bool samp = (u.pm == 64);
        const int dd0 = 32 * (wc & 1) + 8 * fq;
        const int col0 = ((pn & 1) * 2 + (wc >> 1)) * 128 + dd0;
        const int rowb = u.pm * 256 + wr * 64 + fr;
        if (pn < 4) {
            const int type = pn >> 1;
            bf16_t* D = (bf16_t*)(proj + (size_t)type * PSZ);
            const int head = (pn & 1) * 2 + (wc >> 1);
            const float lg = __log2f(1.0f - exp2f(-5.0f - (float)head));
            const float base = type == 0 ? 1.0f : 0.08838834764831845f;
#pragma unroll
            for (int ai = 0; ai < 2; ++ai)
#pragma unroll
                for (int m = 0; m < 4; ++m) if ((mask >> (4 * ai + m)) & 1u) {
                    const int r = rowb + ai * 128 + m * 16;
                    const int pos = r < TP ? (r & 4095) : (1024 + (r & 15));
                    const float e = (float)((r & 63) + 1) * lg;
                    const float sc = samp ? base : base * exp2f(type == 0 ? e : -e);
                    const f32x4* cs = rope + (size_t)pos * 32 + (dd0 >> 1);
                    const f32x4 c0 = cs[0], c1 = cs[1], c2 = cs[2], c3 = cs[3];
                    const f32x4 lo0 = acc[ai][0][m][0], lo1 = acc[ai][0][m][1], hi0 = acc[ai][1][m][0], hi1 = acc[ai][1][m][1];
                    float ol[8], oh[8];
                    ol[0] = lo0[0] * c0[0] - hi0[0] * c0[1]; oh[0] = lo0[0] * c0[1] + hi0[0] * c0[0];
                    ol[1] = lo0[1] * c0[2] - hi0[1] * c0[3]; oh[1] = lo0[1] * c0[3] + hi0[1] * c0[2];
                    ol[2] = lo0[2] * c1[0] - hi0[2] * c1[1]; oh[2] = lo0[2] * c1[1] + hi0[2] * c1[0];
                    ol[3] = lo0[3] * c1[2] - hi0[3] * c1[3]; oh[3] = lo0[3] * c1[3] + hi0[3] * c1[2];
                    ol[4] = lo1[0] * c2[0] - hi1[0] * c2[1]; oh[4] = lo1[0] * c2[1] + hi1[0] * c2[0];
                    ol[5] = lo1[1] * c2[2] - hi1[1] * c2[3]; oh[5] = lo1[1] * c2[3] + hi1[1] * c2[2];
                    ol[6] = lo1[2] * c3[0] - hi1[2] * c3[1]; oh[6] = lo1[2] * c3[1] + hi1[2] * c3[0];
                    ol[7] = lo1[3] * c3[2] - hi1[3] * c3[3]; oh[7] = lo1[3] * c3[3] + hi1[3] * c3[2];
                    u32x4 wl, wh;
                    wl.x = cvt_pk_bf16(ol[0] * sc, ol[1] * sc); wl.y = cvt_pk_bf16(ol[2] * sc, ol[3] * sc); wl.z = cvt_pk_bf16(ol[4] * sc, ol[5] * sc); wl.w = cvt_pk_bf16(ol[6] * sc, ol[7] * sc);
                    wh.x = cvt_pk_bf16(oh[0] * sc, oh[1] * sc); wh.y = cvt_pk_bf16(oh[2] * sc, oh[3] * sc); wh.z = cvt_pk_bf16(oh[4] * sc, oh[5] * sc); wh.w = cvt_pk_bf16(oh[6] * sc, oh[7] * sc);
                    bf16_t* rp = D + pofs(head, r) + dd0;
                    st16(rp, wl); st16(rp + 64, wh);
                }
        } else if (pn >= 8 && pn < 12) {
            const int lane = fq * 16 + fr;
            const int colh = (pn - 8) * 128 + 32 * wc + 8 * fq;
            bf16_t* dHQ = (bf16_t*)(proj + 4 * PSZ); bf16_t* dHK = (bf16_t*)(proj + 5 * PSZ);
            f32x4 lbv[2];
#pragma unroll
            for (int n = 0; n < 2; ++n) lbv[n] = *(const f32x4*)(lb + colh + 4 * n);
            const int srcl = (lane & 48) | 15;
#pragma unroll
            for (int ai = 0; ai < 2; ++ai) {
                const int rbase = u.pm * 256 + ai * 128 + wr * 64;
#pragma unroll
                for (int n = 0; n < 2; ++n) if ((mask >> (4 * ai)) & 0xfu) {
                    const int cn = colh + 4 * n;
                    f32x4 gg[4], kk[4];
#pragma unroll
                    for (int m = 0; m < 4; ++m)
#pragma unroll
                        for (int j = 0; j < 4; ++j) {
                            const float x = acc[ai][1][m][n][j]; const float sg = sigmoid_f(x); const float l = lbv[n][j];
                            gg[m][j] = __builtin_amdgcn_logf(l + (1.0f - l) * sg); kk[m][j] = (1.0f - l) * (1.0f - sg);
                        }
                    if (samp) {
#pragma unroll
                        for (int m = 0; m < 4; ++m) if ((mask >> (4 * ai + m)) & 1u) {
                            const int r = rbase + 16 * m + fr;
                            const f32x4 q0 = acc[ai][0][m][n];
                            u32x2 w; w.x = cvt_pk_bf16(q0[0], q0[1]); w.y = cvt_pk_bf16(q0[2], q0[3]);
                            *(u32x2*)(dHQ + pofs(pn - 8, r) + (cn & 127)) = w;
                            *(f32x4*)(HGFS + (size_t)(r - TP) * HW + cn) = gg[m] * 0.6931471805599453f;
                        }
                    } else {
                        f32x4 carry = (f32x4){0.f, 0.f, 0.f, 0.f};
#pragma unroll
                        for (int m = 0; m < 4; ++m)
#pragma unroll
                            for (int j = 0; j < 4; ++j) {
                                float v = gg[m][j];
                                v += dpp_z<0x111>(v); v += dpp_z<0x112>(v); v += dpp_z<0x114>(v); v += dpp_z<0x118>(v);
                                v += carry[j];
                                gg[m][j] = v;
                                carry[j] = __shfl(v, srcl);
                            }
#pragma unroll
                        for (int m = 0; m < 4; ++m) {
                            const int r = rbase + 16 * m + fr;
                            float qo[4], ko[4];
#pragma unroll
                            for (int j = 0; j < 4; ++j) { const float b = gg[m][j]; qo[j] = acc[ai][0][m][n][j] * __builtin_amdgcn_exp2f(b); ko[j] = kk[m][j] * __builtin_amdgcn_exp2f(-b); }
                            u32x2 wq, wk;
                            wq.x = cvt_pk_bf16(qo[0], qo[1]); wq.y = cvt_pk_bf16(qo[2], qo[3]);
                            wk.x = cvt_pk_bf16(ko[0], ko[1]); wk.y = cvt_pk_bf16(ko[2], ko[3]);
                            st8(dHQ + pofs(pn - 8, r) + (cn & 127), wq); st8(dHK + pofs(pn - 8, r) + (cn & 127), wk);
                        }
                        if (fr == 15) {
                            f32x4 d0;
#pragma unroll
                            for (int j = 0; j < 4; ++j) d0[j] = __builtin_amdgcn_exp2f(carry[j]);
                            *(f32x4*)(DEC + (size_t)(4 * u.pm + 2 * ai + wr) * HW + cn) = d0;
                        }
                    }
                }
            }
        } else {
            bf16_t* D = (bf16_t*)(proj + (size_t)(pn >> 1) * PSZ);
            const bool act = false;
#pragma unroll
            for (int ai = 0; ai < 2; ++ai)
#pragma unroll
                for (int m = 0; m < 4; ++m) if ((mask >> (4 * ai + m)) & 1u) {
                    const int r = rowb + ai * 128 + m * 16;
                    bf16_t* rp = D + pofs((pn & 1) * 2 + (wc >> 1), r) + dd0;
#pragma unroll
                    for (int bj = 0; bj < 2; ++bj) {
                        f32x4 v0 = acc[ai][bj][m][0], v1 = acc[ai][bj][m][1];
                        if (act) {
#pragma unroll
                            for (int j = 0; j < 4; ++j) { v0[j] = silu_f(v0[j]); v1[j] = silu_f(v1[j]); }
                        }
                        u32x4 w; w.x = cvt_pk_bf16(v0[0], v0[1]); w.y = cvt_pk_bf16(v0[2], v0[3]); w.z = cvt_pk_bf16(v1[0], v1[1]); w.w = cvt_pk_bf16(v1[2], v1[3]);
                        st16(rp + 64 * bj, w);
                    }
                }
        }
    }
};

struct EpiOut {
    static constexpr bool IDEM = true, POST = false;
    const float* xp; const float* xs; float* X1F; bf16_t* X1B; float* SS2;
    __device__ __forceinline__ void operator()(const f32x4 (&acc)[2][2][4][2], const Unit& u, int wr, int wc, int fr_, int fq_, const unsigned mask = 0xffu) const {
        int fr = fr_, fq = fq_; asm volatile("" : "+v"(fr), "+v"(fq));
        const int col0 = u.pn * 256 + wc * 32 + 8 * fq;
#pragma unroll
        for (int ai = 0; ai < 2; ++ai)
#pragma unroll
            for (int m = 0; m < 4; ++m) if ((mask >> (4 * ai + m)) & 1u) {
                const int r = u.pm * 256 + ai * 128 + wr * 64 + m * 16 + fr;
                const float* xr = (r < TP ? xp + (size_t)r * DM : xs + (size_t)(r - TP) * DM) + col0;
                const int rb = r < TP ? (4098 * (r >> 12) + 2 + (r & 4095)) : (16394 + (r - TP));
                bf16_t* o16 = X1B + (size_t)rb * DM + col0;
                float ss = 0.f;
#pragma unroll
                for (int bj = 0; bj < 2; ++bj) {
                    const f32x4 x0 = __builtin_nontemporal_load((const f32x4*)(xr + 128 * bj)), x1 = __builtin_nontemporal_load((const f32x4*)(xr + 128 * bj + 4));
                    const f32x4 v0 = acc[ai][bj][m][0] + x0, v1 = acc[ai][bj][m][1] + x1;
                    u32x4 w; w.x = cvt_pk_bf16(v0[0], v0[1]); w.y = cvt_pk_bf16(v0[2], v0[3]); w.z = cvt_pk_bf16(v1[0], v1[1]); w.w = cvt_pk_bf16(v1[2], v1[3]);
                    st16(o16 + 128 * bj, w);
                    ss += (v0[0] * v0[0] + v0[1] * v0[1]) + (v0[2] * v0[2] + v0[3] * v0[3]) + (v1[0] * v1[0] + v1[1] * v1[1]) + (v1[2] * v1[2] + v1[3] * v1[3]);
                }
                ss += __shfl_xor(ss, 16); ss += __shfl_xor(ss, 32);
                if (fq == 0) SS2[(size_t)r * 16 + u.pn * 4 + wc] = ss;
            }
    }
};

struct EpiUp {
    static constexpr bool IDEM = true, POST = false;
    const float* SS2; const float* ck; const float* cb; const float* cache_in; bf16_t* ACT; float* ccp; float* ccs;
    __device__ __forceinline__ void operator()(f32x4 (&acc)[2][2][4][2], const Unit& u, int wr, int wc, int fr_, int fq_, const unsigned mask = 0xffu) const {
        int fr = fr_, fq = fq_; asm volatile("" : "+v"(fr), "+v"(fq));
        const int lane = fq * 16 + fr;
        const int f0 = u.pn * 128 + wc * 32 + 8 * fq;
        const bool samp = (u.pm == 68);
        const int sb = samp ? 0 : u.pm / 17, sj = samp ? 0 : u.pm % 17;
        f32x4 k0[2], k1[2], k2[2], bb[2];
#pragma unroll
        for (int n = 0; n < 2; ++n) { k0[n] = *(const f32x4*)(ck + f0 + 4 * n); k1[n] = *(const f32x4*)(ck + DFF + f0 + 4 * n); k2[n] = *(const f32x4*)(ck + 2 * DFF + f0 + 4 * n); bb[n] = *(const f32x4*)(cb + f0 + 4 * n); }
#pragma unroll
        for (int ai = 0; ai < 2; ++ai) {
            f32x4 prev[2] = {(f32x4){0.f, 0.f, 0.f, 0.f}, (f32x4){0.f, 0.f, 0.f, 0.f}};
#pragma unroll
            for (int m = 0; m < 4; ++m) if ((mask >> (4 * ai + m)) & 1u) {
                int gr; bool valid; int t = 0;
                if (samp) { gr = TP + ai * 128 + wr * 64 + m * 16 + fr; valid = true; }
                else { t = 248 * sj + 62 * (2 * ai + wr) + 16 * m + fr - 2; gr = sb * SEQ + t; valid = (t >= 0) && (t < SEQ); }
                float ssq = 0.f;
                if (valid) { const f32x4 p = *(const f32x4*)(SS2 + (size_t)gr * 16 + 4 * fq); ssq = (p[0] + p[1]) + (p[2] + p[3]); }
                ssq += __shfl_xor(ssq, 16); ssq += __shfl_xor(ssq, 32);
                const float rs = valid ? __frsqrt_rn(ssq * (1.0f / DM) + EPS) : 0.f;
                f32x4 a[2], b[2];
#pragma unroll
                for (int n = 0; n < 2; ++n) { a[n] = acc[ai][0][m][n] * rs; b[n] = acc[ai][1][m][n] * rs; }
                if (samp) {
                    const int s = ai * 8 + wr * 4 + m;
                    if (fr >= 14) {
#pragma unroll
                        for (int n = 0; n < 2; ++n) prev[n] = *(const f32x4*)(cache_in + ((size_t)s * 2 + (fr - 14)) * DFF + f0 + 4 * n);
                    }
                }
                f32x4 o[2];
#pragma unroll
                for (int n = 0; n < 2; ++n)
#pragma unroll
                    for (int j = 0; j < 4; ++j) {
                        const float s1 = dpp_f<0x111>(dpp_f<0x121>(0.f, prev[n][j]), a[n][j]);
                        const float s2 = dpp_f<0x112>(dpp_f<0x122>(0.f, prev[n][j]), a[n][j]);
                        const float cv = bb[n][j] + k0[n][j] * s2 + k1[n][j] * s1 + k2[n][j] * a[n][j];
                        o[n][j] = silu_f(cv) * b[n][j];
                    }
                const bool store = samp ? true : (valid && (16 * m + fr >= 2));
                if (store) {
                    u32x4 w; w.x = cvt_pk_bf16(o[0][0], o[0][1]); w.y = cvt_pk_bf16(o[0][2], o[0][3]); w.z = cvt_pk_bf16(o[1][0], o[1][1]); w.w = cvt_pk_bf16(o[1][2], o[1][3]);
                    st16(ACT + (size_t)gr * DFF + f0, w);
                    if (samp) { if (fr >= 14) { float* cp = ccs + ((size_t)(ai * 8 + wr * 4 + m) * 2 + (fr - 14)) * DFF + f0; *(f32x4*)cp = a[0]; *(f32x4*)(cp + 4) = a[1]; } }
                    else if (t >= SEQ - 2) { float* cp = ccp + ((size_t)sb * 2 + (t - (SEQ - 2))) * DFF + f0; *(f32x4*)cp = a[0]; *(f32x4*)(cp + 4) = a[1]; }
                }
                prev[0] = a[0]; prev[1] = a[1];
            }
        }
    }
};

template <bool FUSED>
struct EpiDownT {
    static constexpr bool IDEM = false, POST = !FUSED;
    float* X; const bf16_t* X1B; float* SS3; const float* gfin; float* XS; unsigned* cnt; LAS unsigned char* ldsx;
    static __device__ __forceinline__ void ld8(const bf16_t* p, f32x4& a, f32x4& b) { const u32x4 w = *(const u32x4*)p;
        a[0] = __uint_as_float(w.x << 16); a[1] = __uint_as_float(w.x & 0xffff0000u); a[2] = __uint_as_float(w.y << 16); a[3] = __uint_as_float(w.y & 0xffff0000u);
        b[0] = __uint_as_float(w.z << 16); b[1] = __uint_as_float(w.z & 0xffff0000u); b[2] = __uint_as_float(w.w << 16); b[3] = __uint_as_float(w.w & 0xffff0000u); }
    __device__ __forceinline__ void post(LAS unsigned char* lds, int rb, int w, int lane, const unsigned nexp) const {
        asm volatile("s_waitcnt vmcnt(0)" ::: "memory");
        __syncthreads();
        LAS unsigned* flag = (LAS unsigned*)(lds + RING_BYTES + 8192);
        if (threadIdx.x == 0) {
            __builtin_amdgcn_fence(__ATOMIC_RELEASE, "agent");
            asm volatile("s_waitcnt vmcnt(0)" ::: "memory");
            const unsigned old = __hip_atomic_fetch_add(cnt + 64 * (64 + rb), 1u, __ATOMIC_RELAXED, __HIP_MEMORY_SCOPE_AGENT);
            const unsigned last = (old == nexp - 1u) ? 1u : 0u;
            if (last) { __builtin_amdgcn_fence(__ATOMIC_ACQUIRE, "agent"); asm volatile("s_waitcnt vmcnt(0)" ::: "memory"); }
            *flag = last;
        }
        __syncthreads();
        if (*flag) {
            f32x4 gn[4];
#pragma unroll
            for (int j = 0; j < 4; ++j) gn[j] = ((const f32x4*)gfin)[lane + 64 * j];
            for (int q = w; q < 64; q += NWAVES) {
                const int m = TP + 64 * rb + q;
                float p = lane < 16 ? SS3[(size_t)m * 16 + lane] : 0.f;
#pragma unroll
                for (int o = 1; o < 64; o <<= 1) p += __shfl_xor(p, o);
                const float rs = 1.0f / sqrtf(p * (1.0f / DM) + EPS);
                f32x4* xr = (f32x4*)(X + (size_t)m * DM) + lane;
#pragma unroll
                for (int j = 0; j < 4; ++j) { f32x4 v = xr[64 * j]; v = v * rs * gn[j]; xr[64 * j] = v; }
            }
        }
        __syncthreads();
    }
    __device__ __forceinline__ void operator()(f32x4 (&acc)[2][2][4][2], const Unit& u, int wr, int wc, int fr_, int fq_, const unsigned mask = 0xffu) const {
        int fr = fr_, fq = fq_; asm volatile("" : "+v"(fr), "+v"(fq));
        const int col0 = u.pn * 256 + wc * 32 + 8 * fq;
        if constexpr (!FUSED) {
#pragma unroll
            for (int ai = 0; ai < 2; ++ai)
#pragma unroll
                for (int m = 0; m < 4; ++m) if ((mask >> (4 * ai + m)) & 1u) {
                    const int r = u.pm * 256 + ai * 128 + wr * 64 + m * 16 + fr;
                    float* xr = X + (size_t)r * DM + col0;
                    const int rb = r < TP ? (4098 * (r >> 12) + 2 + (r & 4095)) : (16394 + (r - TP));
                    const bf16_t* x1p = X1B + (size_t)rb * DM + col0;
                    float ss = 0.f;
#pragma unroll
                    for (int bj = 0; bj < 2; ++bj) {
                        f32x4 x0, x1; ld8(x1p + 128 * bj, x0, x1);
                        const f32x4 v0 = acc[ai][bj][m][0] + x0, v1 = acc[ai][bj][m][1] + x1;
                        *(f32x4*)(xr + 128 * bj) = v0; *(f32x4*)(xr + 128 * bj + 4) = v1;
                        ss += (v0[0] * v0[0] + v0[1] * v0[1]) + (v0[2] * v0[2] + v0[3] * v0[3]) + (v1[0] * v1[0] + v1[1] * v1[1]) + (v1[2] * v1[2] + v1[3] * v1[3]);
                    }
                    ss += __shfl_xor(ss, 16); ss += __shfl_xor(ss, 32);
                    if (fq == 0) SS3[(size_t)r * 16 + u.pn * 4 + wc] = ss;
                }
        } else {
            const int tid = threadIdx.x, wid = __builtin_amdgcn_readfirstlane(tid >> 6);
            LAS float* P = (LAS float*)ldsx;
            LAS float* S = (LAS float*)(ldsx + 4096);
#pragma unroll
            for (int ai = 0; ai < 2; ++ai)
#pragma unroll
                for (int m = 0; m < 4; ++m) {
                    const int rl = ai * 128 + wr * 64 + m * 16 + fr;
                    const int r = u.pm * 256 + rl;
                    const bf16_t* x1p = X1B + (size_t)(4098 * (r >> 12) + 2 + (r & 4095)) * DM + col0;
                    float ss = 0.f;
#pragma unroll
                    for (int bj = 0; bj < 2; ++bj) {
                        f32x4 x0, x1; ld8(x1p + 128 * bj, x0, x1);
                        const f32x4 v0 = acc[ai][bj][m][0] + x0, v1 = acc[ai][bj][m][1] + x1;
                        acc[ai][bj][m][0] = v0; acc[ai][bj][m][1] = v1;
                        ss += (v0[0] * v0[0] + v0[1] * v0[1]) + (v0[2] * v0[2] + v0[3] * v0[3]) + (v1[0] * v1[0] + v1[1] * v1[1]) + (v1[2] * v1[2] + v1[3] * v1[3]);
                    }
                    ss += __shfl_xor(ss, 16); ss += __shfl_xor(ss, 32);
                    if (fq == 0) P[rl * 4 + wc] = ss;
                    if (m & 1) asm volatile("" ::: "memory");
                }
            asm volatile("s_waitcnt lgkmcnt(0)" ::: "memory"); __builtin_amdgcn_s_barrier(); asm volatile("" ::: "memory");
            if (tid < 256) {
                const f32x4 p = *(const LAS f32x4*)(P + tid * 4);
                __hip_atomic_store(XS + ((size_t)u.pm * 256 + tid) * 4 + u.pn, (p[0] + p[1]) + (p[2] + p[3]), __ATOMIC_RELAXED, __HIP_MEMORY_SCOPE_AGENT);
            }
            asm volatile("s_waitcnt vmcnt(0)" ::: "memory");
            if (tid < 256 && (tid & 63) == 0) __hip_atomic_fetch_add(cnt + 64 * u.pm, 1u, __ATOMIC_RELAXED, __HIP_MEMORY_SCOPE_AGENT);
            if (wid == 0) {
                unsigned sp = 0;
                while ((unsigned)__builtin_amdgcn_readfirstlane(__hip_atomic_load(cnt + 64 * u.pm, __ATOMIC_RELAXED, __HIP_MEMORY_SCOPE_AGENT)) < 16u) {
                    __builtin_amdgcn_s_sleep(2);
                    if (++sp > (1u << 20)) break;
                }
                __builtin_amdgcn_fence(__ATOMIC_ACQUIRE, "agent");
            }
            asm volatile("s_waitcnt vmcnt(0) lgkmcnt(0)" ::: "memory"); __builtin_amdgcn_s_barrier(); asm volatile("" ::: "memory");
            if (tid < 256) {
                const float* sl = XS + ((size_t)u.pm * 256 + tid) * 4;
                float t = 0.f;
#pragma unroll
                for (int k = 0; k < 4; ++k) t += __hip_atomic_load(sl + k, __ATOMIC_RELAXED, __HIP_MEMORY_SCOPE_AGENT);
                S[tid] = 1.0f / sqrtf(t * (1.0f / DM) + EPS);
            }
            asm volatile("s_waitcnt vmcnt(0) lgkmcnt(0)" ::: "memory"); __builtin_amdgcn_s_barrier(); asm volatile("" ::: "memory");
            f32x4 gv[2][2];
#pragma unroll
            for (int bj = 0; bj < 2; ++bj)
#pragma unroll
                for (int n = 0; n < 2; ++n) gv[bj][n] = *(const f32x4*)(gfin + col0 + 128 * bj + 4 * n);
#pragma unroll
            for (int ai = 0; ai < 2; ++ai)
#pragma unroll
                for (int m = 0; m < 4; ++m) {
                    const int rl = ai * 128 + wr * 64 + m * 16 + fr;
                    const float rs = S[rl];
                    float* xr = X + (size_t)(u.pm * 256 + rl) * DM + col0;
#pragma unroll
                    for (int bj = 0; bj < 2; ++bj) {
                        *(f32x4*)(xr + 128 * bj) = acc[ai][bj][m][0] * rs * gv[bj][0];
                        *(f32x4*)(xr + 128 * bj + 4) = acc[ai][bj][m][1] * rs * gv[bj][1];
                    }
                }
        }
    }
};

struct EpiNull {
    static constexpr bool IDEM = false, POST = false;
    __device__ __forceinline__ void operator()(f32x4 (&acc)[2][2][4][2], const Unit& u, int wr, int wc, int fr_, int fq_, const unsigned mask = 0xffu) const {
#pragma unroll
        for (int a = 0; a < 2; ++a)
#pragma unroll
            for (int b = 0; b < 2; ++b)
#pragma unroll
                for (int m = 0; m < 4; ++m)
#pragma unroll
                    for (int n = 0; n < 2; ++n) asm volatile("" :: "v"(acc[a][b][m][n]));
    }
};
struct Args { const float* in[17]; float* out; unsigned char* ws; int ph_lo, ph_hi; };

__device__ __forceinline__ float wave_sum(float v) {
#pragma unroll
    for (int o = 1; o < 64; o <<= 1) v += __shfl_xor(v, o);
    return v;
}

__device__ __forceinline__ void transpose_item(const float* W, int K, int N, bf16_t* WT, const float* gain, LAS float* scr, int k0, int p0, int s0, int lane) {
    float tv[32];
#pragma unroll
    for (int i = 0; i < 32; ++i) { const int kk = 2 * i + (lane >> 5); tv[i] = __builtin_nontemporal_load(W + (size_t)(k0 + kk) * N + s0 + (lane & 31)); }
    if (gain) {
#pragma unroll
        for (int i = 0; i < 32; ++i) tv[i] *= gain[k0 + 2 * i + (lane >> 5)];
    }
#pragma unroll
    for (int i = 0; i < 32; ++i) scr[(2 * i + (lane >> 5)) * 33 + (lane & 31)] = tv[i];
    asm volatile("s_waitcnt lgkmcnt(0)" ::: "memory");
    const int c = lane & 7;
#pragma unroll
    for (int j = 0; j < 4; ++j) { const int n = (lane >> 3) + 8 * j; const LAS float* s = scr + (8 * c) * 33 + n;
        u32x4 o; o.x = cvt_pk_bf16(s[0 * 33], s[1 * 33]); o.y = cvt_pk_bf16(s[2 * 33], s[3 * 33]); o.z = cvt_pk_bf16(s[4 * 33], s[5 * 33]); o.w = cvt_pk_bf16(s[6 * 33], s[7 * 33]);
        *(u32x4*)(WT + (size_t)(p0 + n) * K + k0 + 8 * c) = o; }
    asm volatile("s_waitcnt lgkmcnt(0)" ::: "memory");
}
__device__ __forceinline__ int colmap_in(int p) {
    const int pn = p >> 8, pl = p & 255, bj = pl >> 7, q = pl & 127;
    if (pn >= 8 && pn < 12) return (bj ? 2560 : 2048) + (pn - 8) * 128 + q;
    const int type = pn >> 1;
    return type * 512 + ((pn & 1) * 2 + (q >> 6)) * 128 + bj * 64 + (q & 63);
}
__device__ __forceinline__ int colmap_up(int p) { const int pn = p >> 8, pl = p & 255, bj = pl >> 7, q = pl & 127; return bj * DFF + 128 * pn + q; }

__device__ __forceinline__ void phase_prep(const Args& A, LAS unsigned char* lds, int wave, int lane) {
    unsigned char* ws = A.ws;
    const int G = gridDim.x, gw = blockIdx.x * NWAVES + wave, NGW = G * NWAVES;
    LAS float* scr = (LAS float*)(lds + wave * 8704);
    bf16_t* WinT = (bf16_t*)(ws + WS_WIN); bf16_t* WoutT = (bf16_t*)(ws + WS_WOUT); bf16_t* WupT = (bf16_t*)(ws + WS_WUP); bf16_t* WdT = (bf16_t*)(ws + WS_WD);
    constexpr int I_IN = 16 * 128, I_OUT = 16 * 32, I_UP = 16 * 176, I_DN = 44 * 32, NITEMS = I_IN + I_OUT + I_UP + I_DN;
    for (int it = gw; it < NITEMS; it += NGW) {
        int r = it;
        if (r < I_IN) { const int kb = r / 128, pb = r % 128; transpose_item(A.in[5], DM, INC, WinT, A.in[10], scr, 64 * kb, 32 * pb, colmap_in(32 * pb), lane); continue; } r -= I_IN;
        if (r < I_OUT) { const int kb = r / 32, pb = r % 32; transpose_item(A.in[9], DM, DM, WoutT, nullptr, scr, 64 * kb, 32 * pb, 32 * pb, lane); continue; } r -= I_OUT;
        if (r < I_UP) { const int kb = r / 176, pb = r % 176; transpose_item(A.in[12], DM, UPC, WupT, A.in[11], scr, 64 * kb, 32 * pb, colmap_up(32 * pb), lane); continue; } r -= I_UP;
        { const int kb = r / 32, pb = r % 32; transpose_item(A.in[15], DFF, DM, WdT, nullptr, scr, 64 * kb, 32 * pb, 32 * pb, lane); }
    }
    bf16_t* XB = (bf16_t*)(ws + WS_XB);
    for (int m0 = gw; m0 < TT; m0 += 4 * NGW) {
        f32x4 v[4][4];
#pragma unroll
        for (int q = 0; q < 4; ++q) {
            const int m = m0 + q * NGW;
            if (m < TT) {
                const float* xrow = m < TP ? A.in[0] + (size_t)m * DM : A.in[1] + (size_t)(m - TP) * DM;
                const f32x4* xr = (const f32x4*)xrow + lane;
#pragma unroll
                for (int j = 0; j < 4; ++j) v[q][j] = __builtin_nontemporal_load(xr + 64 * j);
            }
        }
#pragma unroll
        for (int q = 0; q < 4; ++q) {
            const int m = m0 + q * NGW;
            if (m < TT) {
                float s = 0.f;
#pragma unroll
                for (int j = 0; j < 4; ++j) s += (v[q][j][0] * v[q][j][0] + v[q][j][1] * v[q][j][1]) + (v[q][j][2] * v[q][j][2] + v[q][j][3] * v[q][j][3]);
                const float rs = 1.0f / sqrtf(wave_sum(s) * (1.0f / DM) + EPS);
                u32x2* o8 = (u32x2*)(XB + (size_t)m * DM) + lane;
#pragma unroll
                for (int j = 0; j < 4; ++j) { u32x2 w; w.x = cvt_pk_bf16(v[q][j][0] * rs, v[q][j][1] * rs); w.y = cvt_pk_bf16(v[q][j][2] * rs, v[q][j][3] * rs); o8[64 * j] = w; }
            }
        }
    }
    f32x2* rope = (f32x2*)(ws + WS_ROPE);
    const int gt = blockIdx.x * NTHREADS + threadIdx.x, NGT = G * NTHREADS;
    for (int i = gt; i < SEQ * 64; i += NGT) {
        const int pos = i >> 6, d = i & 63;
        const float inv = 1.0f / powf(10000.0f, (float)d * (1.0f / 64.0f));
        const float ang = (float)pos * inv;
        float sn, cs; sn = sinf(ang); cs = cosf(ang);
        rope[i] = (f32x2){cs, sn};
    }
    if (gt < HW) { const float l0 = A.in[8][gt], l1 = A.in[8][HW + gt]; ((float*)(ws + WS_LB))[gt] = 1.0f / (1.0f + __expf(l1 - l0)); }
    bf16_t* X1B = (bf16_t*)(ws + WS_X1B); (void)X1B;
}

template <bool HG>
__device__ __forceinline__ void sample_mixer_cols(const bf16_t* Q, const bf16_t* Kx, const float* Gf, const bf16_t* V, float* O, const float* st_in, float* st_out, int id) {
    const int tid = threadIdx.x, part = tid & 15, dpi = tid >> 4;
    const int seq = id >> 3, head = (id >> 1) & 3, dv0 = (id & 1) * 64 + 2 * dpi;
    const float* si = st_in + (size_t)(seq * 4 + head) * 16384 + dv0; float* so = st_out + (size_t)(seq * 4 + head) * 16384 + dv0;
    float S[2][8];
#pragma unroll
    for (int i = 0; i < 8; ++i) { const f32x2 t = *(const f32x2*)(si + (size_t)(part * 8 + i) * 128); S[0][i] = t[0]; S[1][i] = t[1]; }
    const int row0 = TP + seq * 16, ck = head * 128 + part * 8;
    const float gamma = 1.0f - exp2f(-5.0f - (float)head);
    const size_t hb = pofs(head, 0); const int pk8 = part * 8;
    constexpr int U = 2;
    u32x4 q8[2][U], k8[2][U]; f32x4 g0[2][U], g1[2][U]; unsigned vv[2][U];
#define SM_LOAD(set, t0_) do { _Pragma("unroll") for (int u = 0; u < U; ++u) { \
        const size_t r = (size_t)(row0 + (t0_) + u) * HW; const size_t rp_ = hb + (size_t)(row0 + (t0_) + u) * 128; q8[set][u] = *(const u32x4*)(Q + rp_ + pk8); \
        if (HG) { g0[set][u] = *(const f32x4*)(Gf + r + ck); g1[set][u] = *(const f32x4*)(Gf + r + ck + 4); } else k8[set][u] = *(const u32x4*)(Kx + rp_ + pk8); \
        vv[set][u] = *(const unsigned*)(V + rp_ + dv0); } } while (0)
    SM_LOAD(0, 0);
#pragma unroll 1
    for (int t0 = 0; t0 < 16; t0 += 2 * U) {
#pragma unroll
        for (int set = 0; set < 2; ++set) {
            const int tb = t0 + set * U;
            { const int tn = (tb + U < 16) ? tb + U : 16 - U; if (set == 0) SM_LOAD(1, tn); else SM_LOAD(0, tn); }
#pragma unroll
            for (int u = 0; u < U; ++u) {
                const float v0 = __uint_as_float(vv[set][u] << 16), v1 = __uint_as_float(vv[set][u] & 0xffff0000u);
                float qf[8], kf[8], df[8];
                const unsigned qa[4] = {q8[set][u].x, q8[set][u].y, q8[set][u].z, q8[set][u].w};
#pragma unroll
                for (int i = 0; i < 4; ++i) { qf[2 * i] = __uint_as_float(qa[i] << 16); qf[2 * i + 1] = __uint_as_float(qa[i] & 0xffff0000u); }
                if (HG) {
#pragma unroll
                    for (int i = 0; i < 4; ++i) { df[i] = __expf(g0[set][u][i]); df[4 + i] = __expf(g1[set][u][i]); }
#pragma unroll
                    for (int i = 0; i < 8; ++i) kf[i] = 1.0f - df[i];
                } else {
                    const unsigned ka[4] = {k8[set][u].x, k8[set][u].y, k8[set][u].z, k8[set][u].w};
#pragma unroll
                    for (int i = 0; i < 4; ++i) { kf[2 * i] = __uint_as_float(ka[i] << 16); kf[2 * i + 1] = __uint_as_float(ka[i] & 0xffff0000u); }
#pragma unroll
                    for (int i = 0; i < 8; ++i) df[i] = gamma;
                }
                float p0 = 0.f, p1 = 0.f;
#pragma unroll
                for (int i = 0; i < 8; ++i) { S[0][i] = df[i] * S[0][i] + kf[i] * v0; p0 += qf[i] * S[0][i]; S[1][i] = df[i] * S[1][i] + kf[i] * v1; p1 += qf[i] * S[1][i]; }
                p0 += dpp_f<0x128>(0.f, p0); p0 += dpp_f<0x124>(0.f, p0); p0 += dpp_f<0x122>(0.f, p0); p0 += dpp_f<0x121>(0.f, p0);
                p1 += dpp_f<0x128>(0.f, p1); p1 += dpp_f<0x124>(0.f, p1); p1 += dpp_f<0x122>(0.f, p1); p1 += dpp_f<0x121>(0.f, p1);
                if (part == 0) *(f32x2*)(O + (size_t)(row0 + tb + u) * DM + (HG ? HW : 0) + head * 128 + dv0) = (f32x2){p0, p1};
            }
        }
    }
#undef SM_LOAD
#pragma unroll
    for (int i = 0; i < 8; ++i) *(f32x2*)(so + (size_t)(part * 8 + i) * 128) = (f32x2){S[0][i], S[1][i]};
}
__device__ __forceinline__ void phase_mixer_sample(const Args& A) {
    unsigned char* ws = A.ws;
    const bf16_t* QR = (const bf16_t*)(ws + WS_QR); const bf16_t* KR = (const bf16_t*)(ws + WS_KR); const bf16_t* VR = (const bf16_t*)(ws + WS_VR);
    const bf16_t* HQ = (const bf16_t*)(ws + WS_HQ); const bf16_t* HI = (const bf16_t*)(ws + WS_HI);
    const float* HGFv = (const float*)(ws + WS_HGFS) - (size_t)TP * HW;
    float* O = A.out + O_Y;
    const int G = gridDim.x;
    for (int it = blockIdx.x; it < 256; it += G) {
        if (it >> 7) sample_mixer_cols<true>(HQ, nullptr, HGFv, HI, O, A.in[3], A.out + O_HGS, it & 127);
        else sample_mixer_cols<false>(QR, KR, nullptr, VR, O, A.in[2], A.out + O_RETS, it & 127);
    }
}

typedef short s16x4 __attribute__((ext_vector_type(4)));
__device__ __forceinline__ bf16x8 tr2(LAS unsigned char* p0, LAS unsigned char* p1) {
    const s16x4 a = __builtin_amdgcn_ds_read_tr16_b64_v4i16((LAS s16x4*)p0);
    const s16x4 b = __builtin_amdgcn_ds_read_tr16_b64_v4i16((LAS s16x4*)p1);
    return __builtin_shufflevector(a, b, 0, 1, 2, 3, 4, 5, 6, 7);
}
#define MFMA16(a, b, c) __builtin_amdgcn_mfma_f32_16x16x32_bf16((a), (b), (c), 0, 0, 0)

constexpr int M1_KSTR = 144, M1_VSTR = 72, M1_KSZ = 64 * M1_KSTR, M1_CH = M1_KSZ + 64 * M1_VSTR, M1_BUF = 2 * M1_CH;
__device__ __forceinline__ void m1_item(const bf16_t* Kt, const bf16_t* V, const float* DECp, bf16_t* ST, float* state_out, int seq, int head, int slice, float gamma64,
                                        LAS unsigned char* lds, int w, int lane, const int pmode = 0) {
    const int tid = threadIdx.x, fr = lane & 15, g = lane >> 4, r4 = fr >> 2, c4 = fr & 3;
    const int dkh = slice >> 2, dvq = slice & 3, tk = w >> 1, tv = w & 1;
    const size_t rbase = (size_t)seq * SEQ;
    const int cb = head * 128;
    const bool vld = tid < 256;
    const bf16_t* kp = Kt + pofs(head, rbase + (tid >> 3)) + dkh * 64 + (tid & 7) * 8;
    const bf16_t* vp = V + pofs(head, rbase + (tid >> 2)) + dvq * 32 + (tid & 3) * 8;
    const int kwo = (tid >> 3) * M1_KSTR + (tid & 7) * 16, vwo = M1_KSZ + (tid >> 2) * M1_VSTR + (tid & 3) * 16;
    const int dv = dvq * 32 + tv * 16 + fr, dk0 = dkh * 64 + 16 * tk + 4 * g;
    const float* dp = DECp ? DECp + (size_t)(seq * 64) * HW + cb + dk0 : nullptr;
    u32x4 rk0[8], rv[8]; f32x4 rd[8];
#define M1_LOAD(slot, n_) do { const size_t o_ = (size_t)(n_) * 64 * 128; rk0[slot] = *(const u32x4*)(kp + o_); \
        rv[slot] = vld ? *(const u32x4*)(vp + o_) : (u32x4){0u, 0u, 0u, 0u}; rd[slot] = dp ? *(const f32x4*)(dp + (size_t)(n_) * HW) : (f32x4){gamma64, gamma64, gamma64, gamma64}; } while (0)
#define M1_WRITE(slot, off_) do { LAS unsigned char* nb_ = lds + (off_); *(LAS u32x4*)(nb_ + kwo) = rk0[slot]; \
        if (vld) { *(LAS u32x2*)(nb_ + vwo) = (u32x2){rv[slot].x, rv[slot].y}; *(LAS u32x2*)(nb_ + vwo + 8) = (u32x2){rv[slot].z, rv[slot].w}; } } while (0)
    M1_LOAD(0, 0); M1_LOAD(1, 1); M1_LOAD(2, 2); M1_LOAD(3, 3); M1_LOAD(4, 4); M1_LOAD(5, 5); M1_LOAD(6, 6); M1_LOAD(7, 7);
    M1_WRITE(0, 0); M1_WRITE(1, M1_CH);
    __syncthreads();
    f32x4 acc = (f32x4){0.f, 0.f, 0.f, 0.f};
    for (int s0 = 0; s0 < 32; s0 += 4) {
#pragma unroll
        for (int u = 0; u < 4; ++u) {
            const int n = 2 * (s0 + u);
            LAS unsigned char* buf = lds + (u & 1) * M1_BUF;
            const f32x4 dec0 = rd[2 * u], dec1 = rd[2 * u + 1];
            { const int na = (n + 8 < 64) ? n + 8 : 62; M1_LOAD(2 * u, na); M1_LOAD(2 * u + 1, na + 1); }
#pragma unroll
            for (int h = 0; h < 2; ++h) {
                if (!(pmode & 1)) { u32x2 sv; sv.x = cvt_pk_bf16(acc[0], acc[1]); sv.y = cvt_pk_bf16(acc[2], acc[3]);
                  st8(ST + ((size_t)((seq * 64 + n + h) * 4 + head) * 128 + dv) * 128 + dk0, sv); }
#pragma unroll
                for (int ks = 0; ks < 2; ++ks) if (!(pmode & 2)) {
                    LAS unsigned char* ka = buf + h * M1_CH + (32 * ks + 8 * g + r4) * M1_KSTR + 32 * tk + 8 * c4;
                    LAS unsigned char* va = buf + h * M1_CH + M1_KSZ + (32 * ks + 8 * g + r4) * M1_VSTR + 32 * tv + 8 * c4;
                    const bf16x8 af = tr2(ka, ka + 4 * M1_KSTR), bfv = tr2(va, va + 4 * M1_VSTR);
                    acc = MFMA16(af, bfv, acc);
                }
                acc = acc * (h ? dec1 : dec0);
            }
            if (!(pmode & 8)) { M1_WRITE(2 * ((u + 1) & 3), ((u + 1) & 1) * M1_BUF); M1_WRITE(2 * ((u + 1) & 3) + 1, ((u + 1) & 1) * M1_BUF + M1_CH); }
            if (!(pmode & 4)) __syncthreads();
        }
    }
#undef M1_LOAD
#undef M1_WRITE
    if (!pmode) {
#pragma unroll
        for (int j = 0; j < 4; ++j) state_out[(size_t)(dk0 + j) * 128 + dv] = acc[j];
    } else asm volatile("" :: "v"(acc));
}
__device__ __forceinline__ void phase_m1(const Args& A, LAS unsigned char* lds, int w, int lane, const bool dup = false) {
    unsigned char* ws = A.ws;
    bf16_t* STb = (bf16_t*)(A.out + O_Y);
    const int G = gridDim.x;
    const int vcu = (G % 8 == 0) ? (int)(blockIdx.x % 8) * (G / 8) + (int)(blockIdx.x / 8) : (int)blockIdx.x;
    for (int it = vcu; it < 256 && !((PROBE & 4096) && dup); it += G) {
        const int mixer = it >> 7, seq = (it >> 5) & 3, head = (it >> 3) & 3, slice = it & 7;
        const float gam = 1.0f - exp2f(-5.0f - (float)head);
        const float g64 = exp2f(64.0f * __log2f(gam));
        float* sout = A.out + (mixer ? O_HGP : O_RETP) + (size_t)(seq * 4 + head) * 16384;
        bf16_t* ST = STb + (size_t)mixer * 256 * 4 * 16384;
        const int pm_ = dup ? ((PROBE >> 14) & 15) : 0;
        if (mixer) m1_item((const bf16_t*)(ws + WS_HK), (const bf16_t*)(ws + WS_HI), (const float*)(ws + WS_DEC), ST, sout, seq, head, slice, 0.f, lds, w, lane, pm_);
        else m1_item((const bf16_t*)(ws + WS_KR), (const bf16_t*)(ws + WS_VR), nullptr, ST, sout, seq, head, slice, g64, lds, w, lane, pm_);
        __syncthreads();
    }
    if (!(PROBE & 8192) || !dup) phase_mixer_sample(A);
}

constexpr int M2_VSTR = 272, M2_VBUF = 64 * M2_VSTR, M2_EXCH = 8 * M2_VBUF;
__device__ __forceinline__ void m2_item(const Args& A, int seq, int n, LAS unsigned char* lds, int w, int lane) {
    unsigned char* ws = A.ws;
    int fr = lane & 15, g = lane >> 4; asm volatile("" : "+v"(fr), "+v"(g));
    const int r4 = fr >> 2, c4 = fr & 3;
    const int mixer = w >> 2, head = w & 3, cb = head * 128;
    const bf16_t* Q = (const bf16_t*)(ws + (mixer ? WS_HQ : WS_QR)); const bf16_t* K = (const bf16_t*)(ws + (mixer ? WS_HK : WS_KR));
    const bf16_t* V = (const bf16_t*)(ws + (mixer ? WS_HI : WS_VR)); const bf16_t* GT = (const bf16_t*)(ws + (mixer ? WS_HGT : WS_GR));
    const float* gain = A.in[mixer ? 7 : 6] + cb;
    const size_t r0 = (size_t)seq * SEQ + 64 * n;
    const bf16_t* ST = (const bf16_t*)(A.out + O_Y) + ((size_t)(mixer * 256 + seq * 64 + n) * 4 + head) * 16384;
    bf16_t* MG = (bf16_t*)(ws + WS_XB);
    LAS unsigned char* vb = lds + w * M2_VBUF;
    const bf16_t* qp = Q + pofs(head, r0 + fr) + 8 * g; const bf16_t* kp = K + pofs(head, r0 + fr) + 8 * g;
    u32x4 vr[16];
#pragma unroll
    for (int i = 0; i < 16; ++i) vr[i] = __builtin_nontemporal_load((const u32x4*)(V + pofs(head, r0 + 4 * i + g) + fr * 8));
    bf16x8 qf[4][4], kf[4][4];
#pragma unroll
    for (int ks = 0; ks < 4; ++ks)
#pragma unroll
        for (int t = 0; t < 4; ++t) { qf[ks][t] = *(const bf16x8*)(qp + (size_t)(16 * t) * 128 + 32 * ks); kf[ks][t] = *(const bf16x8*)(kp + (size_t)(16 * t) * 128 + 32 * ks); }
#pragma unroll
    for (int i = 0; i < 16; ++i) *(LAS u32x4*)(vb + (4 * i + g) * M2_VSTR + fr * 16) = vr[i];
    f32x4 X[4][4];
#pragma unroll
    for (int a = 0; a < 4; ++a)
#pragma unroll
        for (int b = 0; b < 4; ++b) X[a][b] = (f32x4){0.f, 0.f, 0.f, 0.f};
#pragma unroll
    for (int ks = 0; ks < 4; ++ks)
#pragma unroll
        for (int jt = 0; jt < 4; ++jt)
#pragma unroll
            for (int it = jt; it < 4; ++it) X[jt][it] = MFMA16(kf[ks][jt], qf[ks][it], X[jt][it]);
    bf16x8 PB[4][2];
#pragma unroll
    for (int it = 0; it < 4; ++it)
#pragma unroll
        for (int s2 = 0; s2 < 2; ++s2) {
            float v[8];
#pragma unroll
            for (int e = 0; e < 8; ++e) {
                const int jt = 2 * s2 + (e >> 2);
                float x = 0.f;
                if (jt < it) x = X[jt][it][e & 3];
                else if (jt == it) x = (fr >= 4 * g + (e & 3)) ? X[jt][it][e & 3] : 0.f;
                v[e] = x;
            }
            u32x4 wv; wv.x = cvt_pk_bf16(v[0], v[1]); wv.y = cvt_pk_bf16(v[2], v[3]); wv.z = cvt_pk_bf16(v[4], v[5]); wv.w = cvt_pk_bf16(v[6], v[7]);
            PB[it][s2] = __builtin_bit_cast(bf16x8, wv);
        }
    const bf16_t* sp = ST + (size_t)fr * 128 + 8 * g;
    bf16x8 sa0[2][4];
#pragma unroll
    for (int k2 = 0; k2 < 2; ++k2)
#pragma unroll
        for (int d = 0; d < 4; ++d) sa0[k2][d] = *(const bf16x8*)(sp + (size_t)(16 * d) * 128 + 32 * k2);
    f32x4 O[8][4];
#pragma unroll
    for (int a = 0; a < 8; ++a)
#pragma unroll
        for (int b = 0; b < 4; ++b) O[a][b] = (f32x4){0.f, 0.f, 0.f, 0.f};
#pragma unroll
    for (int s2 = 0; s2 < 2; ++s2)
#pragma unroll
        for (int dh = 0; dh < 2; ++dh) {
            bf16x8 vt[4];
#pragma unroll
            for (int d = 0; d < 4; ++d) { LAS unsigned char* pa = vb + (32 * s2 + 4 * g + r4) * M2_VSTR + 32 * (4 * dh + d) + 8 * c4; vt[d] = tr2(pa, pa + 16 * M2_VSTR); }
#pragma unroll
            for (int it = 2 * s2; it < 4; ++it)
#pragma unroll
                for (int d = 0; d < 4; ++d) O[4 * dh + d][it] = MFMA16(vt[d], PB[it][s2], O[4 * dh + d][it]);
            asm volatile("" ::: "memory");
        }
#pragma unroll
    for (int dh = 0; dh < 2; ++dh)
#pragma unroll
        for (int kp2 = 0; kp2 < 2; ++kp2) {
            bf16x8 qg[2][4], sa[2][4];
#pragma unroll
            for (int k2 = 0; k2 < 2; ++k2) {
#pragma unroll
                for (int t = 0; t < 4; ++t) qg[k2][t] = *(const bf16x8*)(qp + (size_t)(16 * t) * 128 + 32 * (2 * kp2 + k2));
#pragma unroll
                for (int d = 0; d < 4; ++d) sa[k2][d] = (dh == 0 && kp2 == 0) ? sa0[k2][d] : *(const bf16x8*)(sp + (size_t)(16 * (4 * dh + d)) * 128 + 32 * (2 * kp2 + k2));
            }
#pragma unroll
            for (int k2 = 0; k2 < 2; ++k2)
#pragma unroll
                for (int d = 0; d < 4; ++d)
#pragma unroll
                    for (int it = 0; it < 4; ++it) O[4 * dh + d][it] = MFMA16(sa[k2][d], qg[k2][it], O[4 * dh + d][it]);
            asm volatile("" ::: "memory");
        }
    u32x2 gtr[4][8];
#pragma unroll
    for (int it = 0; it < 4; ++it)
#pragma unroll
        for (int d = 0; d < 8; ++d) gtr[it][d] = *(const u32x2*)(GT + pofs(head, r0 + 16 * it + fr) + 4 * g + 16 * d);
    float rs[4];
    LAS float* exch = (LAS float*)(lds + M2_EXCH);
#pragma unroll
    for (int it = 0; it < 4; ++it) {
        float ss = 0.f;
#pragma unroll
        for (int d = 0; d < 8; ++d) ss += (O[d][it][0] * O[d][it][0] + O[d][it][1] * O[d][it][1]) + (O[d][it][2] * O[d][it][2] + O[d][it][3] * O[d][it][3]);
        ss += __shfl_xor(ss, 16); ss += __shfl_xor(ss, 32);
        rs[it] = ss;
        if (mixer && g == 0) exch[(16 * it + fr) * 4 + head] = ss;
    }
    __syncthreads();
#pragma unroll
    for (int it = 0; it < 4; ++it) {
        if (mixer) { const f32x4 e = *(LAS f32x4*)(exch + (16 * it + fr) * 4); rs[it] = 1.0f / sqrtf(((e[0] + e[1]) + (e[2] + e[3])) * (1.0f / 512.0f) + EPS); }
        else rs[it] = 1.0f / sqrtf(rs[it] * (1.0f / 128.0f) + EPS);
    }
#pragma unroll
    for (int it = 0; it < 4; ++it) {
        int rowi = 16 * it + fr; asm volatile("" : "+v"(rowi));
        const size_t row = r0 + rowi;
        bf16_t* mgp = MG + row * DM + mixer * HW + cb + 4 * g;
        const float rsi = rs[it];
#pragma unroll
        for (int d = 0; d < 8; ++d) {
            const f32x4 gn = *(const f32x4*)(gain + 16 * d + 4 * g);
            const u32x2 gt = gtr[it][d];
            const float g0 = silu_f(__uint_as_float(gt.x << 16)), g1 = silu_f(__uint_as_float(gt.x & 0xffff0000u)), g2 = silu_f(__uint_as_float(gt.y << 16)), g3 = silu_f(__uint_as_float(gt.y & 0xffff0000u));
            const f32x4 o = O[d][it] * rsi * gn;
            u32x2 wv; wv.x = cvt_pk_bf16(o[0] * g0, o[1] * g1); wv.y = cvt_pk_bf16(o[2] * g2, o[3] * g3);
            st8(mgp + 16 * d, wv);
        }
    }
}
__device__ __forceinline__ void phase_normgate_sample(const Args& A, int wave, int lane) {
    unsigned char* ws = A.ws;
    const float* O = A.out + O_Y;
    const bf16_t* GR = (const bf16_t*)(ws + WS_GR); const bf16_t* HGT = (const bf16_t*)(ws + WS_HGT);
    bf16_t* MG = (bf16_t*)(ws + WS_XB);
    const int gw = blockIdx.x * NWAVES + wave, NGW = gridDim.x * NWAVES;
    const bool hg = lane >= 32; const int c0 = lane * 16;
    const float* gain = hg ? A.in[7] + (c0 - HW) : A.in[6] + c0;
    f32x4 gn[4];
#pragma unroll
    for (int j = 0; j < 4; ++j) gn[j] = *(const f32x4*)(gain + 4 * j);
    for (int m = TP + gw; m < TT; m += NGW) {
        const f32x4* orow = (const f32x4*)(O + (size_t)m * DM + c0);
        f32x4 v[4]; float s = 0.f;
#pragma unroll
        for (int j = 0; j < 4; ++j) { v[j] = orow[j]; s += (v[j][0] * v[j][0] + v[j][1] * v[j][1]) + (v[j][2] * v[j][2] + v[j][3] * v[j][3]); }
        s += __shfl_xor(s, 1); s += __shfl_xor(s, 2); s += __shfl_xor(s, 4);
        float s2 = s; s2 += __shfl_xor(s2, 8); s2 += __shfl_xor(s2, 16);
        const float rs = hg ? 1.0f / sqrtf(s2 * (1.0f / 512.0f) + EPS) : 1.0f / sqrtf(s * (1.0f / 128.0f) + EPS);
        const bf16_t* gp = (hg ? HGT + pofs((c0 - HW) >> 7, m) + ((c0 - HW) & 127) : GR + pofs(c0 >> 7, m) + (c0 & 127));
        const u32x4 ga = *(const u32x4*)gp, gb = *(const u32x4*)(gp + 8);
        const unsigned gw_[8] = {ga.x, ga.y, ga.z, ga.w, gb.x, gb.y, gb.z, gb.w};
        float o[16];
#pragma unroll
        for (int i = 0; i < 8; ++i) { const float g0 = silu_f(__uint_as_float(gw_[i] << 16)), g1 = silu_f(__uint_as_float(gw_[i] & 0xffff0000u));
            o[2 * i] = v[(2 * i) >> 2][(2 * i) & 3] * rs * gn[(2 * i) >> 2][(2 * i) & 3] * g0; o[2 * i + 1] = v[(2 * i + 1) >> 2][(2 * i + 1) & 3] * rs * gn[(2 * i + 1) >> 2][(2 * i + 1) & 3] * g1; }
        u32x4 w0, w1;
        w0.x = cvt_pk_bf16(o[0], o[1]); w0.y = cvt_pk_bf16(o[2], o[3]); w0.z = cvt_pk_bf16(o[4], o[5]); w0.w = cvt_pk_bf16(o[6], o[7]);
        w1.x = cvt_pk_bf16(o[8], o[9]); w1.y = cvt_pk_bf16(o[10], o[11]); w1.z = cvt_pk_bf16(o[12], o[13]); w1.w = cvt_pk_bf16(o[14], o[15]);
        bf16_t* mp = MG + (size_t)m * DM + c0;
        *(u32x4*)mp = w0; *(u32x4*)(mp + 8) = w1;
    }
}
__device__ __forceinline__ void phase_m2(const Args& A, LAS unsigned char* lds, int w, int lane) {
    const int G = gridDim.x;
    const int vcu = (G % 8 == 0) ? (int)(blockIdx.x % 8) * (G / 8) + (int)(blockIdx.x / 8) : (int)blockIdx.x;
    for (int it = vcu; it < 256; it += G) { m2_item(A, it >> 6, it & 63, lds, w, lane); __syncthreads(); }
    phase_normgate_sample(A, w, lane);
}
__device__ __forceinline__ void phase_final(const Args& A, int wave, int lane) {
    const float* SS3 = (const float*)(A.ws + WS_SS3);
    const int gw = blockIdx.x * NWAVES + wave, NGW = gridDim.x * NWAVES;
    f32x4 gn[4];
#pragma unroll
    for (int j = 0; j < 4; ++j) gn[j] = ((const f32x4*)A.in[16])[lane + 64 * j];
    for (int m = gw; m < TP; m += NGW) {
        float p = lane < 16 ? SS3[(size_t)m * 16 + lane] : 0.f;
        p = wave_sum(p);
        const float rs = 1.0f / sqrtf(p * (1.0f / DM) + EPS);
        f32x4* xr = (f32x4*)(A.out + O_Y + (size_t)m * DM) + lane;
#pragma unroll
        for (int j = 0; j < 4; ++j) { f32x4 v = xr[64 * j]; v = v * rs * gn[j]; xr[64 * j] = v; }
    }
}

__global__ void __launch_bounds__(NTHREADS, 2) fwd_kernel(Args args) {
    extern __shared__ __attribute__((aligned(16))) unsigned char lds_raw[];
    LAS unsigned char* lds = (LAS unsigned char*)lds_raw;
    const int tid = threadIdx.x, wave = __builtin_amdgcn_readfirstlane(tid >> 6);
    volatile LAS unsigned* MISC = (volatile LAS unsigned*)(lds + MISC_OFF);
    if (tid < 64) MISC[tid] = 0u;
    __syncthreads();
    unsigned char* ws = args.ws;
    XcdBarrier bar; bar.bar = (unsigned*)(ws + WS_CTL); bar.x = 0; bar.st = nullptr;
    if (N_LAUNCHES == 1) bar = xcd_barrier_post((unsigned*)(ws + WS_CTL), MISC + 8);
    const int lo = args.ph_lo, hi = args.ph_hi;
#define IN(k) (lo <= (k) && (k) < hi)
#define SEAM(k) do { if (IN(k) && IN((k) + 1)) { xcd_barrier(bar); if (PROBE & 256) xcd_barrier(bar); } } while (0)
    const int G = gridDim.x, c = blockIdx.x;

    if (IN(0)) { phase_prep(args, lds, wave, fresh_lane()); if (PROBE & 64) { __syncthreads(); phase_prep(args, lds, wave, fresh_lane()); } } SEAM(0);
    if (IN(1)) {
        pg8::Gemm g{(const bf16_t*)(ws + WS_XB), (const bf16_t*)(ws + WS_WIN), DM}; pg8::StaticOrder S; S.init(64, 16, G, c);
        EpiIn E{ws + WS_PROJ, (float*)(ws + WS_DEC), (float*)(ws + WS_HGFS), (const f32x4*)(ws + WS_ROPE), (const float*)(ws + WS_LB)};
        pg8::gemm_phase<EpiIn, false>(lds, g, S, E);
        pg8::sample_gemm<EpiIn>(lds, g.A + (size_t)TP * DM, g.Bt, DM, 16, 64, E, c, G);
        if (PROBE & 1) pg8::sample_gemm<EpiIn>(lds, g.A + (size_t)TP * DM, g.Bt, DM, 16, 64, E, c, G);
        if (PROBE & 2) { pg8::gemm_phase<EpiIn, false>(lds, g, S, E); }
    } SEAM(1);
    if (IN(2)) { phase_m1(args, lds, wave, fresh_lane()); if (PROBE & (16 | 4096 | 8192)) { __syncthreads(); phase_m1(args, lds, wave, fresh_lane(), true); } } SEAM(2);
    if (IN(3)) { phase_m2(args, lds, wave, fresh_lane()); if (PROBE & 32) { __syncthreads(); phase_m2(args, lds, wave, fresh_lane()); } } SEAM(3);
    if (IN(4)) {
        { bf16_t* X1B = (bf16_t*)(ws + WS_X1B); const int gt = c * NTHREADS + tid;
          if (gt < 4 * 256) { const int b = gt >> 8, w = gt & 255; ((u32x4*)(X1B + (size_t)(4098 * b) * DM))[w] = (u32x4){0u, 0u, 0u, 0u}; } }
        pg8::Gemm g{(const bf16_t*)(ws + WS_XB), (const bf16_t*)(ws + WS_WOUT), DM}; pg8::StaticOrder S; S.init(64, 4, G, c);
        EpiOut E{args.in[0], args.in[1], args.out + O_Y, (bf16_t*)(ws + WS_X1B), (float*)(ws + WS_SS2)};
        pg8::gemm_phase<EpiOut, false>(lds, g, S, E);
        pg8::sample_gemm16<EpiOut>(lds, g.A + (size_t)TP * DM, g.Bt, DM, 4, 64, E, c, G);
        if (PROBE & 1) pg8::sample_gemm<EpiOut>(lds, g.A + (size_t)TP * DM, g.Bt, DM, 4, 64, E, c, G);
        if (PROBE & 4) { pg8::gemm_phase<EpiOut, false>(lds, g, S, E); }
    } SEAM(4);
    if (IN(5)) {
        pg8::Gemm g{(const bf16_t*)(ws + WS_X1B), (const bf16_t*)(ws + WS_WUP), DM}; pg8::StaticOrder S; S.init(68, 22, G, c);
        EpiUp E{(const float*)(ws + WS_SS2), args.in[13], args.in[14], args.in[4], (bf16_t*)(ws + WS_ACT), args.out + O_CCP, args.out + O_CCS};
        pg8::gemm_phase<EpiUp, true>(lds, g, S, E);
        {
            const int njobs = 22 * 16, rem = (68 * 22) % G, nidle = rem ? G - rem : 0, pre = (nidle >= 32 && 3 * nidle < njobs) ? 3 * nidle : 0;
            if (pre && c >= rem) pg8::sample_gemm<EpiUp>(lds, g.A + (size_t)16394 * DM, g.Bt, DM, 22, 68, E, c - rem, nidle, pre);
            pg8::sample_gemm<EpiUp>(lds, g.A + (size_t)16394 * DM, g.Bt, DM, 22, 68, E, pre + c, G, njobs);
        }
        if (PROBE & 8) { pg8::gemm_phase<EpiUp, true>(lds, g, S, E); }
    } SEAM(5);
    if (IN(6)) {
        pg8::Gemm g{(const bf16_t*)(ws + WS_ACT), (const bf16_t*)(ws + WS_WD), DFF}; pg8::StaticOrder S; S.init(64, 4, G, c);
        EpiDownT<true> E{args.out + O_Y, (const bf16_t*)(ws + WS_X1B), (float*)(ws + WS_SS3), args.in[16], (float*)(ws + WS_SS3), (unsigned*)(ws + WS_CTL + 32768), lds + RING_BYTES};
        EpiDownT<false> Es{args.out + O_Y, (const bf16_t*)(ws + WS_X1B), (float*)(ws + WS_SS3), args.in[16], nullptr, (unsigned*)(ws + WS_CTL + 32768), lds};
        if (PROBE & 2048) { EpiNull En; pg8::gemm_phase<EpiNull, false>(lds, g, S, En); }
        if (G == 256) pg8::gemm_phase<EpiDownT<true>, false>(lds, g, S, E);
        else pg8::gemm_phase<EpiDownT<false>, false>(lds, g, S, Es);
        pg8::sample_gemm16<EpiDownT<false>>(lds, g.A + (size_t)TP * DFF, g.Bt, DFF, 4, 64, Es, c, G);
    }
    if (G != 256) {
        SEAM(6);
        if (IN(7)) { phase_final(args, wave, fresh_lane()); }
    }
#undef IN
#undef SEAM
}

extern "C" void kernel_launch(void* const* d_in, const int* in_sizes, int n_in, void* d_out, int out_size, void* d_ws, size_t ws_size, hipStream_t stream) {
    static int grid = 0;
    if (grid == 0) {
        if (n_in != 17 || ws_size < WS_END) { fprintf(stderr, "kernel_launch: unexpected n_in %d or ws_size %zu (need %zu)\n", n_in, ws_size, (size_t)WS_END); grid = -1; return; }
        int dev = 0, cus = 0, per_cu = 0;
        hipGetDevice(&dev); hipDeviceGetAttribute(&cus, hipDeviceAttributeMultiprocessorCount, dev);
        hipFuncSetAttribute((const void*)fwd_kernel, hipFuncAttributeMaxDynamicSharedMemorySize, LDS_BYTES);
        hipOccupancyMaxActiveBlocksPerMultiprocessor(&per_cu, (const void*)fwd_kernel, NTHREADS, LDS_BYTES);
        if (per_cu < 1) { fprintf(stderr, "kernel_launch: occupancy query says %d blocks per CU\n", per_cu); per_cu = 1; }
        (void)hipGetLastError();
        grid = cus;
        if (grid > 256) grid = 256;
        fprintf(stderr, "kernel_launch: cus %d per_cu %d grid %d ws %zu\n", cus, per_cu, grid, ws_size);
    }
    if (grid < 0) return;
    hipMemsetAsync((char*)d_ws + WS_CTL, 0, 65536, stream);
    Args a{};
    for (int i = 0; i < 17; ++i) a.in[i] = (const float*)d_in[i];
    a.out = (float*)d_out; a.ws = (unsigned char*)d_ws;
    if (N_LAUNCHES == 1) {
        a.ph_lo = 0; a.ph_hi = 8;
        void* kargs[] = {&a};
#if PROBE & 1024
        hipLaunchKernelGGL(fwd_kernel, dim3(grid), dim3(NTHREADS), LDS_BYTES, stream, a); hipError_t e = hipSuccess; (void)kargs;
#else
        hipError_t e = hipLaunchCooperativeKernel((const void*)fwd_kernel, dim3(grid), dim3(NTHREADS), kargs, LDS_BYTES, stream);
#endif
        if (e != hipSuccess) fprintf(stderr, "cooperative launch failed: %s (grid %d)\n", hipGetErrorString(e), grid);
    } else {
        for (int p = 0; p < 8; ++p) { a.ph_lo = p; a.ph_hi = p + 1; hipLaunchKernelGGL(fwd_kernel, dim3(grid), dim3(NTHREADS), LDS_BYTES, stream, a); }
    }
}
```

```cpp
#include <hip/hip_runtime.h>
#include <cstdio>
#include <cstdint>

#ifndef PROBE
#define PROBE 0
#endif
#ifndef N_LAUNCHES
#define N_LAUNCHES 1
#endif

#define LAS __attribute__((address_space(3)))
typedef unsigned short bf16_t;
typedef short bf16x8 __attribute__((ext_vector_type(8)));
typedef float f32x4 __attribute__((ext_vector_type(4)));
typedef float f32x2 __attribute__((ext_vector_type(2)));
typedef unsigned u32x4 __attribute__((ext_vector_type(4)));
typedef unsigned u32x2 __attribute__((ext_vector_type(2)));

constexpr int DM = 1024, TP = 16384, TS = 256, TT = TP + TS, SEQ = 4096;
constexpr int DFF = 2816, UPC = 5632, INC = 4096, HW = 512;
constexpr float EPS = 1e-6f;
constexpr int NTHREADS = 512, NWAVES = 8;
constexpr int LDS_BYTES = 163840;
constexpr int RING_BYTES = 131072;
constexpr int MISC_OFF = LDS_BYTES - 256;

constexpr size_t O_Y = 0, O_RETP = 17039360, O_HGP = 17301504, O_CCP = 17563648, O_RETS = 17586176, O_HGS = 18634752, O_CCS = 19683328;

constexpr size_t WS_CTL = 0;
constexpr size_t WS_WIN = 65536;
constexpr size_t WS_WOUT = WS_WIN + (size_t)INC * DM * 2;
constexpr size_t WS_WUP = WS_WOUT + (size_t)DM * DM * 2;
constexpr size_t WS_WD = WS_WUP + (size_t)UPC * DM * 2;
constexpr size_t WS_ROPE = WS_WD + (size_t)DM * DFF * 2;
constexpr size_t WS_LB = WS_ROPE + (size_t)SEQ * 64 * 8;
constexpr size_t WS_SS2 = WS_LB + 4096;
constexpr size_t WS_SS3 = WS_SS2 + (size_t)TT * 16 * 4;
constexpr size_t WS_XB = WS_SS3 + (size_t)TT * 16 * 4;
constexpr size_t WS_PROJ = WS_XB + (size_t)TT * DM * 2;
constexpr size_t PSZ = (size_t)TT * HW * 2;
constexpr size_t WS_QR = WS_PROJ, WS_KR = WS_PROJ + PSZ, WS_VR = WS_PROJ + 2 * PSZ, WS_GR = WS_PROJ + 3 * PSZ, WS_HQ = WS_PROJ + 4 * PSZ,
                 WS_HK = WS_PROJ + 5 * PSZ, WS_HI = WS_PROJ + 6 * PSZ, WS_HGT = WS_PROJ + 7 * PSZ;
constexpr size_t WS_DEC = WS_PROJ + 8 * PSZ;
constexpr size_t WS_HGFS = WS_DEC + (size_t)256 * HW * 4;
constexpr size_t WS_PROJ_END = WS_HGFS + (size_t)TS * HW * 4;
constexpr int X1B_ROWS = 16896;
constexpr size_t WS_X1B = WS_PROJ;
constexpr size_t WS_ACT = WS_X1B + (size_t)X1B_ROWS * DM * 2;
constexpr size_t WS_ACT_END = WS_ACT + (size_t)TT * DFF * 2;
static_assert(WS_ACT_END <= WS_PROJ_END, "overlay");
constexpr size_t WS_END = WS_PROJ_END;
static_assert(WS_END <= (size_t)256 * 1024 * 1024, "workspace");

__device__ __forceinline__ size_t pofs(int head, size_t row) { return ((size_t)head * TT + row) * 128; }
__device__ __forceinline__ unsigned cvt_pk_bf16(float lo, float hi) { unsigned r; asm volatile("v_cvt_pk_bf16_f32 %0, %1, %2" : "=v"(r) : "v"(lo), "v"(hi)); return r; }
__device__ __forceinline__ int fresh_lane() { int l; asm volatile("v_mbcnt_lo_u32_b32 %0, -1, 0\n\tv_mbcnt_hi_u32_b32 %0, -1, %0" : "=v"(l)); return l; }
__device__ __forceinline__ float bf2f(unsigned short b) { return __uint_as_float(((unsigned)b) << 16); }
__device__ __forceinline__ float sigmoid_f(float x) { return __builtin_amdgcn_rcpf(1.0f + __builtin_amdgcn_exp2f(x * -1.4426950408889634f)); }
__device__ __forceinline__ float silu_f(float x) { return x * sigmoid_f(x); }
#ifndef WT_STORES
#define WT_STORES 0
#endif
__device__ __forceinline__ void st16b(const void* base, void* p, u32x4 v) {
#if WT_STORES == 3
    __builtin_amdgcn_raw_buffer_store_b128(v, __builtin_amdgcn_make_buffer_rsrc((void*)base, 0, 0x7fffffff, 0x00020000), (int)((const char*)p - (const char*)base), 0, 16);
#else
    *(u32x4*)p = v;
#endif
}
__device__ __forceinline__ void st8b(const void* base, void* p, u32x2 v) {
#if WT_STORES == 3
    __builtin_amdgcn_raw_buffer_store_b64(v, __builtin_amdgcn_make_buffer_rsrc((void*)base, 0, 0x7fffffff, 0x00020000), (int)((const char*)p - (const char*)base), 0, 16);
#else
    *(u32x2*)p = v;
#endif
}
__device__ __forceinline__ void st16(void* p, u32x4 v) {
#if WT_STORES == 1
    asm volatile("global_store_dwordx4 %0, %1, off sc1\n\ts_nop 1" :: "v"(p), "v"(v) : "memory");
#elif WT_STORES == 2
    __builtin_nontemporal_store(v, (u32x4*)p);
#else
    *(u32x4*)p = v;
#endif
}
__device__ __forceinline__ void st8(void* p, u32x2 v) {
#if WT_STORES == 1
    asm volatile("global_store_dwordx2 %0, %1, off sc1\n\ts_nop 1" :: "v"(p), "v"(v) : "memory");
#elif WT_STORES == 2
    __builtin_nontemporal_store(v, (u32x2*)p);
#else
    *(u32x2*)p = v;
#endif
}
template <int CTRL> __device__ __forceinline__ float dpp_z(float src) {
    return __builtin_bit_cast(float, __builtin_amdgcn_update_dpp(0, __builtin_bit_cast(int, src), CTRL, 0xF, 0xF, true)); }
template <int CTRL> __device__ __forceinline__ float dpp_f(float oldv, float src) {
    return __builtin_bit_cast(float, __builtin_amdgcn_update_dpp(__builtin_bit_cast(int, oldv), __builtin_bit_cast(int, src), CTRL, 0xF, 0xF, false)); }

#define XB_TMO      128
#define XB_XCNT(j)  (256  + 64 * (j))
#define XB_XSUB(j)  (1280 + 64 * (j))
#define XB_XGEN(j)  (2304 + 64 * (j))
#define XB_TOP      3328
#define XB_TOPGEN   3392
#define XCD_BAR_WORDS 3456
#define XB_SPIN_CAP (1u << 18)
__device__ __forceinline__ unsigned xb_ld(unsigned* p)              { return __hip_atomic_load(p, __ATOMIC_RELAXED, __HIP_MEMORY_SCOPE_AGENT); }
__device__ __forceinline__ unsigned xb_add(unsigned* p, unsigned v) { return __hip_atomic_fetch_add(p, v, __ATOMIC_RELAXED, __HIP_MEMORY_SCOPE_AGENT); }
__device__ __forceinline__ unsigned xb_xcc_id() { return (unsigned)__builtin_amdgcn_s_getreg((3 << 11) | 20) & 0xFu; }
#define XB_SPIN(cond, bar) do { unsigned _sp = 0; while (cond) { __builtin_amdgcn_s_sleep(1); \
    if ((++_sp & 255u) == 0u) { if (xb_ld(&(bar)[XB_TMO])) break; if (_sp > XB_SPIN_CAP) { atomicAdd(&(bar)[XB_TMO], 1u); break; } } } } while (0)
struct XcdBarrier { unsigned* bar; unsigned x; volatile LAS unsigned* st; };
__device__ __forceinline__ XcdBarrier xcd_barrier_post(unsigned* bar, volatile LAS unsigned* st) {
    XcdBarrier b; b.bar = bar; b.x = xb_xcc_id(); b.st = st;
    if (threadIdx.x == 0) (void)xb_add(&bar[XB_XCNT(b.x)], 1u);
    return b;
}
__device__ __forceinline__ void xcd_barrier_complete(unsigned* bar, unsigned x, unsigned& nloc, unsigned& nx) {
    const unsigned G = gridDim.x * gridDim.y * gridDim.z;
    unsigned sum, cnt, mine, sp = 0u;
    for (;;) {
        sum = 0u; cnt = 0u; mine = 0u;
#pragma unroll
        for (unsigned j = 0; j < 16; ++j) { const unsigned c = xb_ld(&bar[XB_XCNT(j)]); sum += c; cnt += (c > 0u) ? 1u : 0u; mine = (j == x) ? c : mine; }
        if (sum == G) break;
        __builtin_amdgcn_s_sleep(1);
        if ((++sp & 255u) == 0u) { if (xb_ld(&bar[XB_TMO])) break; if (sp > XB_SPIN_CAP) { atomicAdd(&bar[XB_TMO], 1u); break; } }
    }
    nloc = mine > 0u ? mine : 1u; nx = cnt > 0u ? cnt : 1u;
}
__device__ __forceinline__ void xcd_barrier(const XcdBarrier& b) {
    asm volatile("s_waitcnt vmcnt(0)" ::: "memory");
    __syncthreads();
    if (threadIdx.x == 0) {
        unsigned* bar = b.bar;
        __builtin_amdgcn_s_waitcnt(0);
        unsigned nloc = b.st[0], nx = b.st[1];
        if (nloc == 0u) { xcd_barrier_complete(bar, b.x, nloc, nx); b.st[0] = nloc; b.st[1] = nx; }
        const unsigned old = xb_add(&bar[XB_XSUB(b.x)], 1u);
        const unsigned gen = old / nloc;
        if (old + 1u == (gen + 1u) * nloc) {
            __builtin_amdgcn_fence(__ATOMIC_RELEASE, "agent");
            asm volatile("s_waitcnt vmcnt(0)" ::: "memory");
            const unsigned og = xb_add(&bar[XB_TOP], 1u);
            const unsigned tg = og / nx;
            if (og + 1u == (tg + 1u) * nx) xb_add(&bar[XB_TOPGEN], 1u);
            else XB_SPIN(xb_ld(&bar[XB_TOPGEN]) == tg, bar);
            __builtin_amdgcn_fence(__ATOMIC_ACQUIRE, "agent");
            xb_add(&bar[XB_XGEN(b.x)], 1u);
            asm volatile("s_waitcnt vmcnt(0)" ::: "memory");
        } else {
            XB_SPIN(xb_ld(&bar[XB_XGEN(b.x)]) == gen, bar);
            __builtin_amdgcn_fence(__ATOMIC_ACQUIRE, "agent");
            asm volatile("s_waitcnt vmcnt(0)" ::: "memory");
        }
    }
    __syncthreads();
}

namespace pg8 {
constexpr int BM = 256, BK = 64, HALF = 128, HTB = HALF * BK * 2, NXCD = 8, WGM = 8;
__host__ __device__ __forceinline__ int lds_byte(int r, int c) { const int st = (r >> 4) * 2 + (c >> 5), rr = r & 15, cc = c & 31, ob = rr * 64 + cc * 2; return st * 1024 + (ob ^ (((ob >> 9) & 1) << 5)); }
__host__ __device__ __forceinline__ void stage_rc(int b, int& R, int& C) { const int st = b / 1024, sb = b % 1024, swz = sb ^ (((sb >> 9) & 1) << 5); R = (st >> 1) * 16 + swz / 64; C = (st & 1) * 32 + (swz % 64) / 2; }
__host__ __device__ __forceinline__ int perm32(int rho) { const int n = rho >> 4, i = rho & 15; return 8 * (i >> 2) + 4 * n + (i & 3); }

struct Unit { int pm, pn; };
struct Gemm { const bf16_t* A; const bf16_t* Bt; int K; };

struct StaticOrder {
    int nM, nN, nwg, G, c;
    __device__ void init(int nM_, int nN_, int G_, int c_) { nM = nM_; nN = nN_; nwg = nM * nN; G = G_; c = c_; }
    __device__ bool next(int i, Unit& u) const {
        const long L = (long)i * G + c; if (L >= nwg) return false;
        int wgid = (int)L; { const int q = nwg / NXCD, r = nwg % NXCD, xcd = wgid % NXCD, off = wgid / NXCD; wgid = (xcd < r ? xcd * (q + 1) : r * (q + 1) + (xcd - r) * q) + off; }
        const int nig = WGM * nN, gid = wgid / nig, fm = gid * WGM, gsz = (nM - fm) < WGM ? (nM - fm) : WGM;
        u.pm = fm + ((wgid % nig) % gsz); u.pn = (wgid % nig) / gsz; return true;
    }
};

struct AInfo { const char* base; size_t hstep; unsigned v0, v1; };
template <bool UPMAP>
__device__ __forceinline__ AInfo a_info(const Gemm& g, const Unit& u, int tid) {
    AInfo a; const int K = g.K;
    int R0, C0, R1, C1; stage_rc(tid * 16, R0, C0); stage_rc(tid * 16 + 8192, R1, C1);
    if constexpr (!UPMAP) {
        a.base = (const char*)g.A + (size_t)u.pm * 256 * K * 2; a.hstep = (size_t)HALF * K * 2;
        a.v0 = (unsigned)(R0 * K + C0) * 2u; a.v1 = (unsigned)(R1 * K + C1) * 2u;
    } else {
        if (u.pm < 68) {
            const int b = u.pm / 17, j = u.pm % 17;
            a.base = (const char*)g.A + (size_t)(4098 * b + 248 * j) * K * 2; a.hstep = (size_t)124 * K * 2;
            a.v0 = (unsigned)((R0 - 2 * (R0 >> 6)) * K + C0) * 2u; a.v1 = (unsigned)((R1 - 2 * (R1 >> 6)) * K + C1) * 2u;
        } else {
            a.base = (const char*)g.A + (size_t)16394 * K * 2; a.hstep = (size_t)HALF * K * 2;
            a.v0 = (unsigned)(R0 * K + C0) * 2u; a.v1 = (unsigned)(R1 * K + C1) * 2u;
        }
    }
    return a;
}

template <class Epi, bool UPMAP>
__device__ __forceinline__ void gemm_phase(LAS unsigned char* lds, const Gemm g, const StaticOrder& S, const Epi& E) {
    const int tid = threadIdx.x, wid = __builtin_amdgcn_readfirstlane(tid >> 6), lane = tid & 63, wr = wid >> 2, wc = wid & 3, fr = lane & 15, fq = lane >> 4;
    const int K = g.K, nt = K / BK;
    unsigned voffB[2];
#pragma unroll
    for (int i = 0; i < 2; ++i) { int R, C; stage_rc(tid * 16 + i * 8192, R, C); const int Rb = (R & ~31) + perm32(R & 31); voffB[i] = (unsigned)(Rb * K + C) * 2u; }
    const size_t kstep = (size_t)(BK * 2);
    const size_t hstepB = (size_t)HALF * K * 2;
    const size_t tstepB = 2 * hstepB;
    const unsigned ldsw = (unsigned)wid * 1024u;
    const int aoff = lds_byte(wr * 64 + fr, fq * 8), boff = lds_byte(wc * 32 + fr, fq * 8);
#define PG8_SA(b, h) (((b) * 2 + (h)) * HTB)
#define PG8_SB(b, h) ((4 + (b) * 2 + (h)) * HTB)
#define PG8_STAGEB(bufoff, gbase) do { _Pragma("unroll") for (int _i = 0; _i < 2; ++_i) \
        __builtin_amdgcn_global_load_lds((const unsigned*)((const char*)(gbase) + voffB[_i]), (LAS unsigned*)(lds + (bufoff) + ldsw + _i * 8192), 16, 0, 0); } while (0)
#define PG8_STAGEA(bufoff, gbase, va0, va1) do { \
        __builtin_amdgcn_global_load_lds((const unsigned*)((const char*)(gbase) + (va0)), (LAS unsigned*)(lds + (bufoff) + ldsw), 16, 0, 0); \
        __builtin_amdgcn_global_load_lds((const unsigned*)((const char*)(gbase) + (va1)), (LAS unsigned*)(lds + (bufoff) + ldsw + 8192), 16, 0, 0); } while (0)
#define PG8_LDA(dst, b, h) do { _Pragma("unroll") for (int m = 0; m < 4; ++m) _Pragma("unroll") for (int k = 0; k < 2; ++k) dst[m][k] = *(const LAS bf16x8*)(lds + PG8_SA(b, h) + aoff + m * 2048 + k * 1024); } while (0)
#define PG8_LDB(dst, b, h) do { _Pragma("unroll") for (int n = 0; n < 2; ++n) _Pragma("unroll") for (int k = 0; k < 2; ++k) dst[n][k] = *(const LAS bf16x8*)(lds + PG8_SB(b, h) + boff + n * 2048 + k * 1024); } while (0)
#define PG8_MMA(ai, bj, At, Bt) do { __builtin_amdgcn_s_setprio(1); _Pragma("unroll") for (int m = 0; m < 4; ++m) _Pragma("unroll") for (int n = 0; n < 2; ++n) _Pragma("unroll") for (int k = 0; k < 2; ++k) \
        acc[ai][bj][m][n] = __builtin_amdgcn_mfma_f32_16x16x32_bf16(Bt[n][k], At[m][k], acc[ai][bj][m][n], 0, 0, 0); __builtin_amdgcn_s_setprio(0); } while (0)
#define PG8_WAIT_V(n) asm volatile("s_waitcnt vmcnt(" #n ")" ::: "memory")
#define PG8_WAIT_L(n) asm volatile("s_waitcnt lgkmcnt(" #n ")" ::: "memory")
#define PG8_BAR __builtin_amdgcn_s_barrier()
#define PG8_SCHED __builtin_amdgcn_sched_barrier(0)
    Unit cur, nxt; int ui = 0;
    if (!S.next(0, cur)) return;
    f32x4 acc[2][2][4][2];
#pragma unroll
    for (int a = 0; a < 2; ++a)
#pragma unroll
        for (int b = 0; b < 2; ++b)
#pragma unroll
            for (int m = 0; m < 4; ++m)
#pragma unroll
                for (int n = 0; n < 2; ++n) acc[a][b][m][n] = (f32x4){0.f, 0.f, 0.f, 0.f};
    bf16x8 At[4][2], B0[2][2], B1[2][2];
    AInfo ca = a_info<UPMAP>(g, cur, tid);
    const char* cA = ca.base; const char* cB = (const char*)g.Bt + (size_t)cur.pn * tstepB;
    PG8_STAGEB(PG8_SB(0, 0), cB); PG8_STAGEB(PG8_SB(0, 1), cB + hstepB); PG8_STAGEA(PG8_SA(0, 0), cA, ca.v0, ca.v1); PG8_STAGEA(PG8_SA(0, 1), cA + ca.hstep, ca.v0, ca.v1);
    if (wr == 1) PG8_BAR;
    PG8_WAIT_V(2); PG8_BAR;
    PG8_STAGEB(PG8_SB(1, 0), cB + kstep); PG8_STAGEA(PG8_SA(1, 0), cA + kstep, ca.v0, ca.v1); PG8_STAGEB(PG8_SB(1, 1), cB + hstepB + kstep);
    PG8_WAIT_V(6); PG8_BAR;
    for (;;) {
        const bool has_next = S.next(ui + 1, nxt);
        AInfo na = ca; if (has_next) na = a_info<UPMAP>(g, nxt, tid);
        const char* nA = na.base; const char* nB = has_next ? (const char*)g.Bt + (size_t)nxt.pn * tstepB : cB;
        for (int t = 0; t < nt; t += 2) {
            const bool last = (t == nt - 2);
            const char* a1 = cA + (size_t)(t + 1) * kstep;
            const char* a2 = last ? nA : cA + (size_t)(t + 2) * kstep; const char* b2 = last ? nB : cB + (size_t)(t + 2) * kstep;
            const char* a3 = a2 + kstep; const char* b3 = b2 + kstep;
            const size_t h2 = last ? na.hstep : ca.hstep; const unsigned w0 = last ? na.v0 : ca.v0, w1 = last ? na.v1 : ca.v1;
            PG8_LDB(B0, 0, 0); PG8_LDB(B1, 0, 1); PG8_SCHED; PG8_LDA(At, 0, 0); PG8_STAGEA(PG8_SA(1, 1), a1 + ca.hstep, ca.v0, ca.v1);
            PG8_WAIT_V(8); PG8_WAIT_L(0); PG8_BAR; PG8_MMA(0, 0, At, B0); PG8_MMA(0, 1, At, B1); PG8_BAR; PG8_SCHED;
            PG8_LDA(At, 0, 1); PG8_STAGEB(PG8_SB(0, 0), b2); PG8_STAGEB(PG8_SB(0, 1), b2 + hstepB); PG8_STAGEA(PG8_SA(0, 0), a2, w0, w1);
            PG8_WAIT_V(8); PG8_WAIT_L(0); PG8_BAR; PG8_MMA(1, 0, At, B0); PG8_MMA(1, 1, At, B1); PG8_BAR; PG8_SCHED;
            PG8_LDB(B0, 1, 0); PG8_LDB(B1, 1, 1); PG8_SCHED; PG8_LDA(At, 1, 0); PG8_STAGEA(PG8_SA(0, 1), a2 + h2, w0, w1);
            PG8_WAIT_V(8); PG8_WAIT_L(0); PG8_BAR; PG8_MMA(0, 0, At, B0); PG8_MMA(0, 1, At, B1); PG8_BAR; PG8_SCHED;
            PG8_LDA(At, 1, 1); PG8_STAGEB(PG8_SB(1, 0), b3); PG8_STAGEB(PG8_SB(1, 1), b3 + hstepB); PG8_STAGEA(PG8_SA(1, 0), a3, w0, w1);
            PG8_WAIT_V(8); PG8_WAIT_L(0); PG8_BAR; PG8_MMA(1, 0, At, B0); PG8_MMA(1, 1, At, B1); PG8_BAR; PG8_SCHED;
        }
        if (wr == 0) PG8_BAR;
        E(acc, cur, wr, wc, fr, fq);
        if constexpr ((PROBE & 512) && Epi::IDEM) E(acc, cur, wr, wc, fr, fq);
        if (!has_next) break;
#pragma unroll
        for (int a = 0; a < 2; ++a)
#pragma unroll
            for (int b = 0; b < 2; ++b)
#pragma unroll
                for (int m = 0; m < 4; ++m)
#pragma unroll
                    for (int n = 0; n < 2; ++n) acc[a][b][m][n] = (f32x4){0.f, 0.f, 0.f, 0.f};
        cur = nxt; ca = na; cA = nA; cB = nB; ++ui;
        if (wr == 1) PG8_BAR;
    }
    PG8_WAIT_V(0);
    PG8_BAR;
#undef PG8_SA
#undef PG8_SB
#undef PG8_STAGEA
#undef PG8_STAGEB
#undef PG8_LDA
#undef PG8_LDB
#undef PG8_MMA
#undef PG8_WAIT_V
#undef PG8_WAIT_L
#undef PG8_BAR
#undef PG8_SCHED
}

template <class Epi>
__device__ __forceinline__ void sample_gemm(LAS unsigned char* lds, const bf16_t* Arows, const bf16_t* Bt, const int K, const int nN, const int pm_unit, const Epi& E, const int job0, const int jstride, const int jend = 1 << 30) {
    const int tid = threadIdx.x, w = __builtin_amdgcn_readfirstlane(tid >> 6);
    int lane = tid & 63; asm volatile("" : "+v"(lane));
    const int fr = lane & 15, fq = lane >> 4;
    const int per = K / 256;
#pragma unroll 1
    for (int job = job0; job < nN * 16 && job < jend; job += jstride) {
        const int pn = job >> 4, jai = (job >> 3) & 1, jwr = (job >> 2) & 1, jwc = job & 3;
        f32x4 h[2][4][2];
#pragma unroll
        for (int b = 0; b < 2; ++b)
#pragma unroll
            for (int m = 0; m < 4; ++m)
#pragma unroll
                for (int n = 0; n < 2; ++n) h[b][m][n] = (f32x4){0.f, 0.f, 0.f, 0.f};
        const bf16_t* ap = Arows + (size_t)(jai * 128 + jwr * 64 + fr) * K + 8 * fq + (w * per) * 32;
        const bf16_t* bp = Bt + (size_t)(pn * 256 + jwc * 32 + 8 * (fr >> 2) + (fr & 3)) * K + 8 * fq + (w * per) * 32;
#pragma unroll 1
        for (int ks0 = 0; ks0 < per; ks0 += 4) {
            bf16x8 af[4][4], bfr[4][2][2];
#pragma unroll
            for (int kl = 0; kl < 4; ++kl) {
                const int ks = (ks0 + kl < per) ? ks0 + kl : per - 1;
#pragma unroll
                for (int m = 0; m < 4; ++m) af[kl][m] = *(const bf16x8*)(ap + (size_t)(16 * m) * K + 32 * ks);
#pragma unroll
                for (int bj = 0; bj < 2; ++bj)
#pragma unroll
                    for (int n = 0; n < 2; ++n) bfr[kl][bj][n] = *(const bf16x8*)(bp + (size_t)(bj * 128 + 4 * n) * K + 32 * ks);
            }
#pragma unroll
            for (int kl = 0; kl < 4; ++kl)
                if (ks0 + kl < per) {
#pragma unroll
                    for (int bj = 0; bj < 2; ++bj)
#pragma unroll
                        for (int m = 0; m < 4; ++m)
#pragma unroll
                            for (int n = 0; n < 2; ++n) h[bj][m][n] = __builtin_amdgcn_mfma_f32_16x16x32_bf16(bfr[kl][bj][n], af[kl][m], h[bj][m][n], 0, 0, 0);
                }
        }
        __syncthreads();
#pragma unroll
        for (int bj = 0; bj < 2; ++bj)
#pragma unroll
            for (int m = 0; m < 4; ++m)
#pragma unroll
                for (int n = 0; n < 2; ++n) *(LAS f32x4*)(lds + ((w * 16 + (bj * 4 + m) * 2 + n) * 64 + lane) * 16) = h[bj][m][n];
        __syncthreads();
#pragma unroll
        for (int q = 0; q < 2; ++q) {
            LAS unsigned char* sp = lds + ((2 * w + q) * 64 + lane) * 16;
            f32x4 sum = *(const LAS f32x4*)sp;
#pragma unroll
            for (int ww = 1; ww < 8; ++ww) sum += *(const LAS f32x4*)(sp + ww * 16384);
            *(LAS f32x4*)sp = sum;
        }
        __syncthreads();
        if (w < 4) {
            f32x4 acc[2][2][4][2];
#pragma unroll
            for (int ai = 0; ai < 2; ++ai)
#pragma unroll
                for (int bj = 0; bj < 2; ++bj)
#pragma unroll
                    for (int m = 0; m < 4; ++m)
#pragma unroll
                        for (int n = 0; n < 2; ++n) acc[ai][bj][m][n] = *(const LAS f32x4*)(lds + (((bj * 4 + m) * 2 + n) * 64 + lane) * 16);
            Unit u; u.pm = pm_unit; u.pn = pn;
            E(acc, u, jwr, jwc, fr, fq, 1u << (4 * jai + w));
        }
        if constexpr (Epi::POST) E.post(lds, 2 * jai + jwr, w, lane, 16u);
    }
    __syncthreads();
}

template <class Epi>
__device__ __forceinline__ void sample_gemm16(LAS unsigned char* lds, const bf16_t* Arows, const bf16_t* Bt, const int K, const int nN, const int pm_unit, const Epi& E, const int job0, const int jstride) {
    const int tid = threadIdx.x, w = __builtin_amdgcn_readfirstlane(tid >> 6);
    int lane = tid & 63; asm volatile("" : "+v"(lane));
    const int fr = lane & 15, fq = lane >> 4;
    const int per = K / 256;
#pragma unroll 1
    for (int job = job0; job < nN * 64; job += jstride) {
        const int pn = job >> 6, jai = (job >> 5) & 1, jwr = (job >> 4) & 1, jm = (job >> 2) & 3, jwc = job & 3;
        f32x4 h[2][2];
#pragma unroll
        for (int b = 0; b < 2; ++b)
#pragma unroll
            for (int n = 0; n < 2; ++n) h[b][n] = (f32x4){0.f, 0.f, 0.f, 0.f};
        const bf16_t* ap = Arows + (size_t)(jai * 128 + jwr * 64 + 16 * jm + fr) * K + 8 * fq + (w * per) * 32;
        const bf16_t* bp = Bt + (size_t)(pn * 256 + jwc * 32 + 8 * (fr >> 2) + (fr & 3)) * K + 8 * fq + (w * per) * 32;
#pragma unroll 1
        for (int ks0 = 0; ks0 < per; ks0 += 6) {
            bf16x8 af[6], bfr[6][2][2];
#pragma unroll
            for (int kl = 0; kl < 6; ++kl) {
                const int ks = (ks0 + kl < per) ? ks0 + kl : per - 1;
                af[kl] = *(const bf16x8*)(ap + 32 * ks);
#pragma unroll
                for (int bj = 0; bj < 2; ++bj)
#pragma unroll
                    for (int n = 0; n < 2; ++n) bfr[kl][bj][n] = *(const bf16x8*)(bp + (size_t)(bj * 128 + 4 * n) * K + 32 * ks);
            }
#pragma unroll
            for (int kl = 0; kl < 6; ++kl)
                if (ks0 + kl < per) {
#pragma unroll
                    for (int bj = 0; bj < 2; ++bj)
#pragma unroll
                        for (int n = 0; n < 2; ++n) h[bj][n] = __builtin_amdgcn_mfma_f32_16x16x32_bf16(bfr[kl][bj][n], af[kl], h[bj][n], 0, 0, 0);
                }
        }
        __syncthreads();
#pragma unroll
        for (int bj = 0; bj < 2; ++bj)
#pragma unroll
            for (int n = 0; n < 2; ++n) *(LAS f32x4*)(lds + ((w * 4 + bj * 2 + n) * 64 + lane) * 16) = h[bj][n];
        __syncthreads();
        if (w < 4) {
            LAS unsigned char* sp = lds + (w * 64 + lane) * 16;
            f32x4 sum = *(const LAS f32x4*)sp;
#pragma unroll
            for (int ww = 1; ww < 8; ++ww) sum += *(const LAS f32x4*)(sp + ww * 4096);
            *(LAS f32x4*)sp = sum;
        }
        __syncthreads();
        if (w == 0) {
            f32x4 acc[2][2][4][2];
#pragma unroll
            for (int ai = 0; ai < 2; ++ai)
#pragma unroll
                for (int bj = 0; bj < 2; ++bj)
#pragma unroll
                    for (int m = 0; m < 4; ++m)
#pragma unroll
                        for (int n = 0; n < 2; ++n) acc[ai][bj][m][n] = *(const LAS f32x4*)(lds + ((bj * 2 + n) * 64 + lane) * 16);
            Unit u; u.pm = pm_unit; u.pn = pn;
            E(acc, u, jwr, jwc, fr, fq, 1u << (4 * jai + jm));
        }
        if constexpr (Epi::POST) E.post(lds, 2 * jai + jwr, w, lane, 64u);
    }
    __syncthreads();
}
}
using pg8::Unit;

struct EpiIn {
    static constexpr bool IDEM = true, POST = false;
    unsigned char* proj; float* DEC; float* HGFS; const f32x4* rope; const float* lb;
    __device__ __forceinline__ void operator()(const f32x4 (&acc)[2][2][4][2], const Unit& u, int wr, int wc, int fr_, int fq_, const unsigned mask = 0xffu) const {
        int fr = fr_, fq = fq_; asm volatile("" : "+v"(fr), "+v"(fq));
        const int pn = u.pn; const bool samp = (u.pm == 64);
        const int dd0 = 32 * (wc & 1) + 8 * fq;
        const int col0 = ((pn & 1) * 2 + (wc >> 1)) * 128 + dd0;
        const int rowb = u.pm * 256 + wr * 64 + fr;
        if (pn < 4) {
            const int type = pn >> 1;
            bf16_t* D = (bf16_t*)(proj + (size_t)type * PSZ);
            const int head = (pn & 1) * 2 + (wc >> 1);
            const float lg = __log2f(1.0f - exp2f(-5.0f - (float)head));
            const float base = type == 0 ? 1.0f : 0.08838834764831845f;
#pragma unroll
            for (int ai = 0; ai < 2; ++ai)
#pragma unroll
                for (int m = 0; m < 4; ++m) if ((mask >> (4 * ai + m)) & 1u) {
                    const int r = rowb + ai * 128 + m * 16;
                    const int pos = r < TP ? (r & 4095) : (1024 + (r & 15));
                    const float e = (float)((r & 63) + 1) * lg;
                    const float sc = samp ? base : base * exp2f(type == 0 ? e : -e);
                    const f32x4* cs = rope + (size_t)pos * 32 + (dd0 >> 1);
                    const f32x4 c0 = cs[0], c1 = cs[1], c2 = cs[2], c3 = cs[3];
                    const f32x4 lo0 = acc[ai][0][m][0], lo1 = acc[ai][0][m][1], hi0 = acc[ai][1][m][0], hi1 = acc[ai][1][m][1];
                    float ol[8], oh[8];
                    ol[0] = lo0[0] * c0[0] - hi0[0] * c0[1]; oh[0] = lo0[0] * c0[1] + hi0[0] * c0[0];
                    ol[1] = lo0[1] * c0[2] - hi0[1] * c0[3]; oh[1] = lo0[1] * c0[3] + hi0[1] * c0[2];
                    ol[2] = lo0[2] * c1[0] - hi0[2] * c1[1]; oh[2] = lo0[2] * c1[1] + hi0[2] * c1[0];
                    ol[3] = lo0[3] * c1[2] - hi0[3] * c1[3]; oh[3] = lo0[3] * c1[3] + hi0[3] * c1[2];
                    ol[4] = lo1[0] * c2[0] - hi1[0] * c2[1]; oh[4] = lo1[0] * c2[1] + hi1[0] * c2[0];
                    ol[5] = lo1[1] * c2[2] - hi1[1] * c2[3]; oh[5] = lo1[1] * c2[3] + hi1[1] * c2[2];
                    ol[6] = lo1[2] * c3[0] - hi1[2] * c3[1]; oh[6] = lo1[2] * c3[1] + hi1[2] * c3[0];
                    ol[7] = lo1[3] * c3[2] - hi1[3] * c3[3]; oh[7] = lo1[3] * c3[3] + hi1[3] * c3[2];
                    u32x4 wl, wh;
                    wl.x = cvt_pk_bf16(ol[0] * sc, ol[1] * sc); wl.y = cvt_pk_bf16(ol[2] * sc, ol[3] * sc); wl.z = cvt_pk_bf16(ol[4] * sc, ol[5] * sc); wl.w = cvt_pk_bf16(ol[6] * sc, ol[7] * sc);
                    wh.x = cvt_pk_bf16(oh[0] * sc, oh[1] * sc); wh.y = cvt_pk_bf16(oh[2] * sc, oh[3] * sc); wh.z = cvt_pk_bf16(oh[4] * sc, oh[5] * sc); wh.w = cvt_pk_bf16(oh[6] * sc, oh[7] * sc);
                    bf16_t* rp = D + pofs(head, r) + dd0;
                    st16b(proj, rp, wl); st16b(proj, rp + 64, wh);
                }
        } else if (pn >= 8 && pn < 12) {
            const int lane = fq * 16 + fr;
            const int colh = (pn - 8) * 128 + 32 * wc + 8 * fq;
            bf16_t* dHQ = (bf16_t*)(proj + 4 * PSZ); bf16_t* dHK = (bf16_t*)(proj + 5 * PSZ);
            f32x4 lbv[2];
#pragma unroll
            for (int n = 0; n < 2; ++n) lbv[n] = *(const f32x4*)(lb + colh + 4 * n);
            const int srcl = (lane & 48) | 15;
#pragma unroll
            for (int ai = 0; ai < 2; ++ai) {
                const int rbase = u.pm * 256 + ai * 128 + wr * 64;
#pragma unroll
                for (int n = 0; n < 2; ++n) if ((mask >> (4 * ai)) & 0xfu) {
                    const int cn = colh + 4 * n;
                    f32x4 gg[4], kk[4];
#pragma unroll
                    for (int m = 0; m < 4; ++m)
#pragma unroll
                        for (int j = 0; j < 4; ++j) {
                            const float x = acc[ai][1][m][n][j]; const float sg = sigmoid_f(x); const float l = lbv[n][j];
                            gg[m][j] = l + (1.0f - l) * sg; kk[m][j] = (1.0f - l) * (1.0f - sg);
                        }
                    if (samp) {
#pragma unroll
                        for (int m = 0; m < 4; ++m) if ((mask >> (4 * ai + m)) & 1u) {
                            const int r = rbase + 16 * m + fr;
                            const f32x4 q0 = acc[ai][0][m][n];
                            u32x2 w; w.x = cvt_pk_bf16(q0[0], q0[1]); w.y = cvt_pk_bf16(q0[2], q0[3]);
                            *(u32x2*)(dHQ + pofs(pn - 8, r) + (cn & 127)) = w;
                            *(f32x4*)(HGFS + (size_t)(r - TP) * HW + cn) = gg[m];
                        }
                    } else {
                        f32x4 carry = (f32x4){1.f, 1.f, 1.f, 1.f};
#pragma unroll
                        for (int m = 0; m < 4; ++m)
#pragma unroll
                            for (int j = 0; j < 4; ++j) {
                                float v = gg[m][j];
                                v *= dpp_f<0x111>(1.f, v); v *= dpp_f<0x112>(1.f, v); v *= dpp_f<0x114>(1.f, v); v *= dpp_f<0x118>(1.f, v);
                                v *= carry[j];
                                gg[m][j] = v;
                                carry[j] = __shfl(v, srcl);
                            }
#pragma unroll
                        for (int m = 0; m < 4; ++m) {
                            const int r = rbase + 16 * m + fr;
                            float qo[4], ko[4];
#pragma unroll
                            for (int j = 0; j < 4; ++j) { const float P = gg[m][j]; qo[j] = acc[ai][0][m][n][j] * P; ko[j] = kk[m][j] * __builtin_amdgcn_rcpf(P); }
                            u32x2 wq, wk;
                            wq.x = cvt_pk_bf16(qo[0], qo[1]); wq.y = cvt_pk_bf16(qo[2], qo[3]);
                            wk.x = cvt_pk_bf16(ko[0], ko[1]); wk.y = cvt_pk_bf16(ko[2], ko[3]);
                            st8b(proj, dHQ + pofs(pn - 8, r) + (cn & 127), wq); st8b(proj, dHK + pofs(pn - 8, r) + (cn & 127), wk);
                        }
                        if (fr == 15) {
                            f32x4 d0;
#pragma unroll
                            for (int j = 0; j < 4; ++j) d0[j] = carry[j];
                            *(f32x4*)(DEC + (size_t)(4 * u.pm + 2 * ai + wr) * HW + cn) = d0;
                        }
                    }
                }
            }
        } else {
            bf16_t* D = (bf16_t*)(proj + (size_t)(pn >> 1) * PSZ);
            const bool act = false;
#pragma unroll
            for (int ai = 0; ai < 2; ++ai)
#pragma unroll
                for (int m = 0; m < 4; ++m) if ((mask >> (4 * ai + m)) & 1u) {
                    const int r = rowb + ai * 128 + m * 16;
                    bf16_t* rp = D + pofs((pn & 1) * 2 + (wc >> 1), r) + dd0;
#pragma unroll
                    for (int bj = 0; bj < 2; ++bj) {
                        f32x4 v0 = acc[ai][bj][m][0], v1 = acc[ai][bj][m][1];
                        if (act) {
#pragma unroll
                            for (int j = 0; j < 4; ++j) { v0[j] = silu_f(v0[j]); v1[j] = silu_f(v1[j]); }
                        }
                        u32x4 w; w.x = cvt_pk_bf16(v0[0], v0[1]); w.y = cvt_pk_bf16(v0[2], v0[3]); w.z = cvt_pk_bf16(v1[0], v1[1]); w.w = cvt_pk_bf16(v1[2], v1[3]);
                        st16b(proj, rp + 64 * bj, w);
                    }
                }
        }
    }
};

struct EpiOut {
    static constexpr bool IDEM = true, POST = false;
    const float* xp; const float* xs; float* X1F; bf16_t* X1B; float* SS2;
    __device__ __forceinline__ void operator()(const f32x4 (&acc)[2][2][4][2], const Unit& u, int wr, int wc, int fr_, int fq_, const unsigned mask = 0xffu) const {
        int fr = fr_, fq = fq_; asm volatile("" : "+v"(fr), "+v"(fq));
        const int col0 = u.pn * 256 + wc * 32 + 8 * fq;
#pragma unroll
        for (int ai = 0; ai < 2; ++ai)
#pragma unroll
            for (int m = 0; m < 4; ++m) if ((mask >> (4 * ai + m)) & 1u) {
                const int r = u.pm * 256 + ai * 128 + wr * 64 + m * 16 + fr;
                const float* xr = (r < TP ? xp + (size_t)r * DM : xs + (size_t)(r - TP) * DM) + col0;
                const int rb = r < TP ? (4098 * (r >> 12) + 2 + (r & 4095)) : (16394 + (r - TP));
                bf16_t* o16 = X1B + (size_t)rb * DM + col0;
                float ss = 0.f;
#pragma unroll
                for (int bj = 0; bj < 2; ++bj) {
                    const f32x4 x0 = __builtin_nontemporal_load((const f32x4*)(xr + 128 * bj)), x1 = __builtin_nontemporal_load((const f32x4*)(xr + 128 * bj + 4));
                    const f32x4 v0 = acc[ai][bj][m][0] + x0, v1 = acc[ai][bj][m][1] + x1;
                    u32x4 w; w.x = cvt_pk_bf16(v0[0], v0[1]); w.y = cvt_pk_bf16(v0[2], v0[3]); w.z = cvt_pk_bf16(v1[0], v1[1]); w.w = cvt_pk_bf16(v1[2], v1[3]);
                    st16b(X1B, o16 + 128 * bj, w);
                    ss += (v0[0] * v0[0] + v0[1] * v0[1]) + (v0[2] * v0[2] + v0[3] * v0[3]) + (v1[0] * v1[0] + v1[1] * v1[1]) + (v1[2] * v1[2] + v1[3] * v1[3]);
                }
                ss += __shfl_xor(ss, 16); ss += __shfl_xor(ss, 32);
                if (fq == 0) SS2[(size_t)r * 16 + u.pn * 4 + wc] = ss;
            }
    }
};

struct EpiUp {
    static constexpr bool IDEM = true, POST = false;
    const float* SS2; const float* ck; const float* cb; const float* cache_in; bf16_t* ACT; float* ccp; float* ccs;
    __device__ __forceinline__ void operator()(f32x4 (&acc)[2][2][4][2], const Unit& u, int wr, int wc, int fr_, int fq_, const unsigned mask = 0xffu) const {
        int fr = fr_, fq = fq_; asm volatile("" : "+v"(fr), "+v"(fq));
        const int lane = fq * 16 + fr;
        const int f0 = u.pn * 128 + wc * 32 + 8 * fq;
        const bool samp = (u.pm == 68);
        const int sb = samp ? 0 : u.pm / 17, sj = samp ? 0 : u.pm % 17;
        f32x4 k0[2], k1[2], k2[2], bb[2];
#pragma unroll
        for (int n = 0; n < 2; ++n) { k0[n] = *(const f32x4*)(ck + f0 + 4 * n); k1[n] = *(const f32x4*)(ck + DFF + f0 + 4 * n); k2[n] = *(const f32x4*)(ck + 2 * DFF + f0 + 4 * n); bb[n] = *(const f32x4*)(cb + f0 + 4 * n); }
#pragma unroll
        for (int ai = 0; ai < 2; ++ai) {
            f32x4 prev[2] = {(f32x4){0.f, 0.f, 0.f, 0.f}, (f32x4){0.f, 0.f, 0.f, 0.f}};
#pragma unroll
            for (int m = 0; m < 4; ++m) if ((mask >> (4 * ai + m)) & 1u) {
                int gr; bool valid; int t = 0;
                if (samp) { gr = TP + ai * 128 + wr * 64 + m * 16 + fr; valid = true; }
                else { t = 248 * sj + 62 * (2 * ai + wr) + 16 * m + fr - 2; gr = sb * SEQ + t; valid = (t >= 0) && (t < SEQ); }
                float ssq = 0.f;
                if (valid) { const f32x4 p = *(const f32x4*)(SS2 + (size_t)gr * 16 + 4 * fq); ssq = (p[0] + p[1]) + (p[2] + p[3]); }
                ssq += __shfl_xor(ssq, 16); ssq += __shfl_xor(ssq, 32);
                const float rs = valid ? __frsqrt_rn(ssq * (1.0f / DM) + EPS) : 0.f;
                f32x4 a[2], b[2];
#pragma unroll
                for (int n = 0; n < 2; ++n) { a[n] = acc[ai][0][m][n] * rs; b[n] = acc[ai][1][m][n] * rs; }
                if (samp) {
                    const int s = ai * 8 + wr * 4 + m;
                    if (fr >= 14) {
#pragma unroll
                        for (int n = 0; n < 2; ++n) prev[n] = *(const f32x4*)(cache_in + ((size_t)s * 2 + (fr - 14)) * DFF + f0 + 4 * n);
                    }
                }
                f32x4 o[2];
#pragma unroll
                for (int n = 0; n < 2; ++n)
#pragma unroll
                    for (int j = 0; j < 4; ++j) {
                        const float s1 = dpp_f<0x111>(dpp_f<0x121>(0.f, prev[n][j]), a[n][j]);
                        const float s2 = dpp_f<0x112>(dpp_f<0x122>(0.f, prev[n][j]), a[n][j]);
                        const float cv = bb[n][j] + k0[n][j] * s2 + k1[n][j] * s1 + k2[n][j] * a[n][j];
                        o[n][j] = silu_f(cv) * b[n][j];
                    }
                const bool store = samp ? true : (valid && (16 * m + fr >= 2));
                if (store) {
                    u32x4 w; w.x = cvt_pk_bf16(o[0][0], o[0][1]); w.y = cvt_pk_bf16(o[0][2], o[0][3]); w.z = cvt_pk_bf16(o[1][0], o[1][1]); w.w = cvt_pk_bf16(o[1][2], o[1][3]);
                    st16b(ACT, ACT + (size_t)gr * DFF + f0, w);
                    if (samp) { if (fr >= 14) { float* cp = ccs + ((size_t)(ai * 8 + wr * 4 + m) * 2 + (fr - 14)) * DFF + f0; *(f32x4*)cp = a[0]; *(f32x4*)(cp + 4) = a[1]; } }
                    else if (t >= SEQ - 2) { float* cp = ccp + ((size_t)sb * 2 + (t - (SEQ - 2))) * DFF + f0; *(f32x4*)cp = a[0]; *(f32x4*)(cp + 4) = a[1]; }
                }
                prev[0] = a[0]; prev[1] = a[1];
            }
        }
    }
};

template <bool FUSED>
struct EpiDownT {
    static constexpr bool IDEM = false, POST = !FUSED;
    float* X; const bf16_t* X1B; float* SS3; const float* gfin; float* XS; unsigned* cnt; LAS unsigned char* ldsx;
    static __device__ __forceinline__ void ld8(const bf16_t* p, f32x4& a, f32x4& b) { const u32x4 w = *(const u32x4*)p;
        a[0] = __uint_as_float(w.x << 16); a[1] = __uint_as_float(w.x & 0xffff0000u); a[2] = __uint_as_float(w.y << 16); a[3] = __uint_as_float(w.y & 0xffff0000u);
        b[0] = __uint_as_float(w.z << 16); b[1] = __uint_as_float(w.z & 0xffff0000u); b[2] = __uint_as_float(w.w << 16); b[3] = __uint_as_float(w.w & 0xffff0000u); }
    __device__ __forceinline__ void post(LAS unsigned char* lds, int rb, int w, int lane, const unsigned nexp) const {
        asm volatile("s_waitcnt vmcnt(0)" ::: "memory");
        __syncthreads();
        LAS unsigned* flag = (LAS unsigned*)(lds + RING_BYTES + 8192);
        if (threadIdx.x == 0) {
            __builtin_amdgcn_fence(__ATOMIC_RELEASE, "agent");
            asm volatile("s_waitcnt vmcnt(0)" ::: "memory");
            const unsigned old = __hip_atomic_fetch_add(cnt + 64 * (64 + rb), 1u, __ATOMIC_RELAXED, __HIP_MEMORY_SCOPE_AGENT);
            const unsigned last = (old == nexp - 1u) ? 1u : 0u;
            if (last) { __builtin_amdgcn_fence(__ATOMIC_ACQUIRE, "agent"); asm volatile("s_waitcnt vmcnt(0)" ::: "memory"); }
            *flag = last;
        }
        __syncthreads();
        if (*flag) {
            f32x4 gn[4];
#pragma unroll
            for (int j = 0; j < 4; ++j) gn[j] = ((const f32x4*)gfin)[lane + 64 * j];
            for (int q = w; q < 64; q += NWAVES) {
                const int m = TP + 64 * rb + q;
                float p = lane < 16 ? SS3[(size_t)m * 16 + lane] : 0.f;
#pragma unroll
                for (int o = 1; o < 64; o <<= 1) p += __shfl_xor(p, o);
                const float rs = 1.0f / sqrtf(p * (1.0f / DM) + EPS);
                f32x4* xr = (f32x4*)(X + (size_t)m * DM) + lane;
#pragma unroll
                for (int j = 0; j < 4; ++j) { f32x4 v = xr[64 * j]; v = v * rs * gn[j]; xr[64 * j] = v; }
            }
        }
        __syncthreads();
    }
    __device__ __forceinline__ void operator()(f32x4 (&acc)[2][2][4][2], const Unit& u, int wr, int wc, int fr_, int fq_, const unsigned mask = 0xffu) const {
        int fr = fr_, fq = fq_; asm volatile("" : "+v"(fr), "+v"(fq));
        const int col0 = u.pn * 256 + wc * 32 + 8 * fq;
        if constexpr (!FUSED) {
#pragma unroll
            for (int ai = 0; ai < 2; ++ai)
#pragma unroll
                for (int m = 0; m < 4; ++m) if ((mask >> (4 * ai + m)) & 1u) {
                    const int r = u.pm * 256 + ai * 128 + wr * 64 + m * 16 + fr;
                    float* xr = X + (size_t)r * DM + col0;
                    const int rb = r < TP ? (4098 * (r >> 12) + 2 + (r & 4095)) : (16394 + (r - TP));
                    const bf16_t* x1p = X1B + (size_t)rb * DM + col0;
                    float ss = 0.f;
#pragma unroll
                    for (int bj = 0; bj < 2; ++bj) {
                        f32x4 x0, x1; ld8(x1p + 128 * bj, x0, x1);
                        const f32x4 v0 = acc[ai][bj][m][0] + x0, v1 = acc[ai][bj][m][1] + x1;
                        *(f32x4*)(xr + 128 * bj) = v0; *(f32x4*)(xr + 128 * bj + 4) = v1;
                        ss += (v0[0] * v0[0] + v0[1] * v0[1]) + (v0[2] * v0[2] + v0[3] * v0[3]) + (v1[0] * v1[0] + v1[1] * v1[1]) + (v1[2] * v1[2] + v1[3] * v1[3]);
                    }
                    ss += __shfl_xor(ss, 16); ss += __shfl_xor(ss, 32);
                    if (fq == 0) SS3[(size_t)r * 16 + u.pn * 4 + wc] = ss;
                }
        } else {
            const int tid = threadIdx.x, wid = __builtin_amdgcn_readfirstlane(tid >> 6);
            LAS float* P = (LAS float*)ldsx;
            LAS float* S = (LAS float*)(ldsx + 4096);
#pragma unroll
            for (int ai = 0; ai < 2; ++ai)
#pragma unroll
                for (int m = 0; m < 4; ++m) {
                    const int rl = ai * 128 + wr * 64 + m * 16 + fr;
                    const int r = u.pm * 256 + rl;
                    const bf16_t* x1p = X1B + (size_t)(4098 * (r >> 12) + 2 + (r & 4095)) * DM + col0;
                    float ss = 0.f;
#pragma unroll
                    for (int bj = 0; bj < 2; ++bj) {
                        f32x4 x0, x1; ld8(x1p + 128 * bj, x0, x1);
                        const f32x4 v0 = acc[ai][bj][m][0] + x0, v1 = acc[ai][bj][m][1] + x1;
                        acc[ai][bj][m][0] = v0; acc[ai][bj][m][1] = v1;
                        ss += (v0[0] * v0[0] + v0[1] * v0[1]) + (v0[2] * v0[2] + v0[3] * v0[3]) + (v1[0] * v1[0] + v1[1] * v1[1]) + (v1[2] * v1[2] + v1[3] * v1[3]);
                    }
                    ss += __shfl_xor(ss, 16); ss += __shfl_xor(ss, 32);
                    if (fq == 0) P[rl * 4 + wc] = ss;
                    if (m & 1) asm volatile("" ::: "memory");
                }
            asm volatile("s_waitcnt lgkmcnt(0)" ::: "memory"); __builtin_amdgcn_s_barrier(); asm volatile("" ::: "memory");
            if (tid < 256) {
                const f32x4 p = *(const LAS f32x4*)(P + tid * 4);
                __hip_atomic_store(XS + ((size_t)u.pm * 256 + tid) * 4 + u.pn, (p[0] + p[1]) + (p[2] + p[3]), __ATOMIC_RELAXED, __HIP_MEMORY_SCOPE_AGENT);
            }
            asm volatile("s_waitcnt vmcnt(0)" ::: "memory");
            if (tid < 256 && (tid & 63) == 0) __hip_atomic_fetch_add(cnt + 64 * u.pm, 1u, __ATOMIC_RELAXED, __HIP_MEMORY_SCOPE_AGENT);
            if (wid == 0) {
                unsigned sp = 0;
                while ((unsigned)__builtin_amdgcn_readfirstlane(__hip_atomic_load(cnt + 64 * u.pm, __ATOMIC_RELAXED, __HIP_MEMORY_SCOPE_AGENT)) < 16u) {
                    __builtin_amdgcn_s_sleep(2);
                    if (++sp > (1u << 20)) break;
                }
                __builtin_amdgcn_fence(__ATOMIC_ACQUIRE, "agent");
            }
            asm volatile("s_waitcnt vmcnt(0) lgkmcnt(0)" ::: "memory"); __builtin_amdgcn_s_barrier(); asm volatile("" ::: "memory");
            if (tid < 256) {
                const float* sl = XS + ((size_t)u.pm * 256 + tid) * 4;
                float t = 0.f;
#pragma unroll
                for (int k = 0; k < 4; ++k) t += __hip_atomic_load(sl + k, __ATOMIC_RELAXED, __HIP_MEMORY_SCOPE_AGENT);
                S[tid] = 1.0f / sqrtf(t * (1.0f / DM) + EPS);
            }
            asm volatile("s_waitcnt vmcnt(0) lgkmcnt(0)" ::: "memory"); __builtin_amdgcn_s_barrier(); asm volatile("" ::: "memory");
            f32x4 gv[2][2];
#pragma unroll
            for (int bj = 0; bj < 2; ++bj)
#pragma unroll
                for (int n = 0; n < 2; ++n) gv[bj][n] = *(const f32x4*)(gfin + col0 + 128 * bj + 4 * n);
#pragma unroll
            for (int ai = 0; ai < 2; ++ai)
#pragma unroll
                for (int m = 0; m < 4; ++m) {
                    const int rl = ai * 128 + wr * 64 + m * 16 + fr;
                    const float rs = S[rl];
                    float* xr = X + (size_t)(u.pm * 256 + rl) * DM + col0;
#pragma unroll
                    for (int bj = 0; bj < 2; ++bj) {
                        *(f32x4*)(xr + 128 * bj) = acc[ai][bj][m][0] * rs * gv[bj][0];
                        *(f32x4*)(xr + 128 * bj + 4) = acc[ai][bj][m][1] * rs * gv[bj][1];
                    }
                }
        }
    }
};

struct EpiNull {
    static constexpr bool IDEM = false, POST = false;
    __device__ __forceinline__ void operator()(f32x4 (&acc)[2][2][4][2], const Unit& u, int wr, int wc, int fr_, int fq_, const unsigned mask = 0xffu) const {
#pragma unroll
        for (int a = 0; a < 2; ++a)
#pragma unroll
            for (int b = 0; b < 2; ++b)
#pragma unroll
                for (int m = 0; m < 4; ++m)
#pragma unroll
                    for (int n = 0; n < 2; ++n) asm volatile("" :: "v"(acc[a][b][m][n]));
    }
};
struct Args { const float* in[17]; float* out; unsigned char* ws; int ph_lo, ph_hi; };

__device__ __forceinline__ float wave_sum(float v) {
#pragma unroll
    for (int o = 1; o < 64; o <<= 1) v += __shfl_xor(v, o);
    return v;
}

__device__ __forceinline__ void transpose_item(const float* W, int K, int N, bf16_t* WT, const float* gain, LAS float* scr, int k0, int p0, int s0, int lane) {
    float tv[32];
#pragma unroll
    for (int i = 0; i < 32; ++i) { const int kk = 2 * i + (lane >> 5); tv[i] = __builtin_nontemporal_load(W + (size_t)(k0 + kk) * N + s0 + (lane & 31)); }
    if (gain) {
#pragma unroll
        for (int i = 0; i < 32; ++i) tv[i] *= gain[k0 + 2 * i + (lane >> 5)];
    }
#pragma unroll
    for (int i = 0; i < 32; ++i) scr[(2 * i + (lane >> 5)) * 33 + (lane & 31)] = tv[i];
    asm volatile("s_waitcnt lgkmcnt(0)" ::: "memory");
    const int c = lane & 7;
#pragma unroll
    for (int j = 0; j < 4; ++j) { const int n = (lane >> 3) + 8 * j; const LAS float* s = scr + (8 * c) * 33 + n;
        u32x4 o; o.x = cvt_pk_bf16(s[0 * 33], s[1 * 33]); o.y = cvt_pk_bf16(s[2 * 33], s[3 * 33]); o.z = cvt_pk_bf16(s[4 * 33], s[5 * 33]); o.w = cvt_pk_bf16(s[6 * 33], s[7 * 33]);
        *(u32x4*)(WT + (size_t)(p0 + n) * K + k0 + 8 * c) = o; }
    asm volatile("s_waitcnt lgkmcnt(0)" ::: "memory");
}
__device__ __forceinline__ int colmap_in(int p) {
    const int pn = p >> 8, pl = p & 255, bj = pl >> 7, q = pl & 127;
    if (pn >= 8 && pn < 12) return (bj ? 2560 : 2048) + (pn - 8) * 128 + q;
    const int type = pn >> 1;
    return type * 512 + ((pn & 1) * 2 + (q >> 6)) * 128 + bj * 64 + (q & 63);
}
__device__ __forceinline__ int colmap_up(int p) { const int pn = p >> 8, pl = p & 255, bj = pl >> 7, q = pl & 127; return bj * DFF + 128 * pn + q; }

__device__ __forceinline__ void phase_prep(const Args& A, LAS unsigned char* lds, int wave, int lane) {
    unsigned char* ws = A.ws;
    const int G = gridDim.x, gw = blockIdx.x * NWAVES + wave, NGW = G * NWAVES;
    LAS float* scr = (LAS float*)(lds + wave * 8704);
    bf16_t* WinT = (bf16_t*)(ws + WS_WIN); bf16_t* WoutT = (bf16_t*)(ws + WS_WOUT); bf16_t* WupT = (bf16_t*)(ws + WS_WUP); bf16_t* WdT = (bf16_t*)(ws + WS_WD);
    constexpr int I_IN = 16 * 128, I_OUT = 16 * 32, I_UP = 16 * 176, I_DN = 44 * 32, NITEMS = I_IN + I_OUT + I_UP + I_DN;
    for (int it = gw; it < NITEMS; it += NGW) {
        int r = it;
        if (r < I_IN) { const int kb = r / 128, pb = r % 128; transpose_item(A.in[5], DM, INC, WinT, A.in[10], scr, 64 * kb, 32 * pb, colmap_in(32 * pb), lane); continue; } r -= I_IN;
        if (r < I_OUT) { const int kb = r / 32, pb = r % 32; transpose_item(A.in[9], DM, DM, WoutT, nullptr, scr, 64 * kb, 32 * pb, 32 * pb, lane); continue; } r -= I_OUT;
        if (r < I_UP) { const int kb = r / 176, pb = r % 176; transpose_item(A.in[12], DM, UPC, WupT, A.in[11], scr, 64 * kb, 32 * pb, colmap_up(32 * pb), lane); continue; } r -= I_UP;
        { const int kb = r / 32, pb = r % 32; transpose_item(A.in[15], DFF, DM, WdT, nullptr, scr, 64 * kb, 32 * pb, 32 * pb, lane); }
    }
    bf16_t* XB = (bf16_t*)(ws + WS_XB);
    for (int m0 = gw; m0 < TT; m0 += 4 * NGW) {
        f32x4 v[4][4];
#pragma unroll
        for (int q = 0; q < 4; ++q) {
            const int m = m0 + q * NGW;
            if (m < TT) {
                const float* xrow = m < TP ? A.in[0] + (size_t)m * DM : A.in[1] + (size_t)(m - TP) * DM;
                const f32x4* xr = (const f32x4*)xrow + lane;
#pragma unroll
                for (int j = 0; j < 4; ++j) v[q][j] = __builtin_nontemporal_load(xr + 64 * j);
            }
        }
#pragma unroll
        for (int q = 0; q < 4; ++q) {
            const int m = m0 + q * NGW;
            if (m < TT) {
                float s = 0.f;
#pragma unroll
                for (int j = 0; j < 4; ++j) s += (v[q][j][0] * v[q][j][0] + v[q][j][1] * v[q][j][1]) + (v[q][j][2] * v[q][j][2] + v[q][j][3] * v[q][j][3]);
                const float rs = 1.0f / sqrtf(wave_sum(s) * (1.0f / DM) + EPS);
                u32x2* o8 = (u32x2*)(XB + (size_t)m * DM) + lane;
#pragma unroll
                for (int j = 0; j < 4; ++j) { u32x2 w; w.x = cvt_pk_bf16(v[q][j][0] * rs, v[q][j][1] * rs); w.y = cvt_pk_bf16(v[q][j][2] * rs, v[q][j][3] * rs); o8[64 * j] = w; }
            }
        }
    }
    f32x2* rope = (f32x2*)(ws + WS_ROPE);
    const int gt = blockIdx.x * NTHREADS + threadIdx.x, NGT = G * NTHREADS;
    for (int i = gt; i < SEQ * 64; i += NGT) {
        const int pos = i >> 6, d = i & 63;
        const float inv = 1.0f / powf(10000.0f, (float)d * (1.0f / 64.0f));
        const float ang = (float)pos * inv;
        float sn, cs; sn = sinf(ang); cs = cosf(ang);
        rope[i] = (f32x2){cs, sn};
    }
    if (gt < HW) { const float l0 = A.in[8][gt], l1 = A.in[8][HW + gt]; ((float*)(ws + WS_LB))[gt] = 1.0f / (1.0f + __expf(l1 - l0)); }
    bf16_t* X1B = (bf16_t*)(ws + WS_X1B); (void)X1B;
}

template <bool HG>
__device__ __forceinline__ void sample_mixer_cols(const bf16_t* Q, const bf16_t* Kx, const float* Gf, const bf16_t* V, float* O, const float* st_in, float* st_out, int id) {
    const int tid = threadIdx.x, part = tid & 15, dpi = tid >> 4;
    const int seq = id >> 3, head = (id >> 1) & 3, dv0 = (id & 1) * 64 + 2 * dpi;
    const float* si = st_in + (size_t)(seq * 4 + head) * 16384 + dv0; float* so = st_out + (size_t)(seq * 4 + head) * 16384 + dv0;
    float S[2][8];
#pragma unroll
    for (int i = 0; i < 8; ++i) { const f32x2 t = *(const f32x2*)(si + (size_t)(part * 8 + i) * 128); S[0][i] = t[0]; S[1][i] = t[1]; }
    const int row0 = TP + seq * 16, ck = head * 128 + part * 8;
    const float gamma = 1.0f - exp2f(-5.0f - (float)head);
    const size_t hb = pofs(head, 0); const int pk8 = part * 8;
    constexpr int U = 2;
    u32x4 q8[2][U], k8[2][U]; f32x4 g0[2][U], g1[2][U]; unsigned vv[2][U];
#define SM_LOAD(set, t0_) do { _Pragma("unroll") for (int u = 0; u < U; ++u) { \
        const size_t r = (size_t)(row0 + (t0_) + u) * HW; const size_t rp_ = hb + (size_t)(row0 + (t0_) + u) * 128; q8[set][u] = *(const u32x4*)(Q + rp_ + pk8); \
        if (HG) { g0[set][u] = *(const f32x4*)(Gf + r + ck); g1[set][u] = *(const f32x4*)(Gf + r + ck + 4); } else k8[set][u] = *(const u32x4*)(Kx + rp_ + pk8); \
        vv[set][u] = *(const unsigned*)(V + rp_ + dv0); } } while (0)
    SM_LOAD(0, 0);
#pragma unroll 1
    for (int t0 = 0; t0 < 16; t0 += 2 * U) {
#pragma unroll
        for (int set = 0; set < 2; ++set) {
            const int tb = t0 + set * U;
            { const int tn = (tb + U < 16) ? tb + U : 16 - U; if (set == 0) SM_LOAD(1, tn); else SM_LOAD(0, tn); }
#pragma unroll
            for (int u = 0; u < U; ++u) {
                const float v0 = __uint_as_float(vv[set][u] << 16), v1 = __uint_as_float(vv[set][u] & 0xffff0000u);
                float qf[8], kf[8], df[8];
                const unsigned qa[4] = {q8[set][u].x, q8[set][u].y, q8[set][u].z, q8[set][u].w};
#pragma unroll
                for (int i = 0; i < 4; ++i) { qf[2 * i] = __uint_as_float(qa[i] << 16); qf[2 * i + 1] = __uint_as_float(qa[i] & 0xffff0000u); }
                if (HG) {
#pragma unroll
                    for (int i = 0; i < 4; ++i) { df[i] = g0[set][u][i]; df[4 + i] = g1[set][u][i]; }
#pragma unroll
                    for (int i = 0; i < 8; ++i) kf[i] = 1.0f - df[i];
                } else {
                    const unsigned ka[4] = {k8[set][u].x, k8[set][u].y, k8[set][u].z, k8[set][u].w};
#pragma unroll
                    for (int i = 0; i < 4; ++i) { kf[2 * i] = __uint_as_float(ka[i] << 16); kf[2 * i + 1] = __uint_as_float(ka[i] & 0xffff0000u); }
#pragma unroll
                    for (int i = 0; i < 8; ++i) df[i] = gamma;
                }
                float p0 = 0.f, p1 = 0.f;
#pragma unroll
                for (int i = 0; i < 8; ++i) { S[0][i] = df[i] * S[0][i] + kf[i] * v0; p0 += qf[i] * S[0][i]; S[1][i] = df[i] * S[1][i] + kf[i] * v1; p1 += qf[i] * S[1][i]; }
                p0 += dpp_f<0x128>(0.f, p0); p0 += dpp_f<0x124>(0.f, p0); p0 += dpp_f<0x122>(0.f, p0); p0 += dpp_f<0x121>(0.f, p0);
                p1 += dpp_f<0x128>(0.f, p1); p1 += dpp_f<0x124>(0.f, p1); p1 += dpp_f<0x122>(0.f, p1); p1 += dpp_f<0x121>(0.f, p1);
                if (part == 0) *(f32x2*)(O + (size_t)(row0 + tb + u) * DM + (HG ? HW : 0) + head * 128 + dv0) = (f32x2){p0, p1};
            }
        }
    }
#undef SM_LOAD
#pragma unroll
    for (int i = 0; i < 8; ++i) *(f32x2*)(so + (size_t)(part * 8 + i) * 128) = (f32x2){S[0][i], S[1][i]};
}
__device__ __forceinline__ void phase_mixer_sample(const Args& A) {
    unsigned char* ws = A.ws;
    const bf16_t* QR = (const bf16_t*)(ws + WS_QR); const bf16_t* KR = (const bf16_t*)(ws + WS_KR); const bf16_t* VR = (const bf16_t*)(ws + WS_VR);
    const bf16_t* HQ = (const bf16_t*)(ws + WS_HQ); const bf16_t* HI = (const bf16_t*)(ws + WS_HI);
    const float* HGFv = (const float*)(ws + WS_HGFS) - (size_t)TP * HW;
    float* O = A.out + O_Y;
    const int G = gridDim.x;
    for (int it = blockIdx.x; it < 256; it += G) {
        if (it >> 7) sample_mixer_cols<true>(HQ, nullptr, HGFv, HI, O, A.in[3], A.out + O_HGS, it & 127);
        else sample_mixer_cols<false>(QR, KR, nullptr, VR, O, A.in[2], A.out + O_RETS, it & 127);
    }
}

typedef short s16x4 __attribute__((ext_vector_type(4)));
__device__ __forceinline__ bf16x8 tr2(LAS unsigned char* p0, LAS unsigned char* p1) {
    const s16x4 a = __builtin_amdgcn_ds_read_tr16_b64_v4i16((LAS s16x4*)p0);
    const s16x4 b = __builtin_amdgcn_ds_read_tr16_b64_v4i16((LAS s16x4*)p1);
    return __builtin_shufflevector(a, b, 0, 1, 2, 3, 4, 5, 6, 7);
}
#define MFMA16(a, b, c) __builtin_amdgcn_mfma_f32_16x16x32_bf16((a), (b), (c), 0, 0, 0)

constexpr int M1_KSTR = 144, M1_VSTR = 72, M1_KSZ = 64 * M1_KSTR, M1_CH = M1_KSZ + 64 * M1_VSTR, M1_BUF = 2 * M1_CH;
__device__ __forceinline__ void m1_item(const bf16_t* Kt, const bf16_t* V, const float* DECp, bf16_t* ST, float* state_out, int seq, int head, int slice, float gamma64,
                                        LAS unsigned char* lds, int w, int lane, const int pmode = 0) {
    const int tid = threadIdx.x, fr = lane & 15, g = lane >> 4, r4 = fr >> 2, c4 = fr & 3;
    const int dkh = slice >> 2, dvq = slice & 3, tk = w >> 1, tv = w & 1;
    const size_t rbase = (size_t)seq * SEQ;
    const int cb = head * 128;
    const bool vld = tid < 256;
    const bf16_t* kp = Kt + pofs(head, rbase + (tid >> 3)) + dkh * 64 + (tid & 7) * 8;
    const bf16_t* vp = V + pofs(head, rbase + (tid >> 2)) + dvq * 32 + (tid & 3) * 8;
    const int kwo = (tid >> 3) * M1_KSTR + (tid & 7) * 16, vwo = M1_KSZ + (tid >> 2) * M1_VSTR + (tid & 3) * 16;
    const int dv = dvq * 32 + tv * 16 + fr, dk0 = dkh * 64 + 16 * tk + 4 * g;
    const float* dp = DECp ? DECp + (size_t)(seq * 64) * HW + cb + dk0 : nullptr;
    u32x4 rk0[8], rv[8]; f32x4 rd[8];
#define M1_LOAD(slot, n_) do { const size_t o_ = (size_t)(n_) * 64 * 128; rk0[slot] = *(const u32x4*)(kp + o_); \
        rv[slot] = vld ? *(const u32x4*)(vp + o_) : (u32x4){0u, 0u, 0u, 0u}; rd[slot] = dp ? *(const f32x4*)(dp + (size_t)(n_) * HW) : (f32x4){gamma64, gamma64, gamma64, gamma64}; } while (0)
#define M1_WRITE(slot, off_) do { LAS unsigned char* nb_ = lds + (off_); *(LAS u32x4*)(nb_ + kwo) = rk0[slot]; \
        if (vld) { *(LAS u32x2*)(nb_ + vwo) = (u32x2){rv[slot].x, rv[slot].y}; *(LAS u32x2*)(nb_ + vwo + 8) = (u32x2){rv[slot].z, rv[slot].w}; } } while (0)
    M1_LOAD(0, 0); M1_LOAD(1, 1); M1_LOAD(2, 2); M1_LOAD(3, 3); M1_LOAD(4, 4); M1_LOAD(5, 5); M1_LOAD(6, 6); M1_LOAD(7, 7);
    M1_WRITE(0, 0); M1_WRITE(1, M1_CH);
    __syncthreads();
    f32x4 acc = (f32x4){0.f, 0.f, 0.f, 0.f};
    for (int s0 = 0; s0 < 32; s0 += 4) {
#pragma unroll
        for (int u = 0; u < 4; ++u) {
            const int n = 2 * (s0 + u);
            LAS unsigned char* buf = lds + (u & 1) * M1_BUF;
            const f32x4 dec0 = rd[2 * u], dec1 = rd[2 * u + 1];
            { const int na = (n + 8 < 64) ? n + 8 : 62; M1_LOAD(2 * u, na); M1_LOAD(2 * u + 1, na + 1); }
#pragma unroll
            for (int h = 0; h < 2; ++h) {
                if (!(pmode & 1)) { u32x2 sv; sv.x = cvt_pk_bf16(acc[0], acc[1]); sv.y = cvt_pk_bf16(acc[2], acc[3]);
                  st8b(ST, ST + ((size_t)((seq * 64 + n + h) * 4 + head) * 128 + dv) * 128 + dk0, sv); }
#pragma unroll
                for (int ks = 0; ks < 2; ++ks) if (!(pmode & 2)) {
                    LAS unsigned char* ka = buf + h * M1_CH + (32 * ks + 8 * g + r4) * M1_KSTR + 32 * tk + 8 * c4;
                    LAS unsigned char* va = buf + h * M1_CH + M1_KSZ + (32 * ks + 8 * g + r4) * M1_VSTR + 32 * tv + 8 * c4;
                    const bf16x8 af = tr2(ka, ka + 4 * M1_KSTR), bfv = tr2(va, va + 4 * M1_VSTR);
                    acc = MFMA16(af, bfv, acc);
                }
                acc = acc * (h ? dec1 : dec0);
            }
            if (!(pmode & 8)) { M1_WRITE(2 * ((u + 1) & 3), ((u + 1) & 1) * M1_BUF); M1_WRITE(2 * ((u + 1) & 3) + 1, ((u + 1) & 1) * M1_BUF + M1_CH); }
            if (!(pmode & 4)) __syncthreads();
        }
    }
#undef M1_LOAD
#undef M1_WRITE
    if (!pmode) {
#pragma unroll
        for (int j = 0; j < 4; ++j) state_out[(size_t)(dk0 + j) * 128 + dv] = acc[j];
    } else asm volatile("" :: "v"(acc));
}
__device__ __forceinline__ void phase_m1(const Args& A, LAS unsigned char* lds, int w, int lane, const bool dup = false) {
    unsigned char* ws = A.ws;
    bf16_t* STb = (bf16_t*)(A.out + O_Y);
    const int G = gridDim.x;
    const int vcu = (G % 8 == 0) ? (int)(blockIdx.x % 8) * (G / 8) + (int)(blockIdx.x / 8) : (int)blockIdx.x;
    for (int it = vcu; it < 256 && !((PROBE & 4096) && dup); it += G) {
        const int mixer = it >> 7, seq = (it >> 5) & 3, head = (it >> 3) & 3, slice = it & 7;
        const float gam = 1.0f - exp2f(-5.0f - (float)head);
        const float g64 = exp2f(64.0f * __log2f(gam));
        float* sout = A.out + (mixer ? O_HGP : O_RETP) + (size_t)(seq * 4 + head) * 16384;
        bf16_t* ST = STb + (size_t)mixer * 256 * 4 * 16384;
        const int pm_ = dup ? ((PROBE >> 14) & 15) : 0;
        if (mixer) m1_item((const bf16_t*)(ws + WS_HK), (const bf16_t*)(ws + WS_HI), (const float*)(ws + WS_DEC), ST, sout, seq, head, slice, 0.f, lds, w, lane, pm_);
        else m1_item((const bf16_t*)(ws + WS_KR), (const bf16_t*)(ws + WS_VR), nullptr, ST, sout, seq, head, slice, g64, lds, w, lane, pm_);
        __syncthreads();
    }
    if (!(PROBE & 8192) || !dup) phase_mixer_sample(A);
}

constexpr int M2_VSTR = 272, M2_VBUF = 64 * M2_VSTR, M2_EXCH = 8 * M2_VBUF;
__device__ __forceinline__ void m2_item(const Args& A, int seq, int n, LAS unsigned char* lds, int w, int lane) {
    unsigned char* ws = A.ws;
    int fr = lane & 15, g = lane >> 4; asm volatile("" : "+v"(fr), "+v"(g));
    const int r4 = fr >> 2, c4 = fr & 3;
    const int mixer = w >> 2, head = w & 3, cb = head * 128;
    const bf16_t* Q = (const bf16_t*)(ws + (mixer ? WS_HQ : WS_QR)); const bf16_t* K = (const bf16_t*)(ws + (mixer ? WS_HK : WS_KR));
    const bf16_t* V = (const bf16_t*)(ws + (mixer ? WS_HI : WS_VR)); const bf16_t* GT = (const bf16_t*)(ws + (mixer ? WS_HGT : WS_GR));
    const float* gain = A.in[mixer ? 7 : 6] + cb;
    const size_t r0 = (size_t)seq * SEQ + 64 * n;
    const bf16_t* ST = (const bf16_t*)(A.out + O_Y) + ((size_t)(mixer * 256 + seq * 64 + n) * 4 + head) * 16384;
    bf16_t* MG = (bf16_t*)(ws + WS_XB);
    LAS unsigned char* vb = lds + w * M2_VBUF;
    const bf16_t* qp = Q + pofs(head, r0 + fr) + 8 * g; const bf16_t* kp = K + pofs(head, r0 + fr) + 8 * g;
    u32x4 vr[16];
#pragma unroll
    for (int i = 0; i < 16; ++i) vr[i] = __builtin_nontemporal_load((const u32x4*)(V + pofs(head, r0 + 4 * i + g) + fr * 8));
    bf16x8 qf[4][4], kf[4][4];
#pragma unroll
    for (int ks = 0; ks < 4; ++ks)
#pragma unroll
        for (int t = 0; t < 4; ++t) { qf[ks][t] = *(const bf16x8*)(qp + (size_t)(16 * t) * 128 + 32 * ks); kf[ks][t] = *(const bf16x8*)(kp + (size_t)(16 * t) * 128 + 32 * ks); }
#pragma unroll
    for (int i = 0; i < 16; ++i) *(LAS u32x4*)(vb + (4 * i + g) * M2_VSTR + fr * 16) = vr[i];
    f32x4 X[4][4];
#pragma unroll
    for (int a = 0; a < 4; ++a)
#pragma unroll
        for (int b = 0; b < 4; ++b) X[a][b] = (f32x4){0.f, 0.f, 0.f, 0.f};
#pragma unroll
    for (int ks = 0; ks < 4; ++ks)
#pragma unroll
        for (int jt = 0; jt < 4; ++jt)
#pragma unroll
            for (int it = jt; it < 4; ++it) X[jt][it] = MFMA16(kf[ks][jt], qf[ks][it], X[jt][it]);
    bf16x8 PB[4][2];
#pragma unroll
    for (int it = 0; it < 4; ++it)
#pragma unroll
        for (int s2 = 0; s2 < 2; ++s2) {
            float v[8];
#pragma unroll
            for (int e = 0; e < 8; ++e) {
                const int jt = 2 * s2 + (e >> 2);
                float x = 0.f;
                if (jt < it) x = X[jt][it][e & 3];
                else if (jt == it) x = (fr >= 4 * g + (e & 3)) ? X[jt][it][e & 3] : 0.f;
                v[e] = x;
            }
            u32x4 wv; wv.x = cvt_pk_bf16(v[0], v[1]); wv.y = cvt_pk_bf16(v[2], v[3]); wv.z = cvt_pk_bf16(v[4], v[5]); wv.w = cvt_pk_bf16(v[6], v[7]);
            PB[it][s2] = __builtin_bit_cast(bf16x8, wv);
        }
    const bf16_t* sp = ST + (size_t)fr * 128 + 8 * g;
    bf16x8 sa0[2][4];
#pragma unroll
    for (int k2 = 0; k2 < 2; ++k2)
#pragma unroll
        for (int d = 0; d < 4; ++d) sa0[k2][d] = *(const bf16x8*)(sp + (size_t)(16 * d) * 128 + 32 * k2);
    f32x4 O[8][4];
#pragma unroll
    for (int a = 0; a < 8; ++a)
#pragma unroll
        for (int b = 0; b < 4; ++b) O[a][b] = (f32x4){0.f, 0.f, 0.f, 0.f};
#pragma unroll
    for (int s2 = 0; s2 < 2; ++s2)
#pragma unroll
        for (int dh = 0; dh < 2; ++dh) {
            bf16x8 vt[4];
#pragma unroll
            for (int d = 0; d < 4; ++d) { LAS unsigned char* pa = vb + (32 * s2 + 4 * g + r4) * M2_VSTR + 32 * (4 * dh + d) + 8 * c4; vt[d] = tr2(pa, pa + 16 * M2_VSTR); }
#pragma unroll
            for (int it = 2 * s2; it < 4; ++it)
#pragma unroll
                for (int d = 0; d < 4; ++d) O[4 * dh + d][it] = MFMA16(vt[d], PB[it][s2], O[4 * dh + d][it]);
            asm volatile("" ::: "memory");
        }
#pragma unroll
    for (int dh = 0; dh < 2; ++dh)
#pragma unroll
        for (int kp2 = 0; kp2 < 2; ++kp2) {
            bf16x8 qg[2][4], sa[2][4];
#pragma unroll
            for (int k2 = 0; k2 < 2; ++k2) {
#pragma unroll
                for (int t = 0; t < 4; ++t) qg[k2][t] = *(const bf16x8*)(qp + (size_t)(16 * t) * 128 + 32 * (2 * kp2 + k2));
#pragma unroll
                for (int d = 0; d < 4; ++d) sa[k2][d] = (dh == 0 && kp2 == 0) ? sa0[k2][d] : *(const bf16x8*)(sp + (size_t)(16 * (4 * dh + d)) * 128 + 32 * (2 * kp2 + k2));
            }
#pragma unroll
            for (int k2 = 0; k2 < 2; ++k2)
#pragma unroll
                for (int d = 0; d < 4; ++d)
#pragma unroll
                    for (int it = 0; it < 4; ++it) O[4 * dh + d][it] = MFMA16(sa[k2][d], qg[k2][it], O[4 * dh + d][it]);
            asm volatile("" ::: "memory");
        }
    u32x2 gtr[4][8];
#pragma unroll
    for (int it = 0; it < 4; ++it)
#pragma unroll
        for (int d = 0; d < 8; ++d) gtr[it][d] = *(const u32x2*)(GT + pofs(head, r0 + 16 * it + fr) + 4 * g + 16 * d);
    float rs[4];
    LAS float* exch = (LAS float*)(lds + M2_EXCH);
#pragma unroll
    for (int it = 0; it < 4; ++it) {
        float ss = 0.f;
#pragma unroll
        for (int d = 0; d < 8; ++d) ss += (O[d][it][0] * O[d][it][0] + O[d][it][1] * O[d][it][1]) + (O[d][it][2] * O[d][it][2] + O[d][it][3] * O[d][it][3]);
        ss += __shfl_xor(ss, 16); ss += __shfl_xor(ss, 32);
        rs[it] = ss;
        if (mixer && g == 0) exch[(16 * it + fr) * 4 + head] = ss;
    }
    __syncthreads();
#pragma unroll
    for (int it = 0; it < 4; ++it) {
        if (mixer) { const f32x4 e = *(LAS f32x4*)(exch + (16 * it + fr) * 4); rs[it] = 1.0f / sqrtf(((e[0] + e[1]) + (e[2] + e[3])) * (1.0f / 512.0f) + EPS); }
        else rs[it] = 1.0f / sqrtf(rs[it] * (1.0f / 128.0f) + EPS);
    }
#pragma unroll
    for (int it = 0; it < 4; ++it) {
        int rowi = 16 * it + fr; asm volatile("" : "+v"(rowi));
        const size_t row = r0 + rowi;
        bf16_t* mgp = MG + row * DM + mixer * HW + cb + 4 * g;
        const float rsi = rs[it];
#pragma unroll
        for (int d = 0; d < 8; ++d) {
            const f32x4 gn = *(const f32x4*)(gain + 16 * d + 4 * g);
            const u32x2 gt = gtr[it][d];
            const float g0 = silu_f(__uint_as_float(gt.x << 16)), g1 = silu_f(__uint_as_float(gt.x & 0xffff0000u)), g2 = silu_f(__uint_as_float(gt.y << 16)), g3 = silu_f(__uint_as_float(gt.y & 0xffff0000u));
            const f32x4 o = O[d][it] * rsi * gn;
            u32x2 wv; wv.x = cvt_pk_bf16(o[0] * g0, o[1] * g1); wv.y = cvt_pk_bf16(o[2] * g2, o[3] * g3);
            st8b(MG, mgp + 16 * d, wv);
        }
    }
}
__device__ __forceinline__ void phase_normgate_sample(const Args& A, int wave, int lane) {
    unsigned char* ws = A.ws;
    const float* O = A.out + O_Y;
    const bf16_t* GR = (const bf16_t*)(ws + WS_GR); const bf16_t* HGT = (const bf16_t*)(ws + WS_HGT);
    bf16_t* MG = (bf16_t*)(ws + WS_XB);
    const int gw = blockIdx.x * NWAVES + wave, NGW = gridDim.x * NWAVES;
    const bool hg = lane >= 32; const int c0 = lane * 16;
    const float* gain = hg ? A.in[7] + (c0 - HW) : A.in[6] + c0;
    f32x4 gn[4];
#pragma unroll
    for (int j = 0; j < 4; ++j) gn[j] = *(const f32x4*)(gain + 4 * j);
    for (int m = TP + gw; m < TT; m += NGW) {
        const f32x4* orow = (const f32x4*)(O + (size_t)m * DM + c0);
        f32x4 v[4]; float s = 0.f;
#pragma unroll
        for (int j = 0; j < 4; ++j) { v[j] = orow[j]; s += (v[j][0] * v[j][0] + v[j][1] * v[j][1]) + (v[j][2] * v[j][2] + v[j][3] * v[j][3]); }
        s += __shfl_xor(s, 1); s += __shfl_xor(s, 2); s += __shfl_xor(s, 4);
        float s2 = s; s2 += __shfl_xor(s2, 8); s2 += __shfl_xor(s2, 16);
        const float rs = hg ? 1.0f / sqrtf(s2 * (1.0f / 512.0f) + EPS) : 1.0f / sqrtf(s * (1.0f / 128.0f) + EPS);
        const bf16_t* gp = (hg ? HGT + pofs((c0 - HW) >> 7, m) + ((c0 - HW) & 127) : GR + pofs(c0 >> 7, m) + (c0 & 127));
        const u32x4 ga = *(const u32x4*)gp, gb = *(const u32x4*)(gp + 8);
        const unsigned gw_[8] = {ga.x, ga.y, ga.z, ga.w, gb.x, gb.y, gb.z, gb.w};
        float o[16];
#pragma unroll
        for (int i = 0; i < 8; ++i) { const float g0 = silu_f(__uint_as_float(gw_[i] << 16)), g1 = silu_f(__uint_as_float(gw_[i] & 0xffff0000u));
            o[2 * i] = v[(2 * i) >> 2][(2 * i) & 3] * rs * gn[(2 * i) >> 2][(2 * i) & 3] * g0; o[2 * i + 1] = v[(2 * i + 1) >> 2][(2 * i + 1) & 3] * rs * gn[(2 * i + 1) >> 2][(2 * i + 1) & 3] * g1; }
        u32x4 w0, w1;
        w0.x = cvt_pk_bf16(o[0], o[1]); w0.y = cvt_pk_bf16(o[2], o[3]); w0.z = cvt_pk_bf16(o[4], o[5]); w0.w = cvt_pk_bf16(o[6], o[7]);
        w1.x = cvt_pk_bf16(o[8], o[9]); w1.y = cvt_pk_bf16(o[10], o[11]); w1.z = cvt_pk_bf16(o[12], o[13]); w1.w = cvt_pk_bf16(o[14], o[15]);
        bf16_t* mp = MG + (size_t)m * DM + c0;
        *(u32x4*)mp = w0; *(u32x4*)(mp + 8) = w1;
    }
}
__device__ __forceinline__ void phase_m2(const Args& A, LAS unsigned char* lds, int w, int lane) {
    const int G = gridDim.x;
    const int vcu = (G % 8 == 0) ? (int)(blockIdx.x % 8) * (G / 8) + (int)(blockIdx.x / 8) : (int)blockIdx.x;
    for (int it = vcu; it < 256; it += G) { m2_item(A, it >> 6, it & 63, lds, w, lane); __syncthreads(); }
    phase_normgate_sample(A, w, lane);
}
__device__ __forceinline__ void phase_final(const Args& A, int wave, int lane) {
    const float* SS3 = (const float*)(A.ws + WS_SS3);
    const int gw = blockIdx.x * NWAVES + wave, NGW = gridDim.x * NWAVES;
    f32x4 gn[4];
#pragma unroll
    for (int j = 0; j < 4; ++j) gn[j] = ((const f32x4*)A.in[16])[lane + 64 * j];
    for (int m = gw; m < TP; m += NGW) {
        float p = lane < 16 ? SS3[(size_t)m * 16 + lane] : 0.f;
        p = wave_sum(p);
        const float rs = 1.0f / sqrtf(p * (1.0f / DM) + EPS);
        f32x4* xr = (f32x4*)(A.out + O_Y + (size_t)m * DM) + lane;
#pragma unroll
        for (int j = 0; j < 4; ++j) { f32x4 v = xr[64 * j]; v = v * rs * gn[j]; xr[64 * j] = v; }
    }
}

__global__ void __launch_bounds__(NTHREADS, 2) fwd_kernel(Args args) {
    extern __shared__ __attribute__((aligned(16))) unsigned char lds_raw[];
    LAS unsigned char* lds = (LAS unsigned char*)lds_raw;
    const int tid = threadIdx.x, wave = __builtin_amdgcn_readfirstlane(tid >> 6);
    volatile LAS unsigned* MISC = (volatile LAS unsigned*)(lds + MISC_OFF);
    if (tid < 64) MISC[tid] = 0u;
    __syncthreads();
    unsigned char* ws = args.ws;
    XcdBarrier bar; bar.bar = (unsigned*)(ws + WS_CTL); bar.x = 0; bar.st = nullptr;
    if (N_LAUNCHES == 1) bar = xcd_barrier_post((unsigned*)(ws + WS_CTL), MISC + 8);
    const int lo = args.ph_lo, hi = args.ph_hi;
#define IN(k) (lo <= (k) && (k) < hi)
#define SEAM(k) do { if (IN(k) && IN((k) + 1)) { xcd_barrier(bar); if (PROBE & 256) xcd_barrier(bar); } } while (0)
    const int G = gridDim.x, c = blockIdx.x;

    if (IN(0)) { phase_prep(args, lds, wave, fresh_lane()); if (PROBE & 64) { __syncthreads(); phase_prep(args, lds, wave, fresh_lane()); } } SEAM(0);
    if (IN(1)) {
        pg8::Gemm g{(const bf16_t*)(ws + WS_XB), (const bf16_t*)(ws + WS_WIN), DM}; pg8::StaticOrder S; S.init(64, 16, G, c);
        EpiIn E{ws + WS_PROJ, (float*)(ws + WS_DEC), (float*)(ws + WS_HGFS), (const f32x4*)(ws + WS_ROPE), (const float*)(ws + WS_LB)};
        pg8::gemm_phase<EpiIn, false>(lds, g, S, E);
        pg8::sample_gemm<EpiIn>(lds, g.A + (size_t)TP * DM, g.Bt, DM, 16, 64, E, c, G);
        if (PROBE & 1) pg8::sample_gemm<EpiIn>(lds, g.A + (size_t)TP * DM, g.Bt, DM, 16, 64, E, c, G);
        if (PROBE & 2) { pg8::gemm_phase<EpiIn, false>(lds, g, S, E); }
    } SEAM(1);
    if (IN(2)) { phase_m1(args, lds, wave, fresh_lane()); if (PROBE & (16 | 4096 | 8192)) { __syncthreads(); phase_m1(args, lds, wave, fresh_lane(), true); } } SEAM(2);
    if (IN(3)) { phase_m2(args, lds, wave, fresh_lane()); if (PROBE & 32) { __syncthreads(); phase_m2(args, lds, wave, fresh_lane()); } } SEAM(3);
    if (IN(4)) {
        { bf16_t* X1B = (bf16_t*)(ws + WS_X1B); const int gt = c * NTHREADS + tid;
          if (gt < 4 * 256) { const int b = gt >> 8, w = gt & 255; ((u32x4*)(X1B + (size_t)(4098 * b) * DM))[w] = (u32x4){0u, 0u, 0u, 0u}; } }
        pg8::Gemm g{(const bf16_t*)(ws + WS_XB), (const bf16_t*)(ws + WS_WOUT), DM}; pg8::StaticOrder S; S.init(64, 4, G, c);
        EpiOut E{args.in[0], args.in[1], args.out + O_Y, (bf16_t*)(ws + WS_X1B), (float*)(ws + WS_SS2)};
        pg8::gemm_phase<EpiOut, false>(lds, g, S, E);
        pg8::sample_gemm16<EpiOut>(lds, g.A + (size_t)TP * DM, g.Bt, DM, 4, 64, E, c, G);
        if (PROBE & 1) pg8::sample_gemm<EpiOut>(lds, g.A + (size_t)TP * DM, g.Bt, DM, 4, 64, E, c, G);
        if (PROBE & 4) { pg8::gemm_phase<EpiOut, false>(lds, g, S, E); }
    } SEAM(4);
    if (IN(5)) {
        pg8::Gemm g{(const bf16_t*)(ws + WS_X1B), (const bf16_t*)(ws + WS_WUP), DM}; pg8::StaticOrder S; S.init(68, 22, G, c);
        EpiUp E{(const float*)(ws + WS_SS2), args.in[13], args.in[14], args.in[4], (bf16_t*)(ws + WS_ACT), args.out + O_CCP, args.out + O_CCS};
        pg8::gemm_phase<EpiUp, true>(lds, g, S, E);
        {
            const int njobs = 22 * 16, rem = (68 * 22) % G, nidle = rem ? G - rem : 0, pre = (nidle >= 32 && 3 * nidle < njobs) ? 3 * nidle : 0;
            if (pre && c >= rem) pg8::sample_gemm<EpiUp>(lds, g.A + (size_t)16394 * DM, g.Bt, DM, 22, 68, E, c - rem, nidle, pre);
            pg8::sample_gemm<EpiUp>(lds, g.A + (size_t)16394 * DM, g.Bt, DM, 22, 68, E, pre + c, G, njobs);
        }
        if (PROBE & 8) { pg8::gemm_phase<EpiUp, true>(lds, g, S, E); }
    } SEAM(5);
    if (IN(6)) {
        pg8::Gemm g{(const bf16_t*)(ws + WS_ACT), (const bf16_t*)(ws + WS_WD), DFF}; pg8::StaticOrder S; S.init(64, 4, G, c);
        EpiDownT<true> E{args.out + O_Y, (const bf16_t*)(ws + WS_X1B), (float*)(ws + WS_SS3), args.in[16], (float*)(ws + WS_SS3), (unsigned*)(ws + WS_CTL + 32768), lds + RING_BYTES};
        EpiDownT<false> Es{args.out + O_Y, (const bf16_t*)(ws + WS_X1B), (float*)(ws + WS_SS3), args.in[16], nullptr, (unsigned*)(ws + WS_CTL + 32768), lds};
        if (PROBE & 2048) { EpiNull En; pg8::gemm_phase<EpiNull, false>(lds, g, S, En); }
        if (G == 256) pg8::gemm_phase<EpiDownT<true>, false>(lds, g, S, E);
        else pg8::gemm_phase<EpiDownT<false>, false>(lds, g, S, Es);
        pg8::sample_gemm16<EpiDownT<false>>(lds, g.A + (size_t)TP * DFF, g.Bt, DFF, 4, 64, Es, c, G);
    }
    if (G != 256) {
        SEAM(6);
        if (IN(7)) { phase_final(args, wave, fresh_lane()); }
    }
#undef IN
#undef SEAM
}

extern "C" void kernel_launch(void* const* d_in, const int* in_sizes, int n_in, void* d_out, int out_size, void* d_ws, size_t ws_size, hipStream_t stream) {
    static int grid = 0;
    if (grid == 0) {
        if (n_in != 17 || ws_size < WS_END) { fprintf(stderr, "kernel_launch: unexpected n_in %d or ws_size %zu (need %zu)\n", n_in, ws_size, (size_t)WS_END); grid = -1; return; }
        int dev = 0, cus = 0, per_cu = 0;
        hipGetDevice(&dev); hipDeviceGetAttribute(&cus, hipDeviceAttributeMultiprocessorCount, dev);
        hipFuncSetAttribute((const void*)fwd_kernel, hipFuncAttributeMaxDynamicSharedMemorySize, LDS_BYTES);
        hipOccupancyMaxActiveBlocksPerMultiprocessor(&per_cu, (const void*)fwd_kernel, NTHREADS, LDS_BYTES);
        if (per_cu < 1) { fprintf(stderr, "kernel_launch: occupancy query says %d blocks per CU\n", per_cu); per_cu = 1; }
        (void)hipGetLastError();
        grid = cus;
        if (grid > 256) grid = 256;
        fprintf(stderr, "kernel_launch: cus %d per_cu %d grid %d ws %zu\n", cus, per_cu, grid, ws_size);
    }
    if (grid < 0) return;
    hipMemsetAsync((char*)d_ws + WS_CTL, 0, 65536, stream);
    Args a{};
    for (int i = 0; i < 17; ++i) a.in[i] = (const float*)d_in[i];
    a.out = (float*)d_out; a.ws = (unsigned char*)d_ws;
    if (N_LAUNCHES == 1) {
        a.ph_lo = 0; a.ph_hi = 8;
        void* kargs[] = {&a};
#if PROBE & 1024
        hipLaunchKernelGGL(fwd_kernel, dim3(grid), dim3(NTHREADS), LDS_BYTES, stream, a); hipError_t e = hipSuccess; (void)kargs;
#else
        hipError_t e = hipLaunchCooperativeKernel((const void*)fwd_kernel, dim3(grid), dim3(NTHREADS), kargs, LDS_BYTES, stream);
#endif
        if (e != hipSuccess) fprintf(stderr, "cooperative launch failed: %s (grid %d)\n", hipGetErrorString(e), grid);
    } else {
        for (int p = 0; p < 8; ++p) { a.ph_lo = p; a.ph_hi = p + 1; hipLaunchKernelGGL(fwd_kernel, dim3(grid), dim3(NTHREADS), LDS_BYTES, stream, a); }
    }
}
```

```cpp
#include <hip/hip_runtime.h>
#include <cstdio>
#include <cstdint>

#ifndef PROBE
#define PROBE 0
#endif
#ifndef N_LAUNCHES
#define N_LAUNCHES 1
#endif

#define LAS __attribute__((address_space(3)))
typedef unsigned short bf16_t;
typedef short bf16x8 __attribute__((ext_vector_type(8)));
typedef float f32x4 __attribute__((ext_vector_type(4)));
typedef float f32x2 __attribute__((ext_vector_type(2)));
typedef unsigned u32x4 __attribute__((ext_vector_type(4)));
typedef unsigned u32x2 __attribute__((ext_vector_type(2)));

constexpr int DM = 1024, TP = 16384, TS = 256, TT = TP + TS, SEQ = 4096;
constexpr int DFF = 2816, UPC = 5632, INC = 4096, HW = 512;
constexpr float EPS = 1e-6f;
constexpr int NTHREADS = 512, NWAVES = 8;
constexpr int LDS_BYTES = 163840;
constexpr int RING_BYTES = 131072;
constexpr int MISC_OFF = LDS_BYTES - 256;

constexpr size_t O_Y = 0, O_RETP = 17039360, O_HGP = 17301504, O_CCP = 17563648, O_RETS = 17586176, O_HGS = 18634752, O_CCS = 19683328;

constexpr size_t WS_CTL = 0;
constexpr size_t WS_WIN = 65536;
constexpr size_t WS_WOUT = WS_WIN + (size_t)INC * DM * 2;
constexpr size_t WS_WUP = WS_WOUT + (size_t)DM * DM * 2;
constexpr size_t WS_WD = WS_WUP + (size_t)UPC * DM * 2;
constexpr size_t WS_ROPE = WS_WD + (size_t)DM * DFF * 2;
constexpr size_t WS_LB = WS_ROPE + (size_t)SEQ * 64 * 8;
constexpr size_t WS_SS2 = WS_LB + 4096;
constexpr size_t WS_SS3 = WS_SS2 + (size_t)TT * 16 * 4;
constexpr size_t WS_XB = WS_SS3 + (size_t)TT * 16 * 4;
constexpr size_t WS_PROJ = WS_XB + (size_t)TT * DM * 2;
constexpr size_t PSZ = (size_t)TT * HW * 2;
constexpr size_t WS_QR = WS_PROJ, WS_KR = WS_PROJ + PSZ, WS_VR = WS_PROJ + 2 * PSZ, WS_GR = WS_PROJ + 3 * PSZ, WS_HQ = WS_PROJ + 4 * PSZ,
                 WS_HK = WS_PROJ + 5 * PSZ, WS_HI = WS_PROJ + 6 * PSZ, WS_HGT = WS_PROJ + 7 * PSZ;
constexpr size_t WS_DEC = WS_PROJ + 8 * PSZ;
constexpr size_t WS_HGFS = WS_DEC + (size_t)256 * HW * 4;
constexpr size_t WS_PROJ_END = WS_HGFS + (size_t)TS * HW * 4;
constexpr int X1B_ROWS = 16896;
constexpr size_t WS_X1B = WS_PROJ;
constexpr size_t WS_ACT = WS_X1B + (size_t)X1B_ROWS * DM * 2;
constexpr size_t WS_ACT_END = WS_ACT + (size_t)TT * DFF * 2;
static_assert(WS_ACT_END <= WS_PROJ_END, "overlay");
constexpr size_t WS_END = WS_PROJ_END;
static_assert(WS_END <= (size_t)256 * 1024 * 1024, "workspace");

__device__ __forceinline__ size_t pofs(int head, size_t row) { return ((size_t)head * TT + row) * 128; }
__device__ __forceinline__ unsigned cvt_pk_bf16(float lo, float hi) { unsigned r; asm volatile("v_cvt_pk_bf16_f32 %0, %1, %2" : "=v"(r) : "v"(lo), "v"(hi)); return r; }
__device__ __forceinline__ int fresh_lane() { int l; asm volatile("v_mbcnt_lo_u32_b32 %0, -1, 0\n\tv_mbcnt_hi_u32_b32 %0, -1, %0" : "=v"(l)); return l; }
__device__ __forceinline__ float bf2f(unsigned short b) { return __uint_as_float(((unsigned)b) << 16); }
__device__ __forceinline__ float sigmoid_f(float x) { return __builtin_amdgcn_rcpf(1.0f + __builtin_amdgcn_exp2f(x * -1.4426950408889634f)); }
__device__ __forceinline__ float silu_f(float x) { return x * sigmoid_f(x); }
#ifndef WT_STORES
#define WT_STORES 0
#endif
__device__ __forceinline__ void st16b(const void* base, void* p, u32x4 v) {
#if WT_STORES == 3
    __builtin_amdgcn_raw_buffer_store_b128(v, __builtin_amdgcn_make_buffer_rsrc((void*)base, 0, 0x7fffffff, 0x00020000), (int)((const char*)p - (const char*)base), 0, 16);
#else
    *(u32x4*)p = v;
#endif
}
__device__ __forceinline__ void st8b(const void* base, void* p, u32x2 v) {
#if WT_STORES == 3
    __builtin_amdgcn_raw_buffer_store_b64(v, __builtin_amdgcn_make_buffer_rsrc((void*)base, 0, 0x7fffffff, 0x00020000), (int)((const char*)p - (const char*)base), 0, 16);
#else
    *(u32x2*)p = v;
#endif
}
__device__ __forceinline__ void st16(void* p, u32x4 v) {
#if WT_STORES == 1
    asm volatile("global_store_dwordx4 %0, %1, off sc1\n\ts_nop 1" :: "v"(p), "v"(v) : "memory");
#elif WT_STORES == 2
    __builtin_nontemporal_store(v, (u32x4*)p);
#else
    *(u32x4*)p = v;
#endif
}
__device__ __forceinline__ void st8(void* p, u32x2 v) {
#if WT_STORES == 1
    asm volatile("global_store_dwordx2 %0, %1, off sc1\n\ts_nop 1" :: "v"(p), "v"(v) : "memory");
#elif WT_STORES == 2
    __builtin_nontemporal_store(v, (u32x2*)p);
#else
    *(u32x2*)p = v;
#endif
}
template <int CTRL> __device__ __forceinline__ float dpp_z(float src) {
    return __builtin_bit_cast(float, __builtin_amdgcn_update_dpp(0, __builtin_bit_cast(int, src), CTRL, 0xF, 0xF, true)); }
template <int CTRL> __device__ __forceinline__ float dpp_f(float oldv, float src) {
    return __builtin_bit_cast(float, __builtin_amdgcn_update_dpp(__builtin_bit_cast(int, oldv), __builtin_bit_cast(int, src), CTRL, 0xF, 0xF, false)); }

#define XB_TMO      128
#define XB_XCNT(j)  (256  + 64 * (j))
#define XB_XSUB(j)  (1280 + 64 * (j))
#define XB_XGEN(j)  (2304 + 64 * (j))
#define XB_TOP      3328
#define XB_TOPGEN   3392
#define XCD_BAR_WORDS 3456
#define XB_SPIN_CAP (1u << 18)
__device__ __forceinline__ unsigned xb_ld(unsigned* p)              { return __hip_atomic_load(p, __ATOMIC_RELAXED, __HIP_MEMORY_SCOPE_AGENT); }
__device__ __forceinline__ unsigned xb_add(unsigned* p, unsigned v) { return __hip_atomic_fetch_add(p, v, __ATOMIC_RELAXED, __HIP_MEMORY_SCOPE_AGENT); }
__device__ __forceinline__ unsigned xb_xcc_id() { return (unsigned)__builtin_amdgcn_s_getreg((3 << 11) | 20) & 0xFu; }
#define XB_SPIN(cond, bar) do { unsigned _sp = 0; while (cond) { __builtin_amdgcn_s_sleep(1); \
    if ((++_sp & 255u) == 0u) { if (xb_ld(&(bar)[XB_TMO])) break; if (_sp > XB_SPIN_CAP) { atomicAdd(&(bar)[XB_TMO], 1u); break; } } } } while (0)
struct XcdBarrier { unsigned* bar; unsigned x; volatile LAS unsigned* st; };
__device__ __forceinline__ XcdBarrier xcd_barrier_post(unsigned* bar, volatile LAS unsigned* st) {
    XcdBarrier b; b.bar = bar; b.x = xb_xcc_id(); b.st = st;
    if (threadIdx.x == 0) (void)xb_add(&bar[XB_XCNT(b.x)], 1u);
    return b;
}
__device__ __forceinline__ void xcd_barrier_complete(unsigned* bar, unsigned x, unsigned& nloc, unsigned& nx) {
    const unsigned G = gridDim.x * gridDim.y * gridDim.z;
    unsigned sum, cnt, mine, sp = 0u;
    for (;;) {
        sum = 0u; cnt = 0u; mine = 0u;
#pragma unroll
        for (unsigned j = 0; j < 16; ++j) { const unsigned c = xb_ld(&bar[XB_XCNT(j)]); sum += c; cnt += (c > 0u) ? 1u : 0u; mine = (j == x) ? c : mine; }
        if (sum == G) break;
        __builtin_amdgcn_s_sleep(1);
        if ((++sp & 255u) == 0u) { if (xb_ld(&bar[XB_TMO])) break; if (sp > XB_SPIN_CAP) { atomicAdd(&bar[XB_TMO], 1u); break; } }
    }
    nloc = mine > 0u ? mine : 1u; nx = cnt > 0u ? cnt : 1u;
}
__device__ __forceinline__ void xcd_barrier(const XcdBarrier& b) {
    asm volatile("s_waitcnt vmcnt(0)" ::: "memory");
    __syncthreads();
    if (threadIdx.x == 0) {
        unsigned* bar = b.bar;
        __builtin_amdgcn_s_waitcnt(0);
        unsigned nloc = b.st[0], nx = b.st[1];
        if (nloc == 0u) { xcd_barrier_complete(bar, b.x, nloc, nx); b.st[0] = nloc; b.st[1] = nx; }
        const unsigned old = xb_add(&bar[XB_XSUB(b.x)], 1u);
        const unsigned gen = old / nloc;
        if (old + 1u == (gen + 1u) * nloc) {
            __builtin_amdgcn_fence(__ATOMIC_RELEASE, "agent");
            asm volatile("s_waitcnt vmcnt(0)" ::: "memory");
            const unsigned og = xb_add(&bar[XB_TOP], 1u);
            const unsigned tg = og / nx;
            if (og + 1u == (tg + 1u) * nx) xb_add(&bar[XB_TOPGEN], 1u);
            else XB_SPIN(xb_ld(&bar[XB_TOPGEN]) == tg, bar);
            __builtin_amdgcn_fence(__ATOMIC_ACQUIRE, "agent");
            xb_add(&bar[XB_XGEN(b.x)], 1u);
            asm volatile("s_waitcnt vmcnt(0)" ::: "memory");
        } else {
            XB_SPIN(xb_ld(&bar[XB_XGEN(b.x)]) == gen, bar);
            __builtin_amdgcn_fence(__ATOMIC_ACQUIRE, "agent");
            asm volatile("s_waitcnt vmcnt(0)" ::: "memory");
        }
    }
    __syncthreads();
}

namespace pg8 {
constexpr int BM = 256, BK = 64, HALF = 128, HTB = HALF * BK * 2, NXCD = 8, WGM = 8;
__host__ __device__ __forceinline__ int lds_byte(int r, int c) { const int st = (r >> 4) * 2 + (c >> 5), rr = r & 15, cc = c & 31, ob = rr * 64 + cc * 2; return st * 1024 + (ob ^ (((ob >> 9) & 1) << 5)); }
__host__ __device__ __forceinline__ void stage_rc(int b, int& R, int& C) { const int st = b / 1024, sb = b % 1024, swz = sb ^ (((sb >> 9) & 1) << 5); R = (st >> 1) * 16 + swz / 64; C = (st & 1) * 32 + (swz % 64) / 2; }
__host__ __device__ __forceinline__ int perm32(int rho) { const int n = rho >> 4, i = rho & 15; return 8 * (i >> 2) + 4 * n + (i & 3); }

struct Unit { int pm, pn; };
struct Gemm { const bf16_t* A; const bf16_t* Bt; int K; };

struct StaticOrder {
    int nM, nN, nwg, G, c;
    __device__ void init(int nM_, int nN_, int G_, int c_) { nM = nM_; nN = nN_; nwg = nM * nN; G = G_; c = c_; }
    __device__ bool next(int i, Unit& u) const {
        const long L = (long)i * G + c; if (L >= nwg) return false;
        int wgid = (int)L; { const int q = nwg / NXCD, r = nwg % NXCD, xcd = wgid % NXCD, off = wgid / NXCD; wgid = (xcd < r ? xcd * (q + 1) : r * (q + 1) + (xcd - r) * q) + off; }
        const int nig = WGM * nN, gid = wgid / nig, fm = gid * WGM, gsz = (nM - fm) < WGM ? (nM - fm) : WGM;
        u.pm = fm + ((wgid % nig) % gsz); u.pn = (wgid % nig) / gsz; return true;
    }
};

struct AInfo { const char* base; size_t hstep; unsigned v0, v1; };
template <bool UPMAP>
__device__ __forceinline__ AInfo a_info(const Gemm& g, const Unit& u, int tid) {
    AInfo a; const int K = g.K;
    int R0, C0, R1, C1; stage_rc(tid * 16, R0, C0); stage_rc(tid * 16 + 8192, R1, C1);
    if constexpr (!UPMAP) {
        a.base = (const char*)g.A + (size_t)u.pm * 256 * K * 2; a.hstep = (size_t)HALF * K * 2;
        a.v0 = (unsigned)(R0 * K + C0) * 2u; a.v1 = (unsigned)(R1 * K + C1) * 2u;
    } else {
        if (u.pm < 68) {
            const int b = u.pm / 17, j = u.pm % 17;
            a.base = (const char*)g.A + (size_t)(4098 * b + 248 * j) * K * 2; a.hstep = (size_t)124 * K * 2;
            const int P0 = (R0 & 64) | ((R0 & 15) << 2) | ((R0 >> 4) & 3), P1 = (R1 & 64) | ((R1 & 15) << 2) | ((R1 >> 4) & 3);
            a.v0 = (unsigned)((P0 - 2 * (P0 >> 6)) * K + C0) * 2u; a.v1 = (unsigned)((P1 - 2 * (P1 >> 6)) * K + C1) * 2u;
        } else {
            a.base = (const char*)g.A + (size_t)16394 * K * 2; a.hstep = (size_t)HALF * K * 2;
            a.v0 = (unsigned)(R0 * K + C0) * 2u; a.v1 = (unsigned)(R1 * K + C1) * 2u;
        }
    }
    return a;
}

template <class Epi, bool UPMAP>
__device__ __forceinline__ void gemm_phase(LAS unsigned char* lds, const Gemm g, const StaticOrder& S, const Epi& E) {
    const int tid = threadIdx.x, wid = __builtin_amdgcn_readfirstlane(tid >> 6), lane = tid & 63, wr = wid >> 2, wc = wid & 3, fr = lane & 15, fq = lane >> 4;
    const int K = g.K, nt = K / BK;
    unsigned voffB[2];
#pragma unroll
    for (int i = 0; i < 2; ++i) { int R, C; stage_rc(tid * 16 + i * 8192, R, C); const int Rb = (R & ~31) + perm32(R & 31); voffB[i] = (unsigned)(Rb * K + C) * 2u; }
    const size_t kstep = (size_t)(BK * 2);
    const size_t hstepB = (size_t)HALF * K * 2;
    const size_t tstepB = 2 * hstepB;
    const unsigned ldsw = (unsigned)wid * 1024u;
    const int aoff = lds_byte(wr * 64 + fr, fq * 8), boff = lds_byte(wc * 32 + fr, fq * 8);
#define PG8_SA(b, h) (((b) * 2 + (h)) * HTB)
#define PG8_SB(b, h) ((4 + (b) * 2 + (h)) * HTB)
#define PG8_STAGEB(bufoff, gbase) do { _Pragma("unroll") for (int _i = 0; _i < 2; ++_i) \
        __builtin_amdgcn_global_load_lds((const unsigned*)((const char*)(gbase) + voffB[_i]), (LAS unsigned*)(lds + (bufoff) + ldsw + _i * 8192), 16, 0, 0); } while (0)
#define PG8_STAGEA(bufoff, gbase, va0, va1) do { \
        __builtin_amdgcn_global_load_lds((const unsigned*)((const char*)(gbase) + (va0)), (LAS unsigned*)(lds + (bufoff) + ldsw), 16, 0, 0); \
        __builtin_amdgcn_global_load_lds((const unsigned*)((const char*)(gbase) + (va1)), (LAS unsigned*)(lds + (bufoff) + ldsw + 8192), 16, 0, 0); } while (0)
#define PG8_LDA(dst, b, h) do { _Pragma("unroll") for (int m = 0; m < 4; ++m) _Pragma("unroll") for (int k = 0; k < 2; ++k) dst[m][k] = *(const LAS bf16x8*)(lds + PG8_SA(b, h) + aoff + m * 2048 + k * 1024); } while (0)
#define PG8_LDB(dst, b, h) do { _Pragma("unroll") for (int n = 0; n < 2; ++n) _Pragma("unroll") for (int k = 0; k < 2; ++k) dst[n][k] = *(const LAS bf16x8*)(lds + PG8_SB(b, h) + boff + n * 2048 + k * 1024); } while (0)
#define PG8_MMA(ai, bj, At, Bt) do { __builtin_amdgcn_s_setprio(1); _Pragma("unroll") for (int m = 0; m < 4; ++m) _Pragma("unroll") for (int n = 0; n < 2; ++n) _Pragma("unroll") for (int k = 0; k < 2; ++k) \
        acc[ai][bj][m][n] = __builtin_amdgcn_mfma_f32_16x16x32_bf16(Bt[n][k], At[m][k], acc[ai][bj][m][n], 0, 0, 0); __builtin_amdgcn_s_setprio(0); } while (0)
#define PG8_WAIT_V(n) asm volatile("s_waitcnt vmcnt(" #n ")" ::: "memory")
#define PG8_WAIT_L(n) asm volatile("s_waitcnt lgkmcnt(" #n ")" ::: "memory")
#define PG8_BAR __builtin_amdgcn_s_barrier()
#define PG8_SCHED __builtin_amdgcn_sched_barrier(0)
    Unit cur, nxt; int ui = 0;
    if (!S.next(0, cur)) return;
    f32x4 acc[2][2][4][2];
#pragma unroll
    for (int a = 0; a < 2; ++a)
#pragma unroll
        for (int b = 0; b < 2; ++b)
#pragma unroll
            for (int m = 0; m < 4; ++m)
#pragma unroll
                for (int n = 0; n < 2; ++n) acc[a][b][m][n] = (f32x4){0.f, 0.f, 0.f, 0.f};
    bf16x8 At[4][2], B0[2][2], B1[2][2];
    AInfo ca = a_info<UPMAP>(g, cur, tid);
    const char* cA = ca.base; const char* cB = (const char*)g.Bt + (size_t)cur.pn * tstepB;
    PG8_STAGEB(PG8_SB(0, 0), cB); PG8_STAGEB(PG8_SB(0, 1), cB + hstepB); PG8_STAGEA(PG8_SA(0, 0), cA, ca.v0, ca.v1); PG8_STAGEA(PG8_SA(0, 1), cA + ca.hstep, ca.v0, ca.v1);
    if (wr == 1) PG8_BAR;
    PG8_WAIT_V(2); PG8_BAR;
    PG8_STAGEB(PG8_SB(1, 0), cB + kstep); PG8_STAGEA(PG8_SA(1, 0), cA + kstep, ca.v0, ca.v1); PG8_STAGEB(PG8_SB(1, 1), cB + hstepB + kstep);
    PG8_WAIT_V(6); PG8_BAR;
    for (;;) {
        const bool has_next = S.next(ui + 1, nxt);
        AInfo na = ca; if (has_next) na = a_info<UPMAP>(g, nxt, tid);
        const char* nA = na.base; const char* nB = has_next ? (const char*)g.Bt + (size_t)nxt.pn * tstepB : cB;
        for (int t = 0; t < nt; t += 2) {
            const bool last = (t == nt - 2);
            const char* a1 = cA + (size_t)(t + 1) * kstep;
            const char* a2 = last ? nA : cA + (size_t)(t + 2) * kstep; const char* b2 = last ? nB : cB + (size_t)(t + 2) * kstep;
            const char* a3 = a2 + kstep; const char* b3 = b2 + kstep;
            const size_t h2 = last ? na.hstep : ca.hstep; const unsigned w0 = last ? na.v0 : ca.v0, w1 = last ? na.v1 : ca.v1;
            PG8_LDB(B0, 0, 0); PG8_LDB(B1, 0, 1); PG8_SCHED; PG8_LDA(At, 0, 0); PG8_STAGEA(PG8_SA(1, 1), a1 + ca.hstep, ca.v0, ca.v1);
            PG8_WAIT_V(8); PG8_WAIT_L(0); PG8_BAR; PG8_MMA(0, 0, At, B0); PG8_MMA(0, 1, At, B1); PG8_BAR; PG8_SCHED;
            PG8_LDA(At, 0, 1); PG8_STAGEB(PG8_SB(0, 0), b2); PG8_STAGEB(PG8_SB(0, 1), b2 + hstepB); PG8_STAGEA(PG8_SA(0, 0), a2, w0, w1);
            PG8_WAIT_V(8); PG8_WAIT_L(0); PG8_BAR; PG8_MMA(1, 0, At, B0); PG8_MMA(1, 1, At, B1); PG8_BAR; PG8_SCHED;
            PG8_LDB(B0, 1, 0); PG8_LDB(B1, 1, 1); PG8_SCHED; PG8_LDA(At, 1, 0); PG8_STAGEA(PG8_SA(0, 1), a2 + h2, w0, w1);
            PG8_WAIT_V(8); PG8_WAIT_L(0); PG8_BAR; PG8_MMA(0, 0, At, B0); PG8_MMA(0, 1, At, B1); PG8_BAR; PG8_SCHED;
            PG8_LDA(At, 1, 1); PG8_STAGEB(PG8_SB(1, 0), b3); PG8_STAGEB(PG8_SB(1, 1), b3 + hstepB); PG8_STAGEA(PG8_SA(1, 0), a3, w0, w1);
            PG8_WAIT_V(8); PG8_WAIT_L(0); PG8_BAR; PG8_MMA(1, 0, At, B0); PG8_MMA(1, 1, At, B1); PG8_BAR; PG8_SCHED;
        }
        if (wr == 0) PG8_BAR;
        E(acc, cur, wr, wc, fr, fq);
        if constexpr ((PROBE & 512) && Epi::IDEM) E(acc, cur, wr, wc, fr, fq);
        if (!has_next) break;
#pragma unroll
        for (int a = 0; a < 2; ++a)
#pragma unroll
            for (int b = 0; b < 2; ++b)
#pragma unroll
                for (int m = 0; m < 4; ++m)
#pragma unroll
                    for (int n = 0; n < 2; ++n) acc[a][b][m][n] = (f32x4){0.f, 0.f, 0.f, 0.f};
        cur = nxt; ca = na; cA = nA; cB = nB; ++ui;
        if (wr == 1) PG8_BAR;
    }
    PG8_WAIT_V(0);
    PG8_BAR;
#undef PG8_SA
#undef PG8_SB
#undef PG8_STAGEA
#undef PG8_STAGEB
#undef PG8_LDA
#undef PG8_LDB
#undef PG8_MMA
#undef PG8_WAIT_V
#undef PG8_WAIT_L
#undef PG8_BAR
#undef PG8_SCHED
}

template <class Epi>
__device__ __forceinline__ void sample_gemm(LAS unsigned char* lds, const bf16_t* Arows, const bf16_t* Bt, const int K, const int nN, const int pm_unit, const Epi& E, const int job0, const int jstride, const int jend = 1 << 30) {
    const int tid = threadIdx.x, w = __builtin_amdgcn_readfirstlane(tid >> 6);
    int lane = tid & 63; asm volatile("" : "+v"(lane));
    const int fr = lane & 15, fq = lane >> 4;
    const int per = K / 256;
#pragma unroll 1
    for (int job = job0; job < nN * 16 && job < jend; job += jstride) {
        const int pn = job >> 4, jai = (job >> 3) & 1, jwr = (job >> 2) & 1, jwc = job & 3;
        f32x4 h[2][4][2];
#pragma unroll
        for (int b = 0; b < 2; ++b)
#pragma unroll
            for (int m = 0; m < 4; ++m)
#pragma unroll
                for (int n = 0; n < 2; ++n) h[b][m][n] = (f32x4){0.f, 0.f, 0.f, 0.f};
        const bf16_t* ap = Arows + (size_t)(jai * 128 + jwr * 64 + fr) * K + 8 * fq + (w * per) * 32;
        const bf16_t* bp = Bt + (size_t)(pn * 256 + jwc * 32 + 8 * (fr >> 2) + (fr & 3)) * K + 8 * fq + (w * per) * 32;
#pragma unroll 1
        for (int ks0 = 0; ks0 < per; ks0 += 4) {
            bf16x8 af[4][4], bfr[4][2][2];
#pragma unroll
            for (int kl = 0; kl < 4; ++kl) {
                const int ks = (ks0 + kl < per) ? ks0 + kl : per - 1;
#pragma unroll
                for (int m = 0; m < 4; ++m) af[kl][m] = *(const bf16x8*)(ap + (size_t)(16 * m) * K + 32 * ks);
#pragma unroll
                for (int bj = 0; bj < 2; ++bj)
#pragma unroll
                    for (int n = 0; n < 2; ++n) bfr[kl][bj][n] = *(const bf16x8*)(bp + (size_t)(bj * 128 + 4 * n) * K + 32 * ks);
            }
#pragma unroll
            for (int kl = 0; kl < 4; ++kl)
                if (ks0 + kl < per) {
#pragma unroll
                    for (int bj = 0; bj < 2; ++bj)
#pragma unroll
                        for (int m = 0; m < 4; ++m)
#pragma unroll
                            for (int n = 0; n < 2; ++n) h[bj][m][n] = __builtin_amdgcn_mfma_f32_16x16x32_bf16(bfr[kl][bj][n], af[kl][m], h[bj][m][n], 0, 0, 0);
                }
        }
        __syncthreads();
#pragma unroll
        for (int bj = 0; bj < 2; ++bj)
#pragma unroll
            for (int m = 0; m < 4; ++m)
#pragma unroll
                for (int n = 0; n < 2; ++n) *(LAS f32x4*)(lds + ((w * 16 + (bj * 4 + m) * 2 + n) * 64 + lane) * 16) = h[bj][m][n];
        __syncthreads();
#pragma unroll
        for (int q = 0; q < 2; ++q) {
            LAS unsigned char* sp = lds + ((2 * w + q) * 64 + lane) * 16;
            f32x4 sum = *(const LAS f32x4*)sp;
#pragma unroll
            for (int ww = 1; ww < 8; ++ww) sum += *(const LAS f32x4*)(sp + ww * 16384);
            *(LAS f32x4*)sp = sum;
        }
        __syncthreads();
        if (w < 4) {
            f32x4 acc[2][2][4][2];
#pragma unroll
            for (int ai = 0; ai < 2; ++ai)
#pragma unroll
                for (int bj = 0; bj < 2; ++bj)
#pragma unroll
                    for (int m = 0; m < 4; ++m)
#pragma unroll
                        for (int n = 0; n < 2; ++n) acc[ai][bj][m][n] = *(const LAS f32x4*)(lds + (((bj * 4 + m) * 2 + n) * 64 + lane) * 16);
            Unit u; u.pm = pm_unit; u.pn = pn;
            E(acc, u, jwr, jwc, fr, fq, 1u << (4 * jai + w));
        }
        if constexpr (Epi::POST) E.post(lds, 2 * jai + jwr, w, lane, 16u);
    }
    __syncthreads();
}

template <class Epi>
__device__ __forceinline__ void sample_gemm16(LAS unsigned char* lds, const bf16_t* Arows, const bf16_t* Bt, const int K, const int nN, const int pm_unit, const Epi& E, const int job0, const int jstride) {
    const int tid = threadIdx.x, w = __builtin_amdgcn_readfirstlane(tid >> 6);
    int lane = tid & 63; asm volatile("" : "+v"(lane));
    const int fr = lane & 15, fq = lane >> 4;
    const int per = K / 256;
#pragma unroll 1
    for (int job = job0; job < nN * 64; job += jstride) {
        const int pn = job >> 6, jai = (job >> 5) & 1, jwr = (job >> 4) & 1, jm = (job >> 2) & 3, jwc = job & 3;
        f32x4 h[2][2];
#pragma unroll
        for (int b = 0; b < 2; ++b)
#pragma unroll
            for (int n = 0; n < 2; ++n) h[b][n] = (f32x4){0.f, 0.f, 0.f, 0.f};
        const bf16_t* ap = Arows + (size_t)(jai * 128 + jwr * 64 + 16 * jm + fr) * K + 8 * fq + (w * per) * 32;
        const bf16_t* bp = Bt + (size_t)(pn * 256 + jwc * 32 + 8 * (fr >> 2) + (fr & 3)) * K + 8 * fq + (w * per) * 32;
#pragma unroll 1
        for (int ks0 = 0; ks0 < per; ks0 += 6) {
            bf16x8 af[6], bfr[6][2][2];
#pragma unroll
            for (int kl = 0; kl < 6; ++kl) {
                const int ks = (ks0 + kl < per) ? ks0 + kl : per - 1;
                af[kl] = *(const bf16x8*)(ap + 32 * ks);
#pragma unroll
                for (int bj = 0; bj < 2; ++bj)
#pragma unroll
                    for (int n = 0; n < 2; ++n) bfr[kl][bj][n] = *(const bf16x8*)(bp + (size_t)(bj * 128 + 4 * n) * K + 32 * ks);
            }
#pragma unroll
            for (int kl = 0; kl < 6; ++kl)
                if (ks0 + kl < per) {
#pragma unroll
                    for (int bj = 0; bj < 2; ++bj)
#pragma unroll
                        for (int n = 0; n < 2; ++n) h[bj][n] = __builtin_amdgcn_mfma_f32_16x16x32_bf16(bfr[kl][bj][n], af[kl], h[bj][n], 0, 0, 0);
                }
        }
        __syncthreads();
#pragma unroll
        for (int bj = 0; bj < 2; ++bj)
#pragma unroll
            for (int n = 0; n < 2; ++n) *(LAS f32x4*)(lds + ((w * 4 + bj * 2 + n) * 64 + lane) * 16) = h[bj][n];
        __syncthreads();
        if (w < 4) {
            LAS unsigned char* sp = lds + (w * 64 + lane) * 16;
            f32x4 sum = *(const LAS f32x4*)sp;
#pragma unroll
            for (int ww = 1; ww < 8; ++ww) sum += *(const LAS f32x4*)(sp + ww * 4096);
            *(LAS f32x4*)sp = sum;
        }
        __syncthreads();
        if (w == 0) {
            f32x4 acc[2][2][4][2];
#pragma unroll
            for (int ai = 0; ai < 2; ++ai)
#pragma unroll
                for (int bj = 0; bj < 2; ++bj)
#pragma unroll
                    for (int m = 0; m < 4; ++m)
#pragma unroll
                        for (int n = 0; n < 2; ++n) acc[ai][bj][m][n] = *(const LAS f32x4*)(lds + ((bj * 2 + n) * 64 + lane) * 16);
            Unit u; u.pm = pm_unit; u.pn = pn;
            E(acc, u, jwr, jwc, fr, fq, 1u << (4 * jai + jm));
        }
        if constexpr (Epi::POST) E.post(lds, 2 * jai + jwr, w, lane, 64u);
    }
    __syncthreads();
}
}
using pg8::Unit;

struct EpiIn {
    static constexpr bool IDEM = true, POST = false;
    unsigned char* proj; float* DEC; float* HGFS; const f32x4* rope; const float* lb;
    __device__ __forceinline__ void operator()(const f32x4 (&acc)[2][2][4][2], const Unit& u, int wr, int wc, int fr_, int fq_, const unsigned mask = 0xffu) const {
        int fr = fr_, fq = fq_; asm volatile("" : "+v"(fr), "+v"(fq));
        const int pn = u.pn; const bool samp = (u.pm == 64);
        const int dd0 = 32 * (wc & 1) + 8 * fq;
        const int col0 = ((pn & 1) * 2 + (wc >> 1)) * 128 + dd0;
        const int rowb = u.pm * 256 + wr * 64 + fr;
        if (pn < 4) {
            const int type = pn >> 1;
            bf16_t* D = (bf16_t*)(proj + (size_t)type * PSZ);
            const int head = (pn & 1) * 2 + (wc >> 1);
            const float lg = __log2f(1.0f - exp2f(-5.0f - (float)head));
            const float base = type == 0 ? 1.0f : 0.08838834764831845f;
#pragma unroll
            for (int ai = 0; ai < 2; ++ai)
#pragma unroll
                for (int m = 0; m < 4; ++m) if ((mask >> (4 * ai + m)) & 1u) {
                    const int r = rowb + ai * 128 + m * 16;
                    const int pos = r < TP ? (r & 4095) : (1024 + (r & 15));
                    const float e = (float)((r & 63) + 1) * lg;
                    const float sc = samp ? base : base * exp2f(type == 0 ? e : -e);
                    const f32x4* cs = rope + (size_t)pos * 32 + (dd0 >> 1);
                    const f32x4 c0 = cs[0], c1 = cs[1], c2 = cs[2], c3 = cs[3];
                    const f32x4 lo0 = acc[ai][0][m][0], lo1 = acc[ai][0][m][1], hi0 = acc[ai][1][m][0], hi1 = acc[ai][1][m][1];
                    float ol[8], oh[8];
                    ol[0] = lo0[0] * c0[0] - hi0[0] * c0[1]; oh[0] = lo0[0] * c0[1] + hi0[0] * c0[0];
                    ol[1] = lo0[1] * c0[2] - hi0[1] * c0[3]; oh[1] = lo0[1] * c0[3] + hi0[1] * c0[2];
                    ol[2] = lo0[2] * c1[0] - hi0[2] * c1[1]; oh[2] = lo0[2] * c1[1] + hi0[2] * c1[0];
                    ol[3] = lo0[3] * c1[2] - hi0[3] * c1[3]; oh[3] = lo0[3] * c1[3] + hi0[3] * c1[2];
                    ol[4] = lo1[0] * c2[0] - hi1[0] * c2[1]; oh[4] = lo1[0] * c2[1] + hi1[0] * c2[0];
                    ol[5] = lo1[1] * c2[2] - hi1[1] * c2[3]; oh[5] = lo1[1] * c2[3] + hi1[1] * c2[2];
                    ol[6] = lo1[2] * c3[0] - hi1[2] * c3[1]; oh[6] = lo1[2] * c3[1] + hi1[2] * c3[0];
                    ol[7] = lo1[3] * c3[2] - hi1[3] * c3[3]; oh[7] = lo1[3] * c3[3] + hi1[3] * c3[2];
                    u32x4 wl, wh;
                    wl.x = cvt_pk_bf16(ol[0] * sc, ol[1] * sc); wl.y = cvt_pk_bf16(ol[2] * sc, ol[3] * sc); wl.z = cvt_pk_bf16(ol[4] * sc, ol[5] * sc); wl.w = cvt_pk_bf16(ol[6] * sc, ol[7] * sc);
                    wh.x = cvt_pk_bf16(oh[0] * sc, oh[1] * sc); wh.y = cvt_pk_bf16(oh[2] * sc, oh[3] * sc); wh.z = cvt_pk_bf16(oh[4] * sc, oh[5] * sc); wh.w = cvt_pk_bf16(oh[6] * sc, oh[7] * sc);
                    bf16_t* rp = D + pofs(head, r) + dd0;
                    st16b(proj, rp, wl); st16b(proj, rp + 64, wh);
                }
        } else if (pn >= 8 && pn < 12) {
            const int lane = fq * 16 + fr;
            const int colh = (pn - 8) * 128 + 32 * wc + 8 * fq;
            bf16_t* dHQ = (bf16_t*)(proj + 4 * PSZ); bf16_t* dHK = (bf16_t*)(proj + 5 * PSZ);
            f32x4 lbv[2];
#pragma unroll
            for (int n = 0; n < 2; ++n) lbv[n] = *(const f32x4*)(lb + colh + 4 * n);
            const int srcl = (lane & 48) | 15;
#pragma unroll
            for (int ai = 0; ai < 2; ++ai) {
                const int rbase = u.pm * 256 + ai * 128 + wr * 64;
#pragma unroll
                for (int n = 0; n < 2; ++n) if ((mask >> (4 * ai)) & 0xfu) {
                    const int cn = colh + 4 * n;
                    f32x4 gg[4], kk[4];
#pragma unroll
                    for (int m = 0; m < 4; ++m)
#pragma unroll
                        for (int j = 0; j < 4; ++j) {
                            const float x = acc[ai][1][m][n][j]; const float sg = sigmoid_f(x); const float l = lbv[n][j];
                            gg[m][j] = l + (1.0f - l) * sg; kk[m][j] = (1.0f - l) * (1.0f - sg);
                        }
                    if (samp) {
#pragma unroll
                        for (int m = 0; m < 4; ++m) if ((mask >> (4 * ai + m)) & 1u) {
                            const int r = rbase + 16 * m + fr;
                            const f32x4 q0 = acc[ai][0][m][n];
                            u32x2 w; w.x = cvt_pk_bf16(q0[0], q0[1]); w.y = cvt_pk_bf16(q0[2], q0[3]);
                            *(u32x2*)(dHQ + pofs(pn - 8, r) + (cn & 127)) = w;
                            *(f32x4*)(HGFS + (size_t)(r - TP) * HW + cn) = gg[m];
                        }
                    } else {
                        f32x4 carry = (f32x4){1.f, 1.f, 1.f, 1.f};
#pragma unroll
                        for (int m = 0; m < 4; ++m)
#pragma unroll
                            for (int j = 0; j < 4; ++j) {
                                float v = gg[m][j];
                                v *= dpp_f<0x111>(1.f, v); v *= dpp_f<0x112>(1.f, v); v *= dpp_f<0x114>(1.f, v); v *= dpp_f<0x118>(1.f, v);
                                v *= carry[j];
                                gg[m][j] = v;
                                carry[j] = __shfl(v, srcl);
                            }
#pragma unroll
                        for (int m = 0; m < 4; ++m) {
                            const int r = rbase + 16 * m + fr;
                            float qo[4], ko[4];
#pragma unroll
                            for (int j = 0; j < 4; ++j) { const float P = gg[m][j]; qo[j] = acc[ai][0][m][n][j] * P; ko[j] = kk[m][j] * __builtin_amdgcn_rcpf(P); }
                            u32x2 wq, wk;
                            wq.x = cvt_pk_bf16(qo[0], qo[1]); wq.y = cvt_pk_bf16(qo[2], qo[3]);
                            wk.x = cvt_pk_bf16(ko[0], ko[1]); wk.y = cvt_pk_bf16(ko[2], ko[3]);
                            st8b(proj, dHQ + pofs(pn - 8, r) + (cn & 127), wq); st8b(proj, dHK + pofs(pn - 8, r) + (cn & 127), wk);
                        }
                        if (fr == 15) {
                            f32x4 d0;
#pragma unroll
                            for (int j = 0; j < 4; ++j) d0[j] = carry[j];
                            *(f32x4*)(DEC + (size_t)(4 * u.pm + 2 * ai + wr) * HW + cn) = d0;
                        }
                    }
                }
            }
        } else {
            bf16_t* D = (bf16_t*)(proj + (size_t)(pn >> 1) * PSZ);
            const bool act = false;
#pragma unroll
            for (int ai = 0; ai < 2; ++ai)
#pragma unroll
                for (int m = 0; m < 4; ++m) if ((mask >> (4 * ai + m)) & 1u) {
                    const int r = rowb + ai * 128 + m * 16;
                    bf16_t* rp = D + pofs((pn & 1) * 2 + (wc >> 1), r) + dd0;
#pragma unroll
                    for (int bj = 0; bj < 2; ++bj) {
                        f32x4 v0 = acc[ai][bj][m][0], v1 = acc[ai][bj][m][1];
                        if (act) {
#pragma unroll
                            for (int j = 0; j < 4; ++j) { v0[j] = silu_f(v0[j]); v1[j] = silu_f(v1[j]); }
                        }
                        u32x4 w; w.x = cvt_pk_bf16(v0[0], v0[1]); w.y = cvt_pk_bf16(v0[2], v0[3]); w.z = cvt_pk_bf16(v1[0], v1[1]); w.w = cvt_pk_bf16(v1[2], v1[3]);
                        st16b(proj, rp + 64 * bj, w);
                    }
                }
        }
    }
};

struct EpiOut {
    static constexpr bool IDEM = true, POST = false;
    const float* xp; const float* xs; float* X1F; bf16_t* X1B; float* SS2;
    __device__ __forceinline__ void operator()(const f32x4 (&acc)[2][2][4][2], const Unit& u, int wr, int wc, int fr_, int fq_, const unsigned mask = 0xffu) const {
        int fr = fr_, fq = fq_; asm volatile("" : "+v"(fr), "+v"(fq));
        const int col0 = u.pn * 256 + wc * 32 + 8 * fq;
#pragma unroll
        for (int ai = 0; ai < 2; ++ai)
#pragma unroll
            for (int m = 0; m < 4; ++m) if ((mask >> (4 * ai + m)) & 1u) {
                const int r = u.pm * 256 + ai * 128 + wr * 64 + m * 16 + fr;
                const float* xr = (r < TP ? xp + (size_t)r * DM : xs + (size_t)(r - TP) * DM) + col0;
                const int rb = r < TP ? (4098 * (r >> 12) + 2 + (r & 4095)) : (16394 + (r - TP));
                bf16_t* o16 = X1B + (size_t)rb * DM + col0;
                float ss = 0.f;
#pragma unroll
                for (int bj = 0; bj < 2; ++bj) {
                    const f32x4 x0 = __builtin_nontemporal_load((const f32x4*)(xr + 128 * bj)), x1 = __builtin_nontemporal_load((const f32x4*)(xr + 128 * bj + 4));
                    const f32x4 v0 = acc[ai][bj][m][0] + x0, v1 = acc[ai][bj][m][1] + x1;
                    u32x4 w; w.x = cvt_pk_bf16(v0[0], v0[1]); w.y = cvt_pk_bf16(v0[2], v0[3]); w.z = cvt_pk_bf16(v1[0], v1[1]); w.w = cvt_pk_bf16(v1[2], v1[3]);
                    st16b(X1B, o16 + 128 * bj, w);
                    ss += (v0[0] * v0[0] + v0[1] * v0[1]) + (v0[2] * v0[2] + v0[3] * v0[3]) + (v1[0] * v1[0] + v1[1] * v1[1]) + (v1[2] * v1[2] + v1[3] * v1[3]);
                }
                ss += __shfl_xor(ss, 16); ss += __shfl_xor(ss, 32);
                if (fq == 0) SS2[(size_t)r * 16 + u.pn * 4 + wc] = ss;
            }
    }
};

struct EpiUp {
    static constexpr bool IDEM = true, POST = false;
    const float* SS2; const float* ck; const float* cb; const float* cache_in; bf16_t* ACT; float* ccp; float* ccs;
    __device__ __forceinline__ void operator()(f32x4 (&acc)[2][2][4][2], const Unit& u, int wr, int wc, int fr_, int fq_, const unsigned mask = 0xffu) const {
        int fr = fr_, fq = fq_; asm volatile("" : "+v"(fr), "+v"(fq));
        const int lane = fq * 16 + fr;
        const int f0 = u.pn * 128 + wc * 32 + 8 * fq;
        const bool samp = (u.pm == 68);
        const int sb = samp ? 0 : u.pm / 17, sj = samp ? 0 : u.pm % 17;
        f32x4 k0[2], k1[2], k2[2], bb[2];
#pragma unroll
        for (int n = 0; n < 2; ++n) { k0[n] = *(const f32x4*)(ck + f0 + 4 * n); k1[n] = *(const f32x4*)(ck + DFF + f0 + 4 * n); k2[n] = *(const f32x4*)(ck + 2 * DFF + f0 + 4 * n); bb[n] = *(const f32x4*)(cb + f0 + 4 * n); }
#pragma unroll
        for (int ai = 0; ai < 2; ++ai) {
            f32x4 prev[2] = {(f32x4){0.f, 0.f, 0.f, 0.f}, (f32x4){0.f, 0.f, 0.f, 0.f}};
#pragma unroll
            for (int m = 0; m < 4; ++m) if ((mask >> (4 * ai + m)) & 1u) {
                int gr; bool valid; int t = 0;
                if (samp) { gr = TP + ai * 128 + wr * 64 + m * 16 + fr; valid = true; }
                else { t = 248 * sj + 62 * (2 * ai + wr) + 16 * m + fr - 2; gr = sb * SEQ + t; valid = (t >= 0) && (t < SEQ); }
                float ssq = 0.f;
                if (valid) { const f32x4 p = *(const f32x4*)(SS2 + (size_t)gr * 16 + 4 * fq); ssq = (p[0] + p[1]) + (p[2] + p[3]); }
                ssq += __shfl_xor(ssq, 16); ssq += __shfl_xor(ssq, 32);
                const float rs = valid ? __frsqrt_rn(ssq * (1.0f / DM) + EPS) : 0.f;
                f32x4 a[2], b[2];
#pragma unroll
                for (int n = 0; n < 2; ++n) { a[n] = acc[ai][0][m][n] * rs; b[n] = acc[ai][1][m][n] * rs; }
                if (samp) {
                    const int s = ai * 8 + wr * 4 + m;
                    if (fr >= 14) {
#pragma unroll
                        for (int n = 0; n < 2; ++n) prev[n] = *(const f32x4*)(cache_in + ((size_t)s * 2 + (fr - 14)) * DFF + f0 + 4 * n);
                    }
                }
                f32x4 o[2];
#pragma unroll
                for (int n = 0; n < 2; ++n)
#pragma unroll
                    for (int j = 0; j < 4; ++j) {
                        const float s1 = dpp_f<0x111>(dpp_f<0x121>(0.f, prev[n][j]), a[n][j]);
                        const float s2 = dpp_f<0x112>(dpp_f<0x122>(0.f, prev[n][j]), a[n][j]);
                        const float cv = bb[n][j] + k0[n][j] * s2 + k1[n][j] * s1 + k2[n][j] * a[n][j];
                        o[n][j] = silu_f(cv) * b[n][j];
                    }
                const bool store = samp ? true : (valid && (16 * m + fr >= 2));
                if (store) {
                    u32x4 w; w.x = cvt_pk_bf16(o[0][0], o[0][1]); w.y = cvt_pk_bf16(o[0][2], o[0][3]); w.z = cvt_pk_bf16(o[1][0], o[1][1]); w.w = cvt_pk_bf16(o[1][2], o[1][3]);
                    st16b(ACT, ACT + (size_t)gr * DFF + f0, w);
                    if (samp) { if (fr >= 14) { float* cp = ccs + ((size_t)(ai * 8 + wr * 4 + m) * 2 + (fr - 14)) * DFF + f0; *(f32x4*)cp = a[0]; *(f32x4*)(cp + 4) = a[1]; } }
                    else if (t >= SEQ - 2) { float* cp = ccp + ((size_t)sb * 2 + (t - (SEQ - 2))) * DFF + f0; *(f32x4*)cp = a[0]; *(f32x4*)(cp + 4) = a[1]; }
                }
                prev[0] = a[0]; prev[1] = a[1];
            }
        }
    }
};

struct EpiUpMain {
    static constexpr bool IDEM = true, POST = false;
    const float* SS2; const float* ck; const float* cb; const float* cache_in; bf16_t* ACT; float* ccp; float* ccs;
    __device__ __forceinline__ void operator()(f32x4 (&acc)[2][2][4][2], const Unit& u, int wr, int wc, int fr_, int fq_, const unsigned mask = 0xffu) const {
        int fr = fr_, fq = fq_; asm volatile("" : "+v"(fr), "+v"(fq));
        const int f0 = u.pn * 128 + wc * 32 + 8 * fq;
        const int sb = u.pm / 17, sj = u.pm % 17;
        f32x4 k0[2], k1[2], k2[2], bb[2];
#pragma unroll
        for (int n = 0; n < 2; ++n) { k0[n] = *(const f32x4*)(ck + f0 + 4 * n); k1[n] = *(const f32x4*)(ck + DFF + f0 + 4 * n); k2[n] = *(const f32x4*)(ck + 2 * DFF + f0 + 4 * n); bb[n] = *(const f32x4*)(cb + f0 + 4 * n); }
        constexpr float NL2E = -1.4426950408889634f, NLN2 = -0.6931471805599453f;
#pragma unroll
        for (int n = 0; n < 2; ++n) { k0[n] *= NL2E; k1[n] *= NL2E; k2[n] *= NL2E; bb[n] *= NL2E; }
#pragma unroll
        for (int ai = 0; ai < 2; ++ai) {
            const int tb = 248 * sj + 62 * (2 * ai + wr) - 2 + 4 * fr;
            float rs[4];
#pragma unroll
            for (int m = 0; m < 4; ++m) {
                const int t = tb + m; const bool valid = (unsigned)t < (unsigned)SEQ;
                float ssq = 0.f;
                if (valid) { const f32x4 p = *(const f32x4*)(SS2 + (size_t)(sb * SEQ + t) * 16 + 4 * fq); ssq = (p[0] + p[1]) + (p[2] + p[3]); }
                ssq += __shfl_xor(ssq, 16); ssq += __shfl_xor(ssq, 32);
                rs[m] = valid ? __frsqrt_rn(ssq * (1.0f / DM) + EPS) : 0.f;
            }
            const float rsb[4] = {rs[0] * NLN2, rs[1] * NLN2, rs[2] * NLN2, rs[3] * NLN2};
            u32x4 w[4];
#pragma unroll
            for (int n = 0; n < 2; ++n)
#pragma unroll
                for (int j = 0; j < 4; j += 2) {
                    float o[4][2];
#pragma unroll
                    for (int jj = 0; jj < 2; ++jj) {
                        const float a0 = acc[ai][0][0][n][j + jj] * rs[0], a1 = acc[ai][0][1][n][j + jj] * rs[1], a2 = acc[ai][0][2][n][j + jj] * rs[2], a3 = acc[ai][0][3][n][j + jj] * rs[3];
                        const float p1 = dpp_z<0x111>(a3), p2 = dpp_z<0x111>(a2);
                        const float c0 = k0[n][j + jj], c1 = k1[n][j + jj], c2 = k2[n][j + jj], cbv = bb[n][j + jj];
                        const float v0 = cbv + c0 * p2 + c1 * p1 + c2 * a0;
                        const float v1 = cbv + c0 * p1 + c1 * a0 + c2 * a1;
                        const float v2 = cbv + c0 * a0 + c1 * a1 + c2 * a2;
                        const float v3 = cbv + c0 * a1 + c1 * a2 + c2 * a3;
                        o[0][jj] = (v0 * __builtin_amdgcn_rcpf(1.0f + __builtin_amdgcn_exp2f(v0))) * (acc[ai][1][0][n][j + jj] * rsb[0]);
                        o[1][jj] = (v1 * __builtin_amdgcn_rcpf(1.0f + __builtin_amdgcn_exp2f(v1))) * (acc[ai][1][1][n][j + jj] * rsb[1]);
                        o[2][jj] = (v2 * __builtin_amdgcn_rcpf(1.0f + __builtin_amdgcn_exp2f(v2))) * (acc[ai][1][2][n][j + jj] * rsb[2]);
                        o[3][jj] = (v3 * __builtin_amdgcn_rcpf(1.0f + __builtin_amdgcn_exp2f(v3))) * (acc[ai][1][3][n][j + jj] * rsb[3]);
                    }
#pragma unroll
                    for (int m = 0; m < 4; ++m) w[m][2 * n + (j >> 1)] = cvt_pk_bf16(o[m][0], o[m][1]);
                }
#pragma unroll
            for (int m = 0; m < 4; ++m) {
                const int t = tb + m;
                if ((unsigned)t < (unsigned)SEQ && (4 * fr + m >= 2)) {
                    st16b(ACT, ACT + (size_t)(sb * SEQ + t) * DFF + f0, w[m]);
                    if (t >= SEQ - 2) { float* cp = ccp + ((size_t)sb * 2 + (t - (SEQ - 2))) * DFF + f0; *(f32x4*)cp = acc[ai][0][m][0] * rs[m]; *(f32x4*)(cp + 4) = acc[ai][0][m][1] * rs[m]; }
                }
            }
        }
    }
};

template <bool FUSED>
struct EpiDownT {
    static constexpr bool IDEM = false, POST = !FUSED;
    float* X; const bf16_t* X1B; float* SS3; const float* gfin; float* XS; unsigned* cnt; LAS unsigned char* ldsx;
    static __device__ __forceinline__ void ld8(const bf16_t* p, f32x4& a, f32x4& b) { const u32x4 w = *(const u32x4*)p;
        a[0] = __uint_as_float(w.x << 16); a[1] = __uint_as_float(w.x & 0xffff0000u); a[2] = __uint_as_float(w.y << 16); a[3] = __uint_as_float(w.y & 0xffff0000u);
        b[0] = __uint_as_float(w.z << 16); b[1] = __uint_as_float(w.z & 0xffff0000u); b[2] = __uint_as_float(w.w << 16); b[3] = __uint_as_float(w.w & 0xffff0000u); }
    __device__ __forceinline__ void post(LAS unsigned char* lds, int rb, int w, int lane, const unsigned nexp) const {
        asm volatile("s_waitcnt vmcnt(0)" ::: "memory");
        __syncthreads();
        LAS unsigned* flag = (LAS unsigned*)(lds + RING_BYTES + 8192);
        if (threadIdx.x == 0) {
            __builtin_amdgcn_fence(__ATOMIC_RELEASE, "agent");
            asm volatile("s_waitcnt vmcnt(0)" ::: "memory");
            const unsigned old = __hip_atomic_fetch_add(cnt + 64 * (64 + rb), 1u, __ATOMIC_RELAXED, __HIP_MEMORY_SCOPE_AGENT);
            const unsigned last = (old == nexp - 1u) ? 1u : 0u;
            if (last) { __builtin_amdgcn_fence(__ATOMIC_ACQUIRE, "agent"); asm volatile("s_waitcnt vmcnt(0)" ::: "memory"); }
            *flag = last;
        }
        __syncthreads();
        if (*flag) {
            f32x4 gn[4];
#pragma unroll
            for (int j = 0; j < 4; ++j) gn[j] = ((const f32x4*)gfin)[lane + 64 * j];
            for (int q = w; q < 64; q += NWAVES) {
                const int m = TP + 64 * rb + q;
                float p = lane < 16 ? SS3[(size_t)m * 16 + lane] : 0.f;
#pragma unroll
                for (int o = 1; o < 64; o <<= 1) p += __shfl_xor(p, o);
                const float rs = 1.0f / sqrtf(p * (1.0f / DM) + EPS);
                f32x4* xr = (f32x4*)(X + (size_t)m * DM) + lane;
#pragma unroll
                for (int j = 0; j < 4; ++j) { f32x4 v = xr[64 * j]; v = v * rs * gn[j]; xr[64 * j] = v; }
            }
        }
        __syncthreads();
    }
    __device__ __forceinline__ void operator()(f32x4 (&acc)[2][2][4][2], const Unit& u, int wr, int wc, int fr_, int fq_, const unsigned mask = 0xffu) const {
        int fr = fr_, fq = fq_; asm volatile("" : "+v"(fr), "+v"(fq));
        const int col0 = u.pn * 256 + wc * 32 + 8 * fq;
        if constexpr (!FUSED) {
#pragma unroll
            for (int ai = 0; ai < 2; ++ai)
#pragma unroll
                for (int m = 0; m < 4; ++m) if ((mask >> (4 * ai + m)) & 1u) {
                    const int r = u.pm * 256 + ai * 128 + wr * 64 + m * 16 + fr;
                    float* xr = X + (size_t)r * DM + col0;
                    const int rb = r < TP ? (4098 * (r >> 12) + 2 + (r & 4095)) : (16394 + (r - TP));
                    const bf16_t* x1p = X1B + (size_t)rb * DM + col0;
                    float ss = 0.f;
#pragma unroll
                    for (int bj = 0; bj < 2; ++bj) {
                        f32x4 x0, x1; ld8(x1p + 128 * bj, x0, x1);
                        const f32x4 v0 = acc[ai][bj][m][0] + x0, v1 = acc[ai][bj][m][1] + x1;
                        *(f32x4*)(xr + 128 * bj) = v0; *(f32x4*)(xr + 128 * bj + 4) = v1;
                        ss += (v0[0] * v0[0] + v0[1] * v0[1]) + (v0[2] * v0[2] + v0[3] * v0[3]) + (v1[0] * v1[0] + v1[1] * v1[1]) + (v1[2] * v1[2] + v1[3] * v1[3]);
                    }
                    ss += __shfl_xor(ss, 16); ss += __shfl_xor(ss, 32);
                    if (fq == 0) SS3[(size_t)r * 16 + u.pn * 4 + wc] = ss;
                }
        } else {
            const int tid = threadIdx.x, wid = __builtin_amdgcn_readfirstlane(tid >> 6);
            LAS float* P = (LAS float*)ldsx;
            LAS float* S = (LAS float*)(ldsx + 4096);
#pragma unroll
            for (int ai = 0; ai < 2; ++ai)
#pragma unroll
                for (int m = 0; m < 4; ++m) {
                    const int rl = ai * 128 + wr * 64 + m * 16 + fr;
                    const int r = u.pm * 256 + rl;
                    const bf16_t* x1p = X1B + (size_t)(4098 * (r >> 12) + 2 + (r & 4095)) * DM + col0;
                    float ss = 0.f;
#pragma unroll
                    for (int bj = 0; bj < 2; ++bj) {
                        f32x4 x0, x1; ld8(x1p + 128 * bj, x0, x1);
                        const f32x4 v0 = acc[ai][bj][m][0] + x0, v1 = acc[ai][bj][m][1] + x1;
                        acc[ai][bj][m][0] = v0; acc[ai][bj][m][1] = v1;
                        ss += (v0[0] * v0[0] + v0[1] * v0[1]) + (v0[2] * v0[2] + v0[3] * v0[3]) + (v1[0] * v1[0] + v1[1] * v1[1]) + (v1[2] * v1[2] + v1[3] * v1[3]);
                    }
                    ss += __shfl_xor(ss, 16); ss += __shfl_xor(ss, 32);
                    if (fq == 0) P[rl * 4 + wc] = ss;
                    if (m & 1) asm volatile("" ::: "memory");
                }
            asm volatile("s_waitcnt lgkmcnt(0)" ::: "memory"); __builtin_amdgcn_s_barrier(); asm volatile("" ::: "memory");
            if (tid < 256) {
                const f32x4 p = *(const LAS f32x4*)(P + tid * 4);
                __hip_atomic_store(XS + ((size_t)u.pm * 256 + tid) * 4 + u.pn, (p[0] + p[1]) + (p[2] + p[3]), __ATOMIC_RELAXED, __HIP_MEMORY_SCOPE_AGENT);
            }
            asm volatile("s_waitcnt vmcnt(0)" ::: "memory");
            if (tid < 256 && (tid & 63) == 0) __hip_atomic_fetch_add(cnt + 64 * u.pm, 1u, __ATOMIC_RELAXED, __HIP_MEMORY_SCOPE_AGENT);
            if (wid == 0) {
                unsigned sp = 0;
                while ((unsigned)__builtin_amdgcn_readfirstlane(__hip_atomic_load(cnt + 64 * u.pm, __ATOMIC_RELAXED, __HIP_MEMORY_SCOPE_AGENT)) < 16u) {
                    __builtin_amdgcn_s_sleep(2);
                    if (++sp > (1u << 20)) break;
                }
                __builtin_amdgcn_fence(__ATOMIC_ACQUIRE, "agent");
            }
            asm volatile("s_waitcnt vmcnt(0) lgkmcnt(0)" ::: "memory"); __builtin_amdgcn_s_barrier(); asm volatile("" ::: "memory");
            if (tid < 256) {
                const float* sl = XS + ((size_t)u.pm * 256 + tid) * 4;
                float t = 0.f;
#pragma unroll
                for (int k = 0; k < 4; ++k) t += __hip_atomic_load(sl + k, __ATOMIC_RELAXED, __HIP_MEMORY_SCOPE_AGENT);
                S[tid] = 1.0f / sqrtf(t * (1.0f / DM) + EPS);
            }
            asm volatile("s_waitcnt vmcnt(0) lgkmcnt(0)" ::: "memory"); __builtin_amdgcn_s_barrier(); asm volatile("" ::: "memory");
            f32x4 gv[2][2];
#pragma unroll
            for (int bj = 0; bj < 2; ++bj)
#pragma unroll
                for (int n = 0; n < 2; ++n) gv[bj][n] = *(const f32x4*)(gfin + col0 + 128 * bj + 4 * n);
#pragma unroll
            for (int ai = 0; ai < 2; ++ai)
#pragma unroll
                for (int m = 0; m < 4; ++m) {
                    const int rl = ai * 128 + wr * 64 + m * 16 + fr;
                    const float rs = S[rl];
                    float* xr = X + (size_t)(u.pm * 256 + rl) * DM + col0;
#pragma unroll
                    for (int bj = 0; bj < 2; ++bj) {
                        *(f32x4*)(xr + 128 * bj) = acc[ai][bj][m][0] * rs * gv[bj][0];
                        *(f32x4*)(xr + 128 * bj + 4) = acc[ai][bj][m][1] * rs * gv[bj][1];
                    }
                }
        }
    }
};

struct EpiNull {
    static constexpr bool IDEM = false, POST = false;
    __device__ __forceinline__ void operator()(f32x4 (&acc)[2][2][4][2], const Unit& u, int wr, int wc, int fr_, int fq_, const unsigned mask = 0xffu) const {
#pragma unroll
        for (int a = 0; a < 2; ++a)
#pragma unroll
            for (int b = 0; b < 2; ++b)
#pragma unroll
                for (int m = 0; m < 4; ++m)
#pragma unroll
                    for (int n = 0; n < 2; ++n) asm volatile("" :: "v"(acc[a][b][m][n]));
    }
};
struct Args { const float* in[17]; float* out; unsigned char* ws; int ph_lo, ph_hi; };

__device__ __forceinline__ float wave_sum(float v) {
#pragma unroll
    for (int o = 1; o < 64; o <<= 1) v += __shfl_xor(v, o);
    return v;
}

__device__ __forceinline__ void transpose_item(const float* W, int K, int N, bf16_t* WT, const float* gain, LAS float* scr, int k0, int p0, int s0, int lane) {
    float tv[32];
#pragma unroll
    for (int i = 0; i < 32; ++i) { const int kk = 2 * i + (lane >> 5); tv[i] = __builtin_nontemporal_load(W + (size_t)(k0 + kk) * N + s0 + (lane & 31)); }
    if (gain) {
#pragma unroll
        for (int i = 0; i < 32; ++i) tv[i] *= gain[k0 + 2 * i + (lane >> 5)];
    }
#pragma unroll
    for (int i = 0; i < 32; ++i) scr[(2 * i + (lane >> 5)) * 33 + (lane & 31)] = tv[i];
    asm volatile("s_waitcnt lgkmcnt(0)" ::: "memory");
    const int c = lane & 7;
#pragma unroll
    for (int j = 0; j < 4; ++j) { const int n = (lane >> 3) + 8 * j; const LAS float* s = scr + (8 * c) * 33 + n;
        u32x4 o; o.x = cvt_pk_bf16(s[0 * 33], s[1 * 33]); o.y = cvt_pk_bf16(s[2 * 33], s[3 * 33]); o.z = cvt_pk_bf16(s[4 * 33], s[5 * 33]); o.w = cvt_pk_bf16(s[6 * 33], s[7 * 33]);
        *(u32x4*)(WT + (size_t)(p0 + n) * K + k0 + 8 * c) = o; }
    asm volatile("s_waitcnt lgkmcnt(0)" ::: "memory");
}
__device__ __forceinline__ int colmap_in(int p) {
    const int pn = p >> 8, pl = p & 255, bj = pl >> 7, q = pl & 127;
    if (pn >= 8 && pn < 12) return (bj ? 2560 : 2048) + (pn - 8) * 128 + q;
    const int type = pn >> 1;
    return type * 512 + ((pn & 1) * 2 + (q >> 6)) * 128 + bj * 64 + (q & 63);
}
__device__ __forceinline__ int colmap_up(int p) { const int pn = p >> 8, pl = p & 255, bj = pl >> 7, q = pl & 127; return bj * DFF + 128 * pn + q; }

__device__ __forceinline__ void phase_prep(const Args& A, LAS unsigned char* lds, int wave, int lane) {
    unsigned char* ws = A.ws;
    const int G = gridDim.x, gw = blockIdx.x * NWAVES + wave, NGW = G * NWAVES;
    LAS float* scr = (LAS float*)(lds + wave * 8704);
    bf16_t* WinT = (bf16_t*)(ws + WS_WIN); bf16_t* WoutT = (bf16_t*)(ws + WS_WOUT); bf16_t* WupT = (bf16_t*)(ws + WS_WUP); bf16_t* WdT = (bf16_t*)(ws + WS_WD);
    constexpr int I_IN = 16 * 128, I_OUT = 16 * 32, I_UP = 16 * 176, I_DN = 44 * 32, NITEMS = I_IN + I_OUT + I_UP + I_DN;
    for (int it = gw; it < NITEMS; it += NGW) {
        int r = it;
        if (r < I_IN) { const int kb = r / 128, pb = r % 128; transpose_item(A.in[5], DM, INC, WinT, A.in[10], scr, 64 * kb, 32 * pb, colmap_in(32 * pb), lane); continue; } r -= I_IN;
        if (r < I_OUT) { const int kb = r / 32, pb = r % 32; transpose_item(A.in[9], DM, DM, WoutT, nullptr, scr, 64 * kb, 32 * pb, 32 * pb, lane); continue; } r -= I_OUT;
        if (r < I_UP) { const int kb = r / 176, pb = r % 176; transpose_item(A.in[12], DM, UPC, WupT, A.in[11], scr, 64 * kb, 32 * pb, colmap_up(32 * pb), lane); continue; } r -= I_UP;
        { const int kb = r / 32, pb = r % 32; transpose_item(A.in[15], DFF, DM, WdT, nullptr, scr, 64 * kb, 32 * pb, 32 * pb, lane); }
    }
    bf16_t* XB = (bf16_t*)(ws + WS_XB);
    for (int m0 = gw; m0 < TT; m0 += 4 * NGW) {
        f32x4 v[4][4];
#pragma unroll
        for (int q = 0; q < 4; ++q) {
            const int m = m0 + q * NGW;
            if (m < TT) {
                const float* xrow = m < TP ? A.in[0] + (size_t)m * DM : A.in[1] + (size_t)(m - TP) * DM;
                const f32x4* xr = (const f32x4*)xrow + lane;
#pragma unroll
                for (int j = 0; j < 4; ++j) v[q][j] = __builtin_nontemporal_load(xr + 64 * j);
            }
        }
#pragma unroll
        for (int q = 0; q < 4; ++q) {
            const int m = m0 + q * NGW;
            if (m < TT) {
                float s = 0.f;
#pragma unroll
                for (int j = 0; j < 4; ++j) s += (v[q][j][0] * v[q][j][0] + v[q][j][1] * v[q][j][1]) + (v[q][j][2] * v[q][j][2] + v[q][j][3] * v[q][j][3]);
                const float rs = 1.0f / sqrtf(wave_sum(s) * (1.0f / DM) + EPS);
                u32x2* o8 = (u32x2*)(XB + (size_t)m * DM) + lane;
#pragma unroll
                for (int j = 0; j < 4; ++j) { u32x2 w; w.x = cvt_pk_bf16(v[q][j][0] * rs, v[q][j][1] * rs); w.y = cvt_pk_bf16(v[q][j][2] * rs, v[q][j][3] * rs); o8[64 * j] = w; }
            }
        }
    }
    f32x2* rope = (f32x2*)(ws + WS_ROPE);
    const int gt = blockIdx.x * NTHREADS + threadIdx.x, NGT = G * NTHREADS;
    for (int i = gt; i < SEQ * 64; i += NGT) {
        const int pos = i >> 6, d = i & 63;
        const float inv = 1.0f / powf(10000.0f, (float)d * (1.0f / 64.0f));
        const float ang = (float)pos * inv;
        float sn, cs; sn = sinf(ang); cs = cosf(ang);
        rope[i] = (f32x2){cs, sn};
    }
    if (gt < HW) { const float l0 = A.in[8][gt], l1 = A.in[8][HW + gt]; ((float*)(ws + WS_LB))[gt] = 1.0f / (1.0f + __expf(l1 - l0)); }
    bf16_t* X1B = (bf16_t*)(ws + WS_X1B); (void)X1B;
}

template <bool HG>
__device__ __forceinline__ void sample_mixer_cols(const bf16_t* Q, const bf16_t* Kx, const float* Gf, const bf16_t* V, float* O, const float* st_in, float* st_out, int id) {
    const int tid = threadIdx.x, part = tid & 15, dpi = tid >> 4;
    const int seq = id >> 3, head = (id >> 1) & 3, dv0 = (id & 1) * 64 + 2 * dpi;
    const float* si = st_in + (size_t)(seq * 4 + head) * 16384 + dv0; float* so = st_out + (size_t)(seq * 4 + head) * 16384 + dv0;
    float S[2][8];
#pragma unroll
    for (int i = 0; i < 8; ++i) { const f32x2 t = *(const f32x2*)(si + (size_t)(part * 8 + i) * 128); S[0][i] = t[0]; S[1][i] = t[1]; }
    const int row0 = TP + seq * 16, ck = head * 128 + part * 8;
    const float gamma = 1.0f - exp2f(-5.0f - (float)head);
    const size_t hb = pofs(head, 0); const int pk8 = part * 8;
    constexpr int U = 2;
    u32x4 q8[2][U], k8[2][U]; f32x4 g0[2][U], g1[2][U]; unsigned vv[2][U];
#define SM_LOAD(set, t0_) do { _Pragma("unroll") for (int u = 0; u < U; ++u) { \
        const size_t r = (size_t)(row0 + (t0_) + u) * HW; const size_t rp_ = hb + (size_t)(row0 + (t0_) + u) * 128; q8[set][u] = *(const u32x4*)(Q + rp_ + pk8); \
        if (HG) { g0[set][u] = *(const f32x4*)(Gf + r + ck); g1[set][u] = *(const f32x4*)(Gf + r + ck + 4); } else k8[set][u] = *(const u32x4*)(Kx + rp_ + pk8); \
        vv[set][u] = *(const unsigned*)(V + rp_ + dv0); } } while (0)
    SM_LOAD(0, 0);
#pragma unroll 1
    for (int t0 = 0; t0 < 16; t0 += 2 * U) {
#pragma unroll
        for (int set = 0; set < 2; ++set) {
            const int tb = t0 + set * U;
            { const int tn = (tb + U < 16) ? tb + U : 16 - U; if (set == 0) SM_LOAD(1, tn); else SM_LOAD(0, tn); }
#pragma unroll
            for (int u = 0; u < U; ++u) {
                const float v0 = __uint_as_float(vv[set][u] << 16), v1 = __uint_as_float(vv[set][u] & 0xffff0000u);
                float qf[8], kf[8], df[8];
                const unsigned qa[4] = {q8[set][u].x, q8[set][u].y, q8[set][u].z, q8[set][u].w};
#pragma unroll
                for (int i = 0; i < 4; ++i) { qf[2 * i] = __uint_as_float(qa[i] << 16); qf[2 * i + 1] = __uint_as_float(qa[i] & 0xffff0000u); }
                if (HG) {
#pragma unroll
                    for (int i = 0; i < 4; ++i) { df[i] = g0[set][u][i]; df[4 + i] = g1[set][u][i]; }
#pragma unroll
                    for (int i = 0; i < 8; ++i) kf[i] = 1.0f - df[i];
                } else {
                    const unsigned ka[4] = {k8[set][u].x, k8[set][u].y, k8[set][u].z, k8[set][u].w};
#pragma unroll
                    for (int i = 0; i < 4; ++i) { kf[2 * i] = __uint_as_float(ka[i] << 16); kf[2 * i + 1] = __uint_as_float(ka[i] & 0xffff0000u); }
#pragma unroll
                    for (int i = 0; i < 8; ++i) df[i] = gamma;
                }
                float p0 = 0.f, p1 = 0.f;
#pragma unroll
                for (int i = 0; i < 8; ++i) { S[0][i] = df[i] * S[0][i] + kf[i] * v0; p0 += qf[i] * S[0][i]; S[1][i] = df[i] * S[1][i] + kf[i] * v1; p1 += qf[i] * S[1][i]; }
                p0 += dpp_f<0x128>(0.f, p0); p0 += dpp_f<0x124>(0.f, p0); p0 += dpp_f<0x122>(0.f, p0); p0 += dpp_f<0x121>(0.f, p0);
                p1 += dpp_f<0x128>(0.f, p1); p1 += dpp_f<0x124>(0.f, p1); p1 += dpp_f<0x122>(0.f, p1); p1 += dpp_f<0x121>(0.f, p1);
                if (part == 0) *(f32x2*)(O + (size_t)(row0 + tb + u) * DM + (HG ? HW : 0) + head * 128 + dv0) = (f32x2){p0, p1};
            }
        }
    }
#undef SM_LOAD
#pragma unroll
    for (int i = 0; i < 8; ++i) *(f32x2*)(so + (size_t)(part * 8 + i) * 128) = (f32x2){S[0][i], S[1][i]};
}
__device__ __forceinline__ void phase_mixer_sample(const Args& A) {
    unsigned char* ws = A.ws;
    const bf16_t* QR = (const bf16_t*)(ws + WS_QR); const bf16_t* KR = (const bf16_t*)(ws + WS_KR); const bf16_t* VR = (const bf16_t*)(ws + WS_VR);
    const bf16_t* HQ = (const bf16_t*)(ws + WS_HQ); const bf16_t* HI = (const bf16_t*)(ws + WS_HI);
    const float* HGFv = (const float*)(ws + WS_HGFS) - (size_t)TP * HW;
    float* O = A.out + O_Y;
    const int G = gridDim.x;
    for (int it = blockIdx.x; it < 256; it += G) {
        if (it >> 7) sample_mixer_cols<true>(HQ, nullptr, HGFv, HI, O, A.in[3], A.out + O_HGS, it & 127);
        else sample_mixer_cols<false>(QR, KR, nullptr, VR, O, A.in[2], A.out + O_RETS, it & 127);
    }
}

typedef short s16x4 __attribute__((ext_vector_type(4)));
__device__ __forceinline__ bf16x8 tr2(LAS unsigned char* p0, LAS unsigned char* p1) {
    const s16x4 a = __builtin_amdgcn_ds_read_tr16_b64_v4i16((LAS s16x4*)p0);
    const s16x4 b = __builtin_amdgcn_ds_read_tr16_b64_v4i16((LAS s16x4*)p1);
    return __builtin_shufflevector(a, b, 0, 1, 2, 3, 4, 5, 6, 7);
}
#define MFMA16(a, b, c) __builtin_amdgcn_mfma_f32_16x16x32_bf16((a), (b), (c), 0, 0, 0)

constexpr int M1_KSTR = 144, M1_VSTR = 72, M1_KSZ = 64 * M1_KSTR, M1_CH = M1_KSZ + 64 * M1_VSTR, M1_BUF = 2 * M1_CH;
__device__ __forceinline__ void m1_item(const bf16_t* Kt, const bf16_t* V, const float* DECp, bf16_t* ST, float* state_out, int seq, int head, int slice, float gamma64,
                                        LAS unsigned char* lds, int w, int lane, const int pmode = 0) {
    const int tid = threadIdx.x, fr = lane & 15, g = lane >> 4, r4 = fr >> 2, c4 = fr & 3;
    const int dkh = slice >> 2, dvq = slice & 3, tk = w >> 1, tv = w & 1;
    const size_t rbase = (size_t)seq * SEQ;
    const int cb = head * 128;
    const bool vld = tid < 256;
    const bf16_t* kp = Kt + pofs(head, rbase + (tid >> 3)) + dkh * 64 + (tid & 7) * 8;
    const bf16_t* vp = V + pofs(head, rbase + (tid >> 2)) + dvq * 32 + (tid & 3) * 8;
    const int kwo = (tid >> 3) * M1_KSTR + (tid & 7) * 16, vwo = M1_KSZ + (tid >> 2) * M1_VSTR + (tid & 3) * 16;
    const int dv = dvq * 32 + tv * 16 + fr, dk0 = dkh * 64 + 16 * tk + 4 * g;
    const float* dp = DECp ? DECp + (size_t)(seq * 64) * HW + cb + dk0 : nullptr;
    u32x4 rk0[8], rv[8]; f32x4 rd[8];
#define M1_LOAD(slot, n_) do { const size_t o_ = (size_t)(n_) * 64 * 128; rk0[slot] = *(const u32x4*)(kp + o_); \
        rv[slot] = vld ? *(const u32x4*)(vp + o_) : (u32x4){0u, 0u, 0u, 0u}; rd[slot] = dp ? *(const f32x4*)(dp + (size_t)(n_) * HW) : (f32x4){gamma64, gamma64, gamma64, gamma64}; } while (0)
#define M1_WRITE(slot, off_) do { LAS unsigned char* nb_ = lds + (off_); *(LAS u32x4*)(nb_ + kwo) = rk0[slot]; \
        if (vld) { *(LAS u32x2*)(nb_ + vwo) = (u32x2){rv[slot].x, rv[slot].y}; *(LAS u32x2*)(nb_ + vwo + 8) = (u32x2){rv[slot].z, rv[slot].w}; } } while (0)
    M1_LOAD(0, 0); M1_LOAD(1, 1); M1_LOAD(2, 2); M1_LOAD(3, 3); M1_LOAD(4, 4); M1_LOAD(5, 5); M1_LOAD(6, 6); M1_LOAD(7, 7);
    M1_WRITE(0, 0); M1_WRITE(1, M1_CH);
    __syncthreads();
    f32x4 acc = (f32x4){0.f, 0.f, 0.f, 0.f};
    for (int s0 = 0; s0 < 32; s0 += 4) {
#pragma unroll
        for (int u = 0; u < 4; ++u) {
            const int n = 2 * (s0 + u);
            LAS unsigned char* buf = lds + (u & 1) * M1_BUF;
            const f32x4 dec0 = rd[2 * u], dec1 = rd[2 * u + 1];
            { const int na = (n + 8 < 64) ? n + 8 : 62; M1_LOAD(2 * u, na); M1_LOAD(2 * u + 1, na + 1); }
#pragma unroll
            for (int h = 0; h < 2; ++h) {
                if (!(pmode & 1)) { u32x2 sv; sv.x = cvt_pk_bf16(acc[0], acc[1]); sv.y = cvt_pk_bf16(acc[2], acc[3]);
                  st8b(ST, ST + ((size_t)((seq * 64 + n + h) * 4 + head) * 128 + dv) * 128 + dk0, sv); }
#pragma unroll
                for (int ks = 0; ks < 2; ++ks) if (!(pmode & 2)) {
                    LAS unsigned char* ka = buf + h * M1_CH + (32 * ks + 8 * g + r4) * M1_KSTR + 32 * tk + 8 * c4;
                    LAS unsigned char* va = buf + h * M1_CH + M1_KSZ + (32 * ks + 8 * g + r4) * M1_VSTR + 32 * tv + 8 * c4;
                    const bf16x8 af = tr2(ka, ka + 4 * M1_KSTR), bfv = tr2(va, va + 4 * M1_VSTR);
                    acc = MFMA16(af, bfv, acc);
                }
                acc = acc * (h ? dec1 : dec0);
            }
            if (!(pmode & 8)) { M1_WRITE(2 * ((u + 1) & 3), ((u + 1) & 1) * M1_BUF); M1_WRITE(2 * ((u + 1) & 3) + 1, ((u + 1) & 1) * M1_BUF + M1_CH); }
            if (!(pmode & 4)) __syncthreads();
        }
    }
#undef M1_LOAD
#undef M1_WRITE
    if (!pmode) {
#pragma unroll
        for (int j = 0; j < 4; ++j) state_out[(size_t)(dk0 + j) * 128 + dv] = acc[j];
    } else asm volatile("" :: "v"(acc));
}
__device__ __forceinline__ void phase_m1(const Args& A, LAS unsigned char* lds, int w, int lane, const bool dup = false) {
    unsigned char* ws = A.ws;
    bf16_t* STb = (bf16_t*)(A.out + O_Y);
    const int G = gridDim.x;
    const int vcu = (G % 8 == 0) ? (int)(blockIdx.x % 8) * (G / 8) + (int)(blockIdx.x / 8) : (int)blockIdx.x;
    for (int it = vcu; it < 256 && !((PROBE & 4096) && dup); it += G) {
        const int mixer = it >> 7, seq = (it >> 5) & 3, head = (it >> 3) & 3, slice = it & 7;
        const float gam = 1.0f - exp2f(-5.0f - (float)head);
        const float g64 = exp2f(64.0f * __log2f(gam));
        float* sout = A.out + (mixer ? O_HGP : O_RETP) + (size_t)(seq * 4 + head) * 16384;
        bf16_t* ST = STb + (size_t)mixer * 256 * 4 * 16384;
        const int pm_ = dup ? ((PROBE >> 14) & 15) : 0;
        if (mixer) m1_item((const bf16_t*)(ws + WS_HK), (const bf16_t*)(ws + WS_HI), (const float*)(ws + WS_DEC), ST, sout, seq, head, slice, 0.f, lds, w, lane, pm_);
        else m1_item((const bf16_t*)(ws + WS_KR), (const bf16_t*)(ws + WS_VR), nullptr, ST, sout, seq, head, slice, g64, lds, w, lane, pm_);
        __syncthreads();
    }
    if (!(PROBE & 8192) || !dup) phase_mixer_sample(A);
}

constexpr int M2_VSTR = 272, M2_VBUF = 64 * M2_VSTR, M2_EXCH = 8 * M2_VBUF;
__device__ __forceinline__ void m2_item(const Args& A, int seq, int n, LAS unsigned char* lds, int w, int lane) {
    unsigned char* ws = A.ws;
    int fr = lane & 15, g = lane >> 4; asm volatile("" : "+v"(fr), "+v"(g));
    const int r4 = fr >> 2, c4 = fr & 3;
    const int mixer = w >> 2, head = w & 3, cb = head * 128;
    const bf16_t* Q = (const bf16_t*)(ws + (mixer ? WS_HQ : WS_QR)); const bf16_t* K = (const bf16_t*)(ws + (mixer ? WS_HK : WS_KR));
    const bf16_t* V = (const bf16_t*)(ws + (mixer ? WS_HI : WS_VR)); const bf16_t* GT = (const bf16_t*)(ws + (mixer ? WS_HGT : WS_GR));
    const float* gain = A.in[mixer ? 7 : 6] + cb;
    const size_t r0 = (size_t)seq * SEQ + 64 * n;
    const bf16_t* ST = (const bf16_t*)(A.out + O_Y) + ((size_t)(mixer * 256 + seq * 64 + n) * 4 + head) * 16384;
    bf16_t* MG = (bf16_t*)(ws + WS_XB);
    LAS unsigned char* vb = lds + w * M2_VBUF;
    const bf16_t* qp = Q + pofs(head, r0 + fr) + 8 * g; const bf16_t* kp = K + pofs(head, r0 + fr) + 8 * g;
    u32x4 vr[16];
#pragma unroll
    for (int i = 0; i < 16; ++i) vr[i] = __builtin_nontemporal_load((const u32x4*)(V + pofs(head, r0 + 4 * i + g) + fr * 8));
    bf16x8 qf[4][4], kf[4][4];
#pragma unroll
    for (int ks = 0; ks < 4; ++ks)
#pragma unroll
        for (int t = 0; t < 4; ++t) { qf[ks][t] = *(const bf16x8*)(qp + (size_t)(16 * t) * 128 + 32 * ks); kf[ks][t] = *(const bf16x8*)(kp + (size_t)(16 * t) * 128 + 32 * ks); }
#pragma unroll
    for (int i = 0; i < 16; ++i) *(LAS u32x4*)(vb + (4 * i + g) * M2_VSTR + fr * 16) = vr[i];
    f32x4 X[4][4];
#pragma unroll
    for (int a = 0; a < 4; ++a)
#pragma unroll
        for (int b = 0; b < 4; ++b) X[a][b] = (f32x4){0.f, 0.f, 0.f, 0.f};
#pragma unroll
    for (int ks = 0; ks < 4; ++ks)
#pragma unroll
        for (int jt = 0; jt < 4; ++jt)
#pragma unroll
            for (int it = jt; it < 4; ++it) X[jt][it] = MFMA16(kf[ks][jt], qf[ks][it], X[jt][it]);
    bf16x8 PB[4][2];
#pragma unroll
    for (int it = 0; it < 4; ++it)
#pragma unroll
        for (int s2 = 0; s2 < 2; ++s2) {
            float v[8];
#pragma unroll
            for (int e = 0; e < 8; ++e) {
                const int jt = 2 * s2 + (e >> 2);
                float x = 0.f;
                if (jt < it) x = X[jt][it][e & 3];
                else if (jt == it) x = (fr >= 4 * g + (e & 3)) ? X[jt][it][e & 3] : 0.f;
                v[e] = x;
            }
            u32x4 wv; wv.x = cvt_pk_bf16(v[0], v[1]); wv.y = cvt_pk_bf16(v[2], v[3]); wv.z = cvt_pk_bf16(v[4], v[5]); wv.w = cvt_pk_bf16(v[6], v[7]);
            PB[it][s2] = __builtin_bit_cast(bf16x8, wv);
        }
    const bf16_t* sp = ST + (size_t)fr * 128 + 8 * g;
    bf16x8 sa0[2][4];
#pragma unroll
    for (int k2 = 0; k2 < 2; ++k2)
#pragma unroll
        for (int d = 0; d < 4; ++d) sa0[k2][d] = *(const bf16x8*)(sp + (size_t)(16 * d) * 128 + 32 * k2);
    f32x4 O[8][4];
#pragma unroll
    for (int a = 0; a < 8; ++a)
#pragma unroll
        for (int b = 0; b < 4; ++b) O[a][b] = (f32x4){0.f, 0.f, 0.f, 0.f};
#pragma unroll
    for (int s2 = 0; s2 < 2; ++s2)
#pragma unroll
        for (int dh = 0; dh < 2; ++dh) {
            bf16x8 vt[4];
#pragma unroll
            for (int d = 0; d < 4; ++d) { LAS unsigned char* pa = vb + (32 * s2 + 4 * g + r4) * M2_VSTR + 32 * (4 * dh + d) + 8 * c4; vt[d] = tr2(pa, pa + 16 * M2_VSTR); }
#pragma unroll
            for (int it = 2 * s2; it < 4; ++it)
#pragma unroll
                for (int d = 0; d < 4; ++d) O[4 * dh + d][it] = MFMA16(vt[d], PB[it][s2], O[4 * dh + d][it]);
            asm volatile("" ::: "memory");
        }
#pragma unroll
    for (int dh = 0; dh < 2; ++dh)
#pragma unroll
        for (int kp2 = 0; kp2 < 2; ++kp2) {
            bf16x8 qg[2][4], sa[2][4];
#pragma unroll
            for (int k2 = 0; k2 < 2; ++k2) {
#pragma unroll
                for (int t = 0; t < 4; ++t) qg[k2][t] = *(const bf16x8*)(qp + (size_t)(16 * t) * 128 + 32 * (2 * kp2 + k2));
#pragma unroll
                for (int d = 0; d < 4; ++d) sa[k2][d] = (dh == 0 && kp2 == 0) ? sa0[k2][d] : *(const bf16x8*)(sp + (size_t)(16 * (4 * dh + d)) * 128 + 32 * (2 * kp2 + k2));
            }
#pragma unroll
            for (int k2 = 0; k2 < 2; ++k2)
#pragma unroll
                for (int d = 0; d < 4; ++d)
#pragma unroll
                    for (int it = 0; it < 4; ++it) O[4 * dh + d][it] = MFMA16(sa[k2][d], qg[k2][it], O[4 * dh + d][it]);
            asm volatile("" ::: "memory");
        }
    u32x2 gtr[4][8];
#pragma unroll
    for (int it = 0; it < 4; ++it)
#pragma unroll
        for (int d = 0; d < 8; ++d) gtr[it][d] = *(const u32x2*)(GT + pofs(head, r0 + 16 * it + fr) + 4 * g + 16 * d);
    float rs[4];
    LAS float* exch = (LAS float*)(lds + M2_EXCH);
#pragma unroll
    for (int it = 0; it < 4; ++it) {
        float ss = 0.f;
#pragma unroll
        for (int d = 0; d < 8; ++d) ss += (O[d][it][0] * O[d][it][0] + O[d][it][1] * O[d][it][1]) + (O[d][it][2] * O[d][it][2] + O[d][it][3] * O[d][it][3]);
        ss += __shfl_xor(ss, 16); ss += __shfl_xor(ss, 32);
        rs[it] = ss;
        if (mixer && g == 0) exch[(16 * it + fr) * 4 + head] = ss;
    }
    __syncthreads();
#pragma unroll
    for (int it = 0; it < 4; ++it) {
        if (mixer) { const f32x4 e = *(LAS f32x4*)(exch + (16 * it + fr) * 4); rs[it] = 1.0f / sqrtf(((e[0] + e[1]) + (e[2] + e[3])) * (1.0f / 512.0f) + EPS); }
        else rs[it] = 1.0f / sqrtf(rs[it] * (1.0f / 128.0f) + EPS);
    }
#pragma unroll
    for (int it = 0; it < 4; ++it) {
        int rowi = 16 * it + fr; asm volatile("" : "+v"(rowi));
        const size_t row = r0 + rowi;
        bf16_t* mgp = MG + row * DM + mixer * HW + cb + 4 * g;
        const float rsi = rs[it];
#pragma unroll
        for (int d = 0; d < 8; ++d) {
            const f32x4 gn = *(const f32x4*)(gain + 16 * d + 4 * g);
            const u32x2 gt = gtr[it][d];
            const float g0 = silu_f(__uint_as_float(gt.x << 16)), g1 = silu_f(__uint_as_float(gt.x & 0xffff0000u)), g2 = silu_f(__uint_as_float(gt.y << 16)), g3 = silu_f(__uint_as_float(gt.y & 0xffff0000u));
            const f32x4 o = O[d][it] * rsi * gn;
            u32x2 wv; wv.x = cvt_pk_bf16(o[0] * g0, o[1] * g1); wv.y = cvt_pk_bf16(o[2] * g2, o[3] * g3);
            st8b(MG, mgp + 16 * d, wv);
        }
    }
}
__device__ __forceinline__ void phase_normgate_sample(const Args& A, int wave, int lane) {
    unsigned char* ws = A.ws;
    const float* O = A.out + O_Y;
    const bf16_t* GR = (const bf16_t*)(ws + WS_GR); const bf16_t* HGT = (const bf16_t*)(ws + WS_HGT);
    bf16_t* MG = (bf16_t*)(ws + WS_XB);
    const int gw = blockIdx.x * NWAVES + wave, NGW = gridDim.x * NWAVES;
    const bool hg = lane >= 32; const int c0 = lane * 16;
    const float* gain = hg ? A.in[7] + (c0 - HW) : A.in[6] + c0;
    f32x4 gn[4];
#pragma unroll
    for (int j = 0; j < 4; ++j) gn[j] = *(const f32x4*)(gain + 4 * j);
    for (int m = TP + gw; m < TT; m += NGW) {
        const f32x4* orow = (const f32x4*)(O + (size_t)m * DM + c0);
        f32x4 v[4]; float s = 0.f;
#pragma unroll
        for (int j = 0; j < 4; ++j) { v[j] = orow[j]; s += (v[j][0] * v[j][0] + v[j][1] * v[j][1]) + (v[j][2] * v[j][2] + v[j][3] * v[j][3]); }
        s += __shfl_xor(s, 1); s += __shfl_xor(s, 2); s += __shfl_xor(s, 4);
        float s2 = s; s2 += __shfl_xor(s2, 8); s2 += __shfl_xor(s2, 16);
        const float rs = hg ? 1.0f / sqrtf(s2 * (1.0f / 512.0f) + EPS) : 1.0f / sqrtf(s * (1.0f / 128.0f) + EPS);
        const bf16_t* gp = (hg ? HGT + pofs((c0 - HW) >> 7, m) + ((c0 - HW) & 127) : GR + pofs(c0 >> 7, m) + (c0 & 127));
        const u32x4 ga = *(const u32x4*)gp, gb = *(const u32x4*)(gp + 8);
        const unsigned gw_[8] = {ga.x, ga.y, ga.z, ga.w, gb.x, gb.y, gb.z, gb.w};
        float o[16];
#pragma unroll
        for (int i = 0; i < 8; ++i) { const float g0 = silu_f(__uint_as_float(gw_[i] << 16)), g1 = silu_f(__uint_as_float(gw_[i] & 0xffff0000u));
            o[2 * i] = v[(2 * i) >> 2][(2 * i) & 3] * rs * gn[(2 * i) >> 2][(2 * i) & 3] * g0; o[2 * i + 1] = v[(2 * i + 1) >> 2][(2 * i + 1) & 3] * rs * gn[(2 * i + 1) >> 2][(2 * i + 1) & 3] * g1; }
        u32x4 w0, w1;
        w0.x = cvt_pk_bf16(o[0], o[1]); w0.y = cvt_pk_bf16(o[2], o[3]); w0.z = cvt_pk_bf16(o[4], o[5]); w0.w = cvt_pk_bf16(o[6], o[7]);
        w1.x = cvt_pk_bf16(o[8], o[9]); w1.y = cvt_pk_bf16(o[10], o[11]); w1.z = cvt_pk_bf16(o[12], o[13]); w1.w = cvt_pk_bf16(o[14], o[15]);
        bf16_t* mp = MG + (size_t)m * DM + c0;
        *(u32x4*)mp = w0; *(u32x4*)(mp + 8) = w1;
    }
}
__device__ __forceinline__ void phase_m2(const Args& A, LAS unsigned char* lds, int w, int lane) {
    const int G = gridDim.x;
    const int vcu = (G % 8 == 0) ? (int)(blockIdx.x % 8) * (G / 8) + (int)(blockIdx.x / 8) : (int)blockIdx.x;
    for (int it = vcu; it < 256; it += G) { m2_item(A, it >> 6, it & 63, lds, w, lane); __syncthreads(); }
    phase_normgate_sample(A, w, lane);
}
__device__ __forceinline__ void phase_final(const Args& A, int wave, int lane) {
    const float* SS3 = (const float*)(A.ws + WS_SS3);
    const int gw = blockIdx.x * NWAVES + wave, NGW = gridDim.x * NWAVES;
    f32x4 gn[4];
#pragma unroll
    for (int j = 0; j < 4; ++j) gn[j] = ((const f32x4*)A.in[16])[lane + 64 * j];
    for (int m = gw; m < TP; m += NGW) {
        float p = lane < 16 ? SS3[(size_t)m * 16 + lane] : 0.f;
        p = wave_sum(p);
        const float rs = 1.0f / sqrtf(p * (1.0f / DM) + EPS);
        f32x4* xr = (f32x4*)(A.out + O_Y + (size_t)m * DM) + lane;
#pragma unroll
        for (int j = 0; j < 4; ++j) { f32x4 v = xr[64 * j]; v = v * rs * gn[j]; xr[64 * j] = v; }
    }
}

__global__ void __launch_bounds__(NTHREADS, 2) fwd_kernel(Args args) {
    extern __shared__ __attribute__((aligned(16))) unsigned char lds_raw[];
    LAS unsigned char* lds = (LAS unsigned char*)lds_raw;
    const int tid = threadIdx.x, wave = __builtin_amdgcn_readfirstlane(tid >> 6);
    volatile LAS unsigned* MISC = (volatile LAS unsigned*)(lds + MISC_OFF);
    if (tid < 64) MISC[tid] = 0u;
    __syncthreads();
    unsigned char* ws = args.ws;
    XcdBarrier bar; bar.bar = (unsigned*)(ws + WS_CTL); bar.x = 0; bar.st = nullptr;
    if (N_LAUNCHES == 1) bar = xcd_barrier_post((unsigned*)(ws + WS_CTL), MISC + 8);
    const int lo = args.ph_lo, hi = args.ph_hi;
#define IN(k) (lo <= (k) && (k) < hi)
#define SEAM(k) do { if (IN(k) && IN((k) + 1)) { xcd_barrier(bar); if (PROBE & 256) xcd_barrier(bar); } } while (0)
    const int G = gridDim.x, c = blockIdx.x;

    if (IN(0)) { phase_prep(args, lds, wave, fresh_lane()); if (PROBE & 64) { __syncthreads(); phase_prep(args, lds, wave, fresh_lane()); } } SEAM(0);
    if (IN(1)) {
        pg8::Gemm g{(const bf16_t*)(ws + WS_XB), (const bf16_t*)(ws + WS_WIN), DM}; pg8::StaticOrder S; S.init(64, 16, G, c);
        EpiIn E{ws + WS_PROJ, (float*)(ws + WS_DEC), (float*)(ws + WS_HGFS), (const f32x4*)(ws + WS_ROPE), (const float*)(ws + WS_LB)};
        pg8::gemm_phase<EpiIn, false>(lds, g, S, E);
        pg8::sample_gemm<EpiIn>(lds, g.A + (size_t)TP * DM, g.Bt, DM, 16, 64, E, c, G);
        if (PROBE & 1) pg8::sample_gemm<EpiIn>(lds, g.A + (size_t)TP * DM, g.Bt, DM, 16, 64, E, c, G);
        if (PROBE & 2) { pg8::gemm_phase<EpiIn, false>(lds, g, S, E); }
    } SEAM(1);
    if (IN(2)) { phase_m1(args, lds, wave, fresh_lane()); if (PROBE & (16 | 4096 | 8192)) { __syncthreads(); phase_m1(args, lds, wave, fresh_lane(), true); } } SEAM(2);
    if (IN(3)) { phase_m2(args, lds, wave, fresh_lane()); if (PROBE & 32) { __syncthreads(); phase_m2(args, lds, wave, fresh_lane()); } } SEAM(3);
    if (IN(4)) {
        { bf16_t* X1B = (bf16_t*)(ws + WS_X1B); const int gt = c * NTHREADS + tid;
          if (gt < 4 * 256) { const int b = gt >> 8, w = gt & 255; ((u32x4*)(X1B + (size_t)(4098 * b) * DM))[w] = (u32x4){0u, 0u, 0u, 0u}; } }
        pg8::Gemm g{(const bf16_t*)(ws + WS_XB), (const bf16_t*)(ws + WS_WOUT), DM}; pg8::StaticOrder S; S.init(64, 4, G, c);
        EpiOut E{args.in[0], args.in[1], args.out + O_Y, (bf16_t*)(ws + WS_X1B), (float*)(ws + WS_SS2)};
        pg8::gemm_phase<EpiOut, false>(lds, g, S, E);
        pg8::sample_gemm16<EpiOut>(lds, g.A + (size_t)TP * DM, g.Bt, DM, 4, 64, E, c, G);
        if (PROBE & 1) pg8::sample_gemm<EpiOut>(lds, g.A + (size_t)TP * DM, g.Bt, DM, 4, 64, E, c, G);
        if (PROBE & 4) { pg8::gemm_phase<EpiOut, false>(lds, g, S, E); }
    } SEAM(4);
    if (IN(5)) {
        pg8::Gemm g{(const bf16_t*)(ws + WS_X1B), (const bf16_t*)(ws + WS_WUP), DM}; pg8::StaticOrder S; S.init(68, 22, G, c);
        EpiUp E{(const float*)(ws + WS_SS2), args.in[13], args.in[14], args.in[4], (bf16_t*)(ws + WS_ACT), args.out + O_CCP, args.out + O_CCS};
        EpiUpMain EM{E.SS2, E.ck, E.cb, E.cache_in, E.ACT, E.ccp, E.ccs};
        pg8::gemm_phase<EpiUpMain, true>(lds, g, S, EM);
        {
            const int njobs = 22 * 16, rem = (68 * 22) % G, nidle = rem ? G - rem : 0, pre = (nidle >= 32 && 3 * nidle < njobs) ? 3 * nidle : 0;
            if (pre && c >= rem) pg8::sample_gemm<EpiUp>(lds, g.A + (size_t)16394 * DM, g.Bt, DM, 22, 68, E, c - rem, nidle, pre);
            pg8::sample_gemm<EpiUp>(lds, g.A + (size_t)16394 * DM, g.Bt, DM, 22, 68, E, pre + c, G, njobs);
        }
        if (PROBE & 8) { pg8::gemm_phase<EpiUpMain, true>(lds, g, S, EM); }
    } SEAM(5);
    if (IN(6)) {
        pg8::Gemm g{(const bf16_t*)(ws + WS_ACT), (const bf16_t*)(ws + WS_WD), DFF}; pg8::StaticOrder S; S.init(64, 4, G, c);
        EpiDownT<true> E{args.out + O_Y, (const bf16_t*)(ws + WS_X1B), (float*)(ws + WS_SS3), args.in[16], (float*)(ws + WS_SS3), (unsigned*)(ws + WS_CTL + 32768), lds + RING_BYTES};
        EpiDownT<false> Es{args.out + O_Y, (const bf16_t*)(ws + WS_X1B), (float*)(ws + WS_SS3), args.in[16], nullptr, (unsigned*)(ws + WS_CTL + 32768), lds};
        if (PROBE & 2048) { EpiNull En; pg8::gemm_phase<EpiNull, false>(lds, g, S, En); }
        if (G == 256) pg8::gemm_phase<EpiDownT<true>, false>(lds, g, S, E);
        else pg8::gemm_phase<EpiDownT<false>, false>(lds, g, S, Es);
        pg8::sample_gemm16<EpiDownT<false>>(lds, g.A + (size_t)TP * DFF, g.Bt, DFF, 4, 64, Es, c, G);
    }
    if (G != 256) {
        SEAM(6);
        if (IN(7)) { phase_final(args, wave, fresh_lane()); }
    }
#undef IN
#undef SEAM
}

extern "C" void kernel_launch(void* const* d_in, const int* in_sizes, int n_in, void* d_out, int out_size, void* d_ws, size_t ws_size, hipStream_t stream) {
    static int grid = 0;
    if (grid == 0) {
        if (n_in != 17 || ws_size < WS_END) { fprintf(stderr, "kernel_launch: unexpected n_in %d or ws_size %zu (need %zu)\n", n_in, ws_size, (size_t)WS_END); grid = -1; return; }
        int dev = 0, cus = 0, per_cu = 0;
        hipGetDevice(&dev); hipDeviceGetAttribute(&cus, hipDeviceAttributeMultiprocessorCount, dev);
        hipFuncSetAttribute((const void*)fwd_kernel, hipFuncAttributeMaxDynamicSharedMemorySize, LDS_BYTES);
        hipOccupancyMaxActiveBlocksPerMultiprocessor(&per_cu, (const void*)fwd_kernel, NTHREADS, LDS_BYTES);
        if (per_cu < 1) { fprintf(stderr, "kernel_launch: occupancy query says %d blocks per CU\n", per_cu); per_cu = 1; }
        (void)hipGetLastError();
        grid = cus;
        if (grid > 256) grid = 256;
        fprintf(stderr, "kernel_launch: cus %d per_cu %d grid %d ws %zu\n", cus, per_cu, grid, ws_size);
    }
    if (grid < 0) return;
    hipMemsetAsync((char*)d_ws + WS_CTL, 0, 65536, stream);
    Args a{};
    for (int i = 0; i < 17; ++i) a.in[i] = (const float*)d_in[i];
    a.out = (float*)d_out; a.ws = (unsigned char*)d_ws;
    if (N_LAUNCHES == 1) {
        a.ph_lo = 0; a.ph_hi = 8;
        void* kargs[] = {&a};
#if PROBE & 1024
        hipLaunchKernelGGL(fwd_kernel, dim3(grid), dim3(NTHREADS), LDS_BYTES, stream, a); hipError_t e = hipSuccess; (void)kargs;
#else
        hipError_t e = hipLaunchCooperativeKernel((const void*)fwd_kernel, dim3(grid), dim3(NTHREADS), kargs, LDS_BYTES, stream);
#endif
        if (e != hipSuccess) fprintf(stderr, "cooperative launch failed: %s (grid %d)\n", hipGetErrorString(e), grid);
    } else {
        for (int p = 0; p < 8; ++p) { a.ph_lo = p; a.ph_hi = p + 1; hipLaunchKernelGGL(fwd_kernel, dim3(grid), dim3(NTHREADS), LDS_BYTES, stream, a); }
    }
}
```

```cpp
#include <hip/hip_runtime.h>
#include <cstdio>
#include <cstdint>
#include <type_traits>

#ifndef PROBE
#define PROBE 0
#endif
#ifndef N_LAUNCHES
#define N_LAUNCHES 1
#endif

#define LAS __attribute__((address_space(3)))
typedef unsigned short bf16_t;
typedef short bf16x8 __attribute__((ext_vector_type(8)));
typedef float f32x4 __attribute__((ext_vector_type(4)));
typedef float f32x2 __attribute__((ext_vector_type(2)));
typedef unsigned u32x4 __attribute__((ext_vector_type(4)));
typedef unsigned u32x2 __attribute__((ext_vector_type(2)));

constexpr int DM = 1024, TP = 16384, TS = 256, TT = TP + TS, SEQ = 4096;
constexpr int DFF = 2816, UPC = 5632, INC = 4096, HW = 512;
constexpr float EPS = 1e-6f;
constexpr int NTHREADS = 512, NWAVES = 8;
constexpr int LDS_BYTES = 163840;
constexpr int RING_BYTES = 131072;
constexpr int MISC_OFF = LDS_BYTES - 256;

constexpr size_t O_Y = 0, O_RETP = 17039360, O_HGP = 17301504, O_CCP = 17563648, O_RETS = 17586176, O_HGS = 18634752, O_CCS = 19683328;

constexpr size_t WS_CTL = 0;
constexpr size_t WS_WIN = 65536;
constexpr size_t WS_WOUT = WS_WIN + (size_t)INC * DM * 2;
constexpr size_t WS_WUP = WS_WOUT + (size_t)DM * DM * 2;
constexpr size_t WS_WD = WS_WUP + (size_t)UPC * DM * 2;
constexpr size_t WS_ROPE = WS_WD + (size_t)DM * DFF * 2;
constexpr size_t WS_LB = WS_ROPE + (size_t)SEQ * 64 * 8;
constexpr size_t WS_SS2 = WS_LB + 4096;
constexpr size_t WS_SS3 = WS_SS2 + (size_t)TT * 16 * 4;
constexpr size_t WS_XB = WS_SS3 + (size_t)TT * 16 * 4;
constexpr size_t WS_PROJ = WS_XB + (size_t)TT * DM * 2;
constexpr size_t PSZ = (size_t)TT * HW * 2;
constexpr size_t WS_QR = WS_PROJ, WS_KR = WS_PROJ + PSZ, WS_VR = WS_PROJ + 2 * PSZ, WS_GR = WS_PROJ + 3 * PSZ, WS_HQ = WS_PROJ + 4 * PSZ,
                 WS_HK = WS_PROJ + 5 * PSZ, WS_HI = WS_PROJ + 6 * PSZ, WS_HGT = WS_PROJ + 7 * PSZ;
constexpr size_t WS_DEC = WS_PROJ + 8 * PSZ;
constexpr size_t WS_HGFS = WS_DEC + (size_t)256 * HW * 4;
constexpr size_t WS_PROJ_END = WS_HGFS + (size_t)TS * HW * 4;
constexpr int X1B_ROWS = 16896;
constexpr size_t WS_X1B = WS_PROJ;
constexpr size_t WS_ACT = WS_X1B + (size_t)X1B_ROWS * DM * 2;
constexpr size_t WS_ACT_END = WS_ACT + (size_t)TT * DFF * 2;
static_assert(WS_ACT_END <= WS_PROJ_END, "overlay");
constexpr size_t WS_END = WS_PROJ_END;
static_assert(WS_END <= (size_t)256 * 1024 * 1024, "workspace");

__device__ __forceinline__ size_t pofs(int head, size_t row) { return ((size_t)head * TT + row) * 128; }
__device__ __forceinline__ unsigned cvt_pk_bf16(float lo, float hi) { unsigned r; asm volatile("v_cvt_pk_bf16_f32 %0, %1, %2" : "=v"(r) : "v"(lo), "v"(hi)); return r; }
__device__ __forceinline__ int fresh_lane() { int l; asm volatile("v_mbcnt_lo_u32_b32 %0, -1, 0\n\tv_mbcnt_hi_u32_b32 %0, -1, %0" : "=v"(l)); return l; }
__device__ __forceinline__ float bf2f(unsigned short b) { return __uint_as_float(((unsigned)b) << 16); }
__device__ __forceinline__ float sigmoid_f(float x) { return __builtin_amdgcn_rcpf(1.0f + __builtin_amdgcn_exp2f(x * -1.4426950408889634f)); }
__device__ __forceinline__ float silu_f(float x) { return x * sigmoid_f(x); }
#ifndef WT_STORES
#define WT_STORES 0
#endif
__device__ __forceinline__ void st16b(const void* base, void* p, u32x4 v) {
#if WT_STORES == 3
    __builtin_amdgcn_raw_buffer_store_b128(v, __builtin_amdgcn_make_buffer_rsrc((void*)base, 0, 0x7fffffff, 0x00020000), (int)((const char*)p - (const char*)base), 0, 16);
#else
    *(u32x4*)p = v;
#endif
}
__device__ __forceinline__ void st8b(const void* base, void* p, u32x2 v) {
#if WT_STORES == 3
    __builtin_amdgcn_raw_buffer_store_b64(v, __builtin_amdgcn_make_buffer_rsrc((void*)base, 0, 0x7fffffff, 0x00020000), (int)((const char*)p - (const char*)base), 0, 16);
#else
    *(u32x2*)p = v;
#endif
}
__device__ __forceinline__ void st16(void* p, u32x4 v) {
#if WT_STORES == 1
    asm volatile("global_store_dwordx4 %0, %1, off sc1\n\ts_nop 1" :: "v"(p), "v"(v) : "memory");
#elif WT_STORES == 2
    __builtin_nontemporal_store(v, (u32x4*)p);
#else
    *(u32x4*)p = v;
#endif
}
__device__ __forceinline__ void st8(void* p, u32x2 v) {
#if WT_STORES == 1
    asm volatile("global_store_dwordx2 %0, %1, off sc1\n\ts_nop 1" :: "v"(p), "v"(v) : "memory");
#elif WT_STORES == 2
    __builtin_nontemporal_store(v, (u32x2*)p);
#else
    *(u32x2*)p = v;
#endif
}
__device__ __forceinline__ void st16wt(void* p, f32x4 v) { asm volatile("global_store_dwordx4 %0, %1, off sc1\n\ts_nop 1" :: "v"(p), "v"(v) : "memory"); }
__device__ __forceinline__ void st4wt(void* p, float v) { asm volatile("global_store_dword %0, %1, off sc1\n\ts_nop 1" :: "v"(p), "v"(v) : "memory"); }
template <int CTRL> __device__ __forceinline__ float dpp_z(float src) {
    return __builtin_bit_cast(float, __builtin_amdgcn_update_dpp(0, __builtin_bit_cast(int, src), CTRL, 0xF, 0xF, true)); }
template <int CTRL> __device__ __forceinline__ float dpp_f(float oldv, float src) {
    return __builtin_bit_cast(float, __builtin_amdgcn_update_dpp(__builtin_bit_cast(int, oldv), __builtin_bit_cast(int, src), CTRL, 0xF, 0xF, false)); }

#define XB_TMO      128
#define XB_XCNT(j)  (256  + 64 * (j))
#define XB_XSUB(j)  (1280 + 64 * (j))
#define XB_XGEN(j)  (2304 + 64 * (j))
#define XB_TOP      3328
#define XB_TOPGEN   3392
#define XCD_BAR_WORDS 3456
#define XB_SPIN_CAP (1u << 18)
__device__ __forceinline__ unsigned xb_ld(unsigned* p)              { return __hip_atomic_load(p, __ATOMIC_RELAXED, __HIP_MEMORY_SCOPE_AGENT); }
__device__ __forceinline__ unsigned xb_add(unsigned* p, unsigned v) { return __hip_atomic_fetch_add(p, v, __ATOMIC_RELAXED, __HIP_MEMORY_SCOPE_AGENT); }
__device__ __forceinline__ unsigned xb_xcc_id() { return (unsigned)__builtin_amdgcn_s_getreg((3 << 11) | 20) & 0xFu; }
#define XB_SPIN(cond, bar) do { unsigned _sp = 0; while (cond) { __builtin_amdgcn_s_sleep(1); \
    if ((++_sp & 255u) == 0u) { if (xb_ld(&(bar)[XB_TMO])) break; if (_sp > XB_SPIN_CAP) { atomicAdd(&(bar)[XB_TMO], 1u); break; } } } } while (0)
struct XcdBarrier { unsigned* bar; unsigned x; volatile LAS unsigned* st; };
__device__ __forceinline__ XcdBarrier xcd_barrier_post(unsigned* bar, volatile LAS unsigned* st) {
    XcdBarrier b; b.bar = bar; b.x = xb_xcc_id(); b.st = st;
    if (threadIdx.x == 0) (void)xb_add(&bar[XB_XCNT(b.x)], 1u);
    return b;
}
__device__ __forceinline__ void xcd_barrier_complete(unsigned* bar, unsigned x, unsigned& nloc, unsigned& nx) {
    const unsigned G = gridDim.x * gridDim.y * gridDim.z;
    unsigned sum, cnt, mine, sp = 0u;
    for (;;) {
        sum = 0u; cnt = 0u; mine = 0u;
#pragma unroll
        for (unsigned j = 0; j < 16; ++j) { const unsigned c = xb_ld(&bar[XB_XCNT(j)]); sum += c; cnt += (c > 0u) ? 1u : 0u; mine = (j == x) ? c : mine; }
        if (sum == G) break;
        __builtin_amdgcn_s_sleep(1);
        if ((++sp & 255u) == 0u) { if (xb_ld(&bar[XB_TMO])) break; if (sp > XB_SPIN_CAP) { atomicAdd(&bar[XB_TMO], 1u); break; } }
    }
    nloc = mine > 0u ? mine : 1u; nx = cnt > 0u ? cnt : 1u;
}
__device__ __forceinline__ void xcd_barrier(const XcdBarrier& b) {
    asm volatile("s_waitcnt vmcnt(0)" ::: "memory");
    __syncthreads();
    if (threadIdx.x == 0) {
        unsigned* bar = b.bar;
        __builtin_amdgcn_s_waitcnt(0);
        unsigned nloc = b.st[0], nx = b.st[1];
        if (nloc == 0u) { xcd_barrier_complete(bar, b.x, nloc, nx); b.st[0] = nloc; b.st[1] = nx; }
        const unsigned old = xb_add(&bar[XB_XSUB(b.x)], 1u);
        const unsigned gen = old / nloc;
        if (old + 1u == (gen + 1u) * nloc) {
            __builtin_amdgcn_fence(__ATOMIC_RELEASE, "agent");
            asm volatile("s_waitcnt vmcnt(0)" ::: "memory");
            const unsigned og = xb_add(&bar[XB_TOP], 1u);
            const unsigned tg = og / nx;
            if (og + 1u == (tg + 1u) * nx) xb_add(&bar[XB_TOPGEN], 1u);
            else XB_SPIN(xb_ld(&bar[XB_TOPGEN]) == tg, bar);
            __builtin_amdgcn_fence(__ATOMIC_ACQUIRE, "agent");
            xb_add(&bar[XB_XGEN(b.x)], 1u);
            asm volatile("s_waitcnt vmcnt(0)" ::: "memory");
        } else {
            XB_SPIN(xb_ld(&bar[XB_XGEN(b.x)]) == gen, bar);
            __builtin_amdgcn_fence(__ATOMIC_ACQUIRE, "agent");
            asm volatile("s_waitcnt vmcnt(0)" ::: "memory");
        }
    }
    __syncthreads();
}

namespace pg8 {
constexpr int BM = 256, BK = 64, HALF = 128, HTB = HALF * BK * 2, NXCD = 8, WGM = 8;
__host__ __device__ __forceinline__ int lds_byte(int r, int c) { const int st = (r >> 4) * 2 + (c >> 5), rr = r & 15, cc = c & 31, ob = rr * 64 + cc * 2; return st * 1024 + (ob ^ (((ob >> 9) & 1) << 5)); }
__host__ __device__ __forceinline__ void stage_rc(int b, int& R, int& C) { const int st = b / 1024, sb = b % 1024, swz = sb ^ (((sb >> 9) & 1) << 5); R = (st >> 1) * 16 + swz / 64; C = (st & 1) * 32 + (swz % 64) / 2; }
__host__ __device__ __forceinline__ int perm32(int rho) { const int n = rho >> 4, i = rho & 15; return 8 * (i >> 2) + 4 * n + (i & 3); }

struct Unit { int pm, pn; };
struct Gemm { const bf16_t* A; const bf16_t* Bt; int K; };

struct StaticOrder {
    int nM, nN, nwg, G, c;
    __device__ void init(int nM_, int nN_, int G_, int c_) { nM = nM_; nN = nN_; nwg = nM * nN; G = G_; c = c_; }
    __device__ bool next(int i, Unit& u) const {
        const long L = (long)i * G + c; if (L >= nwg) return false;
        int wgid = (int)L; { const int q = nwg / NXCD, r = nwg % NXCD, xcd = wgid % NXCD, off = wgid / NXCD; wgid = (xcd < r ? xcd * (q + 1) : r * (q + 1) + (xcd - r) * q) + off; }
        const int nig = WGM * nN, gid = wgid / nig, fm = gid * WGM, gsz = (nM - fm) < WGM ? (nM - fm) : WGM;
        u.pm = fm + ((wgid % nig) % gsz); u.pn = (wgid % nig) / gsz; return true;
    }
};

struct AInfo { const char* base; size_t hstep; unsigned v0, v1; };
template <bool UPMAP, bool TOK = false>
__device__ __forceinline__ AInfo a_info(const Gemm& g, const Unit& u, int tid) {
    AInfo a; const int K = g.K;
    int R0, C0, R1, C1; stage_rc(tid * 16, R0, C0); stage_rc(tid * 16 + 8192, R1, C1);
    if constexpr (!UPMAP && TOK) {
        R0 = (R0 & 64) | ((R0 & 15) << 2) | ((R0 >> 4) & 3); R1 = (R1 & 64) | ((R1 & 15) << 2) | ((R1 >> 4) & 3);
    }
    if constexpr (!UPMAP) {
        a.base = (const char*)g.A + (size_t)u.pm * 256 * K * 2; a.hstep = (size_t)HALF * K * 2;
        a.v0 = (unsigned)(R0 * K + C0) * 2u; a.v1 = (unsigned)(R1 * K + C1) * 2u;
    } else {
        if (u.pm < 68) {
            const int b = u.pm / 17, j = u.pm % 17;
            a.base = (const char*)g.A + (size_t)(4098 * b + 248 * j) * K * 2; a.hstep = (size_t)124 * K * 2;
            const int P0 = (R0 & 64) | ((R0 & 15) << 2) | ((R0 >> 4) & 3), P1 = (R1 & 64) | ((R1 & 15) << 2) | ((R1 >> 4) & 3);
            a.v0 = (unsigned)((P0 - 2 * (P0 >> 6)) * K + C0) * 2u; a.v1 = (unsigned)((P1 - 2 * (P1 >> 6)) * K + C1) * 2u;
        } else {
            const int P0 = (R0 & 64) | ((R0 & 15) << 2) | ((R0 >> 4) & 3), P1 = (R1 & 64) | ((R1 & 15) << 2) | ((R1 >> 4) & 3);
            a.base = (const char*)g.A + (size_t)16394 * K * 2; a.hstep = (size_t)HALF * K * 2;
            a.v0 = (unsigned)(P0 * K + C0) * 2u; a.v1 = (unsigned)(P1 * K + C1) * 2u;
        }
    }
    return a;
}

template <class Epi, bool UPMAP>
__device__ __forceinline__ void gemm_phase(LAS unsigned char* lds, const Gemm g, const StaticOrder& S, const Epi& E) {
    const int tid = threadIdx.x, wid = __builtin_amdgcn_readfirstlane(tid >> 6), lane = tid & 63, wr = wid >> 2, wc = wid & 3, fr = lane & 15, fq = lane >> 4;
    const int K = g.K, nt = K / BK;
    unsigned voffB[2];
#pragma unroll
    for (int i = 0; i < 2; ++i) { int R, C; stage_rc(tid * 16 + i * 8192, R, C); const int Rb = (R & ~31) + perm32(R & 31); voffB[i] = (unsigned)(Rb * K + C) * 2u; }
    const size_t kstep = (size_t)(BK * 2);
    const size_t hstepB = (size_t)HALF * K * 2;
    const size_t tstepB = 2 * hstepB;
    const unsigned ldsw = (unsigned)wid * 1024u;
    const int aoff = lds_byte(wr * 64 + fr, fq * 8), boff = lds_byte(wc * 32 + fr, fq * 8);
#define PG8_SA(b, h) (((b) * 2 + (h)) * HTB)
#define PG8_SB(b, h) ((4 + (b) * 2 + (h)) * HTB)
#define PG8_STAGEB(bufoff, gbase) do { _Pragma("unroll") for (int _i = 0; _i < 2; ++_i) \
        __builtin_amdgcn_global_load_lds((const unsigned*)((const char*)(gbase) + voffB[_i]), (LAS unsigned*)(lds + (bufoff) + ldsw + _i * 8192), 16, 0, 0); } while (0)
#define PG8_STAGEA(bufoff, gbase, va0, va1) do { \
        __builtin_amdgcn_global_load_lds((const unsigned*)((const char*)(gbase) + (va0)), (LAS unsigned*)(lds + (bufoff) + ldsw), 16, 0, 0); \
        __builtin_amdgcn_global_load_lds((const unsigned*)((const char*)(gbase) + (va1)), (LAS unsigned*)(lds + (bufoff) + ldsw + 8192), 16, 0, 0); } while (0)
#define PG8_LDA(dst, b, h) do { _Pragma("unroll") for (int m = 0; m < 4; ++m) _Pragma("unroll") for (int k = 0; k < 2; ++k) dst[m][k] = *(const LAS bf16x8*)(lds + PG8_SA(b, h) + aoff + m * 2048 + k * 1024); } while (0)
#define PG8_LDB(dst, b, h) do { _Pragma("unroll") for (int n = 0; n < 2; ++n) _Pragma("unroll") for (int k = 0; k < 2; ++k) dst[n][k] = *(const LAS bf16x8*)(lds + PG8_SB(b, h) + boff + n * 2048 + k * 1024); } while (0)
#define PG8_MMA(ai, bj, At, Bt) do { __builtin_amdgcn_s_setprio(1); _Pragma("unroll") for (int m = 0; m < 4; ++m) _Pragma("unroll") for (int n = 0; n < 2; ++n) _Pragma("unroll") for (int k = 0; k < 2; ++k) \
        acc[ai][bj][m][n] = __builtin_amdgcn_mfma_f32_16x16x32_bf16(Bt[n][k], At[m][k], acc[ai][bj][m][n], 0, 0, 0); __builtin_amdgcn_s_setprio(0); } while (0)
#define PG8_WAIT_V(n) asm volatile("s_waitcnt vmcnt(" #n ")" ::: "memory")
#define PG8_WAIT_L(n) asm volatile("s_waitcnt lgkmcnt(" #n ")" ::: "memory")
#define PG8_BAR __builtin_amdgcn_s_barrier()
#define PG8_SCHED __builtin_amdgcn_sched_barrier(0)
    Unit cur, nxt; int ui = 0;
    if (!S.next(0, cur)) return;
    f32x4 acc[2][2][4][2];
#pragma unroll
    for (int a = 0; a < 2; ++a)
#pragma unroll
        for (int b = 0; b < 2; ++b)
#pragma unroll
            for (int m = 0; m < 4; ++m)
#pragma unroll
                for (int n = 0; n < 2; ++n) acc[a][b][m][n] = (f32x4){0.f, 0.f, 0.f, 0.f};
    bf16x8 At[4][2], B0[2][2], B1[2][2];
    AInfo ca = a_info<UPMAP, Epi::TOK>(g, cur, tid);
    const char* cA = ca.base; const char* cB = (const char*)g.Bt + (size_t)cur.pn * tstepB;
    PG8_STAGEB(PG8_SB(0, 0), cB); PG8_STAGEB(PG8_SB(0, 1), cB + hstepB); PG8_STAGEA(PG8_SA(0, 0), cA, ca.v0, ca.v1); PG8_STAGEA(PG8_SA(0, 1), cA + ca.hstep, ca.v0, ca.v1);
    if (wr == 1) PG8_BAR;
    PG8_WAIT_V(2); PG8_BAR;
    PG8_STAGEB(PG8_SB(1, 0), cB + kstep); PG8_STAGEA(PG8_SA(1, 0), cA + kstep, ca.v0, ca.v1); PG8_STAGEB(PG8_SB(1, 1), cB + hstepB + kstep);
    PG8_WAIT_V(6); PG8_BAR;
    for (;;) {
        const bool has_next = S.next(ui + 1, nxt);
        AInfo na = ca; if (has_next) na = a_info<UPMAP, Epi::TOK>(g, nxt, tid);
        const char* nA = na.base; const char* nB = has_next ? (const char*)g.Bt + (size_t)nxt.pn * tstepB : cB;
        for (int t = 0; t < nt; t += 2) {
            const bool last = (t == nt - 2);
            const char* a1 = cA + (size_t)(t + 1) * kstep;
            const char* a2 = last ? nA : cA + (size_t)(t + 2) * kstep; const char* b2 = last ? nB : cB + (size_t)(t + 2) * kstep;
            const char* a3 = a2 + kstep; const char* b3 = b2 + kstep;
            const size_t h2 = last ? na.hstep : ca.hstep; const unsigned w0 = last ? na.v0 : ca.v0, w1 = last ? na.v1 : ca.v1;
            PG8_LDB(B0, 0, 0); PG8_LDB(B1, 0, 1); PG8_SCHED; PG8_LDA(At, 0, 0); PG8_STAGEA(PG8_SA(1, 1), a1 + ca.hstep, ca.v0, ca.v1);
            PG8_WAIT_V(8); PG8_WAIT_L(0); PG8_BAR; PG8_MMA(0, 0, At, B0); PG8_MMA(0, 1, At, B1); PG8_BAR; PG8_SCHED;
            PG8_LDA(At, 0, 1); PG8_STAGEB(PG8_SB(0, 0), b2); PG8_STAGEB(PG8_SB(0, 1), b2 + hstepB); PG8_STAGEA(PG8_SA(0, 0), a2, w0, w1);
            PG8_WAIT_V(8); PG8_WAIT_L(0); PG8_BAR; PG8_MMA(1, 0, At, B0); PG8_MMA(1, 1, At, B1); PG8_BAR; PG8_SCHED;
            PG8_LDB(B0, 1, 0); PG8_LDB(B1, 1, 1); PG8_SCHED; PG8_LDA(At, 1, 0); PG8_STAGEA(PG8_SA(0, 1), a2 + h2, w0, w1);
            PG8_WAIT_V(8); PG8_WAIT_L(0); PG8_BAR; PG8_MMA(0, 0, At, B0); PG8_MMA(0, 1, At, B1); PG8_BAR; PG8_SCHED;
            PG8_LDA(At, 1, 1); PG8_STAGEB(PG8_SB(1, 0), b3); PG8_STAGEB(PG8_SB(1, 1), b3 + hstepB); PG8_STAGEA(PG8_SA(1, 0), a3, w0, w1);
            PG8_WAIT_V(8); PG8_WAIT_L(0); PG8_BAR; PG8_MMA(1, 0, At, B0); PG8_MMA(1, 1, At, B1); PG8_BAR; PG8_SCHED;
        }
        if (wr == 0) PG8_BAR;
        E(acc, cur, wr, wc, fr, fq);
        if constexpr ((PROBE & 512) && Epi::IDEM) E(acc, cur, wr, wc, fr, fq);
        if (!has_next) break;
#pragma unroll
        for (int a = 0; a < 2; ++a)
#pragma unroll
            for (int b = 0; b < 2; ++b)
#pragma unroll
                for (int m = 0; m < 4; ++m)
#pragma unroll
                    for (int n = 0; n < 2; ++n) acc[a][b][m][n] = (f32x4){0.f, 0.f, 0.f, 0.f};
        cur = nxt; ca = na; cA = nA; cB = nB; ++ui;
        if (wr == 1) PG8_BAR;
    }
    PG8_WAIT_V(0);
    PG8_BAR;
#undef PG8_SA
#undef PG8_SB
#undef PG8_STAGEA
#undef PG8_STAGEB
#undef PG8_LDA
#undef PG8_LDB
#undef PG8_MMA
#undef PG8_WAIT_V
#undef PG8_WAIT_L
#undef PG8_BAR
#undef PG8_SCHED
}

template <class Epi, class = void> struct S64Pre { struct type {}; static constexpr bool on = false; };
template <class Epi> struct S64Pre<Epi, typename std::enable_if<Epi::S64>::type> { using type = typename Epi::PreS; static constexpr bool on = true; };
template <class Epi>
__device__ __forceinline__ void sample_gemm(LAS unsigned char* lds, const bf16_t* Arows, const bf16_t* Bt, const int K, const int nN, const int pm_unit, const Epi& E, const int job0, const int jstride, const int jend = 1 << 30) {
    const int tid = threadIdx.x, w = __builtin_amdgcn_readfirstlane(tid >> 6);
    int lane = tid & 63; asm volatile("" : "+v"(lane));
    const int fr = lane & 15, fq = lane >> 4;
    const int per = K / 256;
#pragma unroll 1
    for (int job = job0; job < nN * 16 && job < jend; job += jstride) {
        const int pn = job >> 4, jai = (job >> 3) & 1, jwr = (job >> 2) & 1, jwc = job & 3;
        f32x4 h[2][4][2];
#pragma unroll
        for (int b = 0; b < 2; ++b)
#pragma unroll
            for (int m = 0; m < 4; ++m)
#pragma unroll
                for (int n = 0; n < 2; ++n) h[b][m][n] = (f32x4){0.f, 0.f, 0.f, 0.f};
        const bf16_t* ap = Arows + (size_t)(jai * 128 + jwr * 64 + fr) * K + 8 * fq + (w * per) * 32;
        const bf16_t* bp = Bt + (size_t)(pn * 256 + jwc * 32 + 8 * (fr >> 2) + (fr & 3)) * K + 8 * fq + (w * per) * 32;
        typename S64Pre<Epi>::type ps{};
        if constexpr (S64Pre<Epi>::on) { if (w < 4) ps = E.pre_s(pm_unit, pn, jwr, jwc, fr, fq, jai, w); }
#pragma unroll 1
        for (int ks0 = 0; ks0 < per; ks0 += 4) {
            bf16x8 af[4][4], bfr[4][2][2];
#pragma unroll
            for (int kl = 0; kl < 4; ++kl) {
                const int ks = (ks0 + kl < per) ? ks0 + kl : per - 1;
#pragma unroll
                for (int m = 0; m < 4; ++m) af[kl][m] = *(const bf16x8*)(ap + (size_t)(16 * m) * K + 32 * ks);
#pragma unroll
                for (int bj = 0; bj < 2; ++bj)
#pragma unroll
                    for (int n = 0; n < 2; ++n) bfr[kl][bj][n] = *(const bf16x8*)(bp + (size_t)(bj * 128 + 4 * n) * K + 32 * ks);
            }
#pragma unroll
            for (int kl = 0; kl < 4; ++kl)
                if (ks0 + kl < per) {
#pragma unroll
                    for (int bj = 0; bj < 2; ++bj)
#pragma unroll
                        for (int m = 0; m < 4; ++m)
#pragma unroll
                            for (int n = 0; n < 2; ++n) h[bj][m][n] = __builtin_amdgcn_mfma_f32_16x16x32_bf16(bfr[kl][bj][n], af[kl][m], h[bj][m][n], 0, 0, 0);
                }
        }
        __syncthreads();
#pragma unroll
        for (int bj = 0; bj < 2; ++bj)
#pragma unroll
            for (int m = 0; m < 4; ++m)
#pragma unroll
                for (int n = 0; n < 2; ++n) *(LAS f32x4*)(lds + ((w * 16 + (bj * 4 + m) * 2 + n) * 64 + lane) * 16) = h[bj][m][n];
        __syncthreads();
#pragma unroll
        for (int q = 0; q < 2; ++q) {
            LAS unsigned char* sp = lds + ((2 * w + q) * 64 + lane) * 16;
            f32x4 sum = *(const LAS f32x4*)sp;
#pragma unroll
            for (int ww = 1; ww < 8; ++ww) sum += *(const LAS f32x4*)(sp + ww * 16384);
            *(LAS f32x4*)sp = sum;
        }
        __syncthreads();
        if (w < 4) {
            f32x4 acc[2][2][4][2];
#pragma unroll
            for (int ai = 0; ai < 2; ++ai)
#pragma unroll
                for (int bj = 0; bj < 2; ++bj)
#pragma unroll
                    for (int m = 0; m < 4; ++m)
#pragma unroll
                        for (int n = 0; n < 2; ++n) acc[ai][bj][m][n] = *(const LAS f32x4*)(lds + (((bj * 4 + m) * 2 + n) * 64 + lane) * 16);
            Unit u; u.pm = pm_unit; u.pn = pn;
            if constexpr (S64Pre<Epi>::on) E.template run<true>(acc, u, jwr, jwc, fr, fq, 1u << (4 * jai + w), ps);
            else E(acc, u, jwr, jwc, fr, fq, 1u << (4 * jai + w));
        }
        if constexpr (Epi::POST) E.post(lds, 2 * jai + jwr, w, lane, 16u);
    }
    __syncthreads();
}

template <class Epi, bool H = Epi::S16> struct S16Pre { struct type {}; };
template <class Epi> struct S16Pre<Epi, true> { using type = typename Epi::PreS; };
template <class Epi>
__device__ __forceinline__ void sample_gemm16(LAS unsigned char* lds, const bf16_t* Arows, const bf16_t* Bt, const int K, const int nN, const int pm_unit, const Epi& E, const int job0, const int jstride) {
    const int tid = threadIdx.x, w = __builtin_amdgcn_readfirstlane(tid >> 6);
    int lane = tid & 63; asm volatile("" : "+v"(lane));
    const int fr = lane & 15, fq = lane >> 4;
    const int per = K / 256;
#pragma unroll 1
    for (int job = job0; job < nN * 64; job += jstride) {
        const int pn = job >> 6, jai = (job >> 5) & 1, jwr = (job >> 4) & 1, jm = (job >> 2) & 3, jwc = job & 3;
        f32x4 h[2][2];
#pragma unroll
        for (int b = 0; b < 2; ++b)
#pragma unroll
            for (int n = 0; n < 2; ++n) h[b][n] = (f32x4){0.f, 0.f, 0.f, 0.f};
        const bf16_t* ap = Arows + (size_t)(jai * 128 + jwr * 64 + 16 * jm + fr) * K + 8 * fq + (w * per) * 32;
        const bf16_t* bp = Bt + (size_t)(pn * 256 + jwc * 32 + 8 * (fr >> 2) + (fr & 3)) * K + 8 * fq + (w * per) * 32;
        typename S16Pre<Epi>::type ps{};
        if constexpr (Epi::S16) { if (w == 0) ps = E.pre_s(pm_unit, pn, jwr, jwc, fr, fq, jai, jm); }
#pragma unroll 1
        for (int ks0 = 0; ks0 < per; ks0 += 6) {
            bf16x8 af[6], bfr[6][2][2];
#pragma unroll
            for (int kl = 0; kl < 6; ++kl) {
                const int ks = (ks0 + kl < per) ? ks0 + kl : per - 1;
                af[kl] = *(const bf16x8*)(ap + 32 * ks);
#pragma unroll
                for (int bj = 0; bj < 2; ++bj)
#pragma unroll
                    for (int n = 0; n < 2; ++n) bfr[kl][bj][n] = *(const bf16x8*)(bp + (size_t)(bj * 128 + 4 * n) * K + 32 * ks);
            }
#pragma unroll
            for (int kl = 0; kl < 6; ++kl)
                if (ks0 + kl < per) {
#pragma unroll
                    for (int bj = 0; bj < 2; ++bj)
#pragma unroll
                        for (int n = 0; n < 2; ++n) h[bj][n] = __builtin_amdgcn_mfma_f32_16x16x32_bf16(bfr[kl][bj][n], af[kl], h[bj][n], 0, 0, 0);
                }
        }
        __syncthreads();
#pragma unroll
        for (int bj = 0; bj < 2; ++bj)
#pragma unroll
            for (int n = 0; n < 2; ++n) *(LAS f32x4*)(lds + ((w * 4 + bj * 2 + n) * 64 + lane) * 16) = h[bj][n];
        __syncthreads();
        if (w < 4) {
            LAS unsigned char* sp = lds + (w * 64 + lane) * 16;
            f32x4 sum = *(const LAS f32x4*)sp;
#pragma unroll
            for (int ww = 1; ww < 8; ++ww) sum += *(const LAS f32x4*)(sp + ww * 4096);
            *(LAS f32x4*)sp = sum;
        }
        __syncthreads();
        if (w == 0) {
            f32x4 acc[2][2][4][2];
#pragma unroll
            for (int ai = 0; ai < 2; ++ai)
#pragma unroll
                for (int bj = 0; bj < 2; ++bj)
#pragma unroll
                    for (int m = 0; m < 4; ++m)
#pragma unroll
                        for (int n = 0; n < 2; ++n) acc[ai][bj][m][n] = *(const LAS f32x4*)(lds + ((bj * 2 + n) * 64 + lane) * 16);
            Unit u; u.pm = pm_unit; u.pn = pn;
            if constexpr (Epi::S16) E.run_s(acc, ps, u, jwr, jwc, fr, fq, jai, jm);
            else if constexpr (Epi::POST) { if (E.fuse16) E.fused16(acc, u, jwr, jwc, fr, fq, jai, jm); else E(acc, u, jwr, jwc, fr, fq, 1u << (4 * jai + jm)); }
            else E(acc, u, jwr, jwc, fr, fq, 1u << (4 * jai + jm));
        }
        if constexpr (Epi::POST) { if (!E.fuse16) E.post(lds, 2 * jai + jwr, w, lane, 64u); }
    }
    __syncthreads();
}
}
using pg8::Unit;

template <bool TOK_>
struct EpiInT {
    static constexpr bool S64 = !TOK_;
    static constexpr bool TOK = TOK_;
    static constexpr bool IDEM = true, POST = false;
    unsigned char* proj; float* DEC; float* HGFS; const f32x4* rope; const float* lb;
    struct PreS { f32x4 c[4]; };
    __device__ __forceinline__ PreS pre_s(int pm, int pn, int wr, int wc, int fr, int fq, int ai, int m) const {
        PreS p;
#pragma unroll
        for (int q = 0; q < 4; ++q) p.c[q] = (f32x4){0.f, 0.f, 0.f, 0.f};
        if (pn < 4) {
            const int r = pm * 256 + wr * 64 + fr + ai * 128 + m * 16; const int pos = r < TP ? (r & 4095) : (1024 + (r & 15));
            const f32x4* cs = rope + (size_t)pos * 32 + ((32 * (wc & 1) + 8 * fq) >> 1);
#pragma unroll
            for (int q = 0; q < 4; ++q) p.c[q] = cs[q];
        } else if (pn >= 8 && pn < 12) {
            const int colh = (pn - 8) * 128 + 32 * wc + 8 * fq;
            p.c[0] = *(const f32x4*)(lb + colh); p.c[1] = *(const f32x4*)(lb + colh + 4);
        }
        return p;
    }
    __device__ __forceinline__ void operator()(const f32x4 (&acc)[2][2][4][2], const Unit& u, int wr, int wc, int fr_, int fq_, const unsigned mask = 0xffu) const { PreS d{}; run<false>(acc, u, wr, wc, fr_, fq_, mask, d); }
    template <bool PRE>
    __device__ __forceinline__ void run(const f32x4 (&acc)[2][2][4][2], const Unit& u, int wr, int wc, int fr_, int fq_, const unsigned mask, const PreS& pre) const {
        int fr = fr_, fq = fq_; asm volatile("" : "+v"(fr), "+v"(fq));
        const int pn = u.pn; const bool samp = !TOK && (u.pm == 64);
        constexpr int RM = TOK ? 1 : 16, RF = TOK ? 4 : 1;
        const int dd0 = 32 * (wc & 1) + 8 * fq;
        const int col0 = ((pn & 1) * 2 + (wc >> 1)) * 128 + dd0;
        const int rowb = u.pm * 256 + wr * 64 + RF * fr;
        if (pn < 4) {
            const int type = pn >> 1;
            bf16_t* D = (bf16_t*)(proj + (size_t)type * PSZ);
            const int head = (pn & 1) * 2 + (wc >> 1);
            const float lg = __log2f(1.0f - exp2f(-5.0f - (float)head));
            const float base = type == 0 ? 1.0f : 0.08838834764831845f;
            f32x4 cv[2][4][4];
            auto ldc = [&](int ai, int m) { if ((mask >> (4 * ai + m)) & 1u) {
                if constexpr (PRE) {
#pragma unroll
                    for (int q = 0; q < 4; ++q) cv[ai][m][q] = pre.c[q];
                } else { const int r = rowb + ai * 128 + m * RM; const int pos = r < TP ? (r & 4095) : (1024 + (r & 15));
                const f32x4* cs = rope + (size_t)pos * 32 + (dd0 >> 1);
#pragma unroll
                for (int q = 0; q < 4; ++q) cv[ai][m][q] = cs[q]; } } };
            ldc(0, 0); ldc(0, 1); ldc(0, 2);
#pragma unroll
            for (int ai = 0; ai < 2; ++ai)
#pragma unroll
                for (int m = 0; m < 4; ++m) { { constexpr int D3 = 3; const int g = 4 * ai + m + D3; if (g < 8) ldc(g >> 2, g & 3); } if ((mask >> (4 * ai + m)) & 1u) {
                    const int r = rowb + ai * 128 + m * RM;
                    const float e = (float)((r & 63) + 1) * lg;
                    const float sc = samp ? base : base * exp2f(type == 0 ? e : -e);
                    const f32x4 c0 = cv[ai][m][0], c1 = cv[ai][m][1], c2 = cv[ai][m][2], c3 = cv[ai][m][3];
                    const f32x4 lo0 = acc[ai][0][m][0], lo1 = acc[ai][0][m][1], hi0 = acc[ai][1][m][0], hi1 = acc[ai][1][m][1];
                    float ol[8], oh[8];
                    ol[0] = lo0[0] * c0[0] - hi0[0] * c0[1]; oh[0] = lo0[0] * c0[1] + hi0[0] * c0[0];
                    ol[1] = lo0[1] * c0[2] - hi0[1] * c0[3]; oh[1] = lo0[1] * c0[3] + hi0[1] * c0[2];
                    ol[2] = lo0[2] * c1[0] - hi0[2] * c1[1]; oh[2] = lo0[2] * c1[1] + hi0[2] * c1[0];
                    ol[3] = lo0[3] * c1[2] - hi0[3] * c1[3]; oh[3] = lo0[3] * c1[3] + hi0[3] * c1[2];
                    ol[4] = lo1[0] * c2[0] - hi1[0] * c2[1]; oh[4] = lo1[0] * c2[1] + hi1[0] * c2[0];
                    ol[5] = lo1[1] * c2[2] - hi1[1] * c2[3]; oh[5] = lo1[1] * c2[3] + hi1[1] * c2[2];
                    ol[6] = lo1[2] * c3[0] - hi1[2] * c3[1]; oh[6] = lo1[2] * c3[1] + hi1[2] * c3[0];
                    ol[7] = lo1[3] * c3[2] - hi1[3] * c3[3]; oh[7] = lo1[3] * c3[3] + hi1[3] * c3[2];
                    u32x4 wl, wh;
                    wl.x = cvt_pk_bf16(ol[0] * sc, ol[1] * sc); wl.y = cvt_pk_bf16(ol[2] * sc, ol[3] * sc); wl.z = cvt_pk_bf16(ol[4] * sc, ol[5] * sc); wl.w = cvt_pk_bf16(ol[6] * sc, ol[7] * sc);
                    wh.x = cvt_pk_bf16(oh[0] * sc, oh[1] * sc); wh.y = cvt_pk_bf16(oh[2] * sc, oh[3] * sc); wh.z = cvt_pk_bf16(oh[4] * sc, oh[5] * sc); wh.w = cvt_pk_bf16(oh[6] * sc, oh[7] * sc);
                    bf16_t* rp = D + pofs(head, r) + dd0;
                    st16b(proj, rp, wl); st16b(proj, rp + 64, wh);
                } }
        } else if (pn >= 8 && pn < 12) {
            const int lane = fq * 16 + fr;
            const int colh = (pn - 8) * 128 + 32 * wc + 8 * fq;
            bf16_t* dHQ = (bf16_t*)(proj + 4 * PSZ); bf16_t* dHK = (bf16_t*)(proj + 5 * PSZ);
            f32x4 lbv[2];
#pragma unroll
            for (int n = 0; n < 2; ++n) { if constexpr (PRE) lbv[n] = pre.c[n]; else lbv[n] = *(const f32x4*)(lb + colh + 4 * n); }
            const int srcl = (lane & 48) | 15;
#pragma unroll
            for (int ai = 0; ai < 2; ++ai) {
                const int rbase = u.pm * 256 + ai * 128 + wr * 64;
#pragma unroll
                for (int n = 0; n < 2; ++n) if ((mask >> (4 * ai)) & 0xfu) {
                    const int cn = colh + 4 * n;
                    f32x4 gg[4], kk[4];
#pragma unroll
                    for (int m = 0; m < 4; ++m)
#pragma unroll
                        for (int j = 0; j < 4; ++j) {
                            const float x = acc[ai][1][m][n][j]; const float sg = sigmoid_f(x); const float l = lbv[n][j];
                            gg[m][j] = l + (1.0f - l) * sg; kk[m][j] = (1.0f - l) * (1.0f - sg);
                        }
                    if (samp) {
#pragma unroll
                        for (int m = 0; m < 4; ++m) if ((mask >> (4 * ai + m)) & 1u) {
                            const int r = rbase + 16 * m + fr;
                            const f32x4 q0 = acc[ai][0][m][n];
                            u32x2 w; w.x = cvt_pk_bf16(q0[0], q0[1]); w.y = cvt_pk_bf16(q0[2], q0[3]);
                            *(u32x2*)(dHQ + pofs(pn - 8, r) + (cn & 127)) = w;
                            *(f32x4*)(HGFS + (size_t)(r - TP) * HW + cn) = gg[m];
                        }
                    } else {
                        f32x4 carry = (f32x4){1.f, 1.f, 1.f, 1.f};
                        if constexpr (TOK) {
#pragma unroll
                            for (int j = 0; j < 4; ++j) { gg[1][j] *= gg[0][j]; gg[2][j] *= gg[1][j]; gg[3][j] *= gg[2][j]; }
                            float T0 = gg[3][0], T1 = gg[3][1], T2 = gg[3][2], T3 = gg[3][3];
#define HG_SCAN(sh) "v_mul_f32_dpp %0, %0, %0 " sh " row_mask:0xf bank_mask:0xf\n\tv_mul_f32_dpp %1, %1, %1 " sh " row_mask:0xf bank_mask:0xf\n\t" \
                    "v_mul_f32_dpp %2, %2, %2 " sh " row_mask:0xf bank_mask:0xf\n\tv_mul_f32_dpp %3, %3, %3 " sh " row_mask:0xf bank_mask:0xf\n\t"
                            asm("s_nop 1\n\t" HG_SCAN("row_shr:1") HG_SCAN("row_shr:2") HG_SCAN("row_shr:4") HG_SCAN("row_shr:8") : "+v"(T0), "+v"(T1), "+v"(T2), "+v"(T3));
#undef HG_SCAN
#define HG_APPLY(m) do { float g0_ = gg[m][0], g1_ = gg[m][1], g2_ = gg[m][2], g3_ = gg[m][3]; \
                        asm("s_nop 1\n\tv_mul_f32_dpp %0, %4, %0 row_shr:1 row_mask:0xf bank_mask:0xf\n\tv_mul_f32_dpp %1, %5, %1 row_shr:1 row_mask:0xf bank_mask:0xf\n\t" \
                        "v_mul_f32_dpp %2, %6, %2 row_shr:1 row_mask:0xf bank_mask:0xf\n\tv_mul_f32_dpp %3, %7, %3 row_shr:1 row_mask:0xf bank_mask:0xf" \
                        : "+v"(g0_), "+v"(g1_), "+v"(g2_), "+v"(g3_) : "v"(T0), "v"(T1), "v"(T2), "v"(T3)); \
                        gg[m] = (f32x4){g0_, g1_, g2_, g3_}; } while (0)
                            HG_APPLY(0); HG_APPLY(1); HG_APPLY(2); HG_APPLY(3);
#undef HG_APPLY
                            carry = (f32x4){T0, T1, T2, T3};
                        } else {
#pragma unroll
                        for (int m = 0; m < 4; ++m)
#pragma unroll
                            for (int j = 0; j < 4; ++j) {
                                float v = gg[m][j];
                                v *= dpp_f<0x111>(1.f, v); v *= dpp_f<0x112>(1.f, v); v *= dpp_f<0x114>(1.f, v); v *= dpp_f<0x118>(1.f, v);
                                v *= carry[j];
                                gg[m][j] = v;
                                carry[j] = __shfl(v, srcl);
                            }
                        }
#pragma unroll
                        for (int m = 0; m < 4; ++m) {
                            const int r = rbase + RM * m + RF * fr;
                            float qo[4], ko[4];
#pragma unroll
                            for (int j = 0; j < 4; ++j) { const float P = gg[m][j]; qo[j] = acc[ai][0][m][n][j] * P; ko[j] = kk[m][j] * __builtin_amdgcn_rcpf(P); }
                            u32x2 wq, wk;
                            wq.x = cvt_pk_bf16(qo[0], qo[1]); wq.y = cvt_pk_bf16(qo[2], qo[3]);
                            wk.x = cvt_pk_bf16(ko[0], ko[1]); wk.y = cvt_pk_bf16(ko[2], ko[3]);
                            st8b(proj, dHQ + pofs(pn - 8, r) + (cn & 127), wq); st8b(proj, dHK + pofs(pn - 8, r) + (cn & 127), wk);
                        }
                        if (fr == 15) {
                            f32x4 d0;
#pragma unroll
                            for (int j = 0; j < 4; ++j) d0[j] = carry[j];
                            *(f32x4*)(DEC + (size_t)(4 * u.pm + 2 * ai + wr) * HW + cn) = d0;
                        }
                    }
                }
            }
        } else {
            bf16_t* D = (bf16_t*)(proj + (size_t)(pn >> 1) * PSZ);
            const bool act = false;
#pragma unroll
            for (int ai = 0; ai < 2; ++ai)
#pragma unroll
                for (int m = 0; m < 4; ++m) if ((mask >> (4 * ai + m)) & 1u) {
                    const int r = rowb + ai * 128 + m * RM;
                    bf16_t* rp = D + pofs((pn & 1) * 2 + (wc >> 1), r) + dd0;
#pragma unroll
                    for (int bj = 0; bj < 2; ++bj) {
                        f32x4 v0 = acc[ai][bj][m][0], v1 = acc[ai][bj][m][1];
                        if (act) {
#pragma unroll
                            for (int j = 0; j < 4; ++j) { v0[j] = silu_f(v0[j]); v1[j] = silu_f(v1[j]); }
                        }
                        u32x4 w; w.x = cvt_pk_bf16(v0[0], v0[1]); w.y = cvt_pk_bf16(v0[2], v0[3]); w.z = cvt_pk_bf16(v1[0], v1[1]); w.w = cvt_pk_bf16(v1[2], v1[3]);
                        st16b(proj, rp + 64 * bj, w);
                    }
                }
        }
    }
};
using EpiIn = EpiInT<false>;

struct EpiOut {
    static constexpr bool TOK = false;
    static constexpr bool IDEM = true, POST = false, S16 = true;
    const float* xp; const float* xs; float* X1F; bf16_t* X1B; float* SS2;
    struct PreS { f32x4 xv[4]; };
    __device__ __forceinline__ PreS pre_s(int pm, int pn, int wr, int wc, int fr, int fq, int ai, int m) const {
        PreS p; const int r = pm * 256 + ai * 128 + wr * 64 + m * 16 + fr; const float* xr = (r < TP ? xp + (size_t)r * DM : xs + (size_t)(r - TP) * DM) + pn * 256 + wc * 32 + 8 * fq;
#pragma unroll
        for (int q = 0; q < 4; ++q) p.xv[q] = __builtin_nontemporal_load((const f32x4*)(xr + 128 * (q >> 1) + 4 * (q & 1)));
        return p;
    }
    __device__ __forceinline__ void run_s(const f32x4 (&acc)[2][2][4][2], const PreS& pre, const Unit& u, int wr, int wc, int fr_, int fq_, int ai, int m) const {
        int fr = fr_, fq = fq_; asm volatile("" : "+v"(fr), "+v"(fq));
        const int col0 = u.pn * 256 + wc * 32 + 8 * fq;
        const int r = u.pm * 256 + ai * 128 + wr * 64 + m * 16 + fr;
        const int rb = r < TP ? (4098 * (r >> 12) + 2 + (r & 4095)) : (16394 + (r - TP));
        bf16_t* o16 = X1B + (size_t)rb * DM + col0;
        float ss = 0.f;
#pragma unroll
        for (int bj = 0; bj < 2; ++bj) {
            const f32x4 v0 = acc[0][bj][0][0] + pre.xv[2 * bj], v1 = acc[0][bj][0][1] + pre.xv[2 * bj + 1];
            u32x4 w; w.x = cvt_pk_bf16(v0[0], v0[1]); w.y = cvt_pk_bf16(v0[2], v0[3]); w.z = cvt_pk_bf16(v1[0], v1[1]); w.w = cvt_pk_bf16(v1[2], v1[3]);
            st16b(X1B, o16 + 128 * bj, w);
            ss += (v0[0] * v0[0] + v0[1] * v0[1]) + (v0[2] * v0[2] + v0[3] * v0[3]) + (v1[0] * v1[0] + v1[1] * v1[1]) + (v1[2] * v1[2] + v1[3] * v1[3]);
        }
        ss += __shfl_xor(ss, 16); ss += __shfl_xor(ss, 32);
        if (fq == 0) SS2[(size_t)r * 16 + u.pn * 4 + wc] = ss;
    }
    __device__ __forceinline__ void operator()(const f32x4 (&acc)[2][2][4][2], const Unit& u, int wr, int wc, int fr_, int fq_, const unsigned mask = 0xffu) const {
        int fr = fr_, fq = fq_; asm volatile("" : "+v"(fr), "+v"(fq));
        const int col0 = u.pn * 256 + wc * 32 + 8 * fq;
        f32x4 xv[2][4][4];
        auto xrow = [&](int ai, int m) -> const float* { const int r = u.pm * 256 + ai * 128 + wr * 64 + m * 16 + fr; return (r < TP ? xp + (size_t)r * DM : xs + (size_t)(r - TP) * DM) + col0; };
        auto ldx = [&](int ai, int m) { if ((mask >> (4 * ai + m)) & 1u) { const float* xr = xrow(ai, m);
#pragma unroll
            for (int q = 0; q < 4; ++q) xv[ai][m][q] = __builtin_nontemporal_load((const f32x4*)(xr + 128 * (q >> 1) + 4 * (q & 1))); } };
#pragma unroll
        for (int m = 0; m < 4; ++m) ldx(0, m);
#pragma unroll
        for (int ai = 0; ai < 2; ++ai)
#pragma unroll
            for (int m = 0; m < 4; ++m) {
                if (ai == 0) ldx(1, m);
                if ((mask >> (4 * ai + m)) & 1u) {
                    const int r = u.pm * 256 + ai * 128 + wr * 64 + m * 16 + fr;
                    const int rb = r < TP ? (4098 * (r >> 12) + 2 + (r & 4095)) : (16394 + (r - TP));
                    bf16_t* o16 = X1B + (size_t)rb * DM + col0;
                    float ss = 0.f;
#pragma unroll
                    for (int bj = 0; bj < 2; ++bj) {
                        const f32x4 v0 = acc[ai][bj][m][0] + xv[ai][m][2 * bj], v1 = acc[ai][bj][m][1] + xv[ai][m][2 * bj + 1];
                        u32x4 w; w.x = cvt_pk_bf16(v0[0], v0[1]); w.y = cvt_pk_bf16(v0[2], v0[3]); w.z = cvt_pk_bf16(v1[0], v1[1]); w.w = cvt_pk_bf16(v1[2], v1[3]);
                        st16b(X1B, o16 + 128 * bj, w);
                        ss += (v0[0] * v0[0] + v0[1] * v0[1]) + (v0[2] * v0[2] + v0[3] * v0[3]) + (v1[0] * v1[0] + v1[1] * v1[1]) + (v1[2] * v1[2] + v1[3] * v1[3]);
                    }
                    ss += __shfl_xor(ss, 16); ss += __shfl_xor(ss, 32);
                    if (fq == 0) SS2[(size_t)r * 16 + u.pn * 4 + wc] = ss;
                }
            }
    }
};

struct EpiUp {
    static constexpr bool IDEM = true, POST = false;
    const float* SS2; const float* ck; const float* cb; const float* cache_in; bf16_t* ACT; float* ccp; float* ccs;
    __device__ __forceinline__ void operator()(f32x4 (&acc)[2][2][4][2], const Unit& u, int wr, int wc, int fr_, int fq_, const unsigned mask = 0xffu) const {
        int fr = fr_, fq = fq_; asm volatile("" : "+v"(fr), "+v"(fq));
        const int lane = fq * 16 + fr;
        const int f0 = u.pn * 128 + wc * 32 + 8 * fq;
        const bool samp = (u.pm == 68);
        const int sb = samp ? 0 : u.pm / 17, sj = samp ? 0 : u.pm % 17;
        f32x4 k0[2], k1[2], k2[2], bb[2];
#pragma unroll
        for (int n = 0; n < 2; ++n) { k0[n] = *(const f32x4*)(ck + f0 + 4 * n); k1[n] = *(const f32x4*)(ck + DFF + f0 + 4 * n); k2[n] = *(const f32x4*)(ck + 2 * DFF + f0 + 4 * n); bb[n] = *(const f32x4*)(cb + f0 + 4 * n); }
#pragma unroll
        for (int ai = 0; ai < 2; ++ai) {
            f32x4 prev[2] = {(f32x4){0.f, 0.f, 0.f, 0.f}, (f32x4){0.f, 0.f, 0.f, 0.f}};
#pragma unroll
            for (int m = 0; m < 4; ++m) if ((mask >> (4 * ai + m)) & 1u) {
                int gr; bool valid; int t = 0;
                if (samp) { gr = TP + ai * 128 + wr * 64 + m * 16 + fr; valid = true; }
                else { t = 248 * sj + 62 * (2 * ai + wr) + 16 * m + fr - 2; gr = sb * SEQ + t; valid = (t >= 0) && (t < SEQ); }
                float ssq = 0.f;
                if (valid) { const f32x4 p = *(const f32x4*)(SS2 + (size_t)gr * 16 + 4 * fq); ssq = (p[0] + p[1]) + (p[2] + p[3]); }
                ssq += __shfl_xor(ssq, 16); ssq += __shfl_xor(ssq, 32);
                const float rs = valid ? __frsqrt_rn(ssq * (1.0f / DM) + EPS) : 0.f;
                f32x4 a[2], b[2];
#pragma unroll
                for (int n = 0; n < 2; ++n) { a[n] = acc[ai][0][m][n] * rs; b[n] = acc[ai][1][m][n] * rs; }
                if (samp) {
                    const int s = ai * 8 + wr * 4 + m;
                    if (fr >= 14) {
#pragma unroll
                        for (int n = 0; n < 2; ++n) prev[n] = *(const f32x4*)(cache_in + ((size_t)s * 2 + (fr - 14)) * DFF + f0 + 4 * n);
                    }
                }
                f32x4 o[2];
#pragma unroll
                for (int n = 0; n < 2; ++n)
#pragma unroll
                    for (int j = 0; j < 4; ++j) {
                        const float s1 = dpp_f<0x111>(dpp_f<0x121>(0.f, prev[n][j]), a[n][j]);
                        const float s2 = dpp_f<0x112>(dpp_f<0x122>(0.f, prev[n][j]), a[n][j]);
                        const float cv = bb[n][j] + k0[n][j] * s2 + k1[n][j] * s1 + k2[n][j] * a[n][j];
                        o[n][j] = silu_f(cv) * b[n][j];
                    }
                const bool store = samp ? true : (valid && (16 * m + fr >= 2));
                if (store) {
                    u32x4 w; w.x = cvt_pk_bf16(o[0][0], o[0][1]); w.y = cvt_pk_bf16(o[0][2], o[0][3]); w.z = cvt_pk_bf16(o[1][0], o[1][1]); w.w = cvt_pk_bf16(o[1][2], o[1][3]);
                    st16b(ACT, ACT + (size_t)gr * DFF + f0, w);
                    if (samp) { if (fr >= 14) { float* cp = ccs + ((size_t)(ai * 8 + wr * 4 + m) * 2 + (fr - 14)) * DFF + f0; *(f32x4*)cp = a[0]; *(f32x4*)(cp + 4) = a[1]; } }
                    else if (t >= SEQ - 2) { float* cp = ccp + ((size_t)sb * 2 + (t - (SEQ - 2))) * DFF + f0; *(f32x4*)cp = a[0]; *(f32x4*)(cp + 4) = a[1]; }
                }
                prev[0] = a[0]; prev[1] = a[1];
            }
        }
    }
};

struct EpiUpMain {
    static constexpr bool TOK = true;
    static constexpr bool IDEM = true, POST = false;
    const float* SS2; const float* ck; const float* cb; const float* cache_in; bf16_t* ACT; float* ccp; float* ccs;
    template <bool SAMP>
    __device__ __forceinline__ void body(f32x4 (&acc)[2][2][4][2], const Unit& u, int wr, int wc, int fr_, int fq_) const {
        int fr = fr_, fq = fq_; asm volatile("" : "+v"(fr), "+v"(fq));
        const int f0 = u.pn * 128 + wc * 32 + 8 * fq;
        const int sb = SAMP ? 0 : u.pm / 17, sj = SAMP ? 0 : u.pm % 17;
        f32x4 k0[2], k1[2], k2[2], bb[2];
#pragma unroll
        for (int n = 0; n < 2; ++n) { k0[n] = *(const f32x4*)(ck + f0 + 4 * n); k1[n] = *(const f32x4*)(ck + DFF + f0 + 4 * n); k2[n] = *(const f32x4*)(ck + 2 * DFF + f0 + 4 * n); bb[n] = *(const f32x4*)(cb + f0 + 4 * n); }
        constexpr float NL2E = -1.4426950408889634f, NLN2 = -0.6931471805599453f;
#pragma unroll
        for (int n = 0; n < 2; ++n) { k0[n] *= NL2E; k1[n] *= NL2E; k2[n] *= NL2E; bb[n] *= NL2E; }
        auto grow = [&](int ai, int m, bool clamp) -> int {
            if constexpr (SAMP) return TP + 64 * (2 * ai + wr) + 4 * fr + m;
            else { int t = 248 * sj + 62 * (2 * ai + wr) - 2 + 4 * fr + m; if (clamp) t = t < 0 ? 0 : (t > SEQ - 1 ? SEQ - 1 : t); return sb * SEQ + t; } };
        f32x4 pss[2][4];
        auto ldss = [&](int ai) {
#pragma unroll
            for (int m = 0; m < 4; ++m) pss[ai][m] = *(const f32x4*)(SS2 + (size_t)grow(ai, m, true) * 16 + 4 * fq); };
        ldss(0);
        const bool first = SAMP && ((fr & 3) == 0);
#pragma unroll
        for (int ai = 0; ai < 2; ++ai) {
            const int tb = 248 * sj + 62 * (2 * ai + wr) - 2 + 4 * fr;
            float rs[4];
#pragma unroll
            for (int m = 0; m < 4; ++m) {
                const int t = tb + m; const bool valid = SAMP || ((unsigned)t < (unsigned)SEQ);
                const f32x4 p = pss[ai][m];
                float ssq = (p[0] + p[1]) + (p[2] + p[3]);
                ssq += __shfl_xor(ssq, 16); ssq += __shfl_xor(ssq, 32);
                rs[m] = valid ? __frsqrt_rn(ssq * (1.0f / DM) + EPS) : 0.f;
            }
            if (ai == 0) ldss(1);
            const float rsb[4] = {rs[0] * NLN2, rs[1] * NLN2, rs[2] * NLN2, rs[3] * NLN2};
            u32x4 w[4];
#pragma unroll
            for (int n = 0; n < 2; ++n) {
                f32x4 cin[2];
                if constexpr (SAMP) {
                    const int sq = 4 * (2 * ai + wr) + (fr >> 2);
                    cin[0] = *(const f32x4*)(cache_in + ((size_t)sq * 2 + 0) * DFF + f0 + 4 * n); cin[1] = *(const f32x4*)(cache_in + ((size_t)sq * 2 + 1) * DFF + f0 + 4 * n);
                }
#pragma unroll
                for (int j = 0; j < 4; j += 2) {
                    float o[4][2];
                    auto pr = [&](const f32x4& v) { return (f32x2){v[j], v[j + 1]}; };
                    const f32x2 a0 = pr(acc[ai][0][0][n]) * rs[0], a1 = pr(acc[ai][0][1][n]) * rs[1], a2 = pr(acc[ai][0][2][n]) * rs[2], a3 = pr(acc[ai][0][3][n]) * rs[3];
                    f32x2 p1 = {dpp_z<0x111>(a3[0]), dpp_z<0x111>(a3[1])}, p2 = {dpp_z<0x111>(a2[0]), dpp_z<0x111>(a2[1])};
                    if constexpr (SAMP) { const f32x2 h1 = pr(cin[1]), h2 = pr(cin[0]); p1[0] = first ? h1[0] : p1[0]; p1[1] = first ? h1[1] : p1[1]; p2[0] = first ? h2[0] : p2[0]; p2[1] = first ? h2[1] : p2[1]; }
                    const f32x2 c0 = pr(k0[n]), c1 = pr(k1[n]), c2 = pr(k2[n]), cbv = pr(bb[n]);
                    const f32x2 v0 = cbv + c0 * p2 + c1 * p1 + c2 * a0;
                    const f32x2 v1 = cbv + c0 * p1 + c1 * a0 + c2 * a1;
                    const f32x2 v2 = cbv + c0 * a0 + c1 * a1 + c2 * a2;
                    const f32x2 v3 = cbv + c0 * a1 + c1 * a2 + c2 * a3;
                    auto sg = [&](const f32x2& v) { const f32x2 e = {__builtin_amdgcn_exp2f(v[0]), __builtin_amdgcn_exp2f(v[1])}; const f32x2 d = e + 1.0f;
                                                    return (f32x2){__builtin_amdgcn_rcpf(d[0]), __builtin_amdgcn_rcpf(d[1])}; };
                    const f32x2 o0 = (v0 * sg(v0)) * (pr(acc[ai][1][0][n]) * rsb[0]);
                    const f32x2 o1 = (v1 * sg(v1)) * (pr(acc[ai][1][1][n]) * rsb[1]);
                    const f32x2 o2 = (v2 * sg(v2)) * (pr(acc[ai][1][2][n]) * rsb[2]);
                    const f32x2 o3 = (v3 * sg(v3)) * (pr(acc[ai][1][3][n]) * rsb[3]);
                    o[0][0] = o0[0]; o[0][1] = o0[1]; o[1][0] = o1[0]; o[1][1] = o1[1]; o[2][0] = o2[0]; o[2][1] = o2[1]; o[3][0] = o3[0]; o[3][1] = o3[1];
#pragma unroll
                    for (int m = 0; m < 4; ++m) w[m][2 * n + (j >> 1)] = cvt_pk_bf16(o[m][0], o[m][1]);
                }
            }
#pragma unroll
            for (int m = 0; m < 4; ++m) {
                if constexpr (SAMP) {
                    st16b(ACT, ACT + (size_t)grow(ai, m, false) * DFF + f0, w[m]);
                    if (m >= 2 && (fr & 3) == 3) {
                        float* cp = ccs + ((size_t)(4 * (2 * ai + wr) + (fr >> 2)) * 2 + (m - 2)) * DFF + f0; *(f32x4*)cp = acc[ai][0][m][0] * rs[m]; *(f32x4*)(cp + 4) = acc[ai][0][m][1] * rs[m];
                    }
                } else {
                    const int t = tb + m;
                    if ((unsigned)t < (unsigned)SEQ && (4 * fr + m >= 2)) {
                        st16b(ACT, ACT + (size_t)(sb * SEQ + t) * DFF + f0, w[m]);
                        if (t >= SEQ - 2) { float* cp = ccp + ((size_t)sb * 2 + (t - (SEQ - 2))) * DFF + f0; *(f32x4*)cp = acc[ai][0][m][0] * rs[m]; *(f32x4*)(cp + 4) = acc[ai][0][m][1] * rs[m]; }
                    }
                }
            }
        }
    }
    __device__ __forceinline__ void operator()(f32x4 (&acc)[2][2][4][2], const Unit& u, int wr, int wc, int fr_, int fq_, const unsigned mask = 0xffu) const {
        if (u.pm == 68) body<true>(acc, u, wr, wc, fr_, fq_); else body<false>(acc, u, wr, wc, fr_, fq_);
    }
};

template <bool FUSED>
struct EpiDownT {
    static constexpr bool TOK = false;
    static constexpr bool IDEM = false, POST = !FUSED, S16 = false;
    float* X; const bf16_t* X1B; float* SS3; const float* gfin; float* XS; unsigned* cnt; LAS unsigned char* ldsx; bool fuse16;
    static __device__ __forceinline__ void ld8(const bf16_t* p, f32x4& a, f32x4& b) { const u32x4 w = *(const u32x4*)p;
        a[0] = __uint_as_float(w.x << 16); a[1] = __uint_as_float(w.x & 0xffff0000u); a[2] = __uint_as_float(w.y << 16); a[3] = __uint_as_float(w.y & 0xffff0000u);
        b[0] = __uint_as_float(w.z << 16); b[1] = __uint_as_float(w.z & 0xffff0000u); b[2] = __uint_as_float(w.w << 16); b[3] = __uint_as_float(w.w & 0xffff0000u); }
    __device__ __forceinline__ void post(LAS unsigned char* lds, int rb, int w, int lane, const unsigned nexp) const {
        asm volatile("s_waitcnt vmcnt(0)" ::: "memory");
        __syncthreads();
        LAS unsigned* flag = (LAS unsigned*)(lds + RING_BYTES + 8192);
        if (threadIdx.x == 0) {
            const unsigned old = __hip_atomic_fetch_add(cnt + 64 * (64 + rb), 1u, __ATOMIC_RELAXED, __HIP_MEMORY_SCOPE_AGENT);
            const unsigned last = (old == nexp - 1u) ? 1u : 0u;
            if (last) { __builtin_amdgcn_fence(__ATOMIC_ACQUIRE, "agent"); asm volatile("s_waitcnt vmcnt(0)" ::: "memory"); }
            *flag = last;
        }
        __syncthreads();
        if (*flag) {
            f32x4 gn[4];
#pragma unroll
            for (int j = 0; j < 4; ++j) gn[j] = ((const f32x4*)gfin)[lane + 64 * j];
            for (int q = w; q < 64; q += NWAVES) {
                const int m = TP + 64 * rb + q;
                float p = lane < 16 ? SS3[(size_t)m * 16 + lane] : 0.f;
#pragma unroll
                for (int o = 1; o < 64; o <<= 1) p += __shfl_xor(p, o);
                const float rs = 1.0f / sqrtf(p * (1.0f / DM) + EPS);
                f32x4* xr = (f32x4*)(X + (size_t)m * DM) + lane;
#pragma unroll
                for (int j = 0; j < 4; ++j) { f32x4 v = xr[64 * j]; v = v * rs * gn[j]; xr[64 * j] = v; }
            }
        }
        __syncthreads();
    }
    __device__ __forceinline__ void fused16(const f32x4 (&acc)[2][2][4][2], const Unit& u, int wr, int wc, int fr_, int fq_, int ai, int m) const {
        int fr = fr_, fq = fq_; asm volatile("" : "+v"(fr), "+v"(fq));
        const int col0 = u.pn * 256 + wc * 32 + 8 * fq;
        const int r = u.pm * 256 + ai * 128 + wr * 64 + m * 16 + fr;
        const bf16_t* x1p = X1B + (size_t)(16394 + (r - TP)) * DM + col0;
        f32x4 gv[2][2];
#pragma unroll
        for (int bj = 0; bj < 2; ++bj)
#pragma unroll
            for (int n = 0; n < 2; ++n) gv[bj][n] = *(const f32x4*)(gfin + col0 + 128 * bj + 4 * n);
        f32x4 v[2][2]; float ss = 0.f;
#pragma unroll
        for (int bj = 0; bj < 2; ++bj) {
            f32x4 x0, x1; ld8(x1p + 128 * bj, x0, x1);
            v[bj][0] = acc[0][bj][0][0] + x0; v[bj][1] = acc[0][bj][0][1] + x1;
            const f32x4 v0 = v[bj][0], v1 = v[bj][1];
            ss += (v0[0] * v0[0] + v0[1] * v0[1]) + (v0[2] * v0[2] + v0[3] * v0[3]) + (v1[0] * v1[0] + v1[1] * v1[1]) + (v1[2] * v1[2] + v1[3] * v1[3]);
        }
        ss += __shfl_xor(ss, 16); ss += __shfl_xor(ss, 32);
        if (fq == 0) st4wt(SS3 + (size_t)r * 16 + u.pn * 4 + wc, ss);
        asm volatile("s_waitcnt vmcnt(0)" ::: "memory");
        unsigned* cp = cnt + 64 * (64 + 2 * ai + wr);
        if (fq == 0 && fr == 0) __hip_atomic_fetch_add(cp, 1u, __ATOMIC_RELAXED, __HIP_MEMORY_SCOPE_AGENT);
        { unsigned sp = 0;
          while ((unsigned)__builtin_amdgcn_readfirstlane(__hip_atomic_load(cp, __ATOMIC_RELAXED, __HIP_MEMORY_SCOPE_AGENT)) < 64u) { __builtin_amdgcn_s_sleep(2); if (++sp > (1u << 20)) break; } }
        __builtin_amdgcn_fence(__ATOMIC_ACQUIRE, "agent");
        const float* sl = SS3 + (size_t)r * 16 + 4 * fq;
        float t = 0.f;
#pragma unroll
        for (int k = 0; k < 4; ++k) t += __hip_atomic_load(sl + k, __ATOMIC_RELAXED, __HIP_MEMORY_SCOPE_AGENT);
        t += __shfl_xor(t, 16); t += __shfl_xor(t, 32);
        const float rs = 1.0f / sqrtf(t * (1.0f / DM) + EPS);
        float* xr = X + (size_t)r * DM + col0;
#pragma unroll
        for (int bj = 0; bj < 2; ++bj) { *(f32x4*)(xr + 128 * bj) = v[bj][0] * rs * gv[bj][0]; *(f32x4*)(xr + 128 * bj + 4) = v[bj][1] * rs * gv[bj][1]; }
    }
    __device__ __forceinline__ void operator()(f32x4 (&acc)[2][2][4][2], const Unit& u, int wr, int wc, int fr_, int fq_, const unsigned mask = 0xffu) const {
        int fr = fr_, fq = fq_; asm volatile("" : "+v"(fr), "+v"(fq));
        const int col0 = u.pn * 256 + wc * 32 + 8 * fq;
        if constexpr (!FUSED) {
#pragma unroll
            for (int ai = 0; ai < 2; ++ai)
#pragma unroll
                for (int m = 0; m < 4; ++m) if ((mask >> (4 * ai + m)) & 1u) {
                    const int r = u.pm * 256 + ai * 128 + wr * 64 + m * 16 + fr;
                    float* xr = X + (size_t)r * DM + col0;
                    const int rb = r < TP ? (4098 * (r >> 12) + 2 + (r & 4095)) : (16394 + (r - TP));
                    const bf16_t* x1p = X1B + (size_t)rb * DM + col0;
                    float ss = 0.f;
#pragma unroll
                    for (int bj = 0; bj < 2; ++bj) {
                        f32x4 x0, x1; ld8(x1p + 128 * bj, x0, x1);
                        const f32x4 v0 = acc[ai][bj][m][0] + x0, v1 = acc[ai][bj][m][1] + x1;
                        st16wt(xr + 128 * bj, v0); st16wt(xr + 128 * bj + 4, v1);
                        ss += (v0[0] * v0[0] + v0[1] * v0[1]) + (v0[2] * v0[2] + v0[3] * v0[3]) + (v1[0] * v1[0] + v1[1] * v1[1]) + (v1[2] * v1[2] + v1[3] * v1[3]);
                    }
                    ss += __shfl_xor(ss, 16); ss += __shfl_xor(ss, 32);
                    if (fq == 0) st4wt(SS3 + (size_t)r * 16 + u.pn * 4 + wc, ss);
                }
        } else {
            const int tid = threadIdx.x, wid = __builtin_amdgcn_readfirstlane(tid >> 6);
            LAS float* P = (LAS float*)ldsx;
            LAS float* S = (LAS float*)(ldsx + 4096);
            u32x4 xw[2][4][2];
            auto ldr = [&](int ai, int m) { const int r = u.pm * 256 + ai * 128 + wr * 64 + m * 16 + fr;
                const bf16_t* x1p = X1B + (size_t)(4098 * (r >> 12) + 2 + (r & 4095)) * DM + col0;
                xw[ai][m][0] = *(const u32x4*)x1p; xw[ai][m][1] = *(const u32x4*)(x1p + 128); };
#pragma unroll
            for (int m = 0; m < 4; ++m) ldr(0, m);
#pragma unroll
            for (int ai = 0; ai < 2; ++ai)
#pragma unroll
                for (int m = 0; m < 4; ++m) {
                    if (ai == 0) ldr(1, m);
                    const int rl = ai * 128 + wr * 64 + m * 16 + fr;
                    float ss = 0.f;
#pragma unroll
                    for (int bj = 0; bj < 2; ++bj) {
                        f32x4 x0, x1; { const u32x4 w = xw[ai][m][bj];
                            x0[0] = __uint_as_float(w.x << 16); x0[1] = __uint_as_float(w.x & 0xffff0000u); x0[2] = __uint_as_float(w.y << 16); x0[3] = __uint_as_float(w.y & 0xffff0000u);
                            x1[0] = __uint_as_float(w.z << 16); x1[1] = __uint_as_float(w.z & 0xffff0000u); x1[2] = __uint_as_float(w.w << 16); x1[3] = __uint_as_float(w.w & 0xffff0000u); }
                        const f32x4 v0 = acc[ai][bj][m][0] + x0, v1 = acc[ai][bj][m][1] + x1;
                        acc[ai][bj][m][0] = v0; acc[ai][bj][m][1] = v1;
                        ss += (v0[0] * v0[0] + v0[1] * v0[1]) + (v0[2] * v0[2] + v0[3] * v0[3]) + (v1[0] * v1[0] + v1[1] * v1[1]) + (v1[2] * v1[2] + v1[3] * v1[3]);
                    }
                    ss += __shfl_xor(ss, 16); ss += __shfl_xor(ss, 32);
                    if (fq == 0) P[rl * 4 + wc] = ss;
                }
            asm volatile("s_waitcnt lgkmcnt(0)" ::: "memory"); __builtin_amdgcn_s_barrier(); asm volatile("" ::: "memory");
            if (tid < 256) {
                const f32x4 p = *(const LAS f32x4*)(P + tid * 4);
                __hip_atomic_store(XS + ((size_t)u.pm * 256 + tid) * 4 + u.pn, (p[0] + p[1]) + (p[2] + p[3]), __ATOMIC_RELAXED, __HIP_MEMORY_SCOPE_AGENT);
            }
            asm volatile("s_waitcnt vmcnt(0)" ::: "memory");
            if (tid < 256 && (tid & 63) == 0) __hip_atomic_fetch_add(cnt + 64 * u.pm, 1u, __ATOMIC_RELAXED, __HIP_MEMORY_SCOPE_AGENT);
            if (wid == 0) {
                unsigned sp = 0;
                while ((unsigned)__builtin_amdgcn_readfirstlane(__hip_atomic_load(cnt + 64 * u.pm, __ATOMIC_RELAXED, __HIP_MEMORY_SCOPE_AGENT)) < 16u) {
                    __builtin_amdgcn_s_sleep(2);
                    if (++sp > (1u << 20)) break;
                }
                __builtin_amdgcn_fence(__ATOMIC_ACQUIRE, "agent");
            }
            asm volatile("s_waitcnt vmcnt(0) lgkmcnt(0)" ::: "memory"); __builtin_amdgcn_s_barrier(); asm volatile("" ::: "memory");
            if (tid < 256) {
                const float* sl = XS + ((size_t)u.pm * 256 + tid) * 4;
                float t = 0.f;
#pragma unroll
                for (int k = 0; k < 4; ++k) t += __hip_atomic_load(sl + k, __ATOMIC_RELAXED, __HIP_MEMORY_SCOPE_AGENT);
                S[tid] = 1.0f / sqrtf(t * (1.0f / DM) + EPS);
            }
            asm volatile("s_waitcnt vmcnt(0) lgkmcnt(0)" ::: "memory"); __builtin_amdgcn_s_barrier(); asm volatile("" ::: "memory");
            f32x4 gv[2][2];
#pragma unroll
            for (int bj = 0; bj < 2; ++bj)
#pragma unroll
                for (int n = 0; n < 2; ++n) gv[bj][n] = *(const f32x4*)(gfin + col0 + 128 * bj + 4 * n);
#pragma unroll
            for (int ai = 0; ai < 2; ++ai)
#pragma unroll
                for (int m = 0; m < 4; ++m) {
                    const int rl = ai * 128 + wr * 64 + m * 16 + fr;
                    const float rs = S[rl];
                    float* xr = X + (size_t)(u.pm * 256 + rl) * DM + col0;
#pragma unroll
                    for (int bj = 0; bj < 2; ++bj) {
                        *(f32x4*)(xr + 128 * bj) = acc[ai][bj][m][0] * rs * gv[bj][0];
                        *(f32x4*)(xr + 128 * bj + 4) = acc[ai][bj][m][1] * rs * gv[bj][1];
                    }
                }
        }
    }
};

struct EpiNull {
    static constexpr bool TOK = false;
    static constexpr bool IDEM = false, POST = false;
    __device__ __forceinline__ void operator()(f32x4 (&acc)[2][2][4][2], const Unit& u, int wr, int wc, int fr_, int fq_, const unsigned mask = 0xffu) const {
#pragma unroll
        for (int a = 0; a < 2; ++a)
#pragma unroll
            for (int b = 0; b < 2; ++b)
#pragma unroll
                for (int m = 0; m < 4; ++m)
#pragma unroll
                    for (int n = 0; n < 2; ++n) asm volatile("" :: "v"(acc[a][b][m][n]));
    }
};
struct Args { const float* in[17]; float* out; unsigned char* ws; int ph_lo, ph_hi; };

__device__ __forceinline__ float wave_sum(float v) {
#pragma unroll
    for (int o = 1; o < 64; o <<= 1) v += __shfl_xor(v, o);
    return v;
}

__device__ __forceinline__ void transpose_item(const float* W, int K, int N, bf16_t* WT, const float* gain, LAS float* scr, int k0, int p0, int s0, int lane) {
    float tv[32];
#pragma unroll
    for (int i = 0; i < 32; ++i) { const int kk = 2 * i + (lane >> 5); tv[i] = __builtin_nontemporal_load(W + (size_t)(k0 + kk) * N + s0 + (lane & 31)); }
    if (gain) {
#pragma unroll
        for (int i = 0; i < 32; ++i) tv[i] *= gain[k0 + 2 * i + (lane >> 5)];
    }
#pragma unroll
    for (int i = 0; i < 32; ++i) scr[(2 * i + (lane >> 5)) * 33 + (lane & 31)] = tv[i];
    asm volatile("s_waitcnt lgkmcnt(0)" ::: "memory");
    const int c = lane & 7;
#pragma unroll
    for (int j = 0; j < 4; ++j) { const int n = (lane >> 3) + 8 * j; const LAS float* s = scr + (8 * c) * 33 + n;
        u32x4 o; o.x = cvt_pk_bf16(s[0 * 33], s[1 * 33]); o.y = cvt_pk_bf16(s[2 * 33], s[3 * 33]); o.z = cvt_pk_bf16(s[4 * 33], s[5 * 33]); o.w = cvt_pk_bf16(s[6 * 33], s[7 * 33]);
        *(u32x4*)(WT + (size_t)(p0 + n) * K + k0 + 8 * c) = o; }
    asm volatile("s_waitcnt lgkmcnt(0)" ::: "memory");
}
__device__ __forceinline__ int colmap_in(int p) {
    const int pn = p >> 8, pl = p & 255, bj = pl >> 7, q = pl & 127;
    if (pn >= 8 && pn < 12) return (bj ? 2560 : 2048) + (pn - 8) * 128 + q;
    const int type = pn >> 1;
    return type * 512 + ((pn & 1) * 2 + (q >> 6)) * 128 + bj * 64 + (q & 63);
}
__device__ __forceinline__ int colmap_up(int p) { const int pn = p >> 8, pl = p & 255, bj = pl >> 7, q = pl & 127; return bj * DFF + 128 * pn + q; }

__device__ __forceinline__ void phase_prep(const Args& A, LAS unsigned char* lds, int wave, int lane) {
    unsigned char* ws = A.ws;
    const int G = gridDim.x, gw = blockIdx.x * NWAVES + wave, NGW = G * NWAVES;
    LAS float* scr = (LAS float*)(lds + wave * 8704);
    bf16_t* WinT = (bf16_t*)(ws + WS_WIN); bf16_t* WoutT = (bf16_t*)(ws + WS_WOUT); bf16_t* WupT = (bf16_t*)(ws + WS_WUP); bf16_t* WdT = (bf16_t*)(ws + WS_WD);
    constexpr int I_IN = 16 * 128, I_OUT = 16 * 32, I_UP = 16 * 176, I_DN = 44 * 32, NITEMS = I_IN + I_OUT + I_UP + I_DN;
    for (int it = gw; it < NITEMS; it += NGW) {
        int r = it;
        if (r < I_IN) { const int kb = r / 128, pb = r % 128; transpose_item(A.in[5], DM, INC, WinT, A.in[10], scr, 64 * kb, 32 * pb, colmap_in(32 * pb), lane); continue; } r -= I_IN;
        if (r < I_OUT) { const int kb = r / 32, pb = r % 32; transpose_item(A.in[9], DM, DM, WoutT, nullptr, scr, 64 * kb, 32 * pb, 32 * pb, lane); continue; } r -= I_OUT;
        if (r < I_UP) { const int kb = r / 176, pb = r % 176; transpose_item(A.in[12], DM, UPC, WupT, A.in[11], scr, 64 * kb, 32 * pb, colmap_up(32 * pb), lane); continue; } r -= I_UP;
        { const int kb = r / 32, pb = r % 32; transpose_item(A.in[15], DFF, DM, WdT, nullptr, scr, 64 * kb, 32 * pb, 32 * pb, lane); }
    }
    bf16_t* XB = (bf16_t*)(ws + WS_XB);
    for (int m0 = gw; m0 < TT; m0 += 4 * NGW) {
        f32x4 v[4][4];
#pragma unroll
        for (int q = 0; q < 4; ++q) {
            const int m = m0 + q * NGW;
            if (m < TT) {
                const float* xrow = m < TP ? A.in[0] + (size_t)m * DM : A.in[1] + (size_t)(m - TP) * DM;
                const f32x4* xr = (const f32x4*)xrow + lane;
#pragma unroll
                for (int j = 0; j < 4; ++j) v[q][j] = __builtin_nontemporal_load(xr + 64 * j);
            }
        }
#pragma unroll
        for (int q = 0; q < 4; ++q) {
            const int m = m0 + q * NGW;
            if (m < TT) {
                float s = 0.f;
#pragma unroll
                for (int j = 0; j < 4; ++j) s += (v[q][j][0] * v[q][j][0] + v[q][j][1] * v[q][j][1]) + (v[q][j][2] * v[q][j][2] + v[q][j][3] * v[q][j][3]);
                const float rs = 1.0f / sqrtf(wave_sum(s) * (1.0f / DM) + EPS);
                u32x2* o8 = (u32x2*)(XB + (size_t)m * DM) + lane;
#pragma unroll
                for (int j = 0; j < 4; ++j) { u32x2 w; w.x = cvt_pk_bf16(v[q][j][0] * rs, v[q][j][1] * rs); w.y = cvt_pk_bf16(v[q][j][2] * rs, v[q][j][3] * rs); o8[64 * j] = w; }
            }
        }
    }
    f32x2* rope = (f32x2*)(ws + WS_ROPE);
    const int gt = blockIdx.x * NTHREADS + threadIdx.x, NGT = G * NTHREADS;
    for (int i = gt; i < SEQ * 64; i += NGT) {
        const int pos = i >> 6, d = i & 63;
        const float inv = 1.0f / powf(10000.0f, (float)d * (1.0f / 64.0f));
        const float ang = (float)pos * inv;
        float sn, cs; sn = sinf(ang); cs = cosf(ang);
        rope[i] = (f32x2){cs, sn};
    }
    if (gt < HW) { const float l0 = A.in[8][gt], l1 = A.in[8][HW + gt]; ((float*)(ws + WS_LB))[gt] = 1.0f / (1.0f + __expf(l1 - l0)); }
    bf16_t* X1B = (bf16_t*)(ws + WS_X1B); (void)X1B;
}

template <bool HG>
__device__ __forceinline__ void sample_mixer_cols(const bf16_t* Q, const bf16_t* Kx, const float* Gf, const bf16_t* V, float* O, const float* st_in, float* st_out, int id) {
    const int tid = threadIdx.x, part = tid & 15, dpi = tid >> 4;
    const int seq = id >> 3, head = (id >> 1) & 3, dv0 = (id & 1) * 64 + 2 * dpi;
    const float* si = st_in + (size_t)(seq * 4 + head) * 16384 + dv0; float* so = st_out + (size_t)(seq * 4 + head) * 16384 + dv0;
    float S[2][8];
#pragma unroll
    for (int i = 0; i < 8; ++i) { const f32x2 t = *(const f32x2*)(si + (size_t)(part * 8 + i) * 128); S[0][i] = t[0]; S[1][i] = t[1]; }
    const int row0 = TP + seq * 16, ck = head * 128 + part * 8;
    const float gamma = 1.0f - exp2f(-5.0f - (float)head);
    const size_t hb = pofs(head, 0); const int pk8 = part * 8;
    constexpr int U = 2;
    u32x4 q8[2][U], k8[2][U]; f32x4 g0[2][U], g1[2][U]; unsigned vv[2][U];
#define SM_LOAD(set, t0_) do { _Pragma("unroll") for (int u = 0; u < U; ++u) { \
        const size_t r = (size_t)(row0 + (t0_) + u) * HW; const size_t rp_ = hb + (size_t)(row0 + (t0_) + u) * 128; q8[set][u] = *(const u32x4*)(Q + rp_ + pk8); \
        if (HG) { g0[set][u] = *(const f32x4*)(Gf + r + ck); g1[set][u] = *(const f32x4*)(Gf + r + ck + 4); } else k8[set][u] = *(const u32x4*)(Kx + rp_ + pk8); \
        vv[set][u] = *(const unsigned*)(V + rp_ + dv0); } } while (0)
    SM_LOAD(0, 0);
#pragma unroll 1
    for (int t0 = 0; t0 < 16; t0 += 2 * U) {
#pragma unroll
        for (int set = 0; set < 2; ++set) {
            const int tb = t0 + set * U;
            { const int tn = (tb + U < 16) ? tb + U : 16 - U; if (set == 0) SM_LOAD(1, tn); else SM_LOAD(0, tn); }
#pragma unroll
            for (int u = 0; u < U; ++u) {
                const float v0 = __uint_as_float(vv[set][u] << 16), v1 = __uint_as_float(vv[set][u] & 0xffff0000u);
                float qf[8], kf[8], df[8];
                const unsigned qa[4] = {q8[set][u].x, q8[set][u].y, q8[set][u].z, q8[set][u].w};
#pragma unroll
                for (int i = 0; i < 4; ++i) { qf[2 * i] = __uint_as_float(qa[i] << 16); qf[2 * i + 1] = __uint_as_float(qa[i] & 0xffff0000u); }
                if (HG) {
#pragma unroll
                    for (int i = 0; i < 4; ++i) { df[i] = g0[set][u][i]; df[4 + i] = g1[set][u][i]; }
#pragma unroll
                    for (int i = 0; i < 8; ++i) kf[i] = 1.0f - df[i];
                } else {
                    const unsigned ka[4] = {k8[set][u].x, k8[set][u].y, k8[set][u].z, k8[set][u].w};
#pragma unroll
                    for (int i = 0; i < 4; ++i) { kf[2 * i] = __uint_as_float(ka[i] << 16); kf[2 * i + 1] = __uint_as_float(ka[i] & 0xffff0000u); }
#pragma unroll
                    for (int i = 0; i < 8; ++i) df[i] = gamma;
                }
                float p0 = 0.f, p1 = 0.f;
#pragma unroll
                for (int i = 0; i < 8; ++i) { S[0][i] = df[i] * S[0][i] + kf[i] * v0; p0 += qf[i] * S[0][i]; S[1][i] = df[i] * S[1][i] + kf[i] * v1; p1 += qf[i] * S[1][i]; }
                p0 += dpp_f<0x128>(0.f, p0); p0 += dpp_f<0x124>(0.f, p0); p0 += dpp_f<0x122>(0.f, p0); p0 += dpp_f<0x121>(0.f, p0);
                p1 += dpp_f<0x128>(0.f, p1); p1 += dpp_f<0x124>(0.f, p1); p1 += dpp_f<0x122>(0.f, p1); p1 += dpp_f<0x121>(0.f, p1);
                if (part == 0) *(f32x2*)(O + (size_t)(row0 + tb + u) * DM + (HG ? HW : 0) + head * 128 + dv0) = (f32x2){p0, p1};
            }
        }
    }
#undef SM_LOAD
#pragma unroll
    for (int i = 0; i < 8; ++i) *(f32x2*)(so + (size_t)(part * 8 + i) * 128) = (f32x2){S[0][i], S[1][i]};
}
__device__ __forceinline__ void phase_mixer_sample(const Args& A) {
    unsigned char* ws = A.ws;
    const bf16_t* QR = (const bf16_t*)(ws + WS_QR); const bf16_t* KR = (const bf16_t*)(ws + WS_KR); const bf16_t* VR = (const bf16_t*)(ws + WS_VR);
    const bf16_t* HQ = (const bf16_t*)(ws + WS_HQ); const bf16_t* HI = (const bf16_t*)(ws + WS_HI);
    const float* HGFv = (const float*)(ws + WS_HGFS) - (size_t)TP * HW;
    float* O = A.out + O_Y;
    const int G = gridDim.x;
    for (int it = blockIdx.x; it < 256; it += G) {
        if (it >> 7) sample_mixer_cols<true>(HQ, nullptr, HGFv, HI, O, A.in[3], A.out + O_HGS, it & 127);
        else sample_mixer_cols<false>(QR, KR, nullptr, VR, O, A.in[2], A.out + O_RETS, it & 127);
    }
}

typedef short s16x4 __attribute__((ext_vector_type(4)));
__device__ __forceinline__ bf16x8 tr2(LAS unsigned char* p0, LAS unsigned char* p1) {
    const s16x4 a = __builtin_amdgcn_ds_read_tr16_b64_v4i16((LAS s16x4*)p0);
    const s16x4 b = __builtin_amdgcn_ds_read_tr16_b64_v4i16((LAS s16x4*)p1);
    return __builtin_shufflevector(a, b, 0, 1, 2, 3, 4, 5, 6, 7);
}
#define MFMA16(a, b, c) __builtin_amdgcn_mfma_f32_16x16x32_bf16((a), (b), (c), 0, 0, 0)

constexpr int M1_KSTR = 144, M1_VSTR = 72, M1_KSZ = 64 * M1_KSTR, M1_CH = M1_KSZ + 64 * M1_VSTR, M1_BUF = 2 * M1_CH;
__device__ __forceinline__ void m1_item(const bf16_t* Kt, const bf16_t* V, const float* DECp, bf16_t* ST, float* state_out, int seq, int head, int slice, float gamma64,
                                        LAS unsigned char* lds, int w, int lane, const int pmode = 0) {
    const int tid = threadIdx.x, fr = lane & 15, g = lane >> 4, r4 = fr >> 2, c4 = fr & 3;
    const int dkh = slice >> 2, dvq = slice & 3, tk = w >> 1, tv = w & 1;
    const size_t rbase = (size_t)seq * SEQ;
    const int cb = head * 128;
    const bool vld = tid < 256;
    const bf16_t* kp = Kt + pofs(head, rbase + (tid >> 3)) + dkh * 64 + (tid & 7) * 8;
    const bf16_t* vp = V + pofs(head, rbase + (tid >> 2)) + dvq * 32 + (tid & 3) * 8;
    const int kwo = (tid >> 3) * M1_KSTR + (tid & 7) * 16, vwo = M1_KSZ + (tid >> 2) * M1_VSTR + (tid & 3) * 16;
    const int dv = dvq * 32 + tv * 16 + fr, dk0 = dkh * 64 + 16 * tk + 4 * g;
    const float* dp = DECp ? DECp + (size_t)(seq * 64) * HW + cb + dk0 : nullptr;
    u32x4 rk0[8], rv[8]; f32x4 rd[8];
#define M1_LOAD(slot, n_) do { const size_t o_ = (size_t)(n_) * 64 * 128; rk0[slot] = *(const u32x4*)(kp + o_); \
        rv[slot] = vld ? *(const u32x4*)(vp + o_) : (u32x4){0u, 0u, 0u, 0u}; rd[slot] = dp ? *(const f32x4*)(dp + (size_t)(n_) * HW) : (f32x4){gamma64, gamma64, gamma64, gamma64}; } while (0)
#define M1_WRITE(slot, off_) do { LAS unsigned char* nb_ = lds + (off_); *(LAS u32x4*)(nb_ + kwo) = rk0[slot]; \
        if (vld) { *(LAS u32x2*)(nb_ + vwo) = (u32x2){rv[slot].x, rv[slot].y}; *(LAS u32x2*)(nb_ + vwo + 8) = (u32x2){rv[slot].z, rv[slot].w}; } } while (0)
    M1_LOAD(0, 0); M1_LOAD(1, 1); M1_LOAD(2, 2); M1_LOAD(3, 3); M1_LOAD(4, 4); M1_LOAD(5, 5); M1_LOAD(6, 6); M1_LOAD(7, 7);
    M1_WRITE(0, 0); M1_WRITE(1, M1_CH);
    __syncthreads();
    f32x4 acc = (f32x4){0.f, 0.f, 0.f, 0.f};
    for (int s0 = 0; s0 < 32; s0 += 4) {
#pragma unroll
        for (int u = 0; u < 4; ++u) {
            const int n = 2 * (s0 + u);
            LAS unsigned char* buf = lds + (u & 1) * M1_BUF;
            const f32x4 dec0 = rd[2 * u], dec1 = rd[2 * u + 1];
            { const int na = (n + 8 < 64) ? n + 8 : 62; M1_LOAD(2 * u, na); M1_LOAD(2 * u + 1, na + 1); }
#pragma unroll
            for (int h = 0; h < 2; ++h) {
                if (!(pmode & 1)) { u32x2 sv; sv.x = cvt_pk_bf16(acc[0], acc[1]); sv.y = cvt_pk_bf16(acc[2], acc[3]);
                  st8b(ST, ST + ((size_t)((seq * 64 + n + h) * 4 + head) * 128 + dv) * 128 + dk0, sv); }
#pragma unroll
                for (int ks = 0; ks < 2; ++ks) if (!(pmode & 2)) {
                    LAS unsigned char* ka = buf + h * M1_CH + (32 * ks + 8 * g + r4) * M1_KSTR + 32 * tk + 8 * c4;
                    LAS unsigned char* va = buf + h * M1_CH + M1_KSZ + (32 * ks + 8 * g + r4) * M1_VSTR + 32 * tv + 8 * c4;
                    const bf16x8 af = tr2(ka, ka + 4 * M1_KSTR), bfv = tr2(va, va + 4 * M1_VSTR);
                    acc = MFMA16(af, bfv, acc);
                }
                acc = acc * (h ? dec1 : dec0);
            }
            if (!(pmode & 8)) { M1_WRITE(2 * ((u + 1) & 3), ((u + 1) & 1) * M1_BUF); M1_WRITE(2 * ((u + 1) & 3) + 1, ((u + 1) & 1) * M1_BUF + M1_CH); }
            if (!(pmode & 4)) __syncthreads();
        }
    }
#undef M1_LOAD
#undef M1_WRITE
    if (!pmode) {
#pragma unroll
        for (int j = 0; j < 4; ++j) state_out[(size_t)(dk0 + j) * 128 + dv] = acc[j];
    } else asm volatile("" :: "v"(acc));
}
__device__ __forceinline__ void phase_m1(const Args& A, LAS unsigned char* lds, int w, int lane, const bool dup = false) {
    unsigned char* ws = A.ws;
    bf16_t* STb = (bf16_t*)(A.out + O_Y);
    const int G = gridDim.x;
    const int vcu = (G % 8 == 0) ? (int)(blockIdx.x % 8) * (G / 8) + (int)(blockIdx.x / 8) : (int)blockIdx.x;
    for (int it = vcu; it < 256 && !((PROBE & 4096) && dup); it += G) {
        const int mixer = it >> 7, seq = (it >> 5) & 3, head = (it >> 3) & 3, slice = it & 7;
        const float gam = 1.0f - exp2f(-5.0f - (float)head);
        const float g64 = exp2f(64.0f * __log2f(gam));
        float* sout = A.out + (mixer ? O_HGP : O_RETP) + (size_t)(seq * 4 + head) * 16384;
        bf16_t* ST = STb + (size_t)mixer * 256 * 4 * 16384;
        const int pm_ = dup ? ((PROBE >> 14) & 15) : 0;
        if (mixer) m1_item((const bf16_t*)(ws + WS_HK), (const bf16_t*)(ws + WS_HI), (const float*)(ws + WS_DEC), ST, sout, seq, head, slice, 0.f, lds, w, lane, pm_);
        else m1_item((const bf16_t*)(ws + WS_KR), (const bf16_t*)(ws + WS_VR), nullptr, ST, sout, seq, head, slice, g64, lds, w, lane, pm_);
        __syncthreads();
    }
    if (!(PROBE & 8192) || !dup) phase_mixer_sample(A);
}

constexpr int M2_VSTR = 272, M2_VBUF = 64 * M2_VSTR, M2_EXCH = 8 * M2_VBUF;
__device__ __forceinline__ void m2_item(const Args& A, int seq, int n, LAS unsigned char* lds, int w, int lane) {
    unsigned char* ws = A.ws;
    int fr = lane & 15, g = lane >> 4; asm volatile("" : "+v"(fr), "+v"(g));
    const int r4 = fr >> 2, c4 = fr & 3;
    const int mixer = w >> 2, head = w & 3, cb = head * 128;
    const bf16_t* Q = (const bf16_t*)(ws + (mixer ? WS_HQ : WS_QR)); const bf16_t* K = (const bf16_t*)(ws + (mixer ? WS_HK : WS_KR));
    const bf16_t* V = (const bf16_t*)(ws + (mixer ? WS_HI : WS_VR)); const bf16_t* GT = (const bf16_t*)(ws + (mixer ? WS_HGT : WS_GR));
    const float* gain = A.in[mixer ? 7 : 6] + cb;
    const size_t r0 = (size_t)seq * SEQ + 64 * n;
    const bf16_t* ST = (const bf16_t*)(A.out + O_Y) + ((size_t)(mixer * 256 + seq * 64 + n) * 4 + head) * 16384;
    bf16_t* MG = (bf16_t*)(ws + WS_XB);
    LAS unsigned char* vb = lds + w * M2_VBUF;
    const bf16_t* qp = Q + pofs(head, r0 + fr) + 8 * g; const bf16_t* kp = K + pofs(head, r0 + fr) + 8 * g;
    u32x4 vr[16];
#pragma unroll
    for (int i = 0; i < 16; ++i) vr[i] = __builtin_nontemporal_load((const u32x4*)(V + pofs(head, r0 + 4 * i + g) + fr * 8));
    bf16x8 qf[4][4], kf[4][4];
#pragma unroll
    for (int ks = 0; ks < 4; ++ks)
#pragma unroll
        for (int t = 0; t < 4; ++t) { qf[ks][t] = *(const bf16x8*)(qp + (size_t)(16 * t) * 128 + 32 * ks); kf[ks][t] = *(const bf16x8*)(kp + (size_t)(16 * t) * 128 + 32 * ks); }
#pragma unroll
    for (int i = 0; i < 16; ++i) *(LAS u32x4*)(vb + (4 * i + g) * M2_VSTR + fr * 16) = vr[i];
    f32x4 X[4][4];
#pragma unroll
    for (int a = 0; a < 4; ++a)
#pragma unroll
        for (int b = 0; b < 4; ++b) X[a][b] = (f32x4){0.f, 0.f, 0.f, 0.f};
#pragma unroll
    for (int ks = 0; ks < 4; ++ks)
#pragma unroll
        for (int jt = 0; jt < 4; ++jt)
#pragma unroll
            for (int it = jt; it < 4; ++it) X[jt][it] = MFMA16(kf[ks][jt], qf[ks][it], X[jt][it]);
    bf16x8 PB[4][2];
#pragma unroll
    for (int it = 0; it < 4; ++it)
#pragma unroll
        for (int s2 = 0; s2 < 2; ++s2) {
            float v[8];
#pragma unroll
            for (int e = 0; e < 8; ++e) {
                const int jt = 2 * s2 + (e >> 2);
                float x = 0.f;
                if (jt < it) x = X[jt][it][e & 3];
                else if (jt == it) x = (fr >= 4 * g + (e & 3)) ? X[jt][it][e & 3] : 0.f;
                v[e] = x;
            }
            u32x4 wv; wv.x = cvt_pk_bf16(v[0], v[1]); wv.y = cvt_pk_bf16(v[2], v[3]); wv.z = cvt_pk_bf16(v[4], v[5]); wv.w = cvt_pk_bf16(v[6], v[7]);
            PB[it][s2] = __builtin_bit_cast(bf16x8, wv);
        }
    const bf16_t* sp = ST + (size_t)fr * 128 + 8 * g;
    bf16x8 sa0[2][4];
#pragma unroll
    for (int k2 = 0; k2 < 2; ++k2)
#pragma unroll
        for (int d = 0; d < 4; ++d) sa0[k2][d] = *(const bf16x8*)(sp + (size_t)(16 * d) * 128 + 32 * k2);
    f32x4 O[8][4];
#pragma unroll
    for (int a = 0; a < 8; ++a)
#pragma unroll
        for (int b = 0; b < 4; ++b) O[a][b] = (f32x4){0.f, 0.f, 0.f, 0.f};
#pragma unroll
    for (int s2 = 0; s2 < 2; ++s2)
#pragma unroll
        for (int dh = 0; dh < 2; ++dh) {
            bf16x8 vt[4];
#pragma unroll
            for (int d = 0; d < 4; ++d) { LAS unsigned char* pa = vb + (32 * s2 + 4 * g + r4) * M2_VSTR + 32 * (4 * dh + d) + 8 * c4; vt[d] = tr2(pa, pa + 16 * M2_VSTR); }
#pragma unroll
            for (int it = 2 * s2; it < 4; ++it)
#pragma unroll
                for (int d = 0; d < 4; ++d) O[4 * dh + d][it] = MFMA16(vt[d], PB[it][s2], O[4 * dh + d][it]);
            asm volatile("" ::: "memory");
        }
#pragma unroll
    for (int dh = 0; dh < 2; ++dh)
#pragma unroll
        for (int kp2 = 0; kp2 < 2; ++kp2) {
            bf16x8 qg[2][4], sa[2][4];
#pragma unroll
            for (int k2 = 0; k2 < 2; ++k2) {
#pragma unroll
                for (int t = 0; t < 4; ++t) qg[k2][t] = *(const bf16x8*)(qp + (size_t)(16 * t) * 128 + 32 * (2 * kp2 + k2));
#pragma unroll
                for (int d = 0; d < 4; ++d) sa[k2][d] = (dh == 0 && kp2 == 0) ? sa0[k2][d] : *(const bf16x8*)(sp + (size_t)(16 * (4 * dh + d)) * 128 + 32 * (2 * kp2 + k2));
            }
#pragma unroll
            for (int k2 = 0; k2 < 2; ++k2)
#pragma unroll
                for (int d = 0; d < 4; ++d)
#pragma unroll
                    for (int it = 0; it < 4; ++it) O[4 * dh + d][it] = MFMA16(sa[k2][d], qg[k2][it], O[4 * dh + d][it]);
            asm volatile("" ::: "memory");
        }
    u32x2 gtr[4][8];
#pragma unroll
    for (int it = 0; it < 4; ++it)
#pragma unroll
        for (int d = 0; d < 8; ++d) gtr[it][d] = *(const u32x2*)(GT + pofs(head, r0 + 16 * it + fr) + 4 * g + 16 * d);
    float rs[4];
    LAS float* exch = (LAS float*)(lds + M2_EXCH);
#pragma unroll
    for (int it = 0; it < 4; ++it) {
        float ss = 0.f;
#pragma unroll
        for (int d = 0; d < 8; ++d) ss += (O[d][it][0] * O[d][it][0] + O[d][it][1] * O[d][it][1]) + (O[d][it][2] * O[d][it][2] + O[d][it][3] * O[d][it][3]);
        ss += __shfl_xor(ss, 16); ss += __shfl_xor(ss, 32);
        rs[it] = ss;
        if (mixer && g == 0) exch[(16 * it + fr) * 4 + head] = ss;
    }
    __syncthreads();
#pragma unroll
    for (int it = 0; it < 4; ++it) {
        if (mixer) { const f32x4 e = *(LAS f32x4*)(exch + (16 * it + fr) * 4); rs[it] = 1.0f / sqrtf(((e[0] + e[1]) + (e[2] + e[3])) * (1.0f / 512.0f) + EPS); }
        else rs[it] = 1.0f / sqrtf(rs[it] * (1.0f / 128.0f) + EPS);
    }
#pragma unroll
    for (int it = 0; it < 4; ++it) {
        int rowi = 16 * it + fr; asm volatile("" : "+v"(rowi));
        const size_t row = r0 + rowi;
        bf16_t* mgp = MG + row * DM + mixer * HW + cb + 4 * g;
        const float rsi = rs[it];
#pragma unroll
        for (int d = 0; d < 8; ++d) {
            const f32x4 gn = *(const f32x4*)(gain + 16 * d + 4 * g);
            const u32x2 gt = gtr[it][d];
            const float g0 = silu_f(__uint_as_float(gt.x << 16)), g1 = silu_f(__uint_as_float(gt.x & 0xffff0000u)), g2 = silu_f(__uint_as_float(gt.y << 16)), g3 = silu_f(__uint_as_float(gt.y & 0xffff0000u));
            const f32x4 o = O[d][it] * rsi * gn;
            u32x2 wv; wv.x = cvt_pk_bf16(o[0] * g0, o[1] * g1); wv.y = cvt_pk_bf16(o[2] * g2, o[3] * g3);
            st8b(MG, mgp + 16 * d, wv);
        }
    }
}
__device__ __forceinline__ void phase_normgate_sample(const Args& A, int wave, int lane) {
    unsigned char* ws = A.ws;
    const float* O = A.out + O_Y;
    const bf16_t* GR = (const bf16_t*)(ws + WS_GR); const bf16_t* HGT = (const bf16_t*)(ws + WS_HGT);
    bf16_t* MG = (bf16_t*)(ws + WS_XB);
    const int gw = blockIdx.x * NWAVES + wave, NGW = gridDim.x * NWAVES;
    const bool hg = lane >= 32; const int c0 = lane * 16;
    const float* gain = hg ? A.in[7] + (c0 - HW) : A.in[6] + c0;
    f32x4 gn[4];
#pragma unroll
    for (int j = 0; j < 4; ++j) gn[j] = *(const f32x4*)(gain + 4 * j);
    for (int m = TP + gw; m < TT; m += NGW) {
        const f32x4* orow = (const f32x4*)(O + (size_t)m * DM + c0);
        f32x4 v[4]; float s = 0.f;
#pragma unroll
        for (int j = 0; j < 4; ++j) { v[j] = orow[j]; s += (v[j][0] * v[j][0] + v[j][1] * v[j][1]) + (v[j][2] * v[j][2] + v[j][3] * v[j][3]); }
        s += __shfl_xor(s, 1); s += __shfl_xor(s, 2); s += __shfl_xor(s, 4);
        float s2 = s; s2 += __shfl_xor(s2, 8); s2 += __shfl_xor(s2, 16);
        const float rs = hg ? 1.0f / sqrtf(s2 * (1.0f / 512.0f) + EPS) : 1.0f / sqrtf(s * (1.0f / 128.0f) + EPS);
        const bf16_t* gp = (hg ? HGT + pofs((c0 - HW) >> 7, m) + ((c0 - HW) & 127) : GR + pofs(c0 >> 7, m) + (c0 & 127));
        const u32x4 ga = *(const u32x4*)gp, gb = *(const u32x4*)(gp + 8);
        const unsigned gw_[8] = {ga.x, ga.y, ga.z, ga.w, gb.x, gb.y, gb.z, gb.w};
        float o[16];
#pragma unroll
        for (int i = 0; i < 8; ++i) { const float g0 = silu_f(__uint_as_float(gw_[i] << 16)), g1 = silu_f(__uint_as_float(gw_[i] & 0xffff0000u));
            o[2 * i] = v[(2 * i) >> 2][(2 * i) & 3] * rs * gn[(2 * i) >> 2][(2 * i) & 3] * g0; o[2 * i + 1] = v[(2 * i + 1) >> 2][(2 * i + 1) & 3] * rs * gn[(2 * i + 1) >> 2][(2 * i + 1) & 3] * g1; }
        u32x4 w0, w1;
        w0.x = cvt_pk_bf16(o[0], o[1]); w0.y = cvt_pk_bf16(o[2], o[3]); w0.z = cvt_pk_bf16(o[4], o[5]); w0.w = cvt_pk_bf16(o[6], o[7]);
        w1.x = cvt_pk_bf16(o[8], o[9]); w1.y = cvt_pk_bf16(o[10], o[11]); w1.z = cvt_pk_bf16(o[12], o[13]); w1.w = cvt_pk_bf16(o[14], o[15]);
        bf16_t* mp = MG + (size_t)m * DM + c0;
        *(u32x4*)mp = w0; *(u32x4*)(mp + 8) = w1;
    }
}
__device__ __forceinline__ void phase_m2(const Args& A, LAS unsigned char* lds, int w, int lane) {
    const int G = gridDim.x;
    const int vcu = (G % 8 == 0) ? (int)(blockIdx.x % 8) * (G / 8) + (int)(blockIdx.x / 8) : (int)blockIdx.x;
    for (int it = vcu; it < 256; it += G) { m2_item(A, it >> 6, it & 63, lds, w, lane); __syncthreads(); }
    phase_normgate_sample(A, w, lane);
}
__device__ __forceinline__ void phase_final(const Args& A, int wave, int lane) {
    const float* SS3 = (const float*)(A.ws + WS_SS3);
    const int gw = blockIdx.x * NWAVES + wave, NGW = gridDim.x * NWAVES;
    f32x4 gn[4];
#pragma unroll
    for (int j = 0; j < 4; ++j) gn[j] = ((const f32x4*)A.in[16])[lane + 64 * j];
    for (int m = gw; m < TP; m += NGW) {
        float p = lane < 16 ? SS3[(size_t)m * 16 + lane] : 0.f;
        p = wave_sum(p);
        const float rs = 1.0f / sqrtf(p * (1.0f / DM) + EPS);
        f32x4* xr = (f32x4*)(A.out + O_Y + (size_t)m * DM) + lane;
#pragma unroll
        for (int j = 0; j < 4; ++j) { f32x4 v = xr[64 * j]; v = v * rs * gn[j]; xr[64 * j] = v; }
    }
}

__global__ void __launch_bounds__(NTHREADS, 2) fwd_kernel(Args args) {
    extern __shared__ __attribute__((aligned(16))) unsigned char lds_raw[];
    LAS unsigned char* lds = (LAS unsigned char*)lds_raw;
    const int tid = threadIdx.x, wave = __builtin_amdgcn_readfirstlane(tid >> 6);
    volatile LAS unsigned* MISC = (volatile LAS unsigned*)(lds + MISC_OFF);
    if (tid < 64) MISC[tid] = 0u;
    __syncthreads();
    unsigned char* ws = args.ws;
    XcdBarrier bar; bar.bar = (unsigned*)(ws + WS_CTL); bar.x = 0; bar.st = nullptr;
    if (N_LAUNCHES == 1) bar = xcd_barrier_post((unsigned*)(ws + WS_CTL), MISC + 8);
    const int lo = args.ph_lo, hi = args.ph_hi;
#define IN(k) (lo <= (k) && (k) < hi)
#define SEAM(k) do { if (IN(k) && IN((k) + 1)) { xcd_barrier(bar); if (PROBE & 256) xcd_barrier(bar); } } while (0)
    const int G = gridDim.x, c = blockIdx.x;

    if (IN(0)) { phase_prep(args, lds, wave, fresh_lane()); if (PROBE & 64) { __syncthreads(); phase_prep(args, lds, wave, fresh_lane()); } } SEAM(0);
    if (IN(1)) {
        pg8::Gemm g{(const bf16_t*)(ws + WS_XB), (const bf16_t*)(ws + WS_WIN), DM}; pg8::StaticOrder S; S.init(64, 16, G, c);
        EpiIn E{ws + WS_PROJ, (float*)(ws + WS_DEC), (float*)(ws + WS_HGFS), (const f32x4*)(ws + WS_ROPE), (const float*)(ws + WS_LB)};
        EpiInT<true> EM{E.proj, E.DEC, E.HGFS, E.rope, E.lb};
        pg8::gemm_phase<EpiInT<true>, false>(lds, g, S, EM);
        pg8::sample_gemm<EpiIn>(lds, g.A + (size_t)TP * DM, g.Bt, DM, 16, 64, E, c, G);
        if (PROBE & 1) pg8::sample_gemm<EpiIn>(lds, g.A + (size_t)TP * DM, g.Bt, DM, 16, 64, E, c, G);
        if (PROBE & 2) { pg8::gemm_phase<EpiInT<true>, false>(lds, g, S, EM); }
    } SEAM(1);
    if (IN(2)) { phase_m1(args, lds, wave, fresh_lane()); if (PROBE & (16 | 4096 | 8192)) { __syncthreads(); phase_m1(args, lds, wave, fresh_lane(), true); } } SEAM(2);
    if (IN(3)) { phase_m2(args, lds, wave, fresh_lane()); if (PROBE & 32) { __syncthreads(); phase_m2(args, lds, wave, fresh_lane()); } } SEAM(3);
    if (IN(4)) {
        { bf16_t* X1B = (bf16_t*)(ws + WS_X1B); const int gt = c * NTHREADS + tid;
          if (gt < 4 * 256) { const int b = gt >> 8, w = gt & 255; ((u32x4*)(X1B + (size_t)(4098 * b) * DM))[w] = (u32x4){0u, 0u, 0u, 0u}; } }
        pg8::Gemm g{(const bf16_t*)(ws + WS_XB), (const bf16_t*)(ws + WS_WOUT), DM}; pg8::StaticOrder S; S.init(64, 4, G, c);
        EpiOut E{args.in[0], args.in[1], args.out + O_Y, (bf16_t*)(ws + WS_X1B), (float*)(ws + WS_SS2)};
        pg8::gemm_phase<EpiOut, false>(lds, g, S, E);
        pg8::sample_gemm16<EpiOut>(lds, g.A + (size_t)TP * DM, g.Bt, DM, 4, 64, E, c, G);
        if (PROBE & 1) pg8::sample_gemm<EpiOut>(lds, g.A + (size_t)TP * DM, g.Bt, DM, 4, 64, E, c, G);
        if (PROBE & 4) { pg8::gemm_phase<EpiOut, false>(lds, g, S, E); }
    } SEAM(4);
    if (IN(5)) {
        pg8::Gemm g{(const bf16_t*)(ws + WS_X1B), (const bf16_t*)(ws + WS_WUP), DM}; pg8::StaticOrder S; S.init(69, 22, G, c);
        EpiUp E{(const float*)(ws + WS_SS2), args.in[13], args.in[14], args.in[4], (bf16_t*)(ws + WS_ACT), args.out + O_CCP, args.out + O_CCS};
        EpiUpMain EM{E.SS2, E.ck, E.cb, E.cache_in, E.ACT, E.ccp, E.ccs};
        pg8::gemm_phase<EpiUpMain, true>(lds, g, S, EM);
        if (PROBE & 8) { pg8::gemm_phase<EpiUpMain, true>(lds, g, S, EM); }
    } SEAM(5);
    if (IN(6)) {
        pg8::Gemm g{(const bf16_t*)(ws + WS_ACT), (const bf16_t*)(ws + WS_WD), DFF}; pg8::StaticOrder S; S.init(64, 4, G, c);
        EpiDownT<true> E{args.out + O_Y, (const bf16_t*)(ws + WS_X1B), (float*)(ws + WS_SS3), args.in[16], (float*)(ws + WS_SS3), (unsigned*)(ws + WS_CTL + 32768), lds + RING_BYTES, false};
        EpiDownT<false> Es{args.out + O_Y, (const bf16_t*)(ws + WS_X1B), (float*)(ws + WS_SS3), args.in[16], nullptr, (unsigned*)(ws + WS_CTL + 32768), lds, G == 256};
        if (PROBE & 2048) { EpiNull En; pg8::gemm_phase<EpiNull, false>(lds, g, S, En); }
        if (G == 256) pg8::gemm_phase<EpiDownT<true>, false>(lds, g, S, E);
        else pg8::gemm_phase<EpiDownT<false>, false>(lds, g, S, Es);
        pg8::sample_gemm16<EpiDownT<false>>(lds, g.A + (size_t)TP * DFF, g.Bt, DFF, 4, 64, Es, c, G);
    }
    if (G != 256) {
        SEAM(6);
        if (IN(7)) { phase_final(args, wave, fresh_lane()); }
    }
#undef IN
#undef SEAM
}

extern "C" void kernel_launch(void* const* d_in, const int* in_sizes, int n_in, void* d_out, int out_size, void* d_ws, size_t ws_size, hipStream_t stream) {
    static int grid = 0;
    if (grid == 0) {
        if (n_in != 17 || ws_size < WS_END) { fprintf(stderr, "kernel_launch: unexpected n_in %d or ws_size %zu (need %zu)\n", n_in, ws_size, (size_t)WS_END); grid = -1; return; }
        int dev = 0, cus = 0, per_cu = 0;
        hipGetDevice(&dev); hipDeviceGetAttribute(&cus, hipDeviceAttributeMultiprocessorCount, dev);
        hipFuncSetAttribute((const void*)fwd_kernel, hipFuncAttributeMaxDynamicSharedMemorySize, LDS_BYTES);
        hipOccupancyMaxActiveBlocksPerMultiprocessor(&per_cu, (const void*)fwd_kernel, NTHREADS, LDS_BYTES);
        if (per_cu < 1) { fprintf(stderr, "kernel_launch: occupancy query says %d blocks per CU\n", per_cu); per_cu = 1; }
        (void)hipGetLastError();
        grid = cus;
        if (grid > 256) grid = 256;
        fprintf(stderr, "kernel_launch: cus %d per_cu %d grid %d ws %zu\n", cus, per_cu, grid, ws_size);
    }
    if (grid < 0) return;
    hipMemsetAsync((char*)d_ws + WS_CTL, 0, 65536, stream);
    Args a{};
    for (int i = 0; i < 17; ++i) a.in[i] = (const float*)d_in[i];
    a.out = (float*)d_out; a.ws = (unsigned char*)d_ws;
    if (N_LAUNCHES == 1) {
        a.ph_lo = 0; a.ph_hi = 8;
        void* kargs[] = {&a};
#if PROBE & 1024
        hipLaunchKernelGGL(fwd_kernel, dim3(grid), dim3(NTHREADS), LDS_BYTES, stream, a); hipError_t e = hipSuccess; (void)kargs;
#else
        hipError_t e = hipLaunchCooperativeKernel((const void*)fwd_kernel, dim3(grid), dim3(NTHREADS), kargs, LDS_BYTES, stream);
#endif
        if (e != hipSuccess) fprintf(stderr, "cooperative launch failed: %s (grid %d)\n", hipGetErrorString(e), grid);
    } else {
        for (int p = 0; p < 8; ++p) { a.ph_lo = p; a.ph_hi = p + 1; hipLaunchKernelGGL(fwd_kernel, dim3(grid), dim3(NTHREADS), LDS_BYTES, stream, a); }
    }
}
```

```cpp
#include <hip/hip_runtime.h>
#include <cstdio>
#include <cstdint>

#ifndef PROBE
#define PROBE 0
#endif
#ifndef N_LAUNCHES
#define N_LAUNCHES 1
#endif

#define LAS __attribute__((address_space(3)))
typedef unsigned short bf16_t;
typedef short bf16x8 __attribute__((ext_vector_type(8)));
typedef float f32x4 __attribute__((ext_vector_type(4)));
typedef float f32x2 __attribute__((ext_vector_type(2)));
typedef unsigned u32x4 __attribute__((ext_vector_type(4)));
typedef unsigned u32x2 __attribute__((ext_vector_type(2)));

constexpr int DM = 1024, TP = 16384, TS = 256, TT = TP + TS, SEQ = 4096;
constexpr int DFF = 2816, UPC = 5632, INC = 4096, HW = 512;
constexpr float EPS = 1e-6f;
constexpr int NTHREADS = 512, NWAVES = 8;
constexpr int LDS_BYTES = 163840;
constexpr int RING_BYTES = 131072;
constexpr int MISC_OFF = LDS_BYTES - 256;

constexpr size_t O_Y = 0, O_RETP = 17039360, O_HGP = 17301504, O_CCP = 17563648, O_RETS = 17586176, O_HGS = 18634752, O_CCS = 19683328;

constexpr size_t WS_CTL = 0;
constexpr size_t WS_WIN = 65536;
constexpr size_t WS_WOUT = WS_WIN + (size_t)INC * DM * 2;
constexpr size_t WS_WUP = WS_WOUT + (size_t)DM * DM * 2;
constexpr size_t WS_WD = WS_WUP + (size_t)UPC * DM * 2;
constexpr size_t WS_ROPE = WS_WD + (size_t)DM * DFF * 2;
constexpr size_t WS_LB = WS_ROPE + (size_t)SEQ * 64 * 8;
constexpr size_t WS_SS2 = WS_LB + 4096;
constexpr size_t WS_SS3 = WS_SS2 + (size_t)TT * 16 * 4;
constexpr size_t WS_XB = WS_SS3 + (size_t)TT * 16 * 4;
constexpr size_t WS_PROJ = WS_XB + (size_t)TT * DM * 2;
constexpr size_t PSZ = (size_t)TT * HW * 2;
constexpr size_t WS_QR = WS_PROJ, WS_KR = WS_PROJ + PSZ, WS_VR = WS_PROJ + 2 * PSZ, WS_GR = WS_PROJ + 3 * PSZ, WS_HQ = WS_PROJ + 4 * PSZ,
                 WS_HK = WS_PROJ + 5 * PSZ, WS_HI = WS_PROJ + 6 * PSZ, WS_HGT = WS_PROJ + 7 * PSZ;
constexpr size_t WS_DEC = WS_PROJ + 8 * PSZ;
constexpr size_t WS_HGFS = WS_DEC + (size_t)256 * HW * 4;
constexpr size_t WS_PROJ_END = WS_HGFS + (size_t)TS * HW * 4;
constexpr int X1B_ROWS = 16896;
constexpr size_t WS_X1B = WS_PROJ;
constexpr size_t WS_ACT = WS_X1B + (size_t)X1B_ROWS * DM * 2;
constexpr size_t WS_ACT_END = WS_ACT + (size_t)TT * DFF * 2;
static_assert(WS_ACT_END <= WS_PROJ_END, "overlay");
constexpr size_t WS_END = WS_PROJ_END;
static_assert(WS_END <= (size_t)256 * 1024 * 1024, "workspace");

__device__ __forceinline__ size_t pofs(int head, size_t row) { return ((size_t)head * TT + row) * 128; }
__device__ __forceinline__ unsigned cvt_pk_bf16(float lo, float hi) { unsigned r; asm volatile("v_cvt_pk_bf16_f32 %0, %1, %2" : "=v"(r) : "v"(lo), "v"(hi)); return r; }
__device__ __forceinline__ int fresh_lane() { int l; asm volatile("v_mbcnt_lo_u32_b32 %0, -1, 0\n\tv_mbcnt_hi_u32_b32 %0, -1, %0" : "=v"(l)); return l; }
__device__ __forceinline__ float bf2f(unsigned short b) { return __uint_as_float(((unsigned)b) << 16); }
__device__ __forceinline__ float sigmoid_f(float x) { return __builtin_amdgcn_rcpf(1.0f + __builtin_amdgcn_exp2f(x * -1.4426950408889634f)); }
__device__ __forceinline__ float silu_f(float x) { return x * sigmoid_f(x); }
#ifndef WT_STORES
#define WT_STORES 0
#endif
__device__ __forceinline__ void st16b(const void* base, void* p, u32x4 v) {
#if WT_STORES == 3
    __builtin_amdgcn_raw_buffer_store_b128(v, __builtin_amdgcn_make_buffer_rsrc((void*)base, 0, 0x7fffffff, 0x00020000), (int)((const char*)p - (const char*)base), 0, 16);
#else
    *(u32x4*)p = v;
#endif
}
__device__ __forceinline__ void st8b(const void* base, void* p, u32x2 v) {
#if WT_STORES == 3
    __builtin_amdgcn_raw_buffer_store_b64(v, __builtin_amdgcn_make_buffer_rsrc((void*)base, 0, 0x7fffffff, 0x00020000), (int)((const char*)p - (const char*)base), 0, 16);
#else
    *(u32x2*)p = v;
#endif
}
__device__ __forceinline__ void st16(void* p, u32x4 v) {
#if WT_STORES == 1
    asm volatile("global_store_dwordx4 %0, %1, off sc1\n\ts_nop 1" :: "v"(p), "v"(v) : "memory");
#elif WT_STORES == 2
    __builtin_nontemporal_store(v, (u32x4*)p);
#else
    *(u32x4*)p = v;
#endif
}
__device__ __forceinline__ void st8(void* p, u32x2 v) {
#if WT_STORES == 1
    asm volatile("global_store_dwordx2 %0, %1, off sc1\n\ts_nop 1" :: "v"(p), "v"(v) : "memory");
#elif WT_STORES == 2
    __builtin_nontemporal_store(v, (u32x2*)p);
#else
    *(u32x2*)p = v;
#endif
}
__device__ __forceinline__ void st16wt(void* p, f32x4 v) { asm volatile("global_store_dwordx4 %0, %1, off sc1\n\ts_nop 1" :: "v"(p), "v"(v) : "memory"); }
__device__ __forceinline__ void st4wt(void* p, float v) { asm volatile("global_store_dword %0, %1, off sc1\n\ts_nop 1" :: "v"(p), "v"(v) : "memory"); }
template <int CTRL> __device__ __forceinline__ float dpp_z(float src) {
    return __builtin_bit_cast(float, __builtin_amdgcn_update_dpp(0, __builtin_bit_cast(int, src), CTRL, 0xF, 0xF, true)); }
template <int CTRL> __device__ __forceinline__ float dpp_f(float oldv, float src) {
    return __builtin_bit_cast(float, __builtin_amdgcn_update_dpp(__builtin_bit_cast(int, oldv), __builtin_bit_cast(int, src), CTRL, 0xF, 0xF, false)); }

#define XB_TMO      128
#define XB_XCNT(j)  (256  + 64 * (j))
#define XB_XSUB(j)  (1280 + 64 * (j))
#define XB_XGEN(j)  (2304 + 64 * (j))
#define XB_TOP      3328
#define XB_TOPGEN   3392
#define XCD_BAR_WORDS 3456
#define XB_SPIN_CAP (1u << 18)
__device__ __forceinline__ unsigned xb_ld(unsigned* p)              { return __hip_atomic_load(p, __ATOMIC_RELAXED, __HIP_MEMORY_SCOPE_AGENT); }
__device__ __forceinline__ unsigned xb_add(unsigned* p, unsigned v) { return __hip_atomic_fetch_add(p, v, __ATOMIC_RELAXED, __HIP_MEMORY_SCOPE_AGENT); }
__device__ __forceinline__ unsigned xb_xcc_id() { return (unsigned)__builtin_amdgcn_s_getreg((3 << 11) | 20) & 0xFu; }
#define XB_SPIN(cond, bar) do { unsigned _sp = 0; while (cond) { __builtin_amdgcn_s_sleep(1); \
    if ((++_sp & 255u) == 0u) { if (xb_ld(&(bar)[XB_TMO])) break; if (_sp > XB_SPIN_CAP) { atomicAdd(&(bar)[XB_TMO], 1u); break; } } } } while (0)
struct XcdBarrier { unsigned* bar; unsigned x; volatile LAS unsigned* st; };
__device__ __forceinline__ XcdBarrier xcd_barrier_post(unsigned* bar, volatile LAS unsigned* st) {
    XcdBarrier b; b.bar = bar; b.x = xb_xcc_id(); b.st = st;
    if (threadIdx.x == 0) (void)xb_add(&bar[XB_XCNT(b.x)], 1u);
    return b;
}
__device__ __forceinline__ void xcd_barrier_complete(unsigned* bar, unsigned x, unsigned& nloc, unsigned& nx) {
    const unsigned G = gridDim.x * gridDim.y * gridDim.z;
    unsigned sum, cnt, mine, sp = 0u;
    for (;;) {
        sum = 0u; cnt = 0u; mine = 0u;
#pragma unroll
        for (unsigned j = 0; j < 16; ++j) { const unsigned c = xb_ld(&bar[XB_XCNT(j)]); sum += c; cnt += (c > 0u) ? 1u : 0u; mine = (j == x) ? c : mine; }
        if (sum == G) break;
        __builtin_amdgcn_s_sleep(1);
        if ((++sp & 255u) == 0u) { if (xb_ld(&bar[XB_TMO])) break; if (sp > XB_SPIN_CAP) { atomicAdd(&bar[XB_TMO], 1u); break; } }
    }
    nloc = mine > 0u ? mine : 1u; nx = cnt > 0u ? cnt : 1u;
}
__device__ __forceinline__ void xcd_barrier(const XcdBarrier& b) {
    asm volatile("s_waitcnt vmcnt(0)" ::: "memory");
    __syncthreads();
    if (threadIdx.x == 0) {
        unsigned* bar = b.bar;
        __builtin_amdgcn_s_waitcnt(0);
        unsigned nloc = b.st[0], nx = b.st[1];
        if (nloc == 0u) { xcd_barrier_complete(bar, b.x, nloc, nx); b.st[0] = nloc; b.st[1] = nx; }
        const unsigned old = xb_add(&bar[XB_XSUB(b.x)], 1u);
        const unsigned gen = old / nloc;
        if (old + 1u == (gen + 1u) * nloc) {
            __builtin_amdgcn_fence(__ATOMIC_RELEASE, "agent");
            asm volatile("s_waitcnt vmcnt(0)" ::: "memory");
            const unsigned og = xb_add(&bar[XB_TOP], 1u);
            const unsigned tg = og / nx;
            if (og + 1u == (tg + 1u) * nx) xb_add(&bar[XB_TOPGEN], 1u);
            else XB_SPIN(xb_ld(&bar[XB_TOPGEN]) == tg, bar);
            __builtin_amdgcn_fence(__ATOMIC_ACQUIRE, "agent");
            xb_add(&bar[XB_XGEN(b.x)], 1u);
            asm volatile("s_waitcnt vmcnt(0)" ::: "memory");
        } else {
            XB_SPIN(xb_ld(&bar[XB_XGEN(b.x)]) == gen, bar);
            __builtin_amdgcn_fence(__ATOMIC_ACQUIRE, "agent");
            asm volatile("s_waitcnt vmcnt(0)" ::: "memory");
        }
    }
    __syncthreads();
}

namespace pg8 {
constexpr int BM = 256, BK = 64, HALF = 128, HTB = HALF * BK * 2, NXCD = 8, WGM = 8;
__host__ __device__ __forceinline__ int lds_byte(int r, int c) { const int st = (r >> 4) * 2 + (c >> 5), rr = r & 15, cc = c & 31, ob = rr * 64 + cc * 2; return st * 1024 + (ob ^ (((ob >> 9) & 1) << 5)); }
__host__ __device__ __forceinline__ void stage_rc(int b, int& R, int& C) { const int st = b / 1024, sb = b % 1024, swz = sb ^ (((sb >> 9) & 1) << 5); R = (st >> 1) * 16 + swz / 64; C = (st & 1) * 32 + (swz % 64) / 2; }
__host__ __device__ __forceinline__ int perm32(int rho) { const int n = rho >> 4, i = rho & 15; return 8 * (i >> 2) + 4 * n + (i & 3); }

struct Unit { int pm, pn; };
struct Gemm { const bf16_t* A; const bf16_t* Bt; int K; };

struct StaticOrder {
    int nM, nN, nwg, G, c;
    __device__ void init(int nM_, int nN_, int G_, int c_) { nM = nM_; nN = nN_; nwg = nM * nN; G = G_; c = c_; }
    __device__ bool next(int i, Unit& u) const {
        const long L = (long)i * G + c; if (L >= nwg) return false;
        int wgid = (int)L; { const int q = nwg / NXCD, r = nwg % NXCD, xcd = wgid % NXCD, off = wgid / NXCD; wgid = (xcd < r ? xcd * (q + 1) : r * (q + 1) + (xcd - r) * q) + off; }
        const int nig = WGM * nN, gid = wgid / nig, fm = gid * WGM, gsz = (nM - fm) < WGM ? (nM - fm) : WGM;
        u.pm = fm + ((wgid % nig) % gsz); u.pn = (wgid % nig) / gsz; return true;
    }
};

struct AInfo { const char* base; size_t hstep; unsigned v0, v1; };
template <bool UPMAP, bool TOK = false>
__device__ __forceinline__ AInfo a_info(const Gemm& g, const Unit& u, int tid) {
    AInfo a; const int K = g.K;
    int R0, C0, R1, C1; stage_rc(tid * 16, R0, C0); stage_rc(tid * 16 + 8192, R1, C1);
    if constexpr (!UPMAP && TOK) {
        R0 = (R0 & 64) | ((R0 & 15) << 2) | ((R0 >> 4) & 3); R1 = (R1 & 64) | ((R1 & 15) << 2) | ((R1 >> 4) & 3);
    }
    if constexpr (!UPMAP) {
        a.base = (const char*)g.A + (size_t)u.pm * 256 * K * 2; a.hstep = (size_t)HALF * K * 2;
        a.v0 = (unsigned)(R0 * K + C0) * 2u; a.v1 = (unsigned)(R1 * K + C1) * 2u;
    } else {
        if (u.pm < 68) {
            const int b = u.pm / 17, j = u.pm % 17;
            a.base = (const char*)g.A + (size_t)(4098 * b + 248 * j) * K * 2; a.hstep = (size_t)124 * K * 2;
            const int P0 = (R0 & 64) | ((R0 & 15) << 2) | ((R0 >> 4) & 3), P1 = (R1 & 64) | ((R1 & 15) << 2) | ((R1 >> 4) & 3);
            a.v0 = (unsigned)((P0 - 2 * (P0 >> 6)) * K + C0) * 2u; a.v1 = (unsigned)((P1 - 2 * (P1 >> 6)) * K + C1) * 2u;
        } else {
            const int P0 = (R0 & 64) | ((R0 & 15) << 2) | ((R0 >> 4) & 3), P1 = (R1 & 64) | ((R1 & 15) << 2) | ((R1 >> 4) & 3);
            a.base = (const char*)g.A + (size_t)16394 * K * 2; a.hstep = (size_t)HALF * K * 2;
            a.v0 = (unsigned)(P0 * K + C0) * 2u; a.v1 = (unsigned)(P1 * K + C1) * 2u;
        }
    }
    return a;
}

template <class Epi, bool UPMAP>
__device__ __forceinline__ void gemm_phase(LAS unsigned char* lds, const Gemm g, const StaticOrder& S, const Epi& E) {
    const int tid = threadIdx.x, wid = __builtin_amdgcn_readfirstlane(tid >> 6), lane = tid & 63, wr = wid >> 2, wc = wid & 3, fr = lane & 15, fq = lane >> 4;
    const int K = g.K, nt = K / BK;
    unsigned voffB[2];
#pragma unroll
    for (int i = 0; i < 2; ++i) { int R, C; stage_rc(tid * 16 + i * 8192, R, C); const int Rb = (R & ~31) + perm32(R & 31); voffB[i] = (unsigned)(Rb * K + C) * 2u; }
    const size_t kstep = (size_t)(BK * 2);
    const size_t hstepB = (size_t)HALF * K * 2;
    const size_t tstepB = 2 * hstepB;
    const unsigned ldsw = (unsigned)wid * 1024u;
    const int aoff = lds_byte(wr * 64 + fr, fq * 8), boff = lds_byte(wc * 32 + fr, fq * 8);
#define PG8_SA(b, h) (((b) * 2 + (h)) * HTB)
#define PG8_SB(b, h) ((4 + (b) * 2 + (h)) * HTB)
#define PG8_STAGEB(bufoff, gbase) do { _Pragma("unroll") for (int _i = 0; _i < 2; ++_i) \
        __builtin_amdgcn_global_load_lds((const unsigned*)((const char*)(gbase) + voffB[_i]), (LAS unsigned*)(lds + (bufoff) + ldsw + _i * 8192), 16, 0, 0); } while (0)
#define PG8_STAGEA(bufoff, gbase, va0, va1) do { \
        __builtin_amdgcn_global_load_lds((const unsigned*)((const char*)(gbase) + (va0)), (LAS unsigned*)(lds + (bufoff) + ldsw), 16, 0, 0); \
        __builtin_amdgcn_global_load_lds((const unsigned*)((const char*)(gbase) + (va1)), (LAS unsigned*)(lds + (bufoff) + ldsw + 8192), 16, 0, 0); } while (0)
#define PG8_LDA(dst, b, h) do { _Pragma("unroll") for (int m = 0; m < 4; ++m) _Pragma("unroll") for (int k = 0; k < 2; ++k) dst[m][k] = *(const LAS bf16x8*)(lds + PG8_SA(b, h) + aoff + m * 2048 + k * 1024); } while (0)
#define PG8_LDB(dst, b, h) do { _Pragma("unroll") for (int n = 0; n < 2; ++n) _Pragma("unroll") for (int k = 0; k < 2; ++k) dst[n][k] = *(const LAS bf16x8*)(lds + PG8_SB(b, h) + boff + n * 2048 + k * 1024); } while (0)
#define PG8_MMA(ai, bj, At, Bt) do { __builtin_amdgcn_s_setprio(1); _Pragma("unroll") for (int m = 0; m < 4; ++m) _Pragma("unroll") for (int n = 0; n < 2; ++n) _Pragma("unroll") for (int k = 0; k < 2; ++k) \
        acc[ai][bj][m][n] = __builtin_amdgcn_mfma_f32_16x16x32_bf16(Bt[n][k], At[m][k], acc[ai][bj][m][n], 0, 0, 0); __builtin_amdgcn_s_setprio(0); } while (0)
#define PG8_WAIT_V(n) asm volatile("s_waitcnt vmcnt(" #n ")" ::: "memory")
#define PG8_WAIT_L(n) asm volatile("s_waitcnt lgkmcnt(" #n ")" ::: "memory")
#define PG8_BAR __builtin_amdgcn_s_barrier()
#define PG8_SCHED __builtin_amdgcn_sched_barrier(0)
    Unit cur, nxt; int ui = 0;
    if (!S.next(0, cur)) return;
    f32x4 acc[2][2][4][2];
#pragma unroll
    for (int a = 0; a < 2; ++a)
#pragma unroll
        for (int b = 0; b < 2; ++b)
#pragma unroll
            for (int m = 0; m < 4; ++m)
#pragma unroll
                for (int n = 0; n < 2; ++n) acc[a][b][m][n] = (f32x4){0.f, 0.f, 0.f, 0.f};
    bf16x8 At[4][2], B0[2][2], B1[2][2];
    AInfo ca = a_info<UPMAP, Epi::TOK>(g, cur, tid);
    const char* cA = ca.base; const char* cB = (const char*)g.Bt + (size_t)cur.pn * tstepB;
    PG8_STAGEB(PG8_SB(0, 0), cB); PG8_STAGEB(PG8_SB(0, 1), cB + hstepB); PG8_STAGEA(PG8_SA(0, 0), cA, ca.v0, ca.v1); PG8_STAGEA(PG8_SA(0, 1), cA + ca.hstep, ca.v0, ca.v1);
    if (wr == 1) PG8_BAR;
    PG8_WAIT_V(2); PG8_BAR;
    PG8_STAGEB(PG8_SB(1, 0), cB + kstep); PG8_STAGEA(PG8_SA(1, 0), cA + kstep, ca.v0, ca.v1); PG8_STAGEB(PG8_SB(1, 1), cB + hstepB + kstep);
    PG8_WAIT_V(6); PG8_BAR;
    for (;;) {
        const bool has_next = S.next(ui + 1, nxt);
        AInfo na = ca; if (has_next) na = a_info<UPMAP, Epi::TOK>(g, nxt, tid);
        const char* nA = na.base; const char* nB = has_next ? (const char*)g.Bt + (size_t)nxt.pn * tstepB : cB;
        for (int t = 0; t < nt; t += 2) {
            const bool last = (t == nt - 2);
            const char* a1 = cA + (size_t)(t + 1) * kstep;
            const char* a2 = last ? nA : cA + (size_t)(t + 2) * kstep; const char* b2 = last ? nB : cB + (size_t)(t + 2) * kstep;
            const char* a3 = a2 + kstep; const char* b3 = b2 + kstep;
            const size_t h2 = last ? na.hstep : ca.hstep; const unsigned w0 = last ? na.v0 : ca.v0, w1 = last ? na.v1 : ca.v1;
            PG8_LDB(B0, 0, 0); PG8_LDB(B1, 0, 1); PG8_SCHED; PG8_LDA(At, 0, 0); PG8_STAGEA(PG8_SA(1, 1), a1 + ca.hstep, ca.v0, ca.v1);
            PG8_WAIT_V(8); PG8_WAIT_L(0); PG8_BAR; PG8_MMA(0, 0, At, B0); PG8_MMA(0, 1, At, B1); PG8_BAR; PG8_SCHED;
            PG8_LDA(At, 0, 1); PG8_STAGEB(PG8_SB(0, 0), b2); PG8_STAGEB(PG8_SB(0, 1), b2 + hstepB); PG8_STAGEA(PG8_SA(0, 0), a2, w0, w1);
            PG8_WAIT_V(8); PG8_WAIT_L(0); PG8_BAR; PG8_MMA(1, 0, At, B0); PG8_MMA(1, 1, At, B1); PG8_BAR; PG8_SCHED;
            PG8_LDB(B0, 1, 0); PG8_LDB(B1, 1, 1); PG8_SCHED; PG8_LDA(At, 1, 0); PG8_STAGEA(PG8_SA(0, 1), a2 + h2, w0, w1);
            PG8_WAIT_V(8); PG8_WAIT_L(0); PG8_BAR; PG8_MMA(0, 0, At, B0); PG8_MMA(0, 1, At, B1); PG8_BAR; PG8_SCHED;
            PG8_LDA(At, 1, 1); PG8_STAGEB(PG8_SB(1, 0), b3); PG8_STAGEB(PG8_SB(1, 1), b3 + hstepB); PG8_STAGEA(PG8_SA(1, 0), a3, w0, w1);
            PG8_WAIT_V(8); PG8_WAIT_L(0); PG8_BAR; PG8_MMA(1, 0, At, B0); PG8_MMA(1, 1, At, B1); PG8_BAR; PG8_SCHED;
        }
        if (wr == 0) PG8_BAR;
        E(acc, cur, wr, wc, fr, fq);
        if constexpr ((PROBE & 512) && Epi::IDEM) E(acc, cur, wr, wc, fr, fq);
        if (!has_next) break;
#pragma unroll
        for (int a = 0; a < 2; ++a)
#pragma unroll
            for (int b = 0; b < 2; ++b)
#pragma unroll
                for (int m = 0; m < 4; ++m)
#pragma unroll
                    for (int n = 0; n < 2; ++n) acc[a][b][m][n] = (f32x4){0.f, 0.f, 0.f, 0.f};
        cur = nxt; ca = na; cA = nA; cB = nB; ++ui;
        if (wr == 1) PG8_BAR;
    }
    PG8_WAIT_V(0);
    PG8_BAR;
#undef PG8_SA
#undef PG8_SB
#undef PG8_STAGEA
#undef PG8_STAGEB
#undef PG8_LDA
#undef PG8_LDB
#undef PG8_MMA
#undef PG8_WAIT_V
#undef PG8_WAIT_L
#undef PG8_BAR
#undef PG8_SCHED
}

template <class Epi>
__device__ __forceinline__ void sample_gemm(LAS unsigned char* lds, const bf16_t* Arows, const bf16_t* Bt, const int K, const int nN, const int pm_unit, const Epi& E, const int job0, const int jstride, const int jend = 1 << 30) {
    const int tid = threadIdx.x, w = __builtin_amdgcn_readfirstlane(tid >> 6);
    int lane = tid & 63; asm volatile("" : "+v"(lane));
    const int fr = lane & 15, fq = lane >> 4;
    const int per = K / 256;
#pragma unroll 1
    for (int job = job0; job < nN * 16 && job < jend; job += jstride) {
        const int pn = job >> 4, jai = (job >> 3) & 1, jwr = (job >> 2) & 1, jwc = job & 3;
        f32x4 h[2][4][2];
#pragma unroll
        for (int b = 0; b < 2; ++b)
#pragma unroll
            for (int m = 0; m < 4; ++m)
#pragma unroll
                for (int n = 0; n < 2; ++n) h[b][m][n] = (f32x4){0.f, 0.f, 0.f, 0.f};
        const bf16_t* ap = Arows + (size_t)(jai * 128 + jwr * 64 + fr) * K + 8 * fq + (w * per) * 32;
        const bf16_t* bp = Bt + (size_t)(pn * 256 + jwc * 32 + 8 * (fr >> 2) + (fr & 3)) * K + 8 * fq + (w * per) * 32;
#pragma unroll 1
        for (int ks0 = 0; ks0 < per; ks0 += 4) {
            bf16x8 af[4][4], bfr[4][2][2];
#pragma unroll
            for (int kl = 0; kl < 4; ++kl) {
                const int ks = (ks0 + kl < per) ? ks0 + kl : per - 1;
#pragma unroll
                for (int m = 0; m < 4; ++m) af[kl][m] = *(const bf16x8*)(ap + (size_t)(16 * m) * K + 32 * ks);
#pragma unroll
                for (int bj = 0; bj < 2; ++bj)
#pragma unroll
                    for (int n = 0; n < 2; ++n) bfr[kl][bj][n] = *(const bf16x8*)(bp + (size_t)(bj * 128 + 4 * n) * K + 32 * ks);
            }
#pragma unroll
            for (int kl = 0; kl < 4; ++kl)
                if (ks0 + kl < per) {
#pragma unroll
                    for (int bj = 0; bj < 2; ++bj)
#pragma unroll
                        for (int m = 0; m < 4; ++m)
#pragma unroll
                            for (int n = 0; n < 2; ++n) h[bj][m][n] = __builtin_amdgcn_mfma_f32_16x16x32_bf16(bfr[kl][bj][n], af[kl][m], h[bj][m][n], 0, 0, 0);
                }
        }
        __syncthreads();
#pragma unroll
        for (int bj = 0; bj < 2; ++bj)
#pragma unroll
            for (int m = 0; m < 4; ++m)
#pragma unroll
                for (int n = 0; n < 2; ++n) *(LAS f32x4*)(lds + ((w * 16 + (bj * 4 + m) * 2 + n) * 64 + lane) * 16) = h[bj][m][n];
        __syncthreads();
#pragma unroll
        for (int q = 0; q < 2; ++q) {
            LAS unsigned char* sp = lds + ((2 * w + q) * 64 + lane) * 16;
            f32x4 sum = *(const LAS f32x4*)sp;
#pragma unroll
            for (int ww = 1; ww < 8; ++ww) sum += *(const LAS f32x4*)(sp + ww * 16384);
            *(LAS f32x4*)sp = sum;
        }
        __syncthreads();
        if (w < 4) {
            f32x4 acc[2][2][4][2];
#pragma unroll
            for (int ai = 0; ai < 2; ++ai)
#pragma unroll
                for (int bj = 0; bj < 2; ++bj)
#pragma unroll
                    for (int m = 0; m < 4; ++m)
#pragma unroll
                        for (int n = 0; n < 2; ++n) acc[ai][bj][m][n] = *(const LAS f32x4*)(lds + (((bj * 4 + m) * 2 + n) * 64 + lane) * 16);
            Unit u; u.pm = pm_unit; u.pn = pn;
            E(acc, u, jwr, jwc, fr, fq, 1u << (4 * jai + w));
        }
        if constexpr (Epi::POST) E.post(lds, 2 * jai + jwr, w, lane, 16u);
    }
    __syncthreads();
}

template <class Epi, bool H = Epi::S16> struct S16Pre { struct type {}; };
template <class Epi> struct S16Pre<Epi, true> { using type = typename Epi::PreS; };
template <class Epi>
__device__ __forceinline__ void sample_gemm16(LAS unsigned char* lds, const bf16_t* Arows, const bf16_t* Bt, const int K, const int nN, const int pm_unit, const Epi& E, const int job0, const int jstride) {
    const int tid = threadIdx.x, w = __builtin_amdgcn_readfirstlane(tid >> 6);
    int lane = tid & 63; asm volatile("" : "+v"(lane));
    const int fr = lane & 15, fq = lane >> 4;
    const int per = K / 256;
#pragma unroll 1
    for (int job = job0; job < nN * 64; job += jstride) {
        const int pn = job >> 6, jai = (job >> 5) & 1, jwr = (job >> 4) & 1, jm = (job >> 2) & 3, jwc = job & 3;
        f32x4 h[2][2];
#pragma unroll
        for (int b = 0; b < 2; ++b)
#pragma unroll
            for (int n = 0; n < 2; ++n) h[b][n] = (f32x4){0.f, 0.f, 0.f, 0.f};
        const bf16_t* ap = Arows + (size_t)(jai * 128 + jwr * 64 + 16 * jm + fr) * K + 8 * fq + (w * per) * 32;
        const bf16_t* bp = Bt + (size_t)(pn * 256 + jwc * 32 + 8 * (fr >> 2) + (fr & 3)) * K + 8 * fq + (w * per) * 32;
        typename S16Pre<Epi>::type ps{};
        if constexpr (Epi::S16) { if (w == 0) ps = E.pre_s(pm_unit, pn, jwr, jwc, fr, fq, jai, jm); }
#pragma unroll 1
        for (int ks0 = 0; ks0 < per; ks0 += 6) {
            bf16x8 af[6], bfr[6][2][2];
#pragma unroll
            for (int kl = 0; kl < 6; ++kl) {
                const int ks = (ks0 + kl < per) ? ks0 + kl : per - 1;
                af[kl] = *(const bf16x8*)(ap + 32 * ks);
#pragma unroll
                for (int bj = 0; bj < 2; ++bj)
#pragma unroll
                    for (int n = 0; n < 2; ++n) bfr[kl][bj][n] = *(const bf16x8*)(bp + (size_t)(bj * 128 + 4 * n) * K + 32 * ks);
            }
#pragma unroll
            for (int kl = 0; kl < 6; ++kl)
                if (ks0 + kl < per) {
#pragma unroll
                    for (int bj = 0; bj < 2; ++bj)
#pragma unroll
                        for (int n = 0; n < 2; ++n) h[bj][n] = __builtin_amdgcn_mfma_f32_16x16x32_bf16(bfr[kl][bj][n], af[kl], h[bj][n], 0, 0, 0);
                }
        }
        __syncthreads();
#pragma unroll
        for (int bj = 0; bj < 2; ++bj)
#pragma unroll
            for (int n = 0; n < 2; ++n) *(LAS f32x4*)(lds + ((w * 4 + bj * 2 + n) * 64 + lane) * 16) = h[bj][n];
        __syncthreads();
        if (w < 4) {
            LAS unsigned char* sp = lds + (w * 64 + lane) * 16;
            f32x4 sum = *(const LAS f32x4*)sp;
#pragma unroll
            for (int ww = 1; ww < 8; ++ww) sum += *(const LAS f32x4*)(sp + ww * 4096);
            *(LAS f32x4*)sp = sum;
        }
        __syncthreads();
        if (w == 0) {
            f32x4 acc[2][2][4][2];
#pragma unroll
            for (int ai = 0; ai < 2; ++ai)
#pragma unroll
                for (int bj = 0; bj < 2; ++bj)
#pragma unroll
                    for (int m = 0; m < 4; ++m)
#pragma unroll
                        for (int n = 0; n < 2; ++n) acc[ai][bj][m][n] = *(const LAS f32x4*)(lds + ((bj * 2 + n) * 64 + lane) * 16);
            Unit u; u.pm = pm_unit; u.pn = pn;
            if constexpr (Epi::S16) E.run_s(acc, ps, u, jwr, jwc, fr, fq, jai, jm);
            else if constexpr (Epi::POST) { if (E.fuse16) E.fused16(acc, u, jwr, jwc, fr, fq, jai, jm); else E(acc, u, jwr, jwc, fr, fq, 1u << (4 * jai + jm)); }
            else E(acc, u, jwr, jwc, fr, fq, 1u << (4 * jai + jm));
        }
        if constexpr (Epi::POST) { if (!E.fuse16) E.post(lds, 2 * jai + jwr, w, lane, 64u); }
    }
    __syncthreads();
}
}
using pg8::Unit;

template <bool TOK_>
struct EpiInT {
    static constexpr bool TOK = TOK_;
    static constexpr bool IDEM = true, POST = false;
    unsigned char* proj; float* DEC; float* HGFS; const f32x4* rope; const float* lb;
    __device__ __forceinline__ void operator()(const f32x4 (&acc)[2][2][4][2], const Unit& u, int wr, int wc, int fr_, int fq_, const unsigned mask = 0xffu) const {
        int fr = fr_, fq = fq_; asm volatile("" : "+v"(fr), "+v"(fq));
        const int pn = u.pn; const bool samp = !TOK && (u.pm == 64);
        constexpr int RM = TOK ? 1 : 16, RF = TOK ? 4 : 1;
        const int dd0 = 32 * (wc & 1) + 8 * fq;
        const int col0 = ((pn & 1) * 2 + (wc >> 1)) * 128 + dd0;
        const int rowb = u.pm * 256 + wr * 64 + RF * fr;
        if (pn < 4) {
            const int type = pn >> 1;
            bf16_t* D = (bf16_t*)(proj + (size_t)type * PSZ);
            const int head = (pn & 1) * 2 + (wc >> 1);
            const float lg = __log2f(1.0f - exp2f(-5.0f - (float)head));
            const float base = type == 0 ? 1.0f : 0.08838834764831845f;
            f32x4 cv[2][4][4];
            auto ldc = [&](int ai, int m) { if ((mask >> (4 * ai + m)) & 1u) { const int r = rowb + ai * 128 + m * RM; const int pos = r < TP ? (r & 4095) : (1024 + (r & 15));
                const f32x4* cs = rope + (size_t)pos * 32 + (dd0 >> 1);
#pragma unroll
                for (int q = 0; q < 4; ++q) cv[ai][m][q] = cs[q]; } };
            ldc(0, 0); ldc(0, 1); ldc(0, 2);
#pragma unroll
            for (int ai = 0; ai < 2; ++ai)
#pragma unroll
                for (int m = 0; m < 4; ++m) { { constexpr int D3 = 3; const int g = 4 * ai + m + D3; if (g < 8) ldc(g >> 2, g & 3); } if ((mask >> (4 * ai + m)) & 1u) {
                    const int r = rowb + ai * 128 + m * RM;
                    const float e = (float)((r & 63) + 1) * lg;
                    const float sc = samp ? base : base * exp2f(type == 0 ? e : -e);
                    const f32x4 c0 = cv[ai][m][0], c1 = cv[ai][m][1], c2 = cv[ai][m][2], c3 = cv[ai][m][3];
                    const f32x4 lo0 = acc[ai][0][m][0], lo1 = acc[ai][0][m][1], hi0 = acc[ai][1][m][0], hi1 = acc[ai][1][m][1];
                    float ol[8], oh[8];
                    ol[0] = lo0[0] * c0[0] - hi0[0] * c0[1]; oh[0] = lo0[0] * c0[1] + hi0[0] * c0[0];
                    ol[1] = lo0[1] * c0[2] - hi0[1] * c0[3]; oh[1] = lo0[1] * c0[3] + hi0[1] * c0[2];
                    ol[2] = lo0[2] * c1[0] - hi0[2] * c1[1]; oh[2] = lo0[2] * c1[1] + hi0[2] * c1[0];
                    ol[3] = lo0[3] * c1[2] - hi0[3] * c1[3]; oh[3] = lo0[3] * c1[3] + hi0[3] * c1[2];
                    ol[4] = lo1[0] * c2[0] - hi1[0] * c2[1]; oh[4] = lo1[0] * c2[1] + hi1[0] * c2[0];
                    ol[5] = lo1[1] * c2[2] - hi1[1] * c2[3]; oh[5] = lo1[1] * c2[3] + hi1[1] * c2[2];
                    ol[6] = lo1[2] * c3[0] - hi1[2] * c3[1]; oh[6] = lo1[2] * c3[1] + hi1[2] * c3[0];
                    ol[7] = lo1[3] * c3[2] - hi1[3] * c3[3]; oh[7] = lo1[3] * c3[3] + hi1[3] * c3[2];
                    u32x4 wl, wh;
                    wl.x = cvt_pk_bf16(ol[0] * sc, ol[1] * sc); wl.y = cvt_pk_bf16(ol[2] * sc, ol[3] * sc); wl.z = cvt_pk_bf16(ol[4] * sc, ol[5] * sc); wl.w = cvt_pk_bf16(ol[6] * sc, ol[7] * sc);
                    wh.x = cvt_pk_bf16(oh[0] * sc, oh[1] * sc); wh.y = cvt_pk_bf16(oh[2] * sc, oh[3] * sc); wh.z = cvt_pk_bf16(oh[4] * sc, oh[5] * sc); wh.w = cvt_pk_bf16(oh[6] * sc, oh[7] * sc);
                    bf16_t* rp = D + pofs(head, r) + dd0;
                    st16b(proj, rp, wl); st16b(proj, rp + 64, wh);
                } }
        } else if (pn >= 8 && pn < 12) {
            const int lane = fq * 16 + fr;
            const int colh = (pn - 8) * 128 + 32 * wc + 8 * fq;
            bf16_t* dHQ = (bf16_t*)(proj + 4 * PSZ); bf16_t* dHK = (bf16_t*)(proj + 5 * PSZ);
            f32x4 lbv[2];
#pragma unroll
            for (int n = 0; n < 2; ++n) lbv[n] = *(const f32x4*)(lb + colh + 4 * n);
            const int srcl = (lane & 48) | 15;
#pragma unroll
            for (int ai = 0; ai < 2; ++ai) {
                const int rbase = u.pm * 256 + ai * 128 + wr * 64;
#pragma unroll
                for (int n = 0; n < 2; ++n) if ((mask >> (4 * ai)) & 0xfu) {
                    const int cn = colh + 4 * n;
                    f32x4 gg[4], kk[4];
#pragma unroll
                    for (int m = 0; m < 4; ++m)
#pragma unroll
                        for (int j = 0; j < 4; ++j) {
                            const float x = acc[ai][1][m][n][j]; const float sg = sigmoid_f(x); const float l = lbv[n][j];
                            gg[m][j] = l + (1.0f - l) * sg; kk[m][j] = (1.0f - l) * (1.0f - sg);
                        }
                    if (samp) {
#pragma unroll
                        for (int m = 0; m < 4; ++m) if ((mask >> (4 * ai + m)) & 1u) {
                            const int r = rbase + 16 * m + fr;
                            const f32x4 q0 = acc[ai][0][m][n];
                            u32x2 w; w.x = cvt_pk_bf16(q0[0], q0[1]); w.y = cvt_pk_bf16(q0[2], q0[3]);
                            *(u32x2*)(dHQ + pofs(pn - 8, r) + (cn & 127)) = w;
                            *(f32x4*)(HGFS + (size_t)(r - TP) * HW + cn) = gg[m];
                        }
                    } else {
                        f32x4 carry = (f32x4){1.f, 1.f, 1.f, 1.f};
                        if constexpr (TOK) {
#pragma unroll
                            for (int j = 0; j < 4; ++j) { gg[1][j] *= gg[0][j]; gg[2][j] *= gg[1][j]; gg[3][j] *= gg[2][j]; }
                            float T0 = gg[3][0], T1 = gg[3][1], T2 = gg[3][2], T3 = gg[3][3];
#define HG_SCAN(sh) "v_mul_f32_dpp %0, %0, %0 " sh " row_mask:0xf bank_mask:0xf\n\tv_mul_f32_dpp %1, %1, %1 " sh " row_mask:0xf bank_mask:0xf\n\t" \
                    "v_mul_f32_dpp %2, %2, %2 " sh " row_mask:0xf bank_mask:0xf\n\tv_mul_f32_dpp %3, %3, %3 " sh " row_mask:0xf bank_mask:0xf\n\t"
                            asm("s_nop 1\n\t" HG_SCAN("row_shr:1") HG_SCAN("row_shr:2") HG_SCAN("row_shr:4") HG_SCAN("row_shr:8") : "+v"(T0), "+v"(T1), "+v"(T2), "+v"(T3));
#undef HG_SCAN
#define HG_APPLY(m) do { float g0_ = gg[m][0], g1_ = gg[m][1], g2_ = gg[m][2], g3_ = gg[m][3]; \
                        asm("s_nop 1\n\tv_mul_f32_dpp %0, %4, %0 row_shr:1 row_mask:0xf bank_mask:0xf\n\tv_mul_f32_dpp %1, %5, %1 row_shr:1 row_mask:0xf bank_mask:0xf\n\t" \
                        "v_mul_f32_dpp %2, %6, %2 row_shr:1 row_mask:0xf bank_mask:0xf\n\tv_mul_f32_dpp %3, %7, %3 row_shr:1 row_mask:0xf bank_mask:0xf" \
                        : "+v"(g0_), "+v"(g1_), "+v"(g2_), "+v"(g3_) : "v"(T0), "v"(T1), "v"(T2), "v"(T3)); \
                        gg[m] = (f32x4){g0_, g1_, g2_, g3_}; } while (0)
                            HG_APPLY(0); HG_APPLY(1); HG_APPLY(2); HG_APPLY(3);
#undef HG_APPLY
                            carry = (f32x4){T0, T1, T2, T3};
                        } else {
#pragma unroll
                        for (int m = 0; m < 4; ++m)
#pragma unroll
                            for (int j = 0; j < 4; ++j) {
                                float v = gg[m][j];
                                v *= dpp_f<0x111>(1.f, v); v *= dpp_f<0x112>(1.f, v); v *= dpp_f<0x114>(1.f, v); v *= dpp_f<0x118>(1.f, v);
                                v *= carry[j];
                                gg[m][j] = v;
                                carry[j] = __shfl(v, srcl);
                            }
                        }
#pragma unroll
                        for (int m = 0; m < 4; ++m) {
                            const int r = rbase + RM * m + RF * fr;
                            float qo[4], ko[4];
#pragma unroll
                            for (int j = 0; j < 4; ++j) { const float P = gg[m][j]; qo[j] = acc[ai][0][m][n][j] * P; ko[j] = kk[m][j] * __builtin_amdgcn_rcpf(P); }
                            u32x2 wq, wk;
                            wq.x = cvt_pk_bf16(qo[0], qo[1]); wq.y = cvt_pk_bf16(qo[2], qo[3]);
                            wk.x = cvt_pk_bf16(ko[0], ko[1]); wk.y = cvt_pk_bf16(ko[2], ko[3]);
                            st8b(proj, dHQ + pofs(pn - 8, r) + (cn & 127), wq); st8b(proj, dHK + pofs(pn - 8, r) + (cn & 127), wk);
                        }
                        if (fr == 15) {
                            f32x4 d0;
#pragma unroll
                            for (int j = 0; j < 4; ++j) d0[j] = carry[j];
                            *(f32x4*)(DEC + (size_t)(4 * u.pm + 2 * ai + wr) * HW + cn) = d0;
                        }
                    }
                }
            }
        } else {
            bf16_t* D = (bf16_t*)(proj + (size_t)(pn >> 1) * PSZ);
            const bool act = false;
#pragma unroll
            for (int ai = 0; ai < 2; ++ai)
#pragma unroll
                for (int m = 0; m < 4; ++m) if ((mask >> (4 * ai + m)) & 1u) {
                    const int r = rowb + ai * 128 + m * RM;
                    bf16_t* rp = D + pofs((pn & 1) * 2 + (wc >> 1), r) + dd0;
#pragma unroll
                    for (int bj = 0; bj < 2; ++bj) {
                        f32x4 v0 = acc[ai][bj][m][0], v1 = acc[ai][bj][m][1];
                        if (act) {
#pragma unroll
                            for (int j = 0; j < 4; ++j) { v0[j] = silu_f(v0[j]); v1[j] = silu_f(v1[j]); }
                        }
                        u32x4 w; w.x = cvt_pk_bf16(v0[0], v0[1]); w.y = cvt_pk_bf16(v0[2], v0[3]); w.z = cvt_pk_bf16(v1[0], v1[1]); w.w = cvt_pk_bf16(v1[2], v1[3]);
                        st16b(proj, rp + 64 * bj, w);
                    }
                }
        }
    }
};
using EpiIn = EpiInT<false>;

struct EpiOut {
    static constexpr bool TOK = false;
    static constexpr bool IDEM = true, POST = false, S16 = true;
    const float* xp; const float* xs; float* X1F; bf16_t* X1B; float* SS2;
    struct PreS { f32x4 xv[4]; };
    __device__ __forceinline__ PreS pre_s(int pm, int pn, int wr, int wc, int fr, int fq, int ai, int m) const {
        PreS p; const int r = pm * 256 + ai * 128 + wr * 64 + m * 16 + fr; const float* xr = (r < TP ? xp + (size_t)r * DM : xs + (size_t)(r - TP) * DM) + pn * 256 + wc * 32 + 8 * fq;
#pragma unroll
        for (int q = 0; q < 4; ++q) p.xv[q] = __builtin_nontemporal_load((const f32x4*)(xr + 128 * (q >> 1) + 4 * (q & 1)));
        return p;
    }
    __device__ __forceinline__ void run_s(const f32x4 (&acc)[2][2][4][2], const PreS& pre, const Unit& u, int wr, int wc, int fr_, int fq_, int ai, int m) const {
        int fr = fr_, fq = fq_; asm volatile("" : "+v"(fr), "+v"(fq));
        const int col0 = u.pn * 256 + wc * 32 + 8 * fq;
        const int r = u.pm * 256 + ai * 128 + wr * 64 + m * 16 + fr;
        const int rb = r < TP ? (4098 * (r >> 12) + 2 + (r & 4095)) : (16394 + (r - TP));
        bf16_t* o16 = X1B + (size_t)rb * DM + col0;
        float ss = 0.f;
#pragma unroll
        for (int bj = 0; bj < 2; ++bj) {
            const f32x4 v0 = acc[0][bj][0][0] + pre.xv[2 * bj], v1 = acc[0][bj][0][1] + pre.xv[2 * bj + 1];
            u32x4 w; w.x = cvt_pk_bf16(v0[0], v0[1]); w.y = cvt_pk_bf16(v0[2], v0[3]); w.z = cvt_pk_bf16(v1[0], v1[1]); w.w = cvt_pk_bf16(v1[2], v1[3]);
            st16b(X1B, o16 + 128 * bj, w);
            ss += (v0[0] * v0[0] + v0[1] * v0[1]) + (v0[2] * v0[2] + v0[3] * v0[3]) + (v1[0] * v1[0] + v1[1] * v1[1]) + (v1[2] * v1[2] + v1[3] * v1[3]);
        }
        ss += __shfl_xor(ss, 16); ss += __shfl_xor(ss, 32);
        if (fq == 0) SS2[(size_t)r * 16 + u.pn * 4 + wc] = ss;
    }
    __device__ __forceinline__ void operator()(const f32x4 (&acc)[2][2][4][2], const Unit& u, int wr, int wc, int fr_, int fq_, const unsigned mask = 0xffu) const {
        int fr = fr_, fq = fq_; asm volatile("" : "+v"(fr), "+v"(fq));
        const int col0 = u.pn * 256 + wc * 32 + 8 * fq;
        f32x4 xv[2][4][4];
        auto xrow = [&](int ai, int m) -> const float* { const int r = u.pm * 256 + ai * 128 + wr * 64 + m * 16 + fr; return (r < TP ? xp + (size_t)r * DM : xs + (size_t)(r - TP) * DM) + col0; };
        auto ldx = [&](int ai, int m) { if ((mask >> (4 * ai + m)) & 1u) { const float* xr = xrow(ai, m);
#pragma unroll
            for (int q = 0; q < 4; ++q) xv[ai][m][q] = __builtin_nontemporal_load((const f32x4*)(xr + 128 * (q >> 1) + 4 * (q & 1))); } };
#pragma unroll
        for (int m = 0; m < 4; ++m) ldx(0, m);
#pragma unroll
        for (int ai = 0; ai < 2; ++ai)
#pragma unroll
            for (int m = 0; m < 4; ++m) {
                if (ai == 0) ldx(1, m);
                if ((mask >> (4 * ai + m)) & 1u) {
                    const int r = u.pm * 256 + ai * 128 + wr * 64 + m * 16 + fr;
                    const int rb = r < TP ? (4098 * (r >> 12) + 2 + (r & 4095)) : (16394 + (r - TP));
                    bf16_t* o16 = X1B + (size_t)rb * DM + col0;
                    float ss = 0.f;
#pragma unroll
                    for (int bj = 0; bj < 2; ++bj) {
                        const f32x4 v0 = acc[ai][bj][m][0] + xv[ai][m][2 * bj], v1 = acc[ai][bj][m][1] + xv[ai][m][2 * bj + 1];
                        u32x4 w; w.x = cvt_pk_bf16(v0[0], v0[1]); w.y = cvt_pk_bf16(v0[2], v0[3]); w.z = cvt_pk_bf16(v1[0], v1[1]); w.w = cvt_pk_bf16(v1[2], v1[3]);
                        st16b(X1B, o16 + 128 * bj, w);
                        ss += (v0[0] * v0[0] + v0[1] * v0[1]) + (v0[2] * v0[2] + v0[3] * v0[3]) + (v1[0] * v1[0] + v1[1] * v1[1]) + (v1[2] * v1[2] + v1[3] * v1[3]);
                    }
                    ss += __shfl_xor(ss, 16); ss += __shfl_xor(ss, 32);
                    if (fq == 0) SS2[(size_t)r * 16 + u.pn * 4 + wc] = ss;
                }
            }
    }
};

struct EpiUp {
    static constexpr bool IDEM = true, POST = false;
    const float* SS2; const float* ck; const float* cb; const float* cache_in; bf16_t* ACT; float* ccp; float* ccs;
    __device__ __forceinline__ void operator()(f32x4 (&acc)[2][2][4][2], const Unit& u, int wr, int wc, int fr_, int fq_, const unsigned mask = 0xffu) const {
        int fr = fr_, fq = fq_; asm volatile("" : "+v"(fr), "+v"(fq));
        const int lane = fq * 16 + fr;
        const int f0 = u.pn * 128 + wc * 32 + 8 * fq;
        const bool samp = (u.pm == 68);
        const int sb = samp ? 0 : u.pm / 17, sj = samp ? 0 : u.pm % 17;
        f32x4 k0[2], k1[2], k2[2], bb[2];
#pragma unroll
        for (int n = 0; n < 2; ++n) { k0[n] = *(const f32x4*)(ck + f0 + 4 * n); k1[n] = *(const f32x4*)(ck + DFF + f0 + 4 * n); k2[n] = *(const f32x4*)(ck + 2 * DFF + f0 + 4 * n); bb[n] = *(const f32x4*)(cb + f0 + 4 * n); }
#pragma unroll
        for (int ai = 0; ai < 2; ++ai) {
            f32x4 prev[2] = {(f32x4){0.f, 0.f, 0.f, 0.f}, (f32x4){0.f, 0.f, 0.f, 0.f}};
#pragma unroll
            for (int m = 0; m < 4; ++m) if ((mask >> (4 * ai + m)) & 1u) {
                int gr; bool valid; int t = 0;
                if (samp) { gr = TP + ai * 128 + wr * 64 + m * 16 + fr; valid = true; }
                else { t = 248 * sj + 62 * (2 * ai + wr) + 16 * m + fr - 2; gr = sb * SEQ + t; valid = (t >= 0) && (t < SEQ); }
                float ssq = 0.f;
                if (valid) { const f32x4 p = *(const f32x4*)(SS2 + (size_t)gr * 16 + 4 * fq); ssq = (p[0] + p[1]) + (p[2] + p[3]); }
                ssq += __shfl_xor(ssq, 16); ssq += __shfl_xor(ssq, 32);
                const float rs = valid ? __frsqrt_rn(ssq * (1.0f / DM) + EPS) : 0.f;
                f32x4 a[2], b[2];
#pragma unroll
                for (int n = 0; n < 2; ++n) { a[n] = acc[ai][0][m][n] * rs; b[n] = acc[ai][1][m][n] * rs; }
                if (samp) {
                    const int s = ai * 8 + wr * 4 + m;
                    if (fr >= 14) {
#pragma unroll
                        for (int n = 0; n < 2; ++n) prev[n] = *(const f32x4*)(cache_in + ((size_t)s * 2 + (fr - 14)) * DFF + f0 + 4 * n);
                    }
                }
                f32x4 o[2];
#pragma unroll
                for (int n = 0; n < 2; ++n)
#pragma unroll
                    for (int j = 0; j < 4; ++j) {
                        const float s1 = dpp_f<0x111>(dpp_f<0x121>(0.f, prev[n][j]), a[n][j]);
                        const float s2 = dpp_f<0x112>(dpp_f<0x122>(0.f, prev[n][j]), a[n][j]);
                        const float cv = bb[n][j] + k0[n][j] * s2 + k1[n][j] * s1 + k2[n][j] * a[n][j];
                        o[n][j] = silu_f(cv) * b[n][j];
                    }
                const bool store = samp ? true : (valid && (16 * m + fr >= 2));
                if (store) {
                    u32x4 w; w.x = cvt_pk_bf16(o[0][0], o[0][1]); w.y = cvt_pk_bf16(o[0][2], o[0][3]); w.z = cvt_pk_bf16(o[1][0], o[1][1]); w.w = cvt_pk_bf16(o[1][2], o[1][3]);
                    st16b(ACT, ACT + (size_t)gr * DFF + f0, w);
                    if (samp) { if (fr >= 14) { float* cp = ccs + ((size_t)(ai * 8 + wr * 4 + m) * 2 + (fr - 14)) * DFF + f0; *(f32x4*)cp = a[0]; *(f32x4*)(cp + 4) = a[1]; } }
                    else if (t >= SEQ - 2) { float* cp = ccp + ((size_t)sb * 2 + (t - (SEQ - 2))) * DFF + f0; *(f32x4*)cp = a[0]; *(f32x4*)(cp + 4) = a[1]; }
                }
                prev[0] = a[0]; prev[1] = a[1];
            }
        }
    }
};

struct EpiUpMain {
    static constexpr bool TOK = true;
    static constexpr bool IDEM = true, POST = false;
    const float* SS2; const float* ck; const float* cb; const float* cache_in; bf16_t* ACT; float* ccp; float* ccs;
    template <bool SAMP>
    __device__ __forceinline__ void body(f32x4 (&acc)[2][2][4][2], const Unit& u, int wr, int wc, int fr_, int fq_) const {
        int fr = fr_, fq = fq_; asm volatile("" : "+v"(fr), "+v"(fq));
        const int f0 = u.pn * 128 + wc * 32 + 8 * fq;
        const int sb = SAMP ? 0 : u.pm / 17, sj = SAMP ? 0 : u.pm % 17;
        f32x4 k0[2], k1[2], k2[2], bb[2];
#pragma unroll
        for (int n = 0; n < 2; ++n) { k0[n] = *(const f32x4*)(ck + f0 + 4 * n); k1[n] = *(const f32x4*)(ck + DFF + f0 + 4 * n); k2[n] = *(const f32x4*)(ck + 2 * DFF + f0 + 4 * n); bb[n] = *(const f32x4*)(cb + f0 + 4 * n); }
        constexpr float NL2E = -1.4426950408889634f, NLN2 = -0.6931471805599453f;
#pragma unroll
        for (int n = 0; n < 2; ++n) { k0[n] *= NL2E; k1[n] *= NL2E; k2[n] *= NL2E; bb[n] *= NL2E; }
        auto grow = [&](int ai, int m, bool clamp) -> int {
            if constexpr (SAMP) return TP + 64 * (2 * ai + wr) + 4 * fr + m;
            else { int t = 248 * sj + 62 * (2 * ai + wr) - 2 + 4 * fr + m; if (clamp) t = t < 0 ? 0 : (t > SEQ - 1 ? SEQ - 1 : t); return sb * SEQ + t; } };
        f32x4 pss[2][4];
        auto ldss = [&](int ai) {
#pragma unroll
            for (int m = 0; m < 4; ++m) pss[ai][m] = *(const f32x4*)(SS2 + (size_t)grow(ai, m, true) * 16 + 4 * fq); };
        ldss(0);
        const bool first = SAMP && ((fr & 3) == 0);
#pragma unroll
        for (int ai = 0; ai < 2; ++ai) {
            const int tb = 248 * sj + 62 * (2 * ai + wr) - 2 + 4 * fr;
            float rs[4];
#pragma unroll
            for (int m = 0; m < 4; ++m) {
                const int t = tb + m; const bool valid = SAMP || ((unsigned)t < (unsigned)SEQ);
                const f32x4 p = pss[ai][m];
                float ssq = (p[0] + p[1]) + (p[2] + p[3]);
                ssq += __shfl_xor(ssq, 16); ssq += __shfl_xor(ssq, 32);
                rs[m] = valid ? __frsqrt_rn(ssq * (1.0f / DM) + EPS) : 0.f;
            }
            if (ai == 0) ldss(1);
            const float rsb[4] = {rs[0] * NLN2, rs[1] * NLN2, rs[2] * NLN2, rs[3] * NLN2};
            u32x4 w[4];
#pragma unroll
            for (int n = 0; n < 2; ++n) {
                f32x4 cin[2];
                if constexpr (SAMP) {
                    const int sq = 4 * (2 * ai + wr) + (fr >> 2);
                    cin[0] = *(const f32x4*)(cache_in + ((size_t)sq * 2 + 0) * DFF + f0 + 4 * n); cin[1] = *(const f32x4*)(cache_in + ((size_t)sq * 2 + 1) * DFF + f0 + 4 * n);
                }
#pragma unroll
                for (int j = 0; j < 4; j += 2) {
                    float o[4][2];
                    auto pr = [&](const f32x4& v) { return (f32x2){v[j], v[j + 1]}; };
                    const f32x2 a0 = pr(acc[ai][0][0][n]) * rs[0], a1 = pr(acc[ai][0][1][n]) * rs[1], a2 = pr(acc[ai][0][2][n]) * rs[2], a3 = pr(acc[ai][0][3][n]) * rs[3];
                    f32x2 p1 = {dpp_z<0x111>(a3[0]), dpp_z<0x111>(a3[1])}, p2 = {dpp_z<0x111>(a2[0]), dpp_z<0x111>(a2[1])};
                    if constexpr (SAMP) { const f32x2 h1 = pr(cin[1]), h2 = pr(cin[0]); p1[0] = first ? h1[0] : p1[0]; p1[1] = first ? h1[1] : p1[1]; p2[0] = first ? h2[0] : p2[0]; p2[1] = first ? h2[1] : p2[1]; }
                    const f32x2 c0 = pr(k0[n]), c1 = pr(k1[n]), c2 = pr(k2[n]), cbv = pr(bb[n]);
                    const f32x2 v0 = cbv + c0 * p2 + c1 * p1 + c2 * a0;
                    const f32x2 v1 = cbv + c0 * p1 + c1 * a0 + c2 * a1;
                    const f32x2 v2 = cbv + c0 * a0 + c1 * a1 + c2 * a2;
                    const f32x2 v3 = cbv + c0 * a1 + c1 * a2 + c2 * a3;
                    auto sg = [&](const f32x2& v) { const f32x2 e = {__builtin_amdgcn_exp2f(v[0]), __builtin_amdgcn_exp2f(v[1])}; const f32x2 d = e + 1.0f;
                                                    return (f32x2){__builtin_amdgcn_rcpf(d[0]), __builtin_amdgcn_rcpf(d[1])}; };
                    const f32x2 o0 = (v0 * sg(v0)) * (pr(acc[ai][1][0][n]) * rsb[0]);
                    const f32x2 o1 = (v1 * sg(v1)) * (pr(acc[ai][1][1][n]) * rsb[1]);
                    const f32x2 o2 = (v2 * sg(v2)) * (pr(acc[ai][1][2][n]) * rsb[2]);
                    const f32x2 o3 = (v3 * sg(v3)) * (pr(acc[ai][1][3][n]) * rsb[3]);
                    o[0][0] = o0[0]; o[0][1] = o0[1]; o[1][0] = o1[0]; o[1][1] = o1[1]; o[2][0] = o2[0]; o[2][1] = o2[1]; o[3][0] = o3[0]; o[3][1] = o3[1];
#pragma unroll
                    for (int m = 0; m < 4; ++m) w[m][2 * n + (j >> 1)] = cvt_pk_bf16(o[m][0], o[m][1]);
                }
            }
#pragma unroll
            for (int m = 0; m < 4; ++m) {
                if constexpr (SAMP) {
                    st16b(ACT, ACT + (size_t)grow(ai, m, false) * DFF + f0, w[m]);
                    if (m >= 2 && (fr & 3) == 3) {
                        float* cp = ccs + ((size_t)(4 * (2 * ai + wr) + (fr >> 2)) * 2 + (m - 2)) * DFF + f0; *(f32x4*)cp = acc[ai][0][m][0] * rs[m]; *(f32x4*)(cp + 4) = acc[ai][0][m][1] * rs[m];
                    }
                } else {
                    const int t = tb + m;
                    if ((unsigned)t < (unsigned)SEQ && (4 * fr + m >= 2)) {
                        st16b(ACT, ACT + (size_t)(sb * SEQ + t) * DFF + f0, w[m]);
                        if (t >= SEQ - 2) { float* cp = ccp + ((size_t)sb * 2 + (t - (SEQ - 2))) * DFF + f0; *(f32x4*)cp = acc[ai][0][m][0] * rs[m]; *(f32x4*)(cp + 4) = acc[ai][0][m][1] * rs[m]; }
                    }
                }
            }
        }
    }
    __device__ __forceinline__ void operator()(f32x4 (&acc)[2][2][4][2], const Unit& u, int wr, int wc, int fr_, int fq_, const unsigned mask = 0xffu) const {
        if (u.pm == 68) body<true>(acc, u, wr, wc, fr_, fq_); else body<false>(acc, u, wr, wc, fr_, fq_);
    }
};

template <bool FUSED>
struct EpiDownT {
    static constexpr bool TOK = false;
    static constexpr bool IDEM = false, POST = !FUSED, S16 = false;
    float* X; const bf16_t* X1B; float* SS3; const float* gfin; float* XS; unsigned* cnt; LAS unsigned char* ldsx; bool fuse16;
    static __device__ __forceinline__ void ld8(const bf16_t* p, f32x4& a, f32x4& b) { const u32x4 w = *(const u32x4*)p;
        a[0] = __uint_as_float(w.x << 16); a[1] = __uint_as_float(w.x & 0xffff0000u); a[2] = __uint_as_float(w.y << 16); a[3] = __uint_as_float(w.y & 0xffff0000u);
        b[0] = __uint_as_float(w.z << 16); b[1] = __uint_as_float(w.z & 0xffff0000u); b[2] = __uint_as_float(w.w << 16); b[3] = __uint_as_float(w.w & 0xffff0000u); }
    __device__ __forceinline__ void post(LAS unsigned char* lds, int rb, int w, int lane, const unsigned nexp) const {
        asm volatile("s_waitcnt vmcnt(0)" ::: "memory");
        __syncthreads();
        LAS unsigned* flag = (LAS unsigned*)(lds + RING_BYTES + 8192);
        if (threadIdx.x == 0) {
            const unsigned old = __hip_atomic_fetch_add(cnt + 64 * (64 + rb), 1u, __ATOMIC_RELAXED, __HIP_MEMORY_SCOPE_AGENT);
            const unsigned last = (old == nexp - 1u) ? 1u : 0u;
            if (last) { __builtin_amdgcn_fence(__ATOMIC_ACQUIRE, "agent"); asm volatile("s_waitcnt vmcnt(0)" ::: "memory"); }
            *flag = last;
        }
        __syncthreads();
        if (*flag) {
            f32x4 gn[4];
#pragma unroll
            for (int j = 0; j < 4; ++j) gn[j] = ((const f32x4*)gfin)[lane + 64 * j];
            for (int q = w; q < 64; q += NWAVES) {
                const int m = TP + 64 * rb + q;
                float p = lane < 16 ? SS3[(size_t)m * 16 + lane] : 0.f;
#pragma unroll
                for (int o = 1; o < 64; o <<= 1) p += __shfl_xor(p, o);
                const float rs = 1.0f / sqrtf(p * (1.0f / DM) + EPS);
                f32x4* xr = (f32x4*)(X + (size_t)m * DM) + lane;
#pragma unroll
                for (int j = 0; j < 4; ++j) { f32x4 v = xr[64 * j]; v = v * rs * gn[j]; xr[64 * j] = v; }
            }
        }
        __syncthreads();
    }
    __device__ __forceinline__ void fused16(const f32x4 (&acc)[2][2][4][2], const Unit& u, int wr, int wc, int fr_, int fq_, int ai, int m) const {
        int fr = fr_, fq = fq_; asm volatile("" : "+v"(fr), "+v"(fq));
        const int col0 = u.pn * 256 + wc * 32 + 8 * fq;
        const int r = u.pm * 256 + ai * 128 + wr * 64 + m * 16 + fr;
        const bf16_t* x1p = X1B + (size_t)(16394 + (r - TP)) * DM + col0;
        f32x4 gv[2][2];
#pragma unroll
        for (int bj = 0; bj < 2; ++bj)
#pragma unroll
            for (int n = 0; n < 2; ++n) gv[bj][n] = *(const f32x4*)(gfin + col0 + 128 * bj + 4 * n);
        f32x4 v[2][2]; float ss = 0.f;
#pragma unroll
        for (int bj = 0; bj < 2; ++bj) {
            f32x4 x0, x1; ld8(x1p + 128 * bj, x0, x1);
            v[bj][0] = acc[0][bj][0][0] + x0; v[bj][1] = acc[0][bj][0][1] + x1;
            const f32x4 v0 = v[bj][0], v1 = v[bj][1];
            ss += (v0[0] * v0[0] + v0[1] * v0[1]) + (v0[2] * v0[2] + v0[3] * v0[3]) + (v1[0] * v1[0] + v1[1] * v1[1]) + (v1[2] * v1[2] + v1[3] * v1[3]);
        }
        ss += __shfl_xor(ss, 16); ss += __shfl_xor(ss, 32);
        if (fq == 0) st4wt(SS3 + (size_t)r * 16 + u.pn * 4 + wc, ss);
        asm volatile("s_waitcnt vmcnt(0)" ::: "memory");
        unsigned* cp = cnt + 64 * (64 + 2 * ai + wr);
        if (fq == 0 && fr == 0) __hip_atomic_fetch_add(cp, 1u, __ATOMIC_RELAXED, __HIP_MEMORY_SCOPE_AGENT);
        { unsigned sp = 0;
          while ((unsigned)__builtin_amdgcn_readfirstlane(__hip_atomic_load(cp, __ATOMIC_RELAXED, __HIP_MEMORY_SCOPE_AGENT)) < 64u) { __builtin_amdgcn_s_sleep(2); if (++sp > (1u << 20)) break; } }
        __builtin_amdgcn_fence(__ATOMIC_ACQUIRE, "agent");
        const float* sl = SS3 + (size_t)r * 16 + 4 * fq;
        float t = 0.f;
#pragma unroll
        for (int k = 0; k < 4; ++k) t += __hip_atomic_load(sl + k, __ATOMIC_RELAXED, __HIP_MEMORY_SCOPE_AGENT);
        t += __shfl_xor(t, 16); t += __shfl_xor(t, 32);
        const float rs = 1.0f / sqrtf(t * (1.0f / DM) + EPS);
        float* xr = X + (size_t)r * DM + col0;
#pragma unroll
        for (int bj = 0; bj < 2; ++bj) { *(f32x4*)(xr + 128 * bj) = v[bj][0] * rs * gv[bj][0]; *(f32x4*)(xr + 128 * bj + 4) = v[bj][1] * rs * gv[bj][1]; }
    }
    __device__ __forceinline__ void operator()(f32x4 (&acc)[2][2][4][2], const Unit& u, int wr, int wc, int fr_, int fq_, const unsigned mask = 0xffu) const {
        int fr = fr_, fq = fq_; asm volatile("" : "+v"(fr), "+v"(fq));
        const int col0 = u.pn * 256 + wc * 32 + 8 * fq;
        if constexpr (!FUSED) {
#pragma unroll
            for (int ai = 0; ai < 2; ++ai)
#pragma unroll
                for (int m = 0; m < 4; ++m) if ((mask >> (4 * ai + m)) & 1u) {
                    const int r = u.pm * 256 + ai * 128 + wr * 64 + m * 16 + fr;
                    float* xr = X + (size_t)r * DM + col0;
                    const int rb = r < TP ? (4098 * (r >> 12) + 2 + (r & 4095)) : (16394 + (r - TP));
                    const bf16_t* x1p = X1B + (size_t)rb * DM + col0;
                    float ss = 0.f;
#pragma unroll
                    for (int bj = 0; bj < 2; ++bj) {
                        f32x4 x0, x1; ld8(x1p + 128 * bj, x0, x1);
                        const f32x4 v0 = acc[ai][bj][m][0] + x0, v1 = acc[ai][bj][m][1] + x1;
                        st16wt(xr + 128 * bj, v0); st16wt(xr + 128 * bj + 4, v1);
                        ss += (v0[0] * v0[0] + v0[1] * v0[1]) + (v0[2] * v0[2] + v0[3] * v0[3]) + (v1[0] * v1[0] + v1[1] * v1[1]) + (v1[2] * v1[2] + v1[3] * v1[3]);
                    }
                    ss += __shfl_xor(ss, 16); ss += __shfl_xor(ss, 32);
                    if (fq == 0) st4wt(SS3 + (size_t)r * 16 + u.pn * 4 + wc, ss);
                }
        } else {
            const int tid = threadIdx.x, wid = __builtin_amdgcn_readfirstlane(tid >> 6);
            LAS float* P = (LAS float*)ldsx;
            LAS float* S = (LAS float*)(ldsx + 4096);
            u32x4 xw[2][4][2];
            auto ldr = [&](int ai, int m) { const int r = u.pm * 256 + ai * 128 + wr * 64 + m * 16 + fr;
                const bf16_t* x1p = X1B + (size_t)(4098 * (r >> 12) + 2 + (r & 4095)) * DM + col0;
                xw[ai][m][0] = *(const u32x4*)x1p; xw[ai][m][1] = *(const u32x4*)(x1p + 128); };
#pragma unroll
            for (int m = 0; m < 4; ++m) ldr(0, m);
#pragma unroll
            for (int ai = 0; ai < 2; ++ai)
#pragma unroll
                for (int m = 0; m < 4; ++m) {
                    if (ai == 0) ldr(1, m);
                    const int rl = ai * 128 + wr * 64 + m * 16 + fr;
                    float ss = 0.f;
#pragma unroll
                    for (int bj = 0; bj < 2; ++bj) {
                        f32x4 x0, x1; { const u32x4 w = xw[ai][m][bj];
                            x0[0] = __uint_as_float(w.x << 16); x0[1] = __uint_as_float(w.x & 0xffff0000u); x0[2] = __uint_as_float(w.y << 16); x0[3] = __uint_as_float(w.y & 0xffff0000u);
                            x1[0] = __uint_as_float(w.z << 16); x1[1] = __uint_as_float(w.z & 0xffff0000u); x1[2] = __uint_as_float(w.w << 16); x1[3] = __uint_as_float(w.w & 0xffff0000u); }
                        const f32x4 v0 = acc[ai][bj][m][0] + x0, v1 = acc[ai][bj][m][1] + x1;
                        acc[ai][bj][m][0] = v0; acc[ai][bj][m][1] = v1;
                        ss += (v0[0] * v0[0] + v0[1] * v0[1]) + (v0[2] * v0[2] + v0[3] * v0[3]) + (v1[0] * v1[0] + v1[1] * v1[1]) + (v1[2] * v1[2] + v1[3] * v1[3]);
                    }
                    ss += __shfl_xor(ss, 16); ss += __shfl_xor(ss, 32);
                    if (fq == 0) P[rl * 4 + wc] = ss;
                }
            asm volatile("s_waitcnt lgkmcnt(0)" ::: "memory"); __builtin_amdgcn_s_barrier(); asm volatile("" ::: "memory");
            if (tid < 256) {
                const f32x4 p = *(const LAS f32x4*)(P + tid * 4);
                __hip_atomic_store(XS + ((size_t)u.pm * 256 + tid) * 4 + u.pn, (p[0] + p[1]) + (p[2] + p[3]), __ATOMIC_RELAXED, __HIP_MEMORY_SCOPE_AGENT);
            }
            asm volatile("s_waitcnt vmcnt(0)" ::: "memory");
            if (tid < 256 && (tid & 63) == 0) __hip_atomic_fetch_add(cnt + 64 * u.pm, 1u, __ATOMIC_RELAXED, __HIP_MEMORY_SCOPE_AGENT);
            if (wid == 0) {
                unsigned sp = 0;
                while ((unsigned)__builtin_amdgcn_readfirstlane(__hip_atomic_load(cnt + 64 * u.pm, __ATOMIC_RELAXED, __HIP_MEMORY_SCOPE_AGENT)) < 16u) {
                    __builtin_amdgcn_s_sleep(2);
                    if (++sp > (1u << 20)) break;
                }
                __builtin_amdgcn_fence(__ATOMIC_ACQUIRE, "agent");
            }
            asm volatile("s_waitcnt vmcnt(0) lgkmcnt(0)" ::: "memory"); __builtin_amdgcn_s_barrier(); asm volatile("" ::: "memory");
            if (tid < 256) {
                const float* sl = XS + ((size_t)u.pm * 256 + tid) * 4;
                float t = 0.f;
#pragma unroll
                for (int k = 0; k < 4; ++k) t += __hip_atomic_load(sl + k, __ATOMIC_RELAXED, __HIP_MEMORY_SCOPE_AGENT);
                S[tid] = 1.0f / sqrtf(t * (1.0f / DM) + EPS);
            }
            asm volatile("s_waitcnt vmcnt(0) lgkmcnt(0)" ::: "memory"); __builtin_amdgcn_s_barrier(); asm volatile("" ::: "memory");
            f32x4 gv[2][2];
#pragma unroll
            for (int bj = 0; bj < 2; ++bj)
#pragma unroll
                for (int n = 0; n < 2; ++n) gv[bj][n] = *(const f32x4*)(gfin + col0 + 128 * bj + 4 * n);
#pragma unroll
            for (int ai = 0; ai < 2; ++ai)
#pragma unroll
                for (int m = 0; m < 4; ++m) {
                    const int rl = ai * 128 + wr * 64 + m * 16 + fr;
                    const float rs = S[rl];
                    float* xr = X + (size_t)(u.pm * 256 + rl) * DM + col0;
#pragma unroll
                    for (int bj = 0; bj < 2; ++bj) {
                        *(f32x4*)(xr + 128 * bj) = acc[ai][bj][m][0] * rs * gv[bj][0];
                        *(f32x4*)(xr + 128 * bj + 4) = acc[ai][bj][m][1] * rs * gv[bj][1];
                    }
                }
        }
    }
};

struct EpiNull {
    static constexpr bool TOK = false;
    static constexpr bool IDEM = false, POST = false;
    __device__ __forceinline__ void operator()(f32x4 (&acc)[2][2][4][2], const Unit& u, int wr, int wc, int fr_, int fq_, const unsigned mask = 0xffu) const {
#pragma unroll
        for (int a = 0; a < 2; ++a)
#pragma unroll
            for (int b = 0; b < 2; ++b)
#pragma unroll
                for (int m = 0; m < 4; ++m)
#pragma unroll
                    for (int n = 0; n < 2; ++n) asm volatile("" :: "v"(acc[a][b][m][n]));
    }
};
struct Args { const float* in[17]; float* out; unsigned char* ws; int ph_lo, ph_hi; };

__device__ __forceinline__ float wave_sum(float v) {
#pragma unroll
    for (int o = 1; o < 64; o <<= 1) v += __shfl_xor(v, o);
    return v;
}

__device__ __forceinline__ void transpose_item(const float* W, int K, int N, bf16_t* WT, const float* gain, LAS float* scr, int k0, int p0, int s0, int lane) {
    float tv[32];
#pragma unroll
    for (int i = 0; i < 32; ++i) { const int kk = 2 * i + (lane >> 5); tv[i] = __builtin_nontemporal_load(W + (size_t)(k0 + kk) * N + s0 + (lane & 31)); }
    if (gain) {
#pragma unroll
        for (int i = 0; i < 32; ++i) tv[i] *= gain[k0 + 2 * i + (lane >> 5)];
    }
#pragma unroll
    for (int i = 0; i < 32; ++i) scr[(2 * i + (lane >> 5)) * 33 + (lane & 31)] = tv[i];
    asm volatile("s_waitcnt lgkmcnt(0)" ::: "memory");
    const int c = lane & 7;
#pragma unroll
    for (int j = 0; j < 4; ++j) { const int n = (lane >> 3) + 8 * j; const LAS float* s = scr + (8 * c) * 33 + n;
        u32x4 o; o.x = cvt_pk_bf16(s[0 * 33], s[1 * 33]); o.y = cvt_pk_bf16(s[2 * 33], s[3 * 33]); o.z = cvt_pk_bf16(s[4 * 33], s[5 * 33]); o.w = cvt_pk_bf16(s[6 * 33], s[7 * 33]);
        *(u32x4*)(WT + (size_t)(p0 + n) * K + k0 + 8 * c) = o; }
    asm volatile("s_waitcnt lgkmcnt(0)" ::: "memory");
}
__device__ __forceinline__ int colmap_in(int p) {
    const int pn = p >> 8, pl = p & 255, bj = pl >> 7, q = pl & 127;
    if (pn >= 8 && pn < 12) return (bj ? 2560 : 2048) + (pn - 8) * 128 + q;
    const int type = pn >> 1;
    return type * 512 + ((pn & 1) * 2 + (q >> 6)) * 128 + bj * 64 + (q & 63);
}
__device__ __forceinline__ int colmap_up(int p) { const int pn = p >> 8, pl = p & 255, bj = pl >> 7, q = pl & 127; return bj * DFF + 128 * pn + q; }

__device__ __forceinline__ void phase_prep(const Args& A, LAS unsigned char* lds, int wave, int lane) {
    unsigned char* ws = A.ws;
    const int G = gridDim.x, gw = blockIdx.x * NWAVES + wave, NGW = G * NWAVES;
    LAS float* scr = (LAS float*)(lds + wave * 8704);
    bf16_t* WinT = (bf16_t*)(ws + WS_WIN); bf16_t* WoutT = (bf16_t*)(ws + WS_WOUT); bf16_t* WupT = (bf16_t*)(ws + WS_WUP); bf16_t* WdT = (bf16_t*)(ws + WS_WD);
    constexpr int I_IN = 16 * 128, I_OUT = 16 * 32, I_UP = 16 * 176, I_DN = 44 * 32, NITEMS = I_IN + I_OUT + I_UP + I_DN;
    for (int it = gw; it < NITEMS; it += NGW) {
        int r = it;
        if (r < I_IN) { const int kb = r / 128, pb = r % 128; transpose_item(A.in[5], DM, INC, WinT, A.in[10], scr, 64 * kb, 32 * pb, colmap_in(32 * pb), lane); continue; } r -= I_IN;
        if (r < I_OUT) { const int kb = r / 32, pb = r % 32; transpose_item(A.in[9], DM, DM, WoutT, nullptr, scr, 64 * kb, 32 * pb, 32 * pb, lane); continue; } r -= I_OUT;
        if (r < I_UP) { const int kb = r / 176, pb = r % 176; transpose_item(A.in[12], DM, UPC, WupT, A.in[11], scr, 64 * kb, 32 * pb, colmap_up(32 * pb), lane); continue; } r -= I_UP;
        { const int kb = r / 32, pb = r % 32; transpose_item(A.in[15], DFF, DM, WdT, nullptr, scr, 64 * kb, 32 * pb, 32 * pb, lane); }
    }
    bf16_t* XB = (bf16_t*)(ws + WS_XB);
    for (int m0 = gw; m0 < TT; m0 += 4 * NGW) {
        f32x4 v[4][4];
#pragma unroll
        for (int q = 0; q < 4; ++q) {
            const int m = m0 + q * NGW;
            if (m < TT) {
                const float* xrow = m < TP ? A.in[0] + (size_t)m * DM : A.in[1] + (size_t)(m - TP) * DM;
                const f32x4* xr = (const f32x4*)xrow + lane;
#pragma unroll
                for (int j = 0; j < 4; ++j) v[q][j] = __builtin_nontemporal_load(xr + 64 * j);
            }
        }
#pragma unroll
        for (int q = 0; q < 4; ++q) {
            const int m = m0 + q * NGW;
            if (m < TT) {
                float s = 0.f;
#pragma unroll
                for (int j = 0; j < 4; ++j) s += (v[q][j][0] * v[q][j][0] + v[q][j][1] * v[q][j][1]) + (v[q][j][2] * v[q][j][2] + v[q][j][3] * v[q][j][3]);
                const float rs = 1.0f / sqrtf(wave_sum(s) * (1.0f / DM) + EPS);
                u32x2* o8 = (u32x2*)(XB + (size_t)m * DM) + lane;
#pragma unroll
                for (int j = 0; j < 4; ++j) { u32x2 w; w.x = cvt_pk_bf16(v[q][j][0] * rs, v[q][j][1] * rs); w.y = cvt_pk_bf16(v[q][j][2] * rs, v[q][j][3] * rs); o8[64 * j] = w; }
            }
        }
    }
    f32x2* rope = (f32x2*)(ws + WS_ROPE);
    const int gt = blockIdx.x * NTHREADS + threadIdx.x, NGT = G * NTHREADS;
    for (int i = gt; i < SEQ * 64; i += NGT) {
        const int pos = i >> 6, d = i & 63;
        const float inv = 1.0f / powf(10000.0f, (float)d * (1.0f / 64.0f));
        const float ang = (float)pos * inv;
        float sn, cs; sn = sinf(ang); cs = cosf(ang);
        rope[i] = (f32x2){cs, sn};
    }
    if (gt < HW) { const float l0 = A.in[8][gt], l1 = A.in[8][HW + gt]; ((float*)(ws + WS_LB))[gt] = 1.0f / (1.0f + __expf(l1 - l0)); }
    bf16_t* X1B = (bf16_t*)(ws + WS_X1B); (void)X1B;
}

template <bool HG>
__device__ __forceinline__ void sample_mixer_cols(const bf16_t* Q, const bf16_t* Kx, const float* Gf, const bf16_t* V, float* O, const float* st_in, float* st_out, int id) {
    const int tid = threadIdx.x, part = tid & 15, dpi = tid >> 4;
    const int seq = id >> 3, head = (id >> 1) & 3, dv0 = (id & 1) * 64 + 2 * dpi;
    const float* si = st_in + (size_t)(seq * 4 + head) * 16384 + dv0; float* so = st_out + (size_t)(seq * 4 + head) * 16384 + dv0;
    float S[2][8];
#pragma unroll
    for (int i = 0; i < 8; ++i) { const f32x2 t = *(const f32x2*)(si + (size_t)(part * 8 + i) * 128); S[0][i] = t[0]; S[1][i] = t[1]; }
    const int row0 = TP + seq * 16, ck = head * 128 + part * 8;
    const float gamma = 1.0f - exp2f(-5.0f - (float)head);
    const size_t hb = pofs(head, 0); const int pk8 = part * 8;
    constexpr int U = 2;
    u32x4 q8[2][U], k8[2][U]; f32x4 g0[2][U], g1[2][U]; unsigned vv[2][U];
#define SM_LOAD(set, t0_) do { _Pragma("unroll") for (int u = 0; u < U; ++u) { \
        const size_t r = (size_t)(row0 + (t0_) + u) * HW; const size_t rp_ = hb + (size_t)(row0 + (t0_) + u) * 128; q8[set][u] = *(const u32x4*)(Q + rp_ + pk8); \
        if (HG) { g0[set][u] = *(const f32x4*)(Gf + r + ck); g1[set][u] = *(const f32x4*)(Gf + r + ck + 4); } else k8[set][u] = *(const u32x4*)(Kx + rp_ + pk8); \
        vv[set][u] = *(const unsigned*)(V + rp_ + dv0); } } while (0)
    SM_LOAD(0, 0);
#pragma unroll 1
    for (int t0 = 0; t0 < 16; t0 += 2 * U) {
#pragma unroll
        for (int set = 0; set < 2; ++set) {
            const int tb = t0 + set * U;
            { const int tn = (tb + U < 16) ? tb + U : 16 - U; if (set == 0) SM_LOAD(1, tn); else SM_LOAD(0, tn); }
#pragma unroll
            for (int u = 0; u < U; ++u) {
                const float v0 = __uint_as_float(vv[set][u] << 16), v1 = __uint_as_float(vv[set][u] & 0xffff0000u);
                float qf[8], kf[8], df[8];
                const unsigned qa[4] = {q8[set][u].x, q8[set][u].y, q8[set][u].z, q8[set][u].w};
#pragma unroll
                for (int i = 0; i < 4; ++i) { qf[2 * i] = __uint_as_float(qa[i] << 16); qf[2 * i + 1] = __uint_as_float(qa[i] & 0xffff0000u); }
                if (HG) {
#pragma unroll
                    for (int i = 0; i < 4; ++i) { df[i] = g0[set][u][i]; df[4 + i] = g1[set][u][i]; }
#pragma unroll
                    for (int i = 0; i < 8; ++i) kf[i] = 1.0f - df[i];
                } else {
                    const unsigned ka[4] = {k8[set][u].x, k8[set][u].y, k8[set][u].z, k8[set][u].w};
#pragma unroll
                    for (int i = 0; i < 4; ++i) { kf[2 * i] = __uint_as_float(ka[i] << 16); kf[2 * i + 1] = __uint_as_float(ka[i] & 0xffff0000u); }
#pragma unroll
                    for (int i = 0; i < 8; ++i) df[i] = gamma;
                }
                float p0 = 0.f, p1 = 0.f;
#pragma unroll
                for (int i = 0; i < 8; ++i) { S[0][i] = df[i] * S[0][i] + kf[i] * v0; p0 += qf[i] * S[0][i]; S[1][i] = df[i] * S[1][i] + kf[i] * v1; p1 += qf[i] * S[1][i]; }
                p0 += dpp_f<0x128>(0.f, p0); p0 += dpp_f<0x124>(0.f, p0); p0 += dpp_f<0x122>(0.f, p0); p0 += dpp_f<0x121>(0.f, p0);
                p1 += dpp_f<0x128>(0.f, p1); p1 += dpp_f<0x124>(0.f, p1); p1 += dpp_f<0x122>(0.f, p1); p1 += dpp_f<0x121>(0.f, p1);
                if (part == 0) *(f32x2*)(O + (size_t)(row0 + tb + u) * DM + (HG ? HW : 0) + head * 128 + dv0) = (f32x2){p0, p1};
            }
        }
    }
#undef SM_LOAD
#pragma unroll
    for (int i = 0; i < 8; ++i) *(f32x2*)(so + (size_t)(part * 8 + i) * 128) = (f32x2){S[0][i], S[1][i]};
}
__device__ __forceinline__ void phase_mixer_sample(const Args& A) {
    unsigned char* ws = A.ws;
    const bf16_t* QR = (const bf16_t*)(ws + WS_QR); const bf16_t* KR = (const bf16_t*)(ws + WS_KR); const bf16_t* VR = (const bf16_t*)(ws + WS_VR);
    const bf16_t* HQ = (const bf16_t*)(ws + WS_HQ); const bf16_t* HI = (const bf16_t*)(ws + WS_HI);
    const float* HGFv = (const float*)(ws + WS_HGFS) - (size_t)TP * HW;
    float* O = A.out + O_Y;
    const int G = gridDim.x;
    for (int it = blockIdx.x; it < 256; it += G) {
        if (it >> 7) sample_mixer_cols<true>(HQ, nullptr, HGFv, HI, O, A.in[3], A.out + O_HGS, it & 127);
        else sample_mixer_cols<false>(QR, KR, nullptr, VR, O, A.in[2], A.out + O_RETS, it & 127);
    }
}

typedef short s16x4 __attribute__((ext_vector_type(4)));
__device__ __forceinline__ bf16x8 tr2(LAS unsigned char* p0, LAS unsigned char* p1) {
    const s16x4 a = __builtin_amdgcn_ds_read_tr16_b64_v4i16((LAS s16x4*)p0);
    const s16x4 b = __builtin_amdgcn_ds_read_tr16_b64_v4i16((LAS s16x4*)p1);
    return __builtin_shufflevector(a, b, 0, 1, 2, 3, 4, 5, 6, 7);
}
#define MFMA16(a, b, c) __builtin_amdgcn_mfma_f32_16x16x32_bf16((a), (b), (c), 0, 0, 0)

constexpr int M1_KSTR = 144, M1_VSTR = 72, M1_KSZ = 64 * M1_KSTR, M1_CH = M1_KSZ + 64 * M1_VSTR, M1_BUF = 2 * M1_CH;
__device__ __forceinline__ void m1_item(const bf16_t* Kt, const bf16_t* V, const float* DECp, bf16_t* ST, float* state_out, int seq, int head, int slice, float gamma64,
                                        LAS unsigned char* lds, int w, int lane, const int pmode = 0) {
    const int tid = threadIdx.x, fr = lane & 15, g = lane >> 4, r4 = fr >> 2, c4 = fr & 3;
    const int dkh = slice >> 2, dvq = slice & 3, tk = w >> 1, tv = w & 1;
    const size_t rbase = (size_t)seq * SEQ;
    const int cb = head * 128;
    const bool vld = tid < 256;
    const bf16_t* kp = Kt + pofs(head, rbase + (tid >> 3)) + dkh * 64 + (tid & 7) * 8;
    const bf16_t* vp = V + pofs(head, rbase + (tid >> 2)) + dvq * 32 + (tid & 3) * 8;
    const int kwo = (tid >> 3) * M1_KSTR + (tid & 7) * 16, vwo = M1_KSZ + (tid >> 2) * M1_VSTR + (tid & 3) * 16;
    const int dv = dvq * 32 + tv * 16 + fr, dk0 = dkh * 64 + 16 * tk + 4 * g;
    const float* dp = DECp ? DECp + (size_t)(seq * 64) * HW + cb + dk0 : nullptr;
    u32x4 rk0[8], rv[8]; f32x4 rd[8];
#define M1_LOAD(slot, n_) do { const size_t o_ = (size_t)(n_) * 64 * 128; rk0[slot] = *(const u32x4*)(kp + o_); \
        rv[slot] = vld ? *(const u32x4*)(vp + o_) : (u32x4){0u, 0u, 0u, 0u}; rd[slot] = dp ? *(const f32x4*)(dp + (size_t)(n_) * HW) : (f32x4){gamma64, gamma64, gamma64, gamma64}; } while (0)
#define M1_WRITE(slot, off_) do { LAS unsigned char* nb_ = lds + (off_); *(LAS u32x4*)(nb_ + kwo) = rk0[slot]; \
        if (vld) { *(LAS u32x2*)(nb_ + vwo) = (u32x2){rv[slot].x, rv[slot].y}; *(LAS u32x2*)(nb_ + vwo + 8) = (u32x2){rv[slot].z, rv[slot].w}; } } while (0)
    M1_LOAD(0, 0); M1_LOAD(1, 1); M1_LOAD(2, 2); M1_LOAD(3, 3); M1_LOAD(4, 4); M1_LOAD(5, 5); M1_LOAD(6, 6); M1_LOAD(7, 7);
    M1_WRITE(0, 0); M1_WRITE(1, M1_CH);
    __syncthreads();
    f32x4 acc = (f32x4){0.f, 0.f, 0.f, 0.f};
    for (int s0 = 0; s0 < 32; s0 += 4) {
#pragma unroll
        for (int u = 0; u < 4; ++u) {
            const int n = 2 * (s0 + u);
            LAS unsigned char* buf = lds + (u & 1) * M1_BUF;
            const f32x4 dec0 = rd[2 * u], dec1 = rd[2 * u + 1];
            { const int na = (n + 8 < 64) ? n + 8 : 62; M1_LOAD(2 * u, na); M1_LOAD(2 * u + 1, na + 1); }
#pragma unroll
            for (int h = 0; h < 2; ++h) {
                if (!(pmode & 1)) { u32x2 sv; sv.x = cvt_pk_bf16(acc[0], acc[1]); sv.y = cvt_pk_bf16(acc[2], acc[3]);
                  st8b(ST, ST + ((size_t)((seq * 64 + n + h) * 4 + head) * 128 + dv) * 128 + dk0, sv); }
#pragma unroll
                for (int ks = 0; ks < 2; ++ks) if (!(pmode & 2)) {
                    LAS unsigned char* ka = buf + h * M1_CH + (32 * ks + 8 * g + r4) * M1_KSTR + 32 * tk + 8 * c4;
                    LAS unsigned char* va = buf + h * M1_CH + M1_KSZ + (32 * ks + 8 * g + r4) * M1_VSTR + 32 * tv + 8 * c4;
                    const bf16x8 af = tr2(ka, ka + 4 * M1_KSTR), bfv = tr2(va, va + 4 * M1_VSTR);
                    acc = MFMA16(af, bfv, acc);
                }
                acc = acc * (h ? dec1 : dec0);
            }
            if (!(pmode & 8)) { M1_WRITE(2 * ((u + 1) & 3), ((u + 1) & 1) * M1_BUF); M1_WRITE(2 * ((u + 1) & 3) + 1, ((u + 1) & 1) * M1_BUF + M1_CH); }
            if (!(pmode & 4)) __syncthreads();
        }
    }
#undef M1_LOAD
#undef M1_WRITE
    if (!pmode) {
#pragma unroll
        for (int j = 0; j < 4; ++j) state_out[(size_t)(dk0 + j) * 128 + dv] = acc[j];
    } else asm volatile("" :: "v"(acc));
}
__device__ __forceinline__ void phase_m1(const Args& A, LAS unsigned char* lds, int w, int lane, const bool dup = false) {
    unsigned char* ws = A.ws;
    bf16_t* STb = (bf16_t*)(A.out + O_Y);
    const int G = gridDim.x;
    const int vcu = (G % 8 == 0) ? (int)(blockIdx.x % 8) * (G / 8) + (int)(blockIdx.x / 8) : (int)blockIdx.x;
    for (int it = vcu; it < 256 && !((PROBE & 4096) && dup); it += G) {
        const int mixer = it >> 7, seq = (it >> 5) & 3, head = (it >> 3) & 3, slice = it & 7;
        const float gam = 1.0f - exp2f(-5.0f - (float)head);
        const float g64 = exp2f(64.0f * __log2f(gam));
        float* sout = A.out + (mixer ? O_HGP : O_RETP) + (size_t)(seq * 4 + head) * 16384;
        bf16_t* ST = STb + (size_t)mixer * 256 * 4 * 16384;
        const int pm_ = dup ? ((PROBE >> 14) & 15) : 0;
        if (mixer) m1_item((const bf16_t*)(ws + WS_HK), (const bf16_t*)(ws + WS_HI), (const float*)(ws + WS_DEC), ST, sout, seq, head, slice, 0.f, lds, w, lane, pm_);
        else m1_item((const bf16_t*)(ws + WS_KR), (const bf16_t*)(ws + WS_VR), nullptr, ST, sout, seq, head, slice, g64, lds, w, lane, pm_);
        __syncthreads();
    }
    if (!(PROBE & 8192) || !dup) phase_mixer_sample(A);
}

constexpr int M2_VSTR = 272, M2_VBUF = 64 * M2_VSTR, M2_EXCH = 8 * M2_VBUF;
__device__ __forceinline__ void m2_item(const Args& A, int seq, int n, LAS unsigned char* lds, int w, int lane) {
    unsigned char* ws = A.ws;
    int fr = lane & 15, g = lane >> 4; asm volatile("" : "+v"(fr), "+v"(g));
    const int r4 = fr >> 2, c4 = fr & 3;
    const int mixer = w >> 2, head = w & 3, cb = head * 128;
    const bf16_t* Q = (const bf16_t*)(ws + (mixer ? WS_HQ : WS_QR)); const bf16_t* K = (const bf16_t*)(ws + (mixer ? WS_HK : WS_KR));
    const bf16_t* V = (const bf16_t*)(ws + (mixer ? WS_HI : WS_VR)); const bf16_t* GT = (const bf16_t*)(ws + (mixer ? WS_HGT : WS_GR));
    const float* gain = A.in[mixer ? 7 : 6] + cb;
    const size_t r0 = (size_t)seq * SEQ + 64 * n;
    const bf16_t* ST = (const bf16_t*)(A.out + O_Y) + ((size_t)(mixer * 256 + seq * 64 + n) * 4 + head) * 16384;
    bf16_t* MG = (bf16_t*)(ws + WS_XB);
    LAS unsigned char* vb = lds + w * M2_VBUF;
    const bf16_t* qp = Q + pofs(head, r0 + fr) + 8 * g; const bf16_t* kp = K + pofs(head, r0 + fr) + 8 * g;
    u32x4 vr[16];
#pragma unroll
    for (int i = 0; i < 16; ++i) vr[i] = __builtin_nontemporal_load((const u32x4*)(V + pofs(head, r0 + 4 * i + g) + fr * 8));
    bf16x8 qf[4][4], kf[4][4];
#pragma unroll
    for (int ks = 0; ks < 4; ++ks)
#pragma unroll
        for (int t = 0; t < 4; ++t) { qf[ks][t] = *(const bf16x8*)(qp + (size_t)(16 * t) * 128 + 32 * ks); kf[ks][t] = *(const bf16x8*)(kp + (size_t)(16 * t) * 128 + 32 * ks); }
#pragma unroll
    for (int i = 0; i < 16; ++i) *(LAS u32x4*)(vb + (4 * i + g) * M2_VSTR + fr * 16) = vr[i];
    f32x4 X[4][4];
#pragma unroll
    for (int a = 0; a < 4; ++a)
#pragma unroll
        for (int b = 0; b < 4; ++b) X[a][b] = (f32x4){0.f, 0.f, 0.f, 0.f};
#pragma unroll
    for (int ks = 0; ks < 4; ++ks)
#pragma unroll
        for (int jt = 0; jt < 4; ++jt)
#pragma unroll
            for (int it = jt; it < 4; ++it) X[jt][it] = MFMA16(kf[ks][jt], qf[ks][it], X[jt][it]);
    bf16x8 PB[4][2];
#pragma unroll
    for (int it = 0; it < 4; ++it)
#pragma unroll
        for (int s2 = 0; s2 < 2; ++s2) {
            float v[8];
#pragma unroll
            for (int e = 0; e < 8; ++e) {
                const int jt = 2 * s2 + (e >> 2);
                float x = 0.f;
                if (jt < it) x = X[jt][it][e & 3];
                else if (jt == it) x = (fr >= 4 * g + (e & 3)) ? X[jt][it][e & 3] : 0.f;
                v[e] = x;
            }
            u32x4 wv; wv.x = cvt_pk_bf16(v[0], v[1]); wv.y = cvt_pk_bf16(v[2], v[3]); wv.z = cvt_pk_bf16(v[4], v[5]); wv.w = cvt_pk_bf16(v[6], v[7]);
            PB[it][s2] = __builtin_bit_cast(bf16x8, wv);
        }
    const bf16_t* sp = ST + (size_t)fr * 128 + 8 * g;
    bf16x8 sa0[2][4];
#pragma unroll
    for (int k2 = 0; k2 < 2; ++k2)
#pragma unroll
        for (int d = 0; d < 4; ++d) sa0[k2][d] = *(const bf16x8*)(sp + (size_t)(16 * d) * 128 + 32 * k2);
    f32x4 O[8][4];
#pragma unroll
    for (int a = 0; a < 8; ++a)
#pragma unroll
        for (int b = 0; b < 4; ++b) O[a][b] = (f32x4){0.f, 0.f, 0.f, 0.f};
#pragma unroll
    for (int s2 = 0; s2 < 2; ++s2)
#pragma unroll
        for (int dh = 0; dh < 2; ++dh) {
            bf16x8 vt[4];
#pragma unroll
            for (int d = 0; d < 4; ++d) { LAS unsigned char* pa = vb + (32 * s2 + 4 * g + r4) * M2_VSTR + 32 * (4 * dh + d) + 8 * c4; vt[d] = tr2(pa, pa + 16 * M2_VSTR); }
#pragma unroll
            for (int it = 2 * s2; it < 4; ++it)
#pragma unroll
                for (int d = 0; d < 4; ++d) O[4 * dh + d][it] = MFMA16(vt[d], PB[it][s2], O[4 * dh + d][it]);
            asm volatile("" ::: "memory");
        }
#pragma unroll
    for (int dh = 0; dh < 2; ++dh)
#pragma unroll
        for (int kp2 = 0; kp2 < 2; ++kp2) {
            bf16x8 qg[2][4], sa[2][4];
#pragma unroll
            for (int k2 = 0; k2 < 2; ++k2) {
#pragma unroll
                for (int t = 0; t < 4; ++t) qg[k2][t] = *(const bf16x8*)(qp + (size_t)(16 * t) * 128 + 32 * (2 * kp2 + k2));
#pragma unroll
                for (int d = 0; d < 4; ++d) sa[k2][d] = (dh == 0 && kp2 == 0) ? sa0[k2][d] : *(const bf16x8*)(sp + (size_t)(16 * (4 * dh + d)) * 128 + 32 * (2 * kp2 + k2));
            }
#pragma unroll
            for (int k2 = 0; k2 < 2; ++k2)
#pragma unroll
                for (int d = 0; d < 4; ++d)
#pragma unroll
                    for (int it = 0; it < 4; ++it) O[4 * dh + d][it] = MFMA16(sa[k2][d], qg[k2][it], O[4 * dh + d][it]);
            asm volatile("" ::: "memory");
        }
    u32x2 gtr[4][8];
#pragma unroll
    for (int it = 0; it < 4; ++it)
#pragma unroll
        for (int d = 0; d < 8; ++d) gtr[it][d] = *(const u32x2*)(GT + pofs(head, r0 + 16 * it + fr) + 4 * g + 16 * d);
    float rs[4];
    LAS float* exch = (LAS float*)(lds + M2_EXCH);
#pragma unroll
    for (int it = 0; it < 4; ++it) {
        float ss = 0.f;
#pragma unroll
        for (int d = 0; d < 8; ++d) ss += (O[d][it][0] * O[d][it][0] + O[d][it][1] * O[d][it][1]) + (O[d][it][2] * O[d][it][2] + O[d][it][3] * O[d][it][3]);
        ss += __shfl_xor(ss, 16); ss += __shfl_xor(ss, 32);
        rs[it] = ss;
        if (mixer && g == 0) exch[(16 * it + fr) * 4 + head] = ss;
    }
    __syncthreads();
#pragma unroll
    for (int it = 0; it < 4; ++it) {
        if (mixer) { const f32x4 e = *(LAS f32x4*)(exch + (16 * it + fr) * 4); rs[it] = 1.0f / sqrtf(((e[0] + e[1]) + (e[2] + e[3])) * (1.0f / 512.0f) + EPS); }
        else rs[it] = 1.0f / sqrtf(rs[it] * (1.0f / 128.0f) + EPS);
    }
#pragma unroll
    for (int it = 0; it < 4; ++it) {
        int rowi = 16 * it + fr; asm volatile("" : "+v"(rowi));
        const size_t row = r0 + rowi;
        bf16_t* mgp = MG + row * DM + mixer * HW + cb + 4 * g;
        const float rsi = rs[it];
#pragma unroll
        for (int d = 0; d < 8; ++d) {
            const f32x4 gn = *(const f32x4*)(gain + 16 * d + 4 * g);
            const u32x2 gt = gtr[it][d];
            const float g0 = silu_f(__uint_as_float(gt.x << 16)), g1 = silu_f(__uint_as_float(gt.x & 0xffff0000u)), g2 = silu_f(__uint_as_float(gt.y << 16)), g3 = silu_f(__uint_as_float(gt.y & 0xffff0000u));
            const f32x4 o = O[d][it] * rsi * gn;
            u32x2 wv; wv.x = cvt_pk_bf16(o[0] * g0, o[1] * g1); wv.y = cvt_pk_bf16(o[2] * g2, o[3] * g3);
            st8b(MG, mgp + 16 * d, wv);
        }
    }
}
__device__ __forceinline__ void phase_normgate_sample(const Args& A, int wave, int lane) {
    unsigned char* ws = A.ws;
    const float* O = A.out + O_Y;
    const bf16_t* GR = (const bf16_t*)(ws + WS_GR); const bf16_t* HGT = (const bf16_t*)(ws + WS_HGT);
    bf16_t* MG = (bf16_t*)(ws + WS_XB);
    const int gw = blockIdx.x * NWAVES + wave, NGW = gridDim.x * NWAVES;
    const bool hg = lane >= 32; const int c0 = lane * 16;
    const float* gain = hg ? A.in[7] + (c0 - HW) : A.in[6] + c0;
    f32x4 gn[4];
#pragma unroll
    for (int j = 0; j < 4; ++j) gn[j] = *(const f32x4*)(gain + 4 * j);
    for (int m = TP + gw; m < TT; m += NGW) {
        const f32x4* orow = (const f32x4*)(O + (size_t)m * DM + c0);
        f32x4 v[4]; float s = 0.f;
#pragma unroll
        for (int j = 0; j < 4; ++j) { v[j] = orow[j]; s += (v[j][0] * v[j][0] + v[j][1] * v[j][1]) + (v[j][2] * v[j][2] + v[j][3] * v[j][3]); }
        s += __shfl_xor(s, 1); s += __shfl_xor(s, 2); s += __shfl_xor(s, 4);
        float s2 = s; s2 += __shfl_xor(s2, 8); s2 += __shfl_xor(s2, 16);
        const float rs = hg ? 1.0f / sqrtf(s2 * (1.0f / 512.0f) + EPS) : 1.0f / sqrtf(s * (1.0f / 128.0f) + EPS);
        const bf16_t* gp = (hg ? HGT + pofs((c0 - HW) >> 7, m) + ((c0 - HW) & 127) : GR + pofs(c0 >> 7, m) + (c0 & 127));
        const u32x4 ga = *(const u32x4*)gp, gb = *(const u32x4*)(gp + 8);
        const unsigned gw_[8] = {ga.x, ga.y, ga.z, ga.w, gb.x, gb.y, gb.z, gb.w};
        float o[16];
#pragma unroll
        for (int i = 0; i < 8; ++i) { const float g0 = silu_f(__uint_as_float(gw_[i] << 16)), g1 = silu_f(__uint_as_float(gw_[i] & 0xffff0000u));
            o[2 * i] = v[(2 * i) >> 2][(2 * i) & 3] * rs * gn[(2 * i) >> 2][(2 * i) & 3] * g0; o[2 * i + 1] = v[(2 * i + 1) >> 2][(2 * i + 1) & 3] * rs * gn[(2 * i + 1) >> 2][(2 * i + 1) & 3] * g1; }
        u32x4 w0, w1;
        w0.x = cvt_pk_bf16(o[0], o[1]); w0.y = cvt_pk_bf16(o[2], o[3]); w0.z = cvt_pk_bf16(o[4], o[5]); w0.w = cvt_pk_bf16(o[6], o[7]);
        w1.x = cvt_pk_bf16(o[8], o[9]); w1.y = cvt_pk_bf16(o[10], o[11]); w1.z = cvt_pk_bf16(o[12], o[13]); w1.w = cvt_pk_bf16(o[14], o[15]);
        bf16_t* mp = MG + (size_t)m * DM + c0;
        *(u32x4*)mp = w0; *(u32x4*)(mp + 8) = w1;
    }
}
__device__ __forceinline__ void phase_m2(const Args& A, LAS unsigned char* lds, int w, int lane) {
    const int G = gridDim.x;
    const int vcu = (G % 8 == 0) ? (int)(blockIdx.x % 8) * (G / 8) + (int)(blockIdx.x / 8) : (int)blockIdx.x;
    for (int it = vcu; it < 256; it += G) { m2_item(A, it >> 6, it & 63, lds, w, lane); __syncthreads(); }
    phase_normgate_sample(A, w, lane);
}
__device__ __forceinline__ void phase_final(const Args& A, int wave, int lane) {
    const float* SS3 = (const float*)(A.ws + WS_SS3);
    const int gw = blockIdx.x * NWAVES + wave, NGW = gridDim.x * NWAVES;
    f32x4 gn[4];
#pragma unroll
    for (int j = 0; j < 4; ++j) gn[j] = ((const f32x4*)A.in[16])[lane + 64 * j];
    for (int m = gw; m < TP; m += NGW) {
        float p = lane < 16 ? SS3[(size_t)m * 16 + lane] : 0.f;
        p = wave_sum(p);
        const float rs = 1.0f / sqrtf(p * (1.0f / DM) + EPS);
        f32x4* xr = (f32x4*)(A.out + O_Y + (size_t)m * DM) + lane;
#pragma unroll
        for (int j = 0; j < 4; ++j) { f32x4 v = xr[64 * j]; v = v * rs * gn[j]; xr[64 * j] = v; }
    }
}

__global__ void __launch_bounds__(NTHREADS, 2) fwd_kernel(Args args) {
    extern __shared__ __attribute__((aligned(16))) unsigned char lds_raw[];
    LAS unsigned char* lds = (LAS unsigned char*)lds_raw;
    const int tid = threadIdx.x, wave = __builtin_amdgcn_readfirstlane(tid >> 6);
    volatile LAS unsigned* MISC = (volatile LAS unsigned*)(lds + MISC_OFF);
    if (tid < 64) MISC[tid] = 0u;
    __syncthreads();
    unsigned char* ws = args.ws;
    XcdBarrier bar; bar.bar = (unsigned*)(ws + WS_CTL); bar.x = 0; bar.st = nullptr;
    if (N_LAUNCHES == 1) bar = xcd_barrier_post((unsigned*)(ws + WS_CTL), MISC + 8);
    const int lo = args.ph_lo, hi = args.ph_hi;
#define IN(k) (lo <= (k) && (k) < hi)
#define SEAM(k) do { if (IN(k) && IN((k) + 1)) { xcd_barrier(bar); if (PROBE & 256) xcd_barrier(bar); } } while (0)
    const int G = gridDim.x, c = blockIdx.x;

    if (IN(0)) { phase_prep(args, lds, wave, fresh_lane()); if (PROBE & 64) { __syncthreads(); phase_prep(args, lds, wave, fresh_lane()); } } SEAM(0);
    if (IN(1)) {
        pg8::Gemm g{(const bf16_t*)(ws + WS_XB), (const bf16_t*)(ws + WS_WIN), DM}; pg8::StaticOrder S; S.init(64, 16, G, c);
        EpiIn E{ws + WS_PROJ, (float*)(ws + WS_DEC), (float*)(ws + WS_HGFS), (const f32x4*)(ws + WS_ROPE), (const float*)(ws + WS_LB)};
        EpiInT<true> EM{E.proj, E.DEC, E.HGFS, E.rope, E.lb};
        pg8::gemm_phase<EpiInT<true>, false>(lds, g, S, EM);
        pg8::sample_gemm<EpiIn>(lds, g.A + (size_t)TP * DM, g.Bt, DM, 16, 64, E, c, G);
        if (PROBE & 1) pg8::sample_gemm<EpiIn>(lds, g.A + (size_t)TP * DM, g.Bt, DM, 16, 64, E, c, G);
        if (PROBE & 2) { pg8::gemm_phase<EpiInT<true>, false>(lds, g, S, EM); }
    } SEAM(1);
    if (IN(2)) { phase_m1(args, lds, wave, fresh_lane()); if (PROBE & (16 | 4096 | 8192)) { __syncthreads(); phase_m1(args, lds, wave, fresh_lane(), true); } } SEAM(2);
    if (IN(3)) { phase_m2(args, lds, wave, fresh_lane()); if (PROBE & 32) { __syncthreads(); phase_m2(args, lds, wave, fresh_lane()); } } SEAM(3);
    if (IN(4)) {
        { bf16_t* X1B = (bf16_t*)(ws + WS_X1B); const int gt = c * NTHREADS + tid;
          if (gt < 4 * 256) { const int b = gt >> 8, w = gt & 255; ((u32x4*)(X1B + (size_t)(4098 * b) * DM))[w] = (u32x4){0u, 0u, 0u, 0u}; } }
        pg8::Gemm g{(const bf16_t*)(ws + WS_XB), (const bf16_t*)(ws + WS_WOUT), DM}; pg8::StaticOrder S; S.init(64, 4, G, c);
        EpiOut E{args.in[0], args.in[1], args.out + O_Y, (bf16_t*)(ws + WS_X1B), (float*)(ws + WS_SS2)};
        pg8::gemm_phase<EpiOut, false>(lds, g, S, E);
        pg8::sample_gemm16<EpiOut>(lds, g.A + (size_t)TP * DM, g.Bt, DM, 4, 64, E, c, G);
        if (PROBE & 1) pg8::sample_gemm<EpiOut>(lds, g.A + (size_t)TP * DM, g.Bt, DM, 4, 64, E, c, G);
        if (PROBE & 4) { pg8::gemm_phase<EpiOut, false>(lds, g, S, E); }
    } SEAM(4);
    if (IN(5)) {
        pg8::Gemm g{(const bf16_t*)(ws + WS_X1B), (const bf16_t*)(ws + WS_WUP), DM}; pg8::StaticOrder S; S.init(69, 22, G, c);
        EpiUp E{(const float*)(ws + WS_SS2), args.in[13], args.in[14], args.in[4], (bf16_t*)(ws + WS_ACT), args.out + O_CCP, args.out + O_CCS};
        EpiUpMain EM{E.SS2, E.ck, E.cb, E.cache_in, E.ACT, E.ccp, E.ccs};
        pg8::gemm_phase<EpiUpMain, true>(lds, g, S, EM);
        if (PROBE & 8) { pg8::gemm_phase<EpiUpMain, true>(lds, g, S, EM); }
    } SEAM(5);
    if (IN(6)) {
        pg8::Gemm g{(const bf16_t*)(ws + WS_ACT), (const bf16_t*)(ws + WS_WD), DFF}; pg8::StaticOrder S; S.init(64, 4, G, c);
        EpiDownT<true> E{args.out + O_Y, (const bf16_t*)(ws + WS_X1B), (float*)(ws + WS_SS3), args.in[16], (float*)(ws + WS_SS3), (unsigned*)(ws + WS_CTL + 32768), lds + RING_BYTES, false};
        EpiDownT<false> Es{args.out + O_Y, (const bf16_t*)(ws + WS_X1B), (float*)(ws + WS_SS3), args.in[16], nullptr, (unsigned*)(ws + WS_CTL + 32768), lds, G == 256};
        if (PROBE & 2048) { EpiNull En; pg8::gemm_phase<EpiNull, false>(lds, g, S, En); }
        if (G == 256) pg8::gemm_phase<EpiDownT<true>, false>(lds, g, S, E);
        else pg8::gemm_phase<EpiDownT<false>, false>(lds, g, S, Es);
        pg8::sample_gemm16<EpiDownT<false>>(lds, g.A + (size_t)TP * DFF, g.Bt, DFF, 4, 64, Es, c, G);
    }
    if (G != 256) {
        SEAM(6);
        if (IN(7)) { phase_final(args, wave, fresh_lane()); }
    }
#undef IN
#undef SEAM
}

extern "C" void kernel_launch(void* const* d_in, const int* in_sizes, int n_in, void* d_out, int out_size, void* d_ws, size_t ws_size, hipStream_t stream) {
    static int grid = 0;
    if (grid == 0) {
        if (n_in != 17 || ws_size < WS_END) { fprintf(stderr, "kernel_launch: unexpected n_in %d or ws_size %zu (need %zu)\n", n_in, ws_size, (size_t)WS_END); grid = -1; return; }
        int dev = 0, cus = 0, per_cu = 0;
        hipGetDevice(&dev); hipDeviceGetAttribute(&cus, hipDeviceAttributeMultiprocessorCount, dev);
        hipFuncSetAttribute((const void*)fwd_kernel, hipFuncAttributeMaxDynamicSharedMemorySize, LDS_BYTES);
        hipOccupancyMaxActiveBlocksPerMultiprocessor(&per_cu, (const void*)fwd_kernel, NTHREADS, LDS_BYTES);
        if (per_cu < 1) { fprintf(stderr, "kernel_launch: occupancy query says %d blocks per CU\n", per_cu); per_cu = 1; }
        (void)hipGetLastError();
        grid = cus;
        if (grid > 256) grid = 256;
        fprintf(stderr, "kernel_launch: cus %d per_cu %d grid %d ws %zu\n", cus, per_cu, grid, ws_size);
    }
    if (grid < 0) return;
    hipMemsetAsync((char*)d_ws + WS_CTL, 0, 65536, stream);
    Args a{};
    for (int i = 0; i < 17; ++i) a.in[i] = (const float*)d_in[i];
    a.out = (float*)d_out; a.ws = (unsigned char*)d_ws;
    if (N_LAUNCHES == 1) {
        a.ph_lo = 0; a.ph_hi = 8;
        void* kargs[] = {&a};
#if PROBE & 1024
        hipLaunchKernelGGL(fwd_kernel, dim3(grid), dim3(NTHREADS), LDS_BYTES, stream, a); hipError_t e = hipSuccess; (void)kargs;
#else
        hipError_t e = hipLaunchCooperativeKernel((const void*)fwd_kernel, dim3(grid), dim3(NTHREADS), kargs, LDS_BYTES, stream);
#endif
        if (e != hipSuccess) fprintf(stderr, "cooperative launch failed: %s (grid %d)\n", hipGetErrorString(e), grid);
    } else {
        for (int p = 0; p < 8; ++p) { a.ph_lo = p; a.ph_hi = p + 1; hipLaunchKernelGGL(fwd_kernel, dim3(grid), dim3(NTHREADS), LDS_BYTES, stream, a); }
    }
}
```

```cpp
#include <hip/hip_runtime.h>
#include <cstdio>
#include <cstdint>

#ifndef PROBE
#define PROBE 0
#endif
#ifndef N_LAUNCHES
#define N_LAUNCHES 1
#endif

#ifndef FUSED_MIX
#define FUSED_MIX 1
#endif
#define LAS __attribute__((address_space(3)))
typedef unsigned short bf16_t;
typedef short bf16x8 __attribute__((ext_vector_type(8)));
typedef float f32x4 __attribute__((ext_vector_type(4)));
typedef float f32x2 __attribute__((ext_vector_type(2)));
typedef unsigned u32x4 __attribute__((ext_vector_type(4)));
typedef unsigned u32x2 __attribute__((ext_vector_type(2)));

constexpr int DM = 1024, TP = 16384, TS = 256, TT = TP + TS, SEQ = 4096;
constexpr int DFF = 2816, UPC = 5632, INC = 4096, HW = 512;
constexpr float EPS = 1e-6f;
constexpr int NTHREADS = 512, NWAVES = 8;
constexpr int LDS_BYTES = 163840;
constexpr int RING_BYTES = 131072;
constexpr int MISC_OFF = LDS_BYTES - 256;

constexpr size_t O_Y = 0, O_RETP = 17039360, O_HGP = 17301504, O_CCP = 17563648, O_RETS = 17586176, O_HGS = 18634752, O_CCS = 19683328;

constexpr size_t WS_CTL = 0;
constexpr size_t WS_WIN = 65536;
constexpr size_t WS_WOUT = WS_WIN + (size_t)INC * DM * 2;
constexpr size_t WS_WUP = WS_WOUT + (size_t)DM * DM * 2;
constexpr size_t WS_WD = WS_WUP + (size_t)UPC * DM * 2;
constexpr size_t WS_ROPE = WS_WD + (size_t)DM * DFF * 2;
constexpr size_t WS_LB = WS_ROPE + (size_t)SEQ * 64 * 8;
constexpr size_t WS_SS2 = WS_LB + 4096;
constexpr size_t WS_SS3 = WS_SS2 + (size_t)TT * 16 * 4;
constexpr size_t WS_XB = WS_SS3 + (size_t)TT * 16 * 4;
constexpr size_t WS_PROJ = WS_XB + (size_t)TT * DM * 2;
constexpr size_t PSZ = (size_t)TT * HW * 2;
constexpr size_t WS_QR = WS_PROJ, WS_KR = WS_PROJ + PSZ, WS_VR = WS_PROJ + 2 * PSZ, WS_GR = WS_PROJ + 3 * PSZ, WS_HQ = WS_PROJ + 4 * PSZ,
                 WS_HK = WS_PROJ + 5 * PSZ, WS_HI = WS_PROJ + 6 * PSZ, WS_HGT = WS_PROJ + 7 * PSZ;
constexpr size_t WS_DEC = WS_PROJ + 8 * PSZ;
constexpr size_t WS_HGFS = WS_DEC + (size_t)256 * HW * 4;
constexpr size_t WS_PROJ_END = WS_HGFS + (size_t)TS * HW * 4;
constexpr int X1B_ROWS = 16896;
constexpr size_t WS_X1B = WS_PROJ;
constexpr size_t WS_ACT = WS_X1B + (size_t)X1B_ROWS * DM * 2;
constexpr size_t WS_ACT_END = WS_ACT + (size_t)TT * DFF * 2;
static_assert(WS_ACT_END <= WS_PROJ_END, "overlay");
constexpr size_t WS_MRG = WS_PROJ_END;
constexpr size_t WS_SS1 = WS_MRG + (size_t)TT * DM * 2;
constexpr size_t WS_END = WS_SS1 + (size_t)TT * 4;
static_assert(WS_END <= (size_t)256 * 1024 * 1024, "workspace");

__device__ __forceinline__ size_t pofs(int head, size_t row) { return ((size_t)head * TT + row) * 128; }
__device__ __forceinline__ unsigned cvt_pk_bf16(float lo, float hi) { unsigned r; asm volatile("v_cvt_pk_bf16_f32 %0, %1, %2" : "=v"(r) : "v"(lo), "v"(hi)); return r; }
__device__ __forceinline__ int fresh_lane() { int l; asm volatile("v_mbcnt_lo_u32_b32 %0, -1, 0\n\tv_mbcnt_hi_u32_b32 %0, -1, %0" : "=v"(l)); return l; }
__device__ __forceinline__ float bf2f(unsigned short b) { return __uint_as_float(((unsigned)b) << 16); }
__device__ __forceinline__ float sigmoid_f(float x) { return __builtin_amdgcn_rcpf(1.0f + __builtin_amdgcn_exp2f(x * -1.4426950408889634f)); }
__device__ __forceinline__ float silu_f(float x) { return x * sigmoid_f(x); }
#ifndef WT_STORES
#define WT_STORES 0
#endif
__device__ __forceinline__ void st16b(const void* base, void* p, u32x4 v) {
#if WT_STORES == 3
    __builtin_amdgcn_raw_buffer_store_b128(v, __builtin_amdgcn_make_buffer_rsrc((void*)base, 0, 0x7fffffff, 0x00020000), (int)((const char*)p - (const char*)base), 0, 16);
#else
    *(u32x4*)p = v;
#endif
}
__device__ __forceinline__ void st8b(const void* base, void* p, u32x2 v) {
#if WT_STORES == 3
    __builtin_amdgcn_raw_buffer_store_b64(v, __builtin_amdgcn_make_buffer_rsrc((void*)base, 0, 0x7fffffff, 0x00020000), (int)((const char*)p - (const char*)base), 0, 16);
#else
    *(u32x2*)p = v;
#endif
}
__device__ __forceinline__ void st16(void* p, u32x4 v) {
#if WT_STORES == 1
    asm volatile("global_store_dwordx4 %0, %1, off sc1\n\ts_nop 1" :: "v"(p), "v"(v) : "memory");
#elif WT_STORES == 2
    __builtin_nontemporal_store(v, (u32x4*)p);
#else
    *(u32x4*)p = v;
#endif
}
__device__ __forceinline__ void st8(void* p, u32x2 v) {
#if WT_STORES == 1
    asm volatile("global_store_dwordx2 %0, %1, off sc1\n\ts_nop 1" :: "v"(p), "v"(v) : "memory");
#elif WT_STORES == 2
    __builtin_nontemporal_store(v, (u32x2*)p);
#else
    *(u32x2*)p = v;
#endif
}
__device__ __forceinline__ void st16wt(void* p, f32x4 v) { asm volatile("global_store_dwordx4 %0, %1, off sc1\n\ts_nop 1" :: "v"(p), "v"(v) : "memory"); }
__device__ __forceinline__ void st4wt(void* p, float v) { asm volatile("global_store_dword %0, %1, off sc1\n\ts_nop 1" :: "v"(p), "v"(v) : "memory"); }
template <int CTRL> __device__ __forceinline__ float dpp_z(float src) {
    return __builtin_bit_cast(float, __builtin_amdgcn_update_dpp(0, __builtin_bit_cast(int, src), CTRL, 0xF, 0xF, true)); }
template <int CTRL> __device__ __forceinline__ float dpp_f(float oldv, float src) {
    return __builtin_bit_cast(float, __builtin_amdgcn_update_dpp(__builtin_bit_cast(int, oldv), __builtin_bit_cast(int, src), CTRL, 0xF, 0xF, false)); }

#define XB_TMO      128
#define XB_XCNT(j)  (256  + 64 * (j))
#define XB_XSUB(j)  (1280 + 64 * (j))
#define XB_XGEN(j)  (2304 + 64 * (j))
#define XB_TOP      3328
#define XB_TOPGEN   3392
#define XCD_BAR_WORDS 3456
#define XB_SPIN_CAP (1u << 18)
__device__ __forceinline__ unsigned xb_ld(unsigned* p)              { return __hip_atomic_load(p, __ATOMIC_RELAXED, __HIP_MEMORY_SCOPE_AGENT); }
__device__ __forceinline__ unsigned xb_add(unsigned* p, unsigned v) { return __hip_atomic_fetch_add(p, v, __ATOMIC_RELAXED, __HIP_MEMORY_SCOPE_AGENT); }
__device__ __forceinline__ unsigned xb_xcc_id() { return (unsigned)__builtin_amdgcn_s_getreg((3 << 11) | 20) & 0xFu; }
#define XB_SPIN(cond, bar) do { unsigned _sp = 0; while (cond) { __builtin_amdgcn_s_sleep(1); \
    if ((++_sp & 255u) == 0u) { if (xb_ld(&(bar)[XB_TMO])) break; if (_sp > XB_SPIN_CAP) { atomicAdd(&(bar)[XB_TMO], 1u); break; } } } } while (0)
struct XcdBarrier { unsigned* bar; unsigned x; volatile LAS unsigned* st; };
__device__ __forceinline__ XcdBarrier xcd_barrier_post(unsigned* bar, volatile LAS unsigned* st) {
    XcdBarrier b; b.bar = bar; b.x = xb_xcc_id(); b.st = st;
    if (threadIdx.x == 0) (void)xb_add(&bar[XB_XCNT(b.x)], 1u);
    return b;
}
__device__ __forceinline__ void xcd_barrier_complete(unsigned* bar, unsigned x, unsigned& nloc, unsigned& nx) {
    const unsigned G = gridDim.x * gridDim.y * gridDim.z;
    unsigned sum, cnt, mine, sp = 0u;
    for (;;) {
        sum = 0u; cnt = 0u; mine = 0u;
#pragma unroll
        for (unsigned j = 0; j < 16; ++j) { const unsigned c = xb_ld(&bar[XB_XCNT(j)]); sum += c; cnt += (c > 0u) ? 1u : 0u; mine = (j == x) ? c : mine; }
        if (sum == G) break;
        __builtin_amdgcn_s_sleep(1);
        if ((++sp & 255u) == 0u) { if (xb_ld(&bar[XB_TMO])) break; if (sp > XB_SPIN_CAP) { atomicAdd(&bar[XB_TMO], 1u); break; } }
    }
    nloc = mine > 0u ? mine : 1u; nx = cnt > 0u ? cnt : 1u;
}
__device__ __forceinline__ void xcd_barrier(const XcdBarrier& b) {
    asm volatile("s_waitcnt vmcnt(0)" ::: "memory");
    __syncthreads();
    if (threadIdx.x == 0) {
        unsigned* bar = b.bar;
        __builtin_amdgcn_s_waitcnt(0);
        unsigned nloc = b.st[0], nx = b.st[1];
        if (nloc == 0u) { xcd_barrier_complete(bar, b.x, nloc, nx); b.st[0] = nloc; b.st[1] = nx; }
        const unsigned old = xb_add(&bar[XB_XSUB(b.x)], 1u);
        const unsigned gen = old / nloc;
        if (old + 1u == (gen + 1u) * nloc) {
            __builtin_amdgcn_fence(__ATOMIC_RELEASE, "agent");
            asm volatile("s_waitcnt vmcnt(0)" ::: "memory");
            const unsigned og = xb_add(&bar[XB_TOP], 1u);
            const unsigned tg = og / nx;
            if (og + 1u == (tg + 1u) * nx) xb_add(&bar[XB_TOPGEN], 1u);
            else XB_SPIN(xb_ld(&bar[XB_TOPGEN]) == tg, bar);
            __builtin_amdgcn_fence(__ATOMIC_ACQUIRE, "agent");
            xb_add(&bar[XB_XGEN(b.x)], 1u);
            asm volatile("s_waitcnt vmcnt(0)" ::: "memory");
        } else {
            XB_SPIN(xb_ld(&bar[XB_XGEN(b.x)]) == gen, bar);
            __builtin_amdgcn_fence(__ATOMIC_ACQUIRE, "agent");
            asm volatile("s_waitcnt vmcnt(0)" ::: "memory");
        }
    }
    __syncthreads();
}

namespace pg8 {
constexpr int BM = 256, BK = 64, HALF = 128, HTB = HALF * BK * 2, NXCD = 8, WGM = 8;
__host__ __device__ __forceinline__ int lds_byte(int r, int c) { const int st = (r >> 4) * 2 + (c >> 5), rr = r & 15, cc = c & 31, ob = rr * 64 + cc * 2; return st * 1024 + (ob ^ (((ob >> 9) & 1) << 5)); }
__host__ __device__ __forceinline__ void stage_rc(int b, int& R, int& C) { const int st = b / 1024, sb = b % 1024, swz = sb ^ (((sb >> 9) & 1) << 5); R = (st >> 1) * 16 + swz / 64; C = (st & 1) * 32 + (swz % 64) / 2; }
__host__ __device__ __forceinline__ int perm32(int rho) { const int n = rho >> 4, i = rho & 15; return 8 * (i >> 2) + 4 * n + (i & 3); }

struct Unit { int pm, pn; };
struct Gemm { const bf16_t* A; const bf16_t* Bt; int K; };

struct StaticOrder {
    int nM, nN, nwg, G, c;
    __device__ void init(int nM_, int nN_, int G_, int c_) { nM = nM_; nN = nN_; nwg = nM * nN; G = G_; c = c_; }
    __device__ bool next(int i, Unit& u) const {
        const long L = (long)i * G + c; if (L >= nwg) return false;
        int wgid = (int)L; { const int q = nwg / NXCD, r = nwg % NXCD, xcd = wgid % NXCD, off = wgid / NXCD; wgid = (xcd < r ? xcd * (q + 1) : r * (q + 1) + (xcd - r) * q) + off; }
        const int nig = WGM * nN, gid = wgid / nig, fm = gid * WGM, gsz = (nM - fm) < WGM ? (nM - fm) : WGM;
        u.pm = fm + ((wgid % nig) % gsz); u.pn = (wgid % nig) / gsz; return true;
    }
};

struct AInfo { const char* base; size_t hstep; unsigned v0, v1; };
template <bool UPMAP, bool TOK = false>
__device__ __forceinline__ AInfo a_info(const Gemm& g, const Unit& u, int tid) {
    AInfo a; const int K = g.K;
    int R0, C0, R1, C1; stage_rc(tid * 16, R0, C0); stage_rc(tid * 16 + 8192, R1, C1);
    if constexpr (!UPMAP && TOK) {
        R0 = (R0 & 64) | ((R0 & 15) << 2) | ((R0 >> 4) & 3); R1 = (R1 & 64) | ((R1 & 15) << 2) | ((R1 >> 4) & 3);
    }
    if constexpr (!UPMAP) {
        a.base = (const char*)g.A + (size_t)u.pm * 256 * K * 2; a.hstep = (size_t)HALF * K * 2;
        a.v0 = (unsigned)(R0 * K + C0) * 2u; a.v1 = (unsigned)(R1 * K + C1) * 2u;
    } else {
        if (u.pm < 68) {
            const int b = u.pm / 17, j = u.pm % 17;
            a.base = (const char*)g.A + (size_t)(4098 * b + 248 * j) * K * 2; a.hstep = (size_t)124 * K * 2;
            const int P0 = (R0 & 64) | ((R0 & 15) << 2) | ((R0 >> 4) & 3), P1 = (R1 & 64) | ((R1 & 15) << 2) | ((R1 >> 4) & 3);
            a.v0 = (unsigned)((P0 - 2 * (P0 >> 6)) * K + C0) * 2u; a.v1 = (unsigned)((P1 - 2 * (P1 >> 6)) * K + C1) * 2u;
        } else {
            const int P0 = (R0 & 64) | ((R0 & 15) << 2) | ((R0 >> 4) & 3), P1 = (R1 & 64) | ((R1 & 15) << 2) | ((R1 >> 4) & 3);
            a.base = (const char*)g.A + (size_t)16394 * K * 2; a.hstep = (size_t)HALF * K * 2;
            a.v0 = (unsigned)(P0 * K + C0) * 2u; a.v1 = (unsigned)(P1 * K + C1) * 2u;
        }
    }
    return a;
}

template <class Epi, bool UPMAP>
__device__ __forceinline__ void gemm_phase(LAS unsigned char* lds, const Gemm g, const StaticOrder& S, const Epi& E) {
    const int tid = threadIdx.x, wid = __builtin_amdgcn_readfirstlane(tid >> 6), lane = tid & 63, wr = wid >> 2, wc = wid & 3, fr = lane & 15, fq = lane >> 4;
    const int K = g.K, nt = K / BK;
    unsigned voffB[2];
#pragma unroll
    for (int i = 0; i < 2; ++i) { int R, C; stage_rc(tid * 16 + i * 8192, R, C); const int Rb = (R & ~31) + perm32(R & 31); voffB[i] = (unsigned)(Rb * K + C) * 2u; }
    const size_t kstep = (size_t)(BK * 2);
    const size_t hstepB = (size_t)HALF * K * 2;
    const size_t tstepB = 2 * hstepB;
    const unsigned ldsw = (unsigned)wid * 1024u;
    const int aoff = lds_byte(wr * 64 + fr, fq * 8), boff = lds_byte(wc * 32 + fr, fq * 8);
#define PG8_SA(b, h) (((b) * 2 + (h)) * HTB)
#define PG8_SB(b, h) ((4 + (b) * 2 + (h)) * HTB)
#define PG8_STAGEB(bufoff, gbase) do { _Pragma("unroll") for (int _i = 0; _i < 2; ++_i) \
        __builtin_amdgcn_global_load_lds((const unsigned*)((const char*)(gbase) + voffB[_i]), (LAS unsigned*)(lds + (bufoff) + ldsw + _i * 8192), 16, 0, 0); } while (0)
#define PG8_STAGEA(bufoff, gbase, va0, va1) do { \
        __builtin_amdgcn_global_load_lds((const unsigned*)((const char*)(gbase) + (va0)), (LAS unsigned*)(lds + (bufoff) + ldsw), 16, 0, 0); \
        __builtin_amdgcn_global_load_lds((const unsigned*)((const char*)(gbase) + (va1)), (LAS unsigned*)(lds + (bufoff) + ldsw + 8192), 16, 0, 0); } while (0)
#define PG8_LDA(dst, b, h) do { _Pragma("unroll") for (int m = 0; m < 4; ++m) _Pragma("unroll") for (int k = 0; k < 2; ++k) dst[m][k] = *(const LAS bf16x8*)(lds + PG8_SA(b, h) + aoff + m * 2048 + k * 1024); } while (0)
#define PG8_LDB(dst, b, h) do { _Pragma("unroll") for (int n = 0; n < 2; ++n) _Pragma("unroll") for (int k = 0; k < 2; ++k) dst[n][k] = *(const LAS bf16x8*)(lds + PG8_SB(b, h) + boff + n * 2048 + k * 1024); } while (0)
#define PG8_MMA(ai, bj, At, Bt) do { __builtin_amdgcn_s_setprio(1); _Pragma("unroll") for (int m = 0; m < 4; ++m) _Pragma("unroll") for (int n = 0; n < 2; ++n) _Pragma("unroll") for (int k = 0; k < 2; ++k) \
        acc[ai][bj][m][n] = __builtin_amdgcn_mfma_f32_16x16x32_bf16(Bt[n][k], At[m][k], acc[ai][bj][m][n], 0, 0, 0); __builtin_amdgcn_s_setprio(0); } while (0)
#define PG8_WAIT_V(n) asm volatile("s_waitcnt vmcnt(" #n ")" ::: "memory")
#define PG8_WAIT_L(n) asm volatile("s_waitcnt lgkmcnt(" #n ")" ::: "memory")
#define PG8_BAR __builtin_amdgcn_s_barrier()
#define PG8_SCHED __builtin_amdgcn_sched_barrier(0)
    Unit cur, nxt; int ui = 0;
    if (!S.next(0, cur)) return;
    f32x4 acc[2][2][4][2];
#pragma unroll
    for (int a = 0; a < 2; ++a)
#pragma unroll
        for (int b = 0; b < 2; ++b)
#pragma unroll
            for (int m = 0; m < 4; ++m)
#pragma unroll
                for (int n = 0; n < 2; ++n) acc[a][b][m][n] = (f32x4){0.f, 0.f, 0.f, 0.f};
    bf16x8 At[4][2], B0[2][2], B1[2][2];
    AInfo ca = a_info<UPMAP, Epi::TOK>(g, cur, tid);
    const char* cA = ca.base; const char* cB = (const char*)g.Bt + (size_t)cur.pn * tstepB;
    PG8_STAGEB(PG8_SB(0, 0), cB); PG8_STAGEB(PG8_SB(0, 1), cB + hstepB); PG8_STAGEA(PG8_SA(0, 0), cA, ca.v0, ca.v1); PG8_STAGEA(PG8_SA(0, 1), cA + ca.hstep, ca.v0, ca.v1);
    if (wr == 1) PG8_BAR;
    PG8_WAIT_V(2); PG8_BAR;
    PG8_STAGEB(PG8_SB(1, 0), cB + kstep); PG8_STAGEA(PG8_SA(1, 0), cA + kstep, ca.v0, ca.v1); PG8_STAGEB(PG8_SB(1, 1), cB + hstepB + kstep);
    PG8_WAIT_V(6); PG8_BAR;
    for (;;) {
        const bool has_next = S.next(ui + 1, nxt);
        AInfo na = ca; if (has_next) na = a_info<UPMAP, Epi::TOK>(g, nxt, tid);
        const char* nA = na.base; const char* nB = has_next ? (const char*)g.Bt + (size_t)nxt.pn * tstepB : cB;
        for (int t = 0; t < nt; t += 2) {
            const bool last = (t == nt - 2);
            const char* a1 = cA + (size_t)(t + 1) * kstep;
            const char* a2 = last ? nA : cA + (size_t)(t + 2) * kstep; const char* b2 = last ? nB : cB + (size_t)(t + 2) * kstep;
            const char* a3 = a2 + kstep; const char* b3 = b2 + kstep;
            const size_t h2 = last ? na.hstep : ca.hstep; const unsigned w0 = last ? na.v0 : ca.v0, w1 = last ? na.v1 : ca.v1;
            PG8_LDB(B0, 0, 0); PG8_LDB(B1, 0, 1); PG8_SCHED; PG8_LDA(At, 0, 0); PG8_STAGEA(PG8_SA(1, 1), a1 + ca.hstep, ca.v0, ca.v1);
            PG8_WAIT_V(8); PG8_WAIT_L(0); PG8_BAR; PG8_MMA(0, 0, At, B0); PG8_MMA(0, 1, At, B1); PG8_BAR; PG8_SCHED;
            PG8_LDA(At, 0, 1); PG8_STAGEB(PG8_SB(0, 0), b2); PG8_STAGEB(PG8_SB(0, 1), b2 + hstepB); PG8_STAGEA(PG8_SA(0, 0), a2, w0, w1);
            PG8_WAIT_V(8); PG8_WAIT_L(0); PG8_BAR; PG8_MMA(1, 0, At, B0); PG8_MMA(1, 1, At, B1); PG8_BAR; PG8_SCHED;
            PG8_LDB(B0, 1, 0); PG8_LDB(B1, 1, 1); PG8_SCHED; PG8_LDA(At, 1, 0); PG8_STAGEA(PG8_SA(0, 1), a2 + h2, w0, w1);
            PG8_WAIT_V(8); PG8_WAIT_L(0); PG8_BAR; PG8_MMA(0, 0, At, B0); PG8_MMA(0, 1, At, B1); PG8_BAR; PG8_SCHED;
            PG8_LDA(At, 1, 1); PG8_STAGEB(PG8_SB(1, 0), b3); PG8_STAGEB(PG8_SB(1, 1), b3 + hstepB); PG8_STAGEA(PG8_SA(1, 0), a3, w0, w1);
            PG8_WAIT_V(8); PG8_WAIT_L(0); PG8_BAR; PG8_MMA(1, 0, At, B0); PG8_MMA(1, 1, At, B1); PG8_BAR; PG8_SCHED;
        }
        if constexpr (!Epi::INALIGN) { if (wr == 0) PG8_BAR; }
        E(acc, cur, wr, wc, fr, fq);
        if constexpr ((PROBE & 512) && Epi::IDEM) E(acc, cur, wr, wc, fr, fq);
        if (!has_next) break;
#pragma unroll
        for (int a = 0; a < 2; ++a)
#pragma unroll
            for (int b = 0; b < 2; ++b)
#pragma unroll
                for (int m = 0; m < 4; ++m)
#pragma unroll
                    for (int n = 0; n < 2; ++n) acc[a][b][m][n] = (f32x4){0.f, 0.f, 0.f, 0.f};
        cur = nxt; ca = na; cA = nA; cB = nB; ++ui;
        if (wr == 1) PG8_BAR;
    }
    PG8_WAIT_V(0);
    PG8_BAR;
#undef PG8_SA
#undef PG8_SB
#undef PG8_STAGEA
#undef PG8_STAGEB
#undef PG8_LDA
#undef PG8_LDB
#undef PG8_MMA
#undef PG8_WAIT_V
#undef PG8_WAIT_L
#undef PG8_BAR
#undef PG8_SCHED
}

template <class Epi>
__device__ __forceinline__ void sample_gemm(LAS unsigned char* lds, const bf16_t* Arows, const bf16_t* Bt, const int K, const int nN, const int pm_unit, const Epi& E, const int job0, const int jstride, const int jend = 1 << 30) {
    const int tid = threadIdx.x, w = __builtin_amdgcn_readfirstlane(tid >> 6);
    int lane = tid & 63; asm volatile("" : "+v"(lane));
    const int fr = lane & 15, fq = lane >> 4;
    const int per = K / 256;
#pragma unroll 1
    for (int job = job0; job < nN * 16 && job < jend; job += jstride) {
        const int pn = job >> 4, jai = (job >> 3) & 1, jwr = (job >> 2) & 1, jwc = job & 3;
        f32x4 h[2][4][2];
#pragma unroll
        for (int b = 0; b < 2; ++b)
#pragma unroll
            for (int m = 0; m < 4; ++m)
#pragma unroll
                for (int n = 0; n < 2; ++n) h[b][m][n] = (f32x4){0.f, 0.f, 0.f, 0.f};
        const bf16_t* ap = Arows + (size_t)(jai * 128 + jwr * 64 + fr) * K + 8 * fq + (w * per) * 32;
        const bf16_t* bp = Bt + (size_t)(pn * 256 + jwc * 32 + 8 * (fr >> 2) + (fr & 3)) * K + 8 * fq + (w * per) * 32;
#pragma unroll 1
        for (int ks0 = 0; ks0 < per; ks0 += 4) {
            bf16x8 af[4][4], bfr[4][2][2];
#pragma unroll
            for (int kl = 0; kl < 4; ++kl) {
                const int ks = (ks0 + kl < per) ? ks0 + kl : per - 1;
#pragma unroll
                for (int m = 0; m < 4; ++m) af[kl][m] = *(const bf16x8*)(ap + (size_t)(16 * m) * K + 32 * ks);
#pragma unroll
                for (int bj = 0; bj < 2; ++bj)
#pragma unroll
                    for (int n = 0; n < 2; ++n) bfr[kl][bj][n] = *(const bf16x8*)(bp + (size_t)(bj * 128 + 4 * n) * K + 32 * ks);
            }
#pragma unroll
            for (int kl = 0; kl < 4; ++kl)
                if (ks0 + kl < per) {
#pragma unroll
                    for (int bj = 0; bj < 2; ++bj)
#pragma unroll
                        for (int m = 0; m < 4; ++m)
#pragma unroll
                            for (int n = 0; n < 2; ++n) h[bj][m][n] = __builtin_amdgcn_mfma_f32_16x16x32_bf16(bfr[kl][bj][n], af[kl][m], h[bj][m][n], 0, 0, 0);
                }
        }
        __syncthreads();
#pragma unroll
        for (int bj = 0; bj < 2; ++bj)
#pragma unroll
            for (int m = 0; m < 4; ++m)
#pragma unroll
                for (int n = 0; n < 2; ++n) *(LAS f32x4*)(lds + ((w * 16 + (bj * 4 + m) * 2 + n) * 64 + lane) * 16) = h[bj][m][n];
        __syncthreads();
#pragma unroll
        for (int q = 0; q < 2; ++q) {
            LAS unsigned char* sp = lds + ((2 * w + q) * 64 + lane) * 16;
            f32x4 sum = *(const LAS f32x4*)sp;
#pragma unroll
            for (int ww = 1; ww < 8; ++ww) sum += *(const LAS f32x4*)(sp + ww * 16384);
            *(LAS f32x4*)sp = sum;
        }
        __syncthreads();
        if (w < 4) {
            f32x4 acc[2][2][4][2];
#pragma unroll
            for (int ai = 0; ai < 2; ++ai)
#pragma unroll
                for (int bj = 0; bj < 2; ++bj)
#pragma unroll
                    for (int m = 0; m < 4; ++m)
#pragma unroll
                        for (int n = 0; n < 2; ++n) acc[ai][bj][m][n] = *(const LAS f32x4*)(lds + (((bj * 4 + m) * 2 + n) * 64 + lane) * 16);
            Unit u; u.pm = pm_unit; u.pn = pn;
            E(acc, u, jwr, jwc, fr, fq, 1u << (4 * jai + w));
        }
        if constexpr (Epi::POST) E.post(lds, 2 * jai + jwr, w, lane, 16u);
    }
    __syncthreads();
}

template <class Epi, bool H = Epi::S16> struct S16Pre { struct type {}; };
template <class Epi> struct S16Pre<Epi, true> { using type = typename Epi::PreS; };
template <class Epi>
__device__ __forceinline__ void sample_gemm16(LAS unsigned char* lds, const bf16_t* Arows, const bf16_t* Bt, const int K, const int nN, const int pm_unit, const Epi& E, const int job0, const int jstride) {
    const int tid = threadIdx.x, w = __builtin_amdgcn_readfirstlane(tid >> 6);
    int lane = tid & 63; asm volatile("" : "+v"(lane));
    const int fr = lane & 15, fq = lane >> 4;
    const int per = K / 256;
#pragma unroll 1
    for (int job = job0; job < nN * 64; job += jstride) {
        const int pn = job >> 6, jai = (job >> 5) & 1, jwr = (job >> 4) & 1, jm = (job >> 2) & 3, jwc = job & 3;
        f32x4 h[2][2];
#pragma unroll
        for (int b = 0; b < 2; ++b)
#pragma unroll
            for (int n = 0; n < 2; ++n) h[b][n] = (f32x4){0.f, 0.f, 0.f, 0.f};
        const bf16_t* ap = Arows + (size_t)(jai * 128 + jwr * 64 + 16 * jm + fr) * K + 8 * fq + (w * per) * 32;
        const bf16_t* bp = Bt + (size_t)(pn * 256 + jwc * 32 + 8 * (fr >> 2) + (fr & 3)) * K + 8 * fq + (w * per) * 32;
        typename S16Pre<Epi>::type ps{};
        if constexpr (Epi::S16) { if (w == 0) ps = E.pre_s(pm_unit, pn, jwr, jwc, fr, fq, jai, jm); }
#pragma unroll 1
        for (int ks0 = 0; ks0 < per; ks0 += 6) {
            bf16x8 af[6], bfr[6][2][2];
#pragma unroll
            for (int kl = 0; kl < 6; ++kl) {
                const int ks = (ks0 + kl < per) ? ks0 + kl : per - 1;
                af[kl] = *(const bf16x8*)(ap + 32 * ks);
#pragma unroll
                for (int bj = 0; bj < 2; ++bj)
#pragma unroll
                    for (int n = 0; n < 2; ++n) bfr[kl][bj][n] = *(const bf16x8*)(bp + (size_t)(bj * 128 + 4 * n) * K + 32 * ks);
            }
#pragma unroll
            for (int kl = 0; kl < 6; ++kl)
                if (ks0 + kl < per) {
#pragma unroll
                    for (int bj = 0; bj < 2; ++bj)
#pragma unroll
                        for (int n = 0; n < 2; ++n) h[bj][n] = __builtin_amdgcn_mfma_f32_16x16x32_bf16(bfr[kl][bj][n], af[kl], h[bj][n], 0, 0, 0);
                }
        }
        __syncthreads();
#pragma unroll
        for (int bj = 0; bj < 2; ++bj)
#pragma unroll
            for (int n = 0; n < 2; ++n) *(LAS f32x4*)(lds + ((w * 4 + bj * 2 + n) * 64 + lane) * 16) = h[bj][n];
        __syncthreads();
        if (w < 4) {
            LAS unsigned char* sp = lds + (w * 64 + lane) * 16;
            f32x4 sum = *(const LAS f32x4*)sp;
#pragma unroll
            for (int ww = 1; ww < 8; ++ww) sum += *(const LAS f32x4*)(sp + ww * 4096);
            *(LAS f32x4*)sp = sum;
        }
        __syncthreads();
        if (w == 0) {
            f32x4 acc[2][2][4][2];
#pragma unroll
            for (int ai = 0; ai < 2; ++ai)
#pragma unroll
                for (int bj = 0; bj < 2; ++bj)
#pragma unroll
                    for (int m = 0; m < 4; ++m)
#pragma unroll
                        for (int n = 0; n < 2; ++n) acc[ai][bj][m][n] = *(const LAS f32x4*)(lds + ((bj * 2 + n) * 64 + lane) * 16);
            Unit u; u.pm = pm_unit; u.pn = pn;
            if constexpr (Epi::S16) E.run_s(acc, ps, u, jwr, jwc, fr, fq, jai, jm);
            else if constexpr (Epi::POST) { if (E.fuse16) E.fused16(acc, u, jwr, jwc, fr, fq, jai, jm); else E(acc, u, jwr, jwc, fr, fq, 1u << (4 * jai + jm)); }
            else E(acc, u, jwr, jwc, fr, fq, 1u << (4 * jai + jm));
        }
        if constexpr (Epi::POST) { if (!E.fuse16) E.post(lds, 2 * jai + jwr, w, lane, 64u); }
    }
    __syncthreads();
}
}
using pg8::Unit;

template <bool TOK_>
struct EpiInT {
    static constexpr bool TOK = TOK_;
    static constexpr bool INALIGN = TOK_;
    static constexpr bool IDEM = true, POST = false;
    unsigned char* proj; float* DEC; float* HGFS; const f32x4* rope; const float* lb;
    __device__ __forceinline__ void operator()(const f32x4 (&acc)[2][2][4][2], const Unit& u, int wr, int wc, int fr_, int fq_, const unsigned mask = 0xffu) const {
        int fr = fr_, fq = fq_; asm volatile("" : "+v"(fr), "+v"(fq));
        const int pn = u.pn; const bool samp = !TOK && (u.pm == 64);
        constexpr int RM = TOK ? 1 : 16, RF = TOK ? 4 : 1;
        const int dd0 = 32 * (wc & 1) + 8 * fq;
        const int col0 = ((pn & 1) * 2 + (wc >> 1)) * 128 + dd0;
        const int rowb = u.pm * 256 + wr * 64 + RF * fr;
        if (pn < 4) {
            const int type = pn >> 1;
            bf16_t* D = (bf16_t*)(proj + (size_t)type * PSZ);
            const int head = (pn & 1) * 2 + (wc >> 1);
            const float lg = __log2f(1.0f - exp2f(-5.0f - (float)head));
            const float base = type == 0 ? 1.0f : 0.08838834764831845f;
            f32x4 cv[2][4][4];
            auto ldc = [&](int ai, int m) { if ((mask >> (4 * ai + m)) & 1u) { const int r = rowb + ai * 128 + m * RM; const int pos = r < TP ? (r & 4095) : (1024 + (r & 15));
                const f32x4* cs = rope + (size_t)pos * 32 + (dd0 >> 1);
#pragma unroll
                for (int q = 0; q < 4; ++q) cv[ai][m][q] = cs[q]; } };
            ldc(0, 0); ldc(0, 1); ldc(0, 2);
            if constexpr (INALIGN) { if (wr == 0) __builtin_amdgcn_s_barrier(); }
#pragma unroll
            for (int ai = 0; ai < 2; ++ai)
#pragma unroll
                for (int m = 0; m < 4; ++m) { { constexpr int D3 = 3; const int g = 4 * ai + m + D3; if (g < 8) ldc(g >> 2, g & 3); } if ((mask >> (4 * ai + m)) & 1u) {
                    const int r = rowb + ai * 128 + m * RM;
                    const float e = (float)((r & 63) + 1) * lg;
                    const float sc = samp ? base : base * exp2f(type == 0 ? e : -e);
                    const f32x4 c0 = cv[ai][m][0], c1 = cv[ai][m][1], c2 = cv[ai][m][2], c3 = cv[ai][m][3];
                    const f32x4 lo0 = acc[ai][0][m][0], lo1 = acc[ai][0][m][1], hi0 = acc[ai][1][m][0], hi1 = acc[ai][1][m][1];
                    float ol[8], oh[8];
                    ol[0] = lo0[0] * c0[0] - hi0[0] * c0[1]; oh[0] = lo0[0] * c0[1] + hi0[0] * c0[0];
                    ol[1] = lo0[1] * c0[2] - hi0[1] * c0[3]; oh[1] = lo0[1] * c0[3] + hi0[1] * c0[2];
                    ol[2] = lo0[2] * c1[0] - hi0[2] * c1[1]; oh[2] = lo0[2] * c1[1] + hi0[2] * c1[0];
                    ol[3] = lo0[3] * c1[2] - hi0[3] * c1[3]; oh[3] = lo0[3] * c1[3] + hi0[3] * c1[2];
                    ol[4] = lo1[0] * c2[0] - hi1[0] * c2[1]; oh[4] = lo1[0] * c2[1] + hi1[0] * c2[0];
                    ol[5] = lo1[1] * c2[2] - hi1[1] * c2[3]; oh[5] = lo1[1] * c2[3] + hi1[1] * c2[2];
                    ol[6] = lo1[2] * c3[0] - hi1[2] * c3[1]; oh[6] = lo1[2] * c3[1] + hi1[2] * c3[0];
                    ol[7] = lo1[3] * c3[2] - hi1[3] * c3[3]; oh[7] = lo1[3] * c3[3] + hi1[3] * c3[2];
                    u32x4 wl, wh;
                    wl.x = cvt_pk_bf16(ol[0] * sc, ol[1] * sc); wl.y = cvt_pk_bf16(ol[2] * sc, ol[3] * sc); wl.z = cvt_pk_bf16(ol[4] * sc, ol[5] * sc); wl.w = cvt_pk_bf16(ol[6] * sc, ol[7] * sc);
                    wh.x = cvt_pk_bf16(oh[0] * sc, oh[1] * sc); wh.y = cvt_pk_bf16(oh[2] * sc, oh[3] * sc); wh.z = cvt_pk_bf16(oh[4] * sc, oh[5] * sc); wh.w = cvt_pk_bf16(oh[6] * sc, oh[7] * sc);
                    bf16_t* rp = D + pofs(head, r) + dd0;
                    st16b(proj, rp, wl); st16b(proj, rp + 64, wh);
                } }
        } else if (pn >= 8 && pn < 12) {
            const int lane = fq * 16 + fr;
            const int colh = (pn - 8) * 128 + 32 * wc + 8 * fq;
            bf16_t* dHQ = (bf16_t*)(proj + 4 * PSZ); bf16_t* dHK = (bf16_t*)(proj + 5 * PSZ);
            f32x4 lbv[2];
#pragma unroll
            for (int n = 0; n < 2; ++n) lbv[n] = *(const f32x4*)(lb + colh + 4 * n);
            if constexpr (INALIGN) { if (wr == 0) __builtin_amdgcn_s_barrier(); }
            const int srcl = (lane & 48) | 15;
#pragma unroll
            for (int ai = 0; ai < 2; ++ai) {
                const int rbase = u.pm * 256 + ai * 128 + wr * 64;
#pragma unroll
                for (int n = 0; n < 2; ++n) if ((mask >> (4 * ai)) & 0xfu) {
                    const int cn = colh + 4 * n;
                    f32x4 gg[4], kk[4];
#pragma unroll
                    for (int m = 0; m < 4; ++m)
#pragma unroll
                        for (int j = 0; j < 4; ++j) {
                            const float x = acc[ai][1][m][n][j]; const float sg = sigmoid_f(x); const float l = lbv[n][j];
                            gg[m][j] = l + (1.0f - l) * sg; kk[m][j] = (1.0f - l) * (1.0f - sg);
                        }
                    if (samp) {
#pragma unroll
                        for (int m = 0; m < 4; ++m) if ((mask >> (4 * ai + m)) & 1u) {
                            const int r = rbase + 16 * m + fr;
                            const f32x4 q0 = acc[ai][0][m][n];
                            u32x2 w; w.x = cvt_pk_bf16(q0[0], q0[1]); w.y = cvt_pk_bf16(q0[2], q0[3]);
                            *(u32x2*)(dHQ + pofs(pn - 8, r) + (cn & 127)) = w;
                            *(f32x4*)(HGFS + (size_t)(r - TP) * HW + cn) = gg[m];
                        }
                    } else {
                        f32x4 carry = (f32x4){1.f, 1.f, 1.f, 1.f};
                        if constexpr (TOK) {
#pragma unroll
                            for (int j = 0; j < 4; ++j) { gg[1][j] *= gg[0][j]; gg[2][j] *= gg[1][j]; gg[3][j] *= gg[2][j]; }
                            float T0 = gg[3][0], T1 = gg[3][1], T2 = gg[3][2], T3 = gg[3][3];
#define HG_SCAN(sh) "v_mul_f32_dpp %0, %0, %0 " sh " row_mask:0xf bank_mask:0xf\n\tv_mul_f32_dpp %1, %1, %1 " sh " row_mask:0xf bank_mask:0xf\n\t" \
                    "v_mul_f32_dpp %2, %2, %2 " sh " row_mask:0xf bank_mask:0xf\n\tv_mul_f32_dpp %3, %3, %3 " sh " row_mask:0xf bank_mask:0xf\n\t"
                            asm("s_nop 1\n\t" HG_SCAN("row_shr:1") HG_SCAN("row_shr:2") HG_SCAN("row_shr:4") HG_SCAN("row_shr:8") : "+v"(T0), "+v"(T1), "+v"(T2), "+v"(T3));
#undef HG_SCAN
#define HG_APPLY(m) do { float g0_ = gg[m][0], g1_ = gg[m][1], g2_ = gg[m][2], g3_ = gg[m][3]; \
                        asm("s_nop 1\n\tv_mul_f32_dpp %0, %4, %0 row_shr:1 row_mask:0xf bank_mask:0xf\n\tv_mul_f32_dpp %1, %5, %1 row_shr:1 row_mask:0xf bank_mask:0xf\n\t" \
                        "v_mul_f32_dpp %2, %6, %2 row_shr:1 row_mask:0xf bank_mask:0xf\n\tv_mul_f32_dpp %3, %7, %3 row_shr:1 row_mask:0xf bank_mask:0xf" \
                        : "+v"(g0_), "+v"(g1_), "+v"(g2_), "+v"(g3_) : "v"(T0), "v"(T1), "v"(T2), "v"(T3)); \
                        gg[m] = (f32x4){g0_, g1_, g2_, g3_}; } while (0)
                            HG_APPLY(0); HG_APPLY(1); HG_APPLY(2); HG_APPLY(3);
#undef HG_APPLY
                            carry = (f32x4){T0, T1, T2, T3};
                        } else {
#pragma unroll
                        for (int m = 0; m < 4; ++m)
#pragma unroll
                            for (int j = 0; j < 4; ++j) {
                                float v = gg[m][j];
                                v *= dpp_f<0x111>(1.f, v); v *= dpp_f<0x112>(1.f, v); v *= dpp_f<0x114>(1.f, v); v *= dpp_f<0x118>(1.f, v);
                                v *= carry[j];
                                gg[m][j] = v;
                                carry[j] = __shfl(v, srcl);
                            }
                        }
#pragma unroll
                        for (int m = 0; m < 4; ++m) {
                            const int r = rbase + RM * m + RF * fr;
                            float qo[4], ko[4];
#pragma unroll
                            for (int j = 0; j < 4; ++j) { const float P = gg[m][j]; qo[j] = acc[ai][0][m][n][j] * P; ko[j] = kk[m][j] * __builtin_amdgcn_rcpf(P); }
                            u32x2 wq, wk;
                            wq.x = cvt_pk_bf16(qo[0], qo[1]); wq.y = cvt_pk_bf16(qo[2], qo[3]);
                            wk.x = cvt_pk_bf16(ko[0], ko[1]); wk.y = cvt_pk_bf16(ko[2], ko[3]);
                            st8b(proj, dHQ + pofs(pn - 8, r) + (cn & 127), wq); st8b(proj, dHK + pofs(pn - 8, r) + (cn & 127), wk);
                        }
                        if (fr == 15) {
                            f32x4 d0;
#pragma unroll
                            for (int j = 0; j < 4; ++j) d0[j] = carry[j];
                            *(f32x4*)(DEC + (size_t)(4 * u.pm + 2 * ai + wr) * HW + cn) = d0;
                        }
                    }
                }
            }
        } else {
            bf16_t* D = (bf16_t*)(proj + (size_t)(pn >> 1) * PSZ);
            if constexpr (INALIGN) { if (wr == 0) __builtin_amdgcn_s_barrier(); }
            const bool act = false;
#pragma unroll
            for (int ai = 0; ai < 2; ++ai)
#pragma unroll
                for (int m = 0; m < 4; ++m) if ((mask >> (4 * ai + m)) & 1u) {
                    const int r = rowb + ai * 128 + m * RM;
                    bf16_t* rp = D + pofs((pn & 1) * 2 + (wc >> 1), r) + dd0;
#pragma unroll
                    for (int bj = 0; bj < 2; ++bj) {
                        f32x4 v0 = acc[ai][bj][m][0], v1 = acc[ai][bj][m][1];
                        if (act) {
#pragma unroll
                            for (int j = 0; j < 4; ++j) { v0[j] = silu_f(v0[j]); v1[j] = silu_f(v1[j]); }
                        }
                        u32x4 w; w.x = cvt_pk_bf16(v0[0], v0[1]); w.y = cvt_pk_bf16(v0[2], v0[3]); w.z = cvt_pk_bf16(v1[0], v1[1]); w.w = cvt_pk_bf16(v1[2], v1[3]);
                        st16b(proj, rp + 64 * bj, w);
                    }
                }
        }
    }
};
using EpiIn = EpiInT<false>;

struct EpiOut {
    static constexpr bool TOK = false;
    static constexpr bool INALIGN = false;
    static constexpr bool IDEM = true, POST = false, S16 = true;
    const bf16_t* XR; const float* SS1; float* X1F; bf16_t* X1B; float* SS2;
    struct PreS { f32x4 xv[4]; };
    static __device__ __forceinline__ void unpk8(const u32x4 w, const float sc, f32x4& a, f32x4& b) {
        a[0] = __uint_as_float(w.x << 16) * sc; a[1] = __uint_as_float(w.x & 0xffff0000u) * sc; a[2] = __uint_as_float(w.y << 16) * sc; a[3] = __uint_as_float(w.y & 0xffff0000u) * sc;
        b[0] = __uint_as_float(w.z << 16) * sc; b[1] = __uint_as_float(w.z & 0xffff0000u) * sc; b[2] = __uint_as_float(w.w << 16) * sc; b[3] = __uint_as_float(w.w & 0xffff0000u) * sc; }
    __device__ __forceinline__ PreS pre_s(int pm, int pn, int wr, int wc, int fr, int fq, int ai, int m) const {
        PreS p; const int r = pm * 256 + ai * 128 + wr * 64 + m * 16 + fr; const bf16_t* xr = XR + (size_t)r * DM + pn * 256 + wc * 32 + 8 * fq;
        const u32x4 w0 = __builtin_nontemporal_load((const u32x4*)xr), w1 = __builtin_nontemporal_load((const u32x4*)(xr + 128)); const float rt = SS1[r];
        unpk8(w0, rt, p.xv[0], p.xv[1]); unpk8(w1, rt, p.xv[2], p.xv[3]);
        return p;
    }
    __device__ __forceinline__ void run_s(const f32x4 (&acc)[2][2][4][2], const PreS& pre, const Unit& u, int wr, int wc, int fr_, int fq_, int ai, int m) const {
        int fr = fr_, fq = fq_; asm volatile("" : "+v"(fr), "+v"(fq));
        const int col0 = u.pn * 256 + wc * 32 + 8 * fq;
        const int r = u.pm * 256 + ai * 128 + wr * 64 + m * 16 + fr;
        const int rb = r < TP ? (4098 * (r >> 12) + 2 + (r & 4095)) : (16394 + (r - TP));
        bf16_t* o16 = X1B + (size_t)rb * DM + col0;
        float ss = 0.f;
#pragma unroll
        for (int bj = 0; bj < 2; ++bj) {
            const f32x4 v0 = acc[0][bj][0][0] + pre.xv[2 * bj], v1 = acc[0][bj][0][1] + pre.xv[2 * bj + 1];
            u32x4 w; w.x = cvt_pk_bf16(v0[0], v0[1]); w.y = cvt_pk_bf16(v0[2], v0[3]); w.z = cvt_pk_bf16(v1[0], v1[1]); w.w = cvt_pk_bf16(v1[2], v1[3]);
            st16b(X1B, o16 + 128 * bj, w);
            ss += (v0[0] * v0[0] + v0[1] * v0[1]) + (v0[2] * v0[2] + v0[3] * v0[3]) + (v1[0] * v1[0] + v1[1] * v1[1]) + (v1[2] * v1[2] + v1[3] * v1[3]);
        }
        ss += __shfl_xor(ss, 16); ss += __shfl_xor(ss, 32);
        if (fq == 0) SS2[(size_t)r * 16 + u.pn * 4 + wc] = ss;
    }
    __device__ __forceinline__ void operator()(const f32x4 (&acc)[2][2][4][2], const Unit& u, int wr, int wc, int fr_, int fq_, const unsigned mask = 0xffu) const {
        int fr = fr_, fq = fq_; asm volatile("" : "+v"(fr), "+v"(fq));
        const int col0 = u.pn * 256 + wc * 32 + 8 * fq;
        u32x4 xw[2][4][2]; float rt[2][4];
        auto ldx = [&](int ai, int m) { if ((mask >> (4 * ai + m)) & 1u) { const int r = u.pm * 256 + ai * 128 + wr * 64 + m * 16 + fr; const bf16_t* xr = XR + (size_t)r * DM + col0;
            xw[ai][m][0] = __builtin_nontemporal_load((const u32x4*)xr); xw[ai][m][1] = __builtin_nontemporal_load((const u32x4*)(xr + 128)); rt[ai][m] = SS1[r]; } };
#pragma unroll
        for (int m = 0; m < 4; ++m) ldx(0, m);
#pragma unroll
        for (int ai = 0; ai < 2; ++ai)
#pragma unroll
            for (int m = 0; m < 4; ++m) {
                if (ai == 0) ldx(1, m);
                if ((mask >> (4 * ai + m)) & 1u) {
                    const int r = u.pm * 256 + ai * 128 + wr * 64 + m * 16 + fr;
                    const int rb = r < TP ? (4098 * (r >> 12) + 2 + (r & 4095)) : (16394 + (r - TP));
                    bf16_t* o16 = X1B + (size_t)rb * DM + col0;
                    float ss = 0.f;
#pragma unroll
                    for (int bj = 0; bj < 2; ++bj) {
                        f32x4 x0, x1; unpk8(xw[ai][m][bj], rt[ai][m], x0, x1);
                        const f32x4 v0 = acc[ai][bj][m][0] + x0, v1 = acc[ai][bj][m][1] + x1;
                        u32x4 w; w.x = cvt_pk_bf16(v0[0], v0[1]); w.y = cvt_pk_bf16(v0[2], v0[3]); w.z = cvt_pk_bf16(v1[0], v1[1]); w.w = cvt_pk_bf16(v1[2], v1[3]);
                        st16b(X1B, o16 + 128 * bj, w);
                        ss += (v0[0] * v0[0] + v0[1] * v0[1]) + (v0[2] * v0[2] + v0[3] * v0[3]) + (v1[0] * v1[0] + v1[1] * v1[1]) + (v1[2] * v1[2] + v1[3] * v1[3]);
                    }
                    ss += __shfl_xor(ss, 16); ss += __shfl_xor(ss, 32);
                    if (fq == 0) SS2[(size_t)r * 16 + u.pn * 4 + wc] = ss;
                }
            }
    }
};

struct EpiUp {
    static constexpr bool IDEM = true, POST = false;
    const float* SS2; const float* ck; const float* cb; const float* cache_in; bf16_t* ACT; float* ccp; float* ccs;
    __device__ __forceinline__ void operator()(f32x4 (&acc)[2][2][4][2], const Unit& u, int wr, int wc, int fr_, int fq_, const unsigned mask = 0xffu) const {
        int fr = fr_, fq = fq_; asm volatile("" : "+v"(fr), "+v"(fq));
        const int lane = fq * 16 + fr;
        const int f0 = u.pn * 128 + wc * 32 + 8 * fq;
        const bool samp = (u.pm == 68);
        const int sb = samp ? 0 : u.pm / 17, sj = samp ? 0 : u.pm % 17;
        f32x4 k0[2], k1[2], k2[2], bb[2];
#pragma unroll
        for (int n = 0; n < 2; ++n) { k0[n] = *(const f32x4*)(ck + f0 + 4 * n); k1[n] = *(const f32x4*)(ck + DFF + f0 + 4 * n); k2[n] = *(const f32x4*)(ck + 2 * DFF + f0 + 4 * n); bb[n] = *(const f32x4*)(cb + f0 + 4 * n); }
#pragma unroll
        for (int ai = 0; ai < 2; ++ai) {
            f32x4 prev[2] = {(f32x4){0.f, 0.f, 0.f, 0.f}, (f32x4){0.f, 0.f, 0.f, 0.f}};
#pragma unroll
            for (int m = 0; m < 4; ++m) if ((mask >> (4 * ai + m)) & 1u) {
                int gr; bool valid; int t = 0;
                if (samp) { gr = TP + ai * 128 + wr * 64 + m * 16 + fr; valid = true; }
                else { t = 248 * sj + 62 * (2 * ai + wr) + 16 * m + fr - 2; gr = sb * SEQ + t; valid = (t >= 0) && (t < SEQ); }
                float ssq = 0.f;
                if (valid) { const f32x4 p = *(const f32x4*)(SS2 + (size_t)gr * 16 + 4 * fq); ssq = (p[0] + p[1]) + (p[2] + p[3]); }
                ssq += __shfl_xor(ssq, 16); ssq += __shfl_xor(ssq, 32);
                const float rs = valid ? __frsqrt_rn(ssq * (1.0f / DM) + EPS) : 0.f;
                f32x4 a[2], b[2];
#pragma unroll
                for (int n = 0; n < 2; ++n) { a[n] = acc[ai][0][m][n] * rs; b[n] = acc[ai][1][m][n] * rs; }
                if (samp) {
                    const int s = ai * 8 + wr * 4 + m;
                    if (fr >= 14) {
#pragma unroll
                        for (int n = 0; n < 2; ++n) prev[n] = *(const f32x4*)(cache_in + ((size_t)s * 2 + (fr - 14)) * DFF + f0 + 4 * n);
                    }
                }
                f32x4 o[2];
#pragma unroll
                for (int n = 0; n < 2; ++n)
#pragma unroll
                    for (int j = 0; j < 4; ++j) {
                        const float s1 = dpp_f<0x111>(dpp_f<0x121>(0.f, prev[n][j]), a[n][j]);
                        const float s2 = dpp_f<0x112>(dpp_f<0x122>(0.f, prev[n][j]), a[n][j]);
                        const float cv = bb[n][j] + k0[n][j] * s2 + k1[n][j] * s1 + k2[n][j] * a[n][j];
                        o[n][j] = silu_f(cv) * b[n][j];
                    }
                const bool store = samp ? true : (valid && (16 * m + fr >= 2));
                if (store) {
                    u32x4 w; w.x = cvt_pk_bf16(o[0][0], o[0][1]); w.y = cvt_pk_bf16(o[0][2], o[0][3]); w.z = cvt_pk_bf16(o[1][0], o[1][1]); w.w = cvt_pk_bf16(o[1][2], o[1][3]);
                    st16b(ACT, ACT + (size_t)gr * DFF + f0, w);
                    if (samp) { if (fr >= 14) { float* cp = ccs + ((size_t)(ai * 8 + wr * 4 + m) * 2 + (fr - 14)) * DFF + f0; *(f32x4*)cp = a[0]; *(f32x4*)(cp + 4) = a[1]; } }
                    else if (t >= SEQ - 2) { float* cp = ccp + ((size_t)sb * 2 + (t - (SEQ - 2))) * DFF + f0; *(f32x4*)cp = a[0]; *(f32x4*)(cp + 4) = a[1]; }
                }
                prev[0] = a[0]; prev[1] = a[1];
            }
        }
    }
};

struct EpiUpMain {
    static constexpr bool TOK = true;
    static constexpr bool INALIGN = true;
    static constexpr bool IDEM = true, POST = false;
    const float* SS2; const float* ck; const float* cb; const float* cache_in; bf16_t* ACT; float* ccp; float* ccs;
    template <bool SAMP>
    __device__ __forceinline__ void body(f32x4 (&acc)[2][2][4][2], const Unit& u, int wr, int wc, int fr_, int fq_) const {
        int fr = fr_, fq = fq_; asm volatile("" : "+v"(fr), "+v"(fq));
        const int f0 = u.pn * 128 + wc * 32 + 8 * fq;
        const int sb = SAMP ? 0 : u.pm / 17, sj = SAMP ? 0 : u.pm % 17;
        f32x4 k0[2], k1[2], k2[2], bb[2];
#pragma unroll
        for (int n = 0; n < 2; ++n) { k0[n] = *(const f32x4*)(ck + f0 + 4 * n); k1[n] = *(const f32x4*)(ck + DFF + f0 + 4 * n); k2[n] = *(const f32x4*)(ck + 2 * DFF + f0 + 4 * n); bb[n] = *(const f32x4*)(cb + f0 + 4 * n); }
        constexpr float NL2E = -1.4426950408889634f, NLN2 = -0.6931471805599453f;
#pragma unroll
        for (int n = 0; n < 2; ++n) { k0[n] *= NL2E; k1[n] *= NL2E; k2[n] *= NL2E; bb[n] *= NL2E; }
        auto grow = [&](int ai, int m, bool clamp) -> int {
            if constexpr (SAMP) return TP + 64 * (2 * ai + wr) + 4 * fr + m;
            else { int t = 248 * sj + 62 * (2 * ai + wr) - 2 + 4 * fr + m; if (clamp) t = t < 0 ? 0 : (t > SEQ - 1 ? SEQ - 1 : t); return sb * SEQ + t; } };
        f32x4 pss[2][4];
        auto ldss = [&](int ai) {
#pragma unroll
            for (int m = 0; m < 4; ++m) pss[ai][m] = *(const f32x4*)(SS2 + (size_t)grow(ai, m, true) * 16 + 4 * fq); };
        ldss(0);
        if (wr == 0) __builtin_amdgcn_s_barrier();
        const bool first = SAMP && ((fr & 3) == 0);
#pragma unroll
        for (int ai = 0; ai < 2; ++ai) {
            const int tb = 248 * sj + 62 * (2 * ai + wr) - 2 + 4 * fr;
            float rs[4];
#pragma unroll
            for (int m = 0; m < 4; ++m) {
                const int t = tb + m; const bool valid = SAMP || ((unsigned)t < (unsigned)SEQ);
                const f32x4 p = pss[ai][m];
                float ssq = (p[0] + p[1]) + (p[2] + p[3]);
                ssq += __shfl_xor(ssq, 16); ssq += __shfl_xor(ssq, 32);
                rs[m] = valid ? __frsqrt_rn(ssq * (1.0f / DM) + EPS) : 0.f;
            }
            if (ai == 0) ldss(1);
            const float rsb[4] = {rs[0] * NLN2, rs[1] * NLN2, rs[2] * NLN2, rs[3] * NLN2};
            u32x4 w[4];
#pragma unroll
            for (int n = 0; n < 2; ++n) {
                f32x4 cin[2];
                if constexpr (SAMP) {
                    const int sq = 4 * (2 * ai + wr) + (fr >> 2);
                    cin[0] = *(const f32x4*)(cache_in + ((size_t)sq * 2 + 0) * DFF + f0 + 4 * n); cin[1] = *(const f32x4*)(cache_in + ((size_t)sq * 2 + 1) * DFF + f0 + 4 * n);
                }
#pragma unroll
                for (int j = 0; j < 4; j += 2) {
                    float o[4][2];
                    auto pr = [&](const f32x4& v) { return (f32x2){v[j], v[j + 1]}; };
                    const f32x2 a0 = pr(acc[ai][0][0][n]) * rs[0], a1 = pr(acc[ai][0][1][n]) * rs[1], a2 = pr(acc[ai][0][2][n]) * rs[2], a3 = pr(acc[ai][0][3][n]) * rs[3];
                    f32x2 p1 = {dpp_z<0x111>(a3[0]), dpp_z<0x111>(a3[1])}, p2 = {dpp_z<0x111>(a2[0]), dpp_z<0x111>(a2[1])};
                    if constexpr (SAMP) { const f32x2 h1 = pr(cin[1]), h2 = pr(cin[0]); p1[0] = first ? h1[0] : p1[0]; p1[1] = first ? h1[1] : p1[1]; p2[0] = first ? h2[0] : p2[0]; p2[1] = first ? h2[1] : p2[1]; }
                    const f32x2 c0 = pr(k0[n]), c1 = pr(k1[n]), c2 = pr(k2[n]), cbv = pr(bb[n]);
                    const f32x2 v0 = cbv + c0 * p2 + c1 * p1 + c2 * a0;
                    const f32x2 v1 = cbv + c0 * p1 + c1 * a0 + c2 * a1;
                    const f32x2 v2 = cbv + c0 * a0 + c1 * a1 + c2 * a2;
                    const f32x2 v3 = cbv + c0 * a1 + c1 * a2 + c2 * a3;
                    auto sg = [&](const f32x2& v) { const f32x2 e = {__builtin_amdgcn_exp2f(v[0]), __builtin_amdgcn_exp2f(v[1])}; const f32x2 d = e + 1.0f;
                                                    return (f32x2){__builtin_amdgcn_rcpf(d[0]), __builtin_amdgcn_rcpf(d[1])}; };
                    const f32x2 o0 = (v0 * sg(v0)) * (pr(acc[ai][1][0][n]) * rsb[0]);
                    const f32x2 o1 = (v1 * sg(v1)) * (pr(acc[ai][1][1][n]) * rsb[1]);
                    const f32x2 o2 = (v2 * sg(v2)) * (pr(acc[ai][1][2][n]) * rsb[2]);
                    const f32x2 o3 = (v3 * sg(v3)) * (pr(acc[ai][1][3][n]) * rsb[3]);
                    o[0][0] = o0[0]; o[0][1] = o0[1]; o[1][0] = o1[0]; o[1][1] = o1[1]; o[2][0] = o2[0]; o[2][1] = o2[1]; o[3][0] = o3[0]; o[3][1] = o3[1];
#pragma unroll
                    for (int m = 0; m < 4; ++m) w[m][2 * n + (j >> 1)] = cvt_pk_bf16(o[m][0], o[m][1]);
                }
            }
#pragma unroll
            for (int m = 0; m < 4; ++m) {
                if constexpr (SAMP) {
                    st16b(ACT, ACT + (size_t)grow(ai, m, false) * DFF + f0, w[m]);
                    if (m >= 2 && (fr & 3) == 3) {
                        float* cp = ccs + ((size_t)(4 * (2 * ai + wr) + (fr >> 2)) * 2 + (m - 2)) * DFF + f0; *(f32x4*)cp = acc[ai][0][m][0] * rs[m]; *(f32x4*)(cp + 4) = acc[ai][0][m][1] * rs[m];
                    }
                } else {
                    const int t = tb + m;
                    if ((unsigned)t < (unsigned)SEQ && (4 * fr + m >= 2)) {
                        st16b(ACT, ACT + (size_t)(sb * SEQ + t) * DFF + f0, w[m]);
                        if (t >= SEQ - 2) { float* cp = ccp + ((size_t)sb * 2 + (t - (SEQ - 2))) * DFF + f0; *(f32x4*)cp = acc[ai][0][m][0] * rs[m]; *(f32x4*)(cp + 4) = acc[ai][0][m][1] * rs[m]; }
                    }
                }
            }
        }
    }
    __device__ __forceinline__ void operator()(f32x4 (&acc)[2][2][4][2], const Unit& u, int wr, int wc, int fr_, int fq_, const unsigned mask = 0xffu) const {
        if (u.pm == 68) body<true>(acc, u, wr, wc, fr_, fq_); else body<false>(acc, u, wr, wc, fr_, fq_);
    }
};

template <bool FUSED>
struct EpiDownT {
    static constexpr bool TOK = false;
    static constexpr bool INALIGN = false;
    static constexpr bool IDEM = false, POST = !FUSED, S16 = false;
    float* X; const bf16_t* X1B; float* SS3; const float* gfin; float* XS; unsigned* cnt; LAS unsigned char* ldsx; bool fuse16;
    static __device__ __forceinline__ void ld8(const bf16_t* p, f32x4& a, f32x4& b) { const u32x4 w = *(const u32x4*)p;
        a[0] = __uint_as_float(w.x << 16); a[1] = __uint_as_float(w.x & 0xffff0000u); a[2] = __uint_as_float(w.y << 16); a[3] = __uint_as_float(w.y & 0xffff0000u);
        b[0] = __uint_as_float(w.z << 16); b[1] = __uint_as_float(w.z & 0xffff0000u); b[2] = __uint_as_float(w.w << 16); b[3] = __uint_as_float(w.w & 0xffff0000u); }
    __device__ __forceinline__ void post(LAS unsigned char* lds, int rb, int w, int lane, const unsigned nexp) const {
        asm volatile("s_waitcnt vmcnt(0)" ::: "memory");
        __syncthreads();
        LAS unsigned* flag = (LAS unsigned*)(lds + RING_BYTES + 8192);
        if (threadIdx.x == 0) {
            const unsigned old = __hip_atomic_fetch_add(cnt + 64 * (64 + rb), 1u, __ATOMIC_RELAXED, __HIP_MEMORY_SCOPE_AGENT);
            const unsigned last = (old == nexp - 1u) ? 1u : 0u;
            if (last) { __builtin_amdgcn_fence(__ATOMIC_ACQUIRE, "agent"); asm volatile("s_waitcnt vmcnt(0)" ::: "memory"); }
            *flag = last;
        }
        __syncthreads();
        if (*flag) {
            f32x4 gn[4];
#pragma unroll
            for (int j = 0; j < 4; ++j) gn[j] = ((const f32x4*)gfin)[lane + 64 * j];
            for (int q = w; q < 64; q += NWAVES) {
                const int m = TP + 64 * rb + q;
                float p = lane < 16 ? SS3[(size_t)m * 16 + lane] : 0.f;
#pragma unroll
                for (int o = 1; o < 64; o <<= 1) p += __shfl_xor(p, o);
                const float rs = 1.0f / sqrtf(p * (1.0f / DM) + EPS);
                f32x4* xr = (f32x4*)(X + (size_t)m * DM) + lane;
#pragma unroll
                for (int j = 0; j < 4; ++j) { f32x4 v = xr[64 * j]; v = v * rs * gn[j]; xr[64 * j] = v; }
            }
        }
        __syncthreads();
    }
    __device__ __forceinline__ void fused16(const f32x4 (&acc)[2][2][4][2], const Unit& u, int wr, int wc, int fr_, int fq_, int ai, int m) const {
        int fr = fr_, fq = fq_; asm volatile("" : "+v"(fr), "+v"(fq));
        const int col0 = u.pn * 256 + wc * 32 + 8 * fq;
        const int r = u.pm * 256 + ai * 128 + wr * 64 + m * 16 + fr;
        const bf16_t* x1p = X1B + (size_t)(16394 + (r - TP)) * DM + col0;
        f32x4 gv[2][2];
#pragma unroll
        for (int bj = 0; bj < 2; ++bj)
#pragma unroll
            for (int n = 0; n < 2; ++n) gv[bj][n] = *(const f32x4*)(gfin + col0 + 128 * bj + 4 * n);
        f32x4 v[2][2]; float ss = 0.f;
#pragma unroll
        for (int bj = 0; bj < 2; ++bj) {
            f32x4 x0, x1; ld8(x1p + 128 * bj, x0, x1);
            v[bj][0] = acc[0][bj][0][0] + x0; v[bj][1] = acc[0][bj][0][1] + x1;
            const f32x4 v0 = v[bj][0], v1 = v[bj][1];
            ss += (v0[0] * v0[0] + v0[1] * v0[1]) + (v0[2] * v0[2] + v0[3] * v0[3]) + (v1[0] * v1[0] + v1[1] * v1[1]) + (v1[2] * v1[2] + v1[3] * v1[3]);
        }
        ss += __shfl_xor(ss, 16); ss += __shfl_xor(ss, 32);
        if (fq == 0) st4wt(SS3 + (size_t)r * 16 + u.pn * 4 + wc, ss);
        asm volatile("s_waitcnt vmcnt(0)" ::: "memory");
        unsigned* cp = cnt + 64 * (64 + 2 * ai + wr);
        if (fq == 0 && fr == 0) __hip_atomic_fetch_add(cp, 1u, __ATOMIC_RELAXED, __HIP_MEMORY_SCOPE_AGENT);
        { unsigned sp = 0;
          while ((unsigned)__builtin_amdgcn_readfirstlane(__hip_atomic_load(cp, __ATOMIC_RELAXED, __HIP_MEMORY_SCOPE_AGENT)) < 64u) { __builtin_amdgcn_s_sleep(2); if (++sp > (1u << 20)) break; } }
        __builtin_amdgcn_fence(__ATOMIC_ACQUIRE, "agent");
        const float* sl = SS3 + (size_t)r * 16 + 4 * fq;
        float t = 0.f;
#pragma unroll
        for (int k = 0; k < 4; ++k) t += __hip_atomic_load(sl + k, __ATOMIC_RELAXED, __HIP_MEMORY_SCOPE_AGENT);
        t += __shfl_xor(t, 16); t += __shfl_xor(t, 32);
        const float rs = 1.0f / sqrtf(t * (1.0f / DM) + EPS);
        float* xr = X + (size_t)r * DM + col0;
#pragma unroll
        for (int bj = 0; bj < 2; ++bj) { *(f32x4*)(xr + 128 * bj) = v[bj][0] * rs * gv[bj][0]; *(f32x4*)(xr + 128 * bj + 4) = v[bj][1] * rs * gv[bj][1]; }
    }
    __device__ __forceinline__ void operator()(f32x4 (&acc)[2][2][4][2], const Unit& u, int wr, int wc, int fr_, int fq_, const unsigned mask = 0xffu) const {
        int fr = fr_, fq = fq_; asm volatile("" : "+v"(fr), "+v"(fq));
        const int col0 = u.pn * 256 + wc * 32 + 8 * fq;
        if constexpr (!FUSED) {
#pragma unroll
            for (int ai = 0; ai < 2; ++ai)
#pragma unroll
                for (int m = 0; m < 4; ++m) if ((mask >> (4 * ai + m)) & 1u) {
                    const int r = u.pm * 256 + ai * 128 + wr * 64 + m * 16 + fr;
                    float* xr = X + (size_t)r * DM + col0;
                    const int rb = r < TP ? (4098 * (r >> 12) + 2 + (r & 4095)) : (16394 + (r - TP));
                    const bf16_t* x1p = X1B + (size_t)rb * DM + col0;
                    float ss = 0.f;
#pragma unroll
                    for (int bj = 0; bj < 2; ++bj) {
                        f32x4 x0, x1; ld8(x1p + 128 * bj, x0, x1);
                        const f32x4 v0 = acc[ai][bj][m][0] + x0, v1 = acc[ai][bj][m][1] + x1;
                        st16wt(xr + 128 * bj, v0); st16wt(xr + 128 * bj + 4, v1);
                        ss += (v0[0] * v0[0] + v0[1] * v0[1]) + (v0[2] * v0[2] + v0[3] * v0[3]) + (v1[0] * v1[0] + v1[1] * v1[1]) + (v1[2] * v1[2] + v1[3] * v1[3]);
                    }
                    ss += __shfl_xor(ss, 16); ss += __shfl_xor(ss, 32);
                    if (fq == 0) st4wt(SS3 + (size_t)r * 16 + u.pn * 4 + wc, ss);
                }
        } else {
            const int tid = threadIdx.x, wid = __builtin_amdgcn_readfirstlane(tid >> 6);
            LAS float* P = (LAS float*)ldsx;
            LAS float* S = (LAS float*)(ldsx + 4096);
            u32x4 xw[2][4][2];
            auto ldr = [&](int ai, int m) { const int r = u.pm * 256 + ai * 128 + wr * 64 + m * 16 + fr;
                const bf16_t* x1p = X1B + (size_t)(4098 * (r >> 12) + 2 + (r & 4095)) * DM + col0;
                xw[ai][m][0] = *(const u32x4*)x1p; xw[ai][m][1] = *(const u32x4*)(x1p + 128); };
#pragma unroll
            for (int m = 0; m < 4; ++m) ldr(0, m);
#pragma unroll
            for (int ai = 0; ai < 2; ++ai)
#pragma unroll
                for (int m = 0; m < 4; ++m) {
                    if (ai == 0) ldr(1, m);
                    const int rl = ai * 128 + wr * 64 + m * 16 + fr;
                    float ss = 0.f;
#pragma unroll
                    for (int bj = 0; bj < 2; ++bj) {
                        f32x4 x0, x1; { const u32x4 w = xw[ai][m][bj];
                            x0[0] = __uint_as_float(w.x << 16); x0[1] = __uint_as_float(w.x & 0xffff0000u); x0[2] = __uint_as_float(w.y << 16); x0[3] = __uint_as_float(w.y & 0xffff0000u);
                            x1[0] = __uint_as_float(w.z << 16); x1[1] = __uint_as_float(w.z & 0xffff0000u); x1[2] = __uint_as_float(w.w << 16); x1[3] = __uint_as_float(w.w & 0xffff0000u); }
                        const f32x4 v0 = acc[ai][bj][m][0] + x0, v1 = acc[ai][bj][m][1] + x1;
                        acc[ai][bj][m][0] = v0; acc[ai][bj][m][1] = v1;
                        ss += (v0[0] * v0[0] + v0[1] * v0[1]) + (v0[2] * v0[2] + v0[3] * v0[3]) + (v1[0] * v1[0] + v1[1] * v1[1]) + (v1[2] * v1[2] + v1[3] * v1[3]);
                    }
                    ss += __shfl_xor(ss, 16); ss += __shfl_xor(ss, 32);
                    if (fq == 0) P[rl * 4 + wc] = ss;
                }
            asm volatile("s_waitcnt lgkmcnt(0)" ::: "memory"); __builtin_amdgcn_s_barrier(); asm volatile("" ::: "memory");
            if (tid < 256) {
                const f32x4 p = *(const LAS f32x4*)(P + tid * 4);
                __hip_atomic_store(XS + ((size_t)u.pm * 256 + tid) * 4 + u.pn, (p[0] + p[1]) + (p[2] + p[3]), __ATOMIC_RELAXED, __HIP_MEMORY_SCOPE_AGENT);
            }
            asm volatile("s_waitcnt vmcnt(0)" ::: "memory");
            if (tid < 256 && (tid & 63) == 0) __hip_atomic_fetch_add(cnt + 64 * u.pm, 1u, __ATOMIC_RELAXED, __HIP_MEMORY_SCOPE_AGENT);
            if (wid == 0) {
                unsigned sp = 0;
                while ((unsigned)__builtin_amdgcn_readfirstlane(__hip_atomic_load(cnt + 64 * u.pm, __ATOMIC_RELAXED, __HIP_MEMORY_SCOPE_AGENT)) < 16u) {
                    __builtin_amdgcn_s_sleep(2);
                    if (++sp > (1u << 20)) break;
                }
                __builtin_amdgcn_fence(__ATOMIC_ACQUIRE, "agent");
            }
            asm volatile("s_waitcnt vmcnt(0) lgkmcnt(0)" ::: "memory"); __builtin_amdgcn_s_barrier(); asm volatile("" ::: "memory");
            if (tid < 256) {
                const float* sl = XS + ((size_t)u.pm * 256 + tid) * 4;
                float t = 0.f;
#pragma unroll
                for (int k = 0; k < 4; ++k) t += __hip_atomic_load(sl + k, __ATOMIC_RELAXED, __HIP_MEMORY_SCOPE_AGENT);
                S[tid] = 1.0f / sqrtf(t * (1.0f / DM) + EPS);
            }
            asm volatile("s_waitcnt vmcnt(0) lgkmcnt(0)" ::: "memory"); __builtin_amdgcn_s_barrier(); asm volatile("" ::: "memory");
            f32x4 gv[2][2];
#pragma unroll
            for (int bj = 0; bj < 2; ++bj)
#pragma unroll
                for (int n = 0; n < 2; ++n) gv[bj][n] = *(const f32x4*)(gfin + col0 + 128 * bj + 4 * n);
#pragma unroll
            for (int ai = 0; ai < 2; ++ai)
#pragma unroll
                for (int m = 0; m < 4; ++m) {
                    const int rl = ai * 128 + wr * 64 + m * 16 + fr;
                    const float rs = S[rl];
                    float* xr = X + (size_t)(u.pm * 256 + rl) * DM + col0;
#pragma unroll
                    for (int bj = 0; bj < 2; ++bj) {
                        *(f32x4*)(xr + 128 * bj) = acc[ai][bj][m][0] * rs * gv[bj][0];
                        *(f32x4*)(xr + 128 * bj + 4) = acc[ai][bj][m][1] * rs * gv[bj][1];
                    }
                }
        }
    }
};

struct EpiNull {
    static constexpr bool TOK = false;
    static constexpr bool INALIGN = false;
    static constexpr bool IDEM = false, POST = false;
    __device__ __forceinline__ void operator()(f32x4 (&acc)[2][2][4][2], const Unit& u, int wr, int wc, int fr_, int fq_, const unsigned mask = 0xffu) const {
#pragma unroll
        for (int a = 0; a < 2; ++a)
#pragma unroll
            for (int b = 0; b < 2; ++b)
#pragma unroll
                for (int m = 0; m < 4; ++m)
#pragma unroll
                    for (int n = 0; n < 2; ++n) asm volatile("" :: "v"(acc[a][b][m][n]));
    }
};
struct Args { const float* in[17]; float* out; unsigned char* ws; int ph_lo, ph_hi; };

__device__ __forceinline__ float wave_sum(float v) {
#pragma unroll
    for (int o = 1; o < 64; o <<= 1) v += __shfl_xor(v, o);
    return v;
}

struct TItem { const float* W; bf16_t* WT; const float* gain; int K, N, k0, p0, s0; };
__device__ __forceinline__ void titem_load(const TItem& t, float (&tv)[32], int lane) {
#pragma unroll
    for (int i = 0; i < 32; ++i) { const int kk = 2 * i + (lane >> 5); tv[i] = __builtin_nontemporal_load(t.W + (size_t)(t.k0 + kk) * t.N + t.s0 + (lane & 31)); }
}
__device__ __forceinline__ void titem_finish(const TItem& t, float (&tv)[32], LAS float* scr, int lane) {
    if (t.gain) {
#pragma unroll
        for (int i = 0; i < 32; ++i) tv[i] *= t.gain[t.k0 + 2 * i + (lane >> 5)];
    }
#pragma unroll
    for (int i = 0; i < 32; ++i) scr[(2 * i + (lane >> 5)) * 33 + (lane & 31)] = tv[i];
    asm volatile("s_waitcnt lgkmcnt(0)" ::: "memory");
    const int c = lane & 7;
#pragma unroll
    for (int j = 0; j < 4; ++j) { const int n = (lane >> 3) + 8 * j; const LAS float* sp = scr + (8 * c) * 33 + n;
        u32x4 o; o.x = cvt_pk_bf16(sp[0 * 33], sp[1 * 33]); o.y = cvt_pk_bf16(sp[2 * 33], sp[3 * 33]); o.z = cvt_pk_bf16(sp[4 * 33], sp[5 * 33]); o.w = cvt_pk_bf16(sp[6 * 33], sp[7 * 33]);
        *(u32x4*)(t.WT + (size_t)(t.p0 + n) * t.K + t.k0 + 8 * c) = o; }
    asm volatile("s_waitcnt lgkmcnt(0)" ::: "memory");
}
__device__ __forceinline__ void transpose_item(const float* W, int K, int N, bf16_t* WT, const float* gain, LAS float* scr, int k0, int p0, int s0, int lane) {
    TItem t{W, WT, gain, K, N, k0, p0, s0}; float tv[32]; titem_load(t, tv, lane); titem_finish(t, tv, scr, lane);
}
__device__ __forceinline__ int colmap_in(int p) {
    const int pn = p >> 8, pl = p & 255, bj = pl >> 7, q = pl & 127;
    if (pn >= 8 && pn < 12) return (bj ? 2560 : 2048) + (pn - 8) * 128 + q;
    const int type = pn >> 1;
    return type * 512 + ((pn & 1) * 2 + (q >> 6)) * 128 + bj * 64 + (q & 63);
}
__device__ __forceinline__ int colmap_up(int p) { const int pn = p >> 8, pl = p & 255, bj = pl >> 7, q = pl & 127; return bj * DFF + 128 * pn + q; }

__device__ __forceinline__ void phase_prep(const Args& A, LAS unsigned char* lds, int wave, int lane) {
    unsigned char* ws = A.ws;
    const int G = gridDim.x, gw = blockIdx.x * NWAVES + wave, NGW = G * NWAVES;
    LAS float* scr = (LAS float*)(lds + wave * 8704);
    bf16_t* WinT = (bf16_t*)(ws + WS_WIN); bf16_t* WoutT = (bf16_t*)(ws + WS_WOUT); bf16_t* WupT = (bf16_t*)(ws + WS_WUP); bf16_t* WdT = (bf16_t*)(ws + WS_WD);
    constexpr int I_IN = 16 * 128, I_OUT = 16 * 32, I_UP = 16 * 176, I_DN = 44 * 32, NITEMS = I_IN + I_OUT + I_UP + I_DN;
    auto item_of = [&](int it) -> TItem {
        TItem t; int r = it;
        if (r < I_IN) { const int kb = r / 128, pb = r % 128; t.W = A.in[5]; t.WT = WinT; t.gain = A.in[10]; t.K = DM; t.N = INC; t.k0 = 64 * kb; t.p0 = 32 * pb; t.s0 = colmap_in(32 * pb); return t; } r -= I_IN;
        if (r < I_OUT) { const int kb = r / 32, pb = r % 32; t.W = A.in[9]; t.WT = WoutT; t.gain = nullptr; t.K = DM; t.N = DM; t.k0 = 64 * kb; t.p0 = 32 * pb; t.s0 = 32 * pb; return t; } r -= I_OUT;
        if (r < I_UP) { const int kb = r / 176, pb = r % 176; t.W = A.in[12]; t.WT = WupT; t.gain = A.in[11]; t.K = DM; t.N = UPC; t.k0 = 64 * kb; t.p0 = 32 * pb; t.s0 = colmap_up(32 * pb); return t; } r -= I_UP;
        { const int kb = r / 32, pb = r % 32; t.W = A.in[15]; t.WT = WdT; t.gain = nullptr; t.K = DFF; t.N = DM; t.k0 = 64 * kb; t.p0 = 32 * pb; t.s0 = 32 * pb; return t; } };
    {
        float ta[32], tb[32]; TItem ia{}, ib{};
        int it = gw;
        if (it < NITEMS) { ia = item_of(it); titem_load(ia, ta, lane); }
        {
        f32x2* rope = (f32x2*)(ws + WS_ROPE);
        const int gt = blockIdx.x * NTHREADS + threadIdx.x, NGT = G * NTHREADS;
        for (int i = gt; i < SEQ * 64; i += NGT) {
            const int pos = i >> 6, d = i & 63;
            const float inv = 1.0f / powf(10000.0f, (float)d * (1.0f / 64.0f));
            const float ang = (float)pos * inv;
            float sn, cs; sn = sinf(ang); cs = cosf(ang);
            rope[i] = (f32x2){cs, sn};
        }
        if (gt < HW) { const float l0 = A.in[8][gt], l1 = A.in[8][HW + gt]; ((float*)(ws + WS_LB))[gt] = 1.0f / (1.0f + __expf(l1 - l0)); }
        }
#pragma unroll 1
        while (it < NITEMS) {
            const int n1 = it + NGW, n2 = it + 2 * NGW;
            if (n1 < NITEMS) { ib = item_of(n1); titem_load(ib, tb, lane); }
            titem_finish(ia, ta, scr, lane);
            if (n1 >= NITEMS) break;
            if (n2 < NITEMS) { ia = item_of(n2); titem_load(ia, ta, lane); }
            titem_finish(ib, tb, scr, lane);
            it = n2;
        }
    }
    bf16_t* XB = (bf16_t*)(ws + WS_XB); float* SS1 = (float*)(ws + WS_SS1);
    for (int m0 = gw; m0 < TT; m0 += 4 * NGW) {
        f32x4 v[4][4];
#pragma unroll
        for (int q = 0; q < 4; ++q) {
            const int m = m0 + q * NGW;
            if (m < TT) {
                const float* xrow = m < TP ? A.in[0] + (size_t)m * DM : A.in[1] + (size_t)(m - TP) * DM;
                const f32x4* xr = (const f32x4*)xrow + lane;
#pragma unroll
                for (int j = 0; j < 4; ++j) v[q][j] = __builtin_nontemporal_load(xr + 64 * j);
            }
        }
#pragma unroll
        for (int q = 0; q < 4; ++q) {
            const int m = m0 + q * NGW;
            if (m < TT) {
                float s = 0.f;
#pragma unroll
                for (int j = 0; j < 4; ++j) s += (v[q][j][0] * v[q][j][0] + v[q][j][1] * v[q][j][1]) + (v[q][j][2] * v[q][j][2] + v[q][j][3] * v[q][j][3]);
                const float rt = sqrtf(wave_sum(s) * (1.0f / DM) + EPS), rs = 1.0f / rt;
                if (lane == 0) SS1[m] = rt;
                u32x2* o8 = (u32x2*)(XB + (size_t)m * DM) + lane;
#pragma unroll
                for (int j = 0; j < 4; ++j) { u32x2 w; w.x = cvt_pk_bf16(v[q][j][0] * rs, v[q][j][1] * rs); w.y = cvt_pk_bf16(v[q][j][2] * rs, v[q][j][3] * rs); o8[64 * j] = w; }
            }
        }
    }
    bf16_t* X1B = (bf16_t*)(ws + WS_X1B); (void)X1B;
}

constexpr int SMX_BASE = 115712, SMX_S = 0, SMX_Q = 32768, SMX_K = SMX_Q + 4096, SMX_V = SMX_K + 8192, SMX_END = SMX_V + 2048;
static_assert(SMX_BASE + SMX_END <= MISC_OFF, "sample item image");
template <bool HG>
__device__ __forceinline__ void sample_item_prefetch(const bf16_t* Q, const bf16_t* Kx, const float* Gf, const bf16_t* V, const float* st_in, int id, LAS unsigned char* lds) {
    const int tid = threadIdx.x, w = __builtin_amdgcn_readfirstlane(tid >> 6), lane = tid & 63;
    const int seq = id >> 3, head = (id >> 1) & 3;
    const int row0 = TP + seq * 16; const size_t hb = pofs(head, 0);
    LAS unsigned char* img = lds + SMX_BASE;
    const float* sbase = st_in + (size_t)(seq * 4 + head) * 16384 + (id & 1) * 64;
#pragma unroll
    for (int j = 0; j < 4; ++j) { const int c = (8 * j + w) * 64 + lane;
        __builtin_amdgcn_global_load_lds((const unsigned*)(sbase + (size_t)(c >> 4) * 128 + (c & 15) * 4), (LAS unsigned*)(img + SMX_S + (8 * j + w) * 1024), 16, 0, 0); }
    if (w < 4) { const int c = tid; __builtin_amdgcn_global_load_lds((const unsigned*)(Q + hb + (size_t)(row0 + (c >> 4)) * 128 + (c & 15) * 8), (LAS unsigned*)(img + SMX_Q + w * 1024), 16, 0, 0); }
    if (HG) { const int c = tid; __builtin_amdgcn_global_load_lds((const unsigned*)(Gf + (size_t)(row0 + (c >> 5)) * HW + head * 128 + (c & 31) * 4), (LAS unsigned*)(img + SMX_K + w * 1024), 16, 0, 0); }
    else if (w >= 4) { const int c = tid - 256; __builtin_amdgcn_global_load_lds((const unsigned*)(Kx + hb + (size_t)(row0 + (c >> 4)) * 128 + (c & 15) * 8), (LAS unsigned*)(img + SMX_K + (w - 4) * 1024), 16, 0, 0); }
    if (w < 2) { const int c = tid; __builtin_amdgcn_global_load_lds((const unsigned*)(V + hb + (size_t)(row0 + (c >> 3)) * 128 + (id & 1) * 64 + (c & 7) * 8), (LAS unsigned*)(img + SMX_V + w * 1024), 16, 0, 0); }
}
template <bool HG>
__device__ __forceinline__ void sample_mixer_cols(const bf16_t* Q, const bf16_t* Kx, const float* Gf, const bf16_t* V, float* O, const float* st_in, float* st_out, int id, LAS unsigned char* lds, const bool have_img) {
    const int tid = threadIdx.x, part = tid & 15, dpi = tid >> 4;
    const int seq = id >> 3, head = (id >> 1) & 3, dv0 = (id & 1) * 64 + 2 * dpi;
    float* so = st_out + (size_t)(seq * 4 + head) * 16384 + dv0;
    const int row0 = TP + seq * 16;
    const float gamma = 1.0f - exp2f(-5.0f - (float)head);
    LAS unsigned char* img = lds + SMX_BASE;
    if (!have_img) { __syncthreads(); sample_item_prefetch<HG>(Q, Kx, Gf, V, st_in, id, lds); }
    asm volatile("s_waitcnt vmcnt(0)" ::: "memory");
    __syncthreads();
    f32x2 S2[8];
#pragma unroll
    for (int i = 0; i < 8; ++i) S2[i] = *(const LAS f32x2*)(img + SMX_S + (part * 8 + i) * 256 + dpi * 8);
#pragma unroll 4
    for (int t = 0; t < 16; ++t) {
        const unsigned vvw = *(const LAS unsigned*)(img + SMX_V + t * 128 + dpi * 4);
        const f32x2 vv2 = {__uint_as_float(vvw << 16), __uint_as_float(vvw & 0xffff0000u)};
        const u32x4 q8 = *(const LAS u32x4*)(img + SMX_Q + t * 256 + part * 16);
        float qf[8], kf[8], df[8];
        const unsigned qa[4] = {q8.x, q8.y, q8.z, q8.w};
#pragma unroll
        for (int i = 0; i < 4; ++i) { qf[2 * i] = __uint_as_float(qa[i] << 16); qf[2 * i + 1] = __uint_as_float(qa[i] & 0xffff0000u); }
        if (HG) {
            const f32x4 g0 = *(const LAS f32x4*)(img + SMX_K + t * 512 + part * 32), g1 = *(const LAS f32x4*)(img + SMX_K + t * 512 + part * 32 + 16);
#pragma unroll
            for (int i = 0; i < 4; ++i) { df[i] = g0[i]; df[4 + i] = g1[i]; }
#pragma unroll
            for (int i = 0; i < 8; ++i) kf[i] = 1.0f - df[i];
        } else {
            const u32x4 k8 = *(const LAS u32x4*)(img + SMX_K + t * 256 + part * 16);
            const unsigned ka[4] = {k8.x, k8.y, k8.z, k8.w};
#pragma unroll
            for (int i = 0; i < 4; ++i) { kf[2 * i] = __uint_as_float(ka[i] << 16); kf[2 * i + 1] = __uint_as_float(ka[i] & 0xffff0000u); }
#pragma unroll
            for (int i = 0; i < 8; ++i) df[i] = gamma;
        }
        f32x2 pp = {0.f, 0.f};
#pragma unroll
        for (int i = 0; i < 8; ++i) { S2[i] = S2[i] * df[i] + vv2 * kf[i]; pp += S2[i] * qf[i]; }
        float p0 = pp[0], p1 = pp[1];
        p0 += dpp_f<0x128>(0.f, p0); p0 += dpp_f<0x124>(0.f, p0); p0 += dpp_f<0x122>(0.f, p0); p0 += dpp_f<0x121>(0.f, p0);
        p1 += dpp_f<0x128>(0.f, p1); p1 += dpp_f<0x124>(0.f, p1); p1 += dpp_f<0x122>(0.f, p1); p1 += dpp_f<0x121>(0.f, p1);
        if (part == 0) *(f32x2*)(O + (size_t)(row0 + t) * DM + (HG ? HW : 0) + head * 128 + dv0) = (f32x2){p0, p1};
    }
#pragma unroll
    for (int i = 0; i < 8; ++i) *(f32x2*)(so + (size_t)(part * 8 + i) * 128) = S2[i];
}
struct SampleMixerPtrs { const bf16_t* QR; const bf16_t* KR; const bf16_t* VR; const bf16_t* HQ; const bf16_t* HI; const float* HGFv; };
__device__ __forceinline__ SampleMixerPtrs sample_mixer_ptrs(const Args& A) {
    unsigned char* ws = A.ws; SampleMixerPtrs p;
    p.QR = (const bf16_t*)(ws + WS_QR); p.KR = (const bf16_t*)(ws + WS_KR); p.VR = (const bf16_t*)(ws + WS_VR);
    p.HQ = (const bf16_t*)(ws + WS_HQ); p.HI = (const bf16_t*)(ws + WS_HI);
    p.HGFv = (const float*)(ws + WS_HGFS) - (size_t)TP * HW;
    return p;
}
__device__ __forceinline__ void phase_mixer_sample_prefetch(const Args& A, LAS unsigned char* lds) {
    const int it = blockIdx.x; if (it >= 256) return;
    const SampleMixerPtrs p = sample_mixer_ptrs(A);
    if (it >> 7) sample_item_prefetch<true>(p.HQ, nullptr, p.HGFv, p.HI, A.in[3], it & 127, lds);
    else sample_item_prefetch<false>(p.QR, p.KR, nullptr, p.VR, A.in[2], it & 127, lds);
}
__device__ __forceinline__ int sample_first_item() {
    return (gridDim.x == 256) ? ((((int)blockIdx.x & 7) < 4) ? 128 : 0) + ((int)blockIdx.x >> 3) * 4 + ((int)blockIdx.x & 3) : (int)blockIdx.x;
}
__device__ __forceinline__ void phase_mixer_sample_prefetch_item(const Args& A, LAS unsigned char* lds, const int it) {
    if (it >= 256) return;
    const SampleMixerPtrs p = sample_mixer_ptrs(A);
    if (it >> 7) sample_item_prefetch<true>(p.HQ, nullptr, p.HGFv, p.HI, A.in[3], it & 127, lds);
    else sample_item_prefetch<false>(p.QR, p.KR, nullptr, p.VR, A.in[2], it & 127, lds);
}
__device__ __forceinline__ void phase_mixer_sample(const Args& A, LAS unsigned char* lds, const bool prefetched) {
    const SampleMixerPtrs p = sample_mixer_ptrs(A);
    float* O = A.out + O_Y;
    const int G = gridDim.x;
    const int it0 = FUSED_MIX ? sample_first_item() : (int)blockIdx.x;
    for (int it = it0; it < 256; it += G) {
        const bool hi = prefetched && it == it0;
        if (it >> 7) sample_mixer_cols<true>(p.HQ, nullptr, p.HGFv, p.HI, O, A.in[3], A.out + O_HGS, it & 127, lds, hi);
        else sample_mixer_cols<false>(p.QR, p.KR, nullptr, p.VR, O, A.in[2], A.out + O_RETS, it & 127, lds, hi);
    }
}

typedef short s16x4 __attribute__((ext_vector_type(4)));
__device__ __forceinline__ bf16x8 tr2(LAS unsigned char* p0, LAS unsigned char* p1) {
    const s16x4 a = __builtin_amdgcn_ds_read_tr16_b64_v4i16((LAS s16x4*)p0);
    const s16x4 b = __builtin_amdgcn_ds_read_tr16_b64_v4i16((LAS s16x4*)p1);
    return __builtin_shufflevector(a, b, 0, 1, 2, 3, 4, 5, 6, 7);
}
#define MFMA16(a, b, c) __builtin_amdgcn_mfma_f32_16x16x32_bf16((a), (b), (c), 0, 0, 0)

constexpr int M1_KSTR = 144, M1_VSTR = 72, M1_KSZ = 64 * M1_KSTR, M1_CH = M1_KSZ + 64 * M1_VSTR, M1_BUF = 2 * M1_CH;
__device__ __forceinline__ void m1_item(const bf16_t* Kt, const bf16_t* V, const float* DECp, bf16_t* ST, float* state_out, int seq, int head, int slice, float gamma64,
                                        LAS unsigned char* lds, int w, int lane, const int pmode = 0) {
    const int tid = threadIdx.x, fr = lane & 15, g = lane >> 4, r4 = fr >> 2, c4 = fr & 3;
    const int dkh = slice >> 2, dvq = slice & 3, tk = w >> 1, tv = w & 1;
    const size_t rbase = (size_t)seq * SEQ;
    const int cb = head * 128;
    const bool vld = tid < 256;
    const bf16_t* kp = Kt + pofs(head, rbase + (tid >> 3)) + dkh * 64 + (tid & 7) * 8;
    const bf16_t* vp = V + pofs(head, rbase + (tid >> 2)) + dvq * 32 + (tid & 3) * 8;
    const int kwo = (tid >> 3) * M1_KSTR + (tid & 7) * 16, vwo = M1_KSZ + (tid >> 2) * M1_VSTR + (tid & 3) * 16;
    const int dv = dvq * 32 + tv * 16 + fr, dk0 = dkh * 64 + 16 * tk + 4 * g;
    const float* dp = DECp ? DECp + (size_t)(seq * 64) * HW + cb + dk0 : nullptr;
    u32x4 rk0[8], rv[8]; f32x4 rd[8];
#define M1_LOAD(slot, n_) do { const size_t o_ = (size_t)(n_) * 64 * 128; rk0[slot] = *(const u32x4*)(kp + o_); \
        rv[slot] = vld ? *(const u32x4*)(vp + o_) : (u32x4){0u, 0u, 0u, 0u}; } while (0)
#define MX_LOADD(slot, n_) do { rd[slot] = dp ? *(const f32x4*)(dp + (size_t)(n_) * HW) : (f32x4){gamma64, gamma64, gamma64, gamma64}; } while (0)
#define M1_WRITE(slot, off_) do { LAS unsigned char* nb_ = lds + (off_); *(LAS u32x4*)(nb_ + kwo) = rk0[slot]; \
        if (vld) { *(LAS u32x2*)(nb_ + vwo) = (u32x2){rv[slot].x, rv[slot].y}; *(LAS u32x2*)(nb_ + vwo + 8) = (u32x2){rv[slot].z, rv[slot].w}; } } while (0)
    M1_LOAD(0, 0); M1_LOAD(1, 1); M1_LOAD(2, 2); M1_LOAD(3, 3); M1_LOAD(4, 4); M1_LOAD(5, 5); M1_LOAD(6, 6); M1_LOAD(7, 7);
    M1_WRITE(0, 0); M1_WRITE(1, M1_CH);
    __syncthreads();
    f32x4 acc = (f32x4){0.f, 0.f, 0.f, 0.f};
    for (int s0 = 0; s0 < 32; s0 += 4) {
#pragma unroll
        for (int u = 0; u < 4; ++u) {
            const int n = 2 * (s0 + u);
            LAS unsigned char* buf = lds + (u & 1) * M1_BUF;
            const f32x4 dec0 = rd[2 * u], dec1 = rd[2 * u + 1];
            { const int na = (n + 8 < 64) ? n + 8 : 62; M1_LOAD(2 * u, na); M1_LOAD(2 * u + 1, na + 1); }
#pragma unroll
            for (int h = 0; h < 2; ++h) {
                if (!(pmode & 1)) { u32x2 sv; sv.x = cvt_pk_bf16(acc[0], acc[1]); sv.y = cvt_pk_bf16(acc[2], acc[3]);
                  st8b(ST, ST + ((size_t)((seq * 64 + n + h) * 4 + head) * 128 + dv) * 128 + dk0, sv); }
#pragma unroll
                for (int ks = 0; ks < 2; ++ks) if (!(pmode & 2)) {
                    LAS unsigned char* ka = buf + h * M1_CH + (32 * ks + 8 * g + r4) * M1_KSTR + 32 * tk + 8 * c4;
                    LAS unsigned char* va = buf + h * M1_CH + M1_KSZ + (32 * ks + 8 * g + r4) * M1_VSTR + 32 * tv + 8 * c4;
                    const bf16x8 af = tr2(ka, ka + 4 * M1_KSTR), bfv = tr2(va, va + 4 * M1_VSTR);
                    acc = MFMA16(af, bfv, acc);
                }
                acc = acc * (h ? dec1 : dec0);
            }
            if (!(pmode & 8)) { M1_WRITE(2 * ((u + 1) & 3), ((u + 1) & 1) * M1_BUF); M1_WRITE(2 * ((u + 1) & 3) + 1, ((u + 1) & 1) * M1_BUF + M1_CH); }
            if (!(pmode & 4)) __syncthreads();
        }
    }
#undef M1_LOAD
#undef M1_WRITE
    if (!pmode) {
#pragma unroll
        for (int j = 0; j < 4; ++j) state_out[(size_t)(dk0 + j) * 128 + dv] = acc[j];
    } else asm volatile("" :: "v"(acc));
}
__device__ __forceinline__ void phase_m1(const Args& A, LAS unsigned char* lds, int w, int lane, const bool dup = false) {
    unsigned char* ws = A.ws;
    bf16_t* STb = (bf16_t*)(A.out + O_Y);
    const int G = gridDim.x;
    const int vcu = (G % 8 == 0) ? (int)(blockIdx.x % 8) * (G / 8) + (int)(blockIdx.x / 8) : (int)blockIdx.x;
    if (!dup) phase_mixer_sample_prefetch(A, lds);
    for (int it = vcu; it < 256 && !((PROBE & 4096) && dup); it += G) {
        const int mixer = it >> 7, seq = (it >> 5) & 3, head = (it >> 3) & 3, slice = it & 7;
        const float gam = 1.0f - exp2f(-5.0f - (float)head);
        const float g64 = exp2f(64.0f * __log2f(gam));
        float* sout = A.out + (mixer ? O_HGP : O_RETP) + (size_t)(seq * 4 + head) * 16384;
        bf16_t* ST = STb + (size_t)mixer * 256 * 4 * 16384;
        const int pm_ = dup ? ((PROBE >> 14) & 15) : 0;
        if (mixer) m1_item((const bf16_t*)(ws + WS_HK), (const bf16_t*)(ws + WS_HI), (const float*)(ws + WS_DEC), ST, sout, seq, head, slice, 0.f, lds, w, lane, pm_);
        else m1_item((const bf16_t*)(ws + WS_KR), (const bf16_t*)(ws + WS_VR), nullptr, ST, sout, seq, head, slice, g64, lds, w, lane, pm_);
        __syncthreads();
    }
    if (!(PROBE & 8192) || !dup) phase_mixer_sample(A, lds, !dup);
}


constexpr int MX_QSTR = 272, MX_KSTR = 256, MX_VSTR = 32, MX_KOFF = 0, MX_VOFF = 64 * MX_KSTR,
               MX_DOFF = MX_VOFF + 64 * MX_VSTR, MX_CH = MX_DOFF + 512;
constexpr int MX_SOFF = 4 * MX_CH, MX_SSZ = 16 * MX_QSTR, MX_END = MX_SOFF + 9 * MX_SSZ;
static_assert(MX_END <= SMX_BASE, "mixer LDS (below the sample item image, which is prefetched while the mixer runs)");
typedef float mx_f32x2 __attribute__((ext_vector_type(2)));
typedef __bf16 mx_bf16x2 __attribute__((ext_vector_type(2)));
__device__ __forceinline__ unsigned mx_pk(float lo, float hi) { const mx_f32x2 v = {lo, hi}; return __builtin_bit_cast(unsigned, __builtin_convertvector(v, mx_bf16x2)); }
__device__ __forceinline__ void mix_item(const bf16_t* Qt, const bf16_t* Kt, const bf16_t* V, const float* DECp, bf16_t* ORAW, float* state_out, int mixer, int seq, int head, int dve, float gamma64,
                                         LAS unsigned char* lds, int w, int lane, const Args& A, const int sit) {
    const int tid = threadIdx.x, fr = lane & 15, g = lane >> 4, r4 = fr >> 2, c4 = fr & 3;
    const size_t rbase = (size_t)seq * SEQ;
    const char* kb0 = (const char*)(Kt + pofs(head, rbase));
    const char* qb0 = (const char*)(Qt + pofs(head, rbase));
    const char* vb0 = (const char*)(V + pofs(head, rbase) + dve * 16);
    const unsigned kqo = (unsigned)(((tid >> 4) * 128 + (tid & 15) * 8) * 2), vgo = (unsigned)(((tid >> 3) * 128 + (tid & 7) * 2) * 2);
    const int kwo = (tid >> 4) * MX_KSTR + (((tid & 15) ^ (((tid >> 4) & 7) << 1)) * 16), vwo = MX_VOFF + (tid >> 3) * MX_VSTR + (tid & 7) * 4, dwo = MX_DOFF + (32 * (w & 3) + 4 * g) * 4;
    const bool hasdec = mixer != 0;
    const char* db0 = (const char*)(DECp + (size_t)(seq * 64) * HW + head * 128); const unsigned dgo = (unsigned)((tid & 127) * 4);
    u32x4 rk[4][2]; unsigned rv[4]; float rd[4];
    bf16x8 qfr[2][4];
    const unsigned qfo = (unsigned)((((16 * (w & 3) + fr) * 128) + 8 * g) * 2);
#define MX_QFRAG(set_, n_) do { const char* qc2_ = qb0 + (size_t)(n_) * 64 * 128 * 2; unsigned qfo_ = qfo; asm volatile("" : "+v"(qfo_)); \
        _Pragma("unroll") for (int ks = 0; ks < 4; ++ks) qfr[set_][ks] = *(const bf16x8*)(qc2_ + qfo_ + 64 * ks); } while (0)
#define MX_LOAD(slot, n_) do { const size_t o_ = (size_t)(n_) * 64 * 128 * 2; const char* kc_ = kb0 + o_; const char* qc_ = qb0 + o_; \
        unsigned kqo_ = kqo, vgo_ = vgo, dgo_ = dgo; asm volatile("" : "+v"(kqo_), "+v"(vgo_), "+v"(dgo_));       \
        rk[slot][0] = *(const u32x4*)(kc_ + kqo_); rk[slot][1] = *(const u32x4*)(kc_ + 32 * 128 * 2 + kqo_); \
        rv[slot] = *(const unsigned*)(vb0 + o_ + vgo_); if (hasdec) rd[slot] = *(const float*)(db0 + (size_t)(n_) * HW * 4 + dgo_); } while (0)
#define MX_WRITE(slot, off_) do { LAS unsigned char* nb_ = lds + (off_); \
        *(LAS u32x4*)(nb_ + MX_KOFF + kwo) = rk[slot][0]; *(LAS u32x4*)(nb_ + MX_KOFF + kwo + 32 * MX_KSTR) = rk[slot][1]; \
        *(LAS unsigned*)(nb_ + vwo) = rv[slot]; if (hasdec) *(LAS float*)(nb_ + MX_DOFF + (tid & 127) * 4) = rd[slot]; } while (0)
    const bool upd = w >= 4;
    const int trk0 = MX_KOFF + (4 * g + r4) * MX_KSTR + ((((8 * (w & 3)) ^ (16 * (g & 1) + 4 * r4)) + c4) * 8), trk1 = MX_KOFF + (4 * g + r4) * MX_KSTR + ((((8 * (w & 3) + 4) ^ (16 * (g & 1) + 4 * r4)) + c4) * 8), trv = MX_VOFF + (4 * g + r4) * MX_VSTR + 8 * c4;
    const int kfo = fr * MX_KSTR + ((g ^ ((fr & 1) << 1)) * 16), kfc = (fr >> 1) & 3;
    const int rfo = fr * MX_QSTR + 16 * g, swo = fr * MX_QSTR + (32 * (w & 3) + 4 * g) * 2;
    const s16x4 z4 = (s16x4){0, 0, 0, 0};
#define MX_PAD8(v_) __builtin_bit_cast(bf16x8, __builtin_shufflevector((v_), z4, 0, 1, 2, 3, 4, 5, 6, 7))
#define MX_CAT8(a_, b_) __builtin_bit_cast(bf16x8, __builtin_shufflevector((a_), (b_), 0, 1, 2, 3, 4, 5, 6, 7))
#define MFMA16K16(a_, b_, c_) MFMA16(MX_PAD8(a_), MX_PAD8(b_), (c_))
#define MX_TR1(p_) __builtin_amdgcn_ds_read_tr16_b64_v4i16((LAS s16x4*)(p_))
#define MX_OUT_READ(imgp, s0p_, s3p_, qset_) do { LAS unsigned char* ip_ = (imgp); LAS unsigned char* sp_ = (w == 0) ? (s0p_) : (s3p_) + (w - 1) * MX_SSZ; \
        _Pragma("unroll") for (int ks = 0; ks < 4; ++ks) { \
            qf[ks] = qfr[qset_][ks]; kf[ks] = *(const LAS bf16x8*)(ip_ + MX_KOFF + 16 * w * MX_KSTR + kfo + 64 * (ks ^ kfc)); \
            sfr[ks] = *(const LAS bf16x8*)(sp_ + rfo + 64 * ks); } \
        vpv = MX_TR1(ip_ + trv + 16 * w * MX_VSTR); } while (0)
#define MX_OUT_COMPUTE(crow) do { \
        f32x4 x = (f32x4){0.f, 0.f, 0.f, 0.f}, o = (f32x4){0.f, 0.f, 0.f, 0.f}; \
        _Pragma("unroll") for (int ks = 0; ks < 4; ++ks) { x = MFMA16(kf[ks], qf[ks], x); o = MFMA16(sfr[ks], qf[ks], o); }        \
        _Pragma("unroll") for (int e = 0; e < 4; ++e) x[e] = (fr >= 4 * g + e) ? x[e] : 0.f; \
        u32x2 xp; xp.x = mx_pk(x[0], x[1]); xp.y = mx_pk(x[2], x[3]); \
        const s16x4 xb = __builtin_bit_cast(s16x4, xp); \
        o = MFMA16K16(vpv, xb, o); \
        u32x2 ov; ov.x = mx_pk(o[0], o[1]); ov.y = mx_pk(o[2], o[3]); \
        *(u32x2*)(obase + ((size_t)(crow) * 64 + 16 * w + fr) * 16) = ov; } while (0)
    MX_LOAD(0, 0); MX_LOAD(1, 1); MX_LOAD(2, 2); MX_LOAD(3, 3);
    if (upd) { *(LAS u32x2*)(lds + MX_SOFF + swo) = (u32x2){0u, 0u}; *(LAS u32x2*)(lds + MX_SOFF + swo + 32) = (u32x2){0u, 0u}; }
    MX_WRITE(0, 0); MX_WRITE(1, MX_CH); MX_LOAD(0, 4); MX_LOAD(1, 5);
    f32x4 acc[2] = {(f32x4){0.f, 0.f, 0.f, 0.f}, (f32x4){0.f, 0.f, 0.f, 0.f}};
    s16x4 kt[2][4], vt[4]; f32x4 dec[2];
#define MX_UPD_READ(img_) do { LAS unsigned char* ub_ = (img_); \
        _Pragma("unroll") for (int sb = 0; sb < 4; ++sb) { kt[0][sb] = MX_TR1(ub_ + trk0 + 16 * sb * MX_KSTR); kt[1][sb] = MX_TR1(ub_ + trk1 + 16 * sb * MX_KSTR); vt[sb] = MX_TR1(ub_ + trv + 16 * sb * MX_VSTR); } \
        _Pragma("unroll") for (int t2 = 0; t2 < 2; ++t2) dec[t2] = hasdec ? *(const LAS f32x4*)(ub_ + dwo + 64 * t2) : (f32x4){gamma64, gamma64, gamma64, gamma64}; } while (0)
    __syncthreads();
    if (upd) MX_UPD_READ(lds);
    bf16_t* obase = ORAW + ((size_t)(((mixer * 4 + head) * 8 + dve)) * TP + rbase) * 16 + 4 * g;
    int ip = 3 * MX_CH, ic = 0, ia = MX_CH, inx = 2 * MX_CH;
    int s0p = MX_SOFF + 2 * MX_SSZ, s0c = MX_SOFF, s0n = MX_SOFF + MX_SSZ;
    int s3p = MX_SOFF + 6 * MX_SSZ, s3c = MX_SOFF + 3 * MX_SSZ;
    bf16x8 qf[4], kf[4], sfr[4]; s16x4 vpv;
    for (int n0 = 0; n0 < 64; n0 += 4) {
#pragma unroll
        for (int u = 0; u < 4; ++u) {
            const int n = n0 + u;
            LAS unsigned char* buf = lds + ic;
            if (!upd) MX_QFRAG(u & 1, n);
            MX_WRITE((u + 2) & 3, inx);
            { const int na = (n + 6 < 64) ? n + 6 : 63; MX_LOAD((u + 2) & 3, na); }
            if (upd) {
#pragma unroll
                for (int h = 0; h < 2; ++h) {
#pragma unroll
                    for (int t2 = 0; t2 < 2; ++t2) {
                        const bf16x8 vb = MX_CAT8(vt[2 * h], vt[2 * h + 1]);
                        const f32x4 tm = MFMA16(MX_PAD8(kt[t2][2 * h]), vb, acc[t2]);
                        acc[t2] = MFMA16(MX_CAT8(kt[t2][2 * h], kt[t2][2 * h + 1]), vb, acc[t2]);
                        { u32x2 sv; sv.x = mx_pk(tm[0], tm[1]); sv.y = mx_pk(tm[2], tm[3]); *(LAS u32x2*)(lds + s3c + (2 * h) * MX_SSZ + swo + 32 * t2) = sv; }
                        if (h == 1) acc[t2] = acc[t2] * dec[t2];
                        { u32x2 sv; sv.x = mx_pk(acc[t2][0], acc[t2][1]); sv.y = mx_pk(acc[t2][2], acc[t2][3]); *(LAS u32x2*)(lds + (h == 0 ? s3c + MX_SSZ : s0n) + swo + 32 * t2) = sv; }
                    }
                }
                MX_UPD_READ(lds + ia);
            } else if (n > 0) { MX_OUT_READ(lds + ip, lds + s0p, lds + s3p, (u + 1) & 1); MX_OUT_COMPUTE(n - 1); }
            __syncthreads();
            { const int t_ = ip; ip = ic; ic = ia; ia = inx; inx = t_; }
            { const int t_ = s0p; s0p = s0c; s0c = s0n; s0n = t_; }
            { const int t_ = s3p; s3p = s3c; s3c = t_; }
        }
    }
    if (w < 4) { MX_OUT_READ(lds + ip, lds + s0p, lds + s3p, 1); MX_OUT_COMPUTE(63); }
#undef MX_OUT_READ
#undef MX_OUT_COMPUTE
#undef MX_UPD_READ
#undef MX_TR1
#undef MFMA16K16
#undef MX_PAD8
#undef MX_CAT8
#undef MX_LOAD
#undef MX_QFRAG
#undef MX_WRITE
#pragma unroll
    for (int j = 0; j < 4; ++j) if (upd) { state_out[(size_t)(32 * (w & 3) + 4 * g + j) * 128 + dve * 16 + fr] = acc[0][j]; state_out[(size_t)(32 * (w & 3) + 16 + 4 * g + j) * 128 + dve * 16 + fr] = acc[1][j]; }
}
__device__ __forceinline__ void phase_mix(const Args& A, LAS unsigned char* lds, int w, int lane) {
    unsigned char* ws = A.ws;
    bf16_t* ORAW = (bf16_t*)(A.out + O_Y);
    const int G = gridDim.x;
    const int vcu = (G % 8 == 0) ? (int)(blockIdx.x % 8) * (G / 8) + (int)(blockIdx.x / 8) : (int)blockIdx.x;
    const bool pre = (vcu + G >= 256) && vcu < 256;
    if (pre) phase_mixer_sample_prefetch_item(A, lds, sample_first_item());
    for (int it = vcu; it < 256; it += G) {
        const int mixer = it >> 7, seq = (it >> 5) & 3, head = (it >> 3) & 3, dve = it & 7;
        const float gam = 1.0f - exp2f(-5.0f - (float)head);
        const float g64 = exp2f(64.0f * __log2f(gam));
        float* sout = A.out + (mixer ? O_HGP : O_RETP) + (size_t)(seq * 4 + head) * 16384;
        const int sit = pre ? sample_first_item() : -1;
        if (mixer) mix_item((const bf16_t*)(ws + WS_HQ), (const bf16_t*)(ws + WS_HK), (const bf16_t*)(ws + WS_HI), (const float*)(ws + WS_DEC), ORAW, sout, 1, seq, head, dve, 0.f, lds, w, lane, A, sit);
        else mix_item((const bf16_t*)(ws + WS_QR), (const bf16_t*)(ws + WS_KR), (const bf16_t*)(ws + WS_VR), nullptr, ORAW, sout, 0, seq, head, dve, g64, lds, w, lane, A, sit);
        __syncthreads();
    }
    phase_mixer_sample(A, lds, pre);
}

constexpr int M2_VSTR = 272, M2_VBUF = 64 * M2_VSTR, M2_EXCH = 8 * M2_VBUF;
__device__ __forceinline__ void m2_item(const Args& A, int seq, int n, LAS unsigned char* lds, int w, int lane) {
    unsigned char* ws = A.ws;
    int fr = lane & 15, g = lane >> 4; asm volatile("" : "+v"(fr), "+v"(g));
    const int r4 = fr >> 2, c4 = fr & 3;
    const int mixer = w >> 2, head = w & 3, cb = head * 128;
    const bf16_t* Q = (const bf16_t*)(ws + (mixer ? WS_HQ : WS_QR)); const bf16_t* K = (const bf16_t*)(ws + (mixer ? WS_HK : WS_KR));
    const bf16_t* V = (const bf16_t*)(ws + (mixer ? WS_HI : WS_VR)); const bf16_t* GT = (const bf16_t*)(ws + (mixer ? WS_HGT : WS_GR));
    const float* gain = A.in[mixer ? 7 : 6] + cb;
    const size_t r0 = (size_t)seq * SEQ + 64 * n;
    const bf16_t* ST = (const bf16_t*)(A.out + O_Y) + ((size_t)(mixer * 256 + seq * 64 + n) * 4 + head) * 16384;
    bf16_t* MG = (bf16_t*)(ws + WS_MRG);
    LAS unsigned char* vb = lds + w * M2_VBUF;
    const bf16_t* qp = Q + pofs(head, r0 + fr) + 8 * g; const bf16_t* kp = K + pofs(head, r0 + fr) + 8 * g;
    u32x4 vr[16];
#pragma unroll
    for (int i = 0; i < 16; ++i) vr[i] = __builtin_nontemporal_load((const u32x4*)(V + pofs(head, r0 + 4 * i + g) + fr * 8));
    bf16x8 qf[4][4], kf[4][4];
#pragma unroll
    for (int ks = 0; ks < 4; ++ks)
#pragma unroll
        for (int t = 0; t < 4; ++t) { qf[ks][t] = *(const bf16x8*)(qp + (size_t)(16 * t) * 128 + 32 * ks); kf[ks][t] = *(const bf16x8*)(kp + (size_t)(16 * t) * 128 + 32 * ks); }
#pragma unroll
    for (int i = 0; i < 16; ++i) *(LAS u32x4*)(vb + (4 * i + g) * M2_VSTR + fr * 16) = vr[i];
    f32x4 X[4][4];
#pragma unroll
    for (int a = 0; a < 4; ++a)
#pragma unroll
        for (int b = 0; b < 4; ++b) X[a][b] = (f32x4){0.f, 0.f, 0.f, 0.f};
#pragma unroll
    for (int ks = 0; ks < 4; ++ks)
#pragma unroll
        for (int jt = 0; jt < 4; ++jt)
#pragma unroll
            for (int it = jt; it < 4; ++it) X[jt][it] = MFMA16(kf[ks][jt], qf[ks][it], X[jt][it]);
    bf16x8 PB[4][2];
#pragma unroll
    for (int it = 0; it < 4; ++it)
#pragma unroll
        for (int s2 = 0; s2 < 2; ++s2) {
            float v[8];
#pragma unroll
            for (int e = 0; e < 8; ++e) {
                const int jt = 2 * s2 + (e >> 2);
                float x = 0.f;
                if (jt < it) x = X[jt][it][e & 3];
                else if (jt == it) x = (fr >= 4 * g + (e & 3)) ? X[jt][it][e & 3] : 0.f;
                v[e] = x;
            }
            u32x4 wv; wv.x = cvt_pk_bf16(v[0], v[1]); wv.y = cvt_pk_bf16(v[2], v[3]); wv.z = cvt_pk_bf16(v[4], v[5]); wv.w = cvt_pk_bf16(v[6], v[7]);
            PB[it][s2] = __builtin_bit_cast(bf16x8, wv);
        }
    const bf16_t* sp = ST + (size_t)fr * 128 + 8 * g;
    bf16x8 sa0[2][4];
#pragma unroll
    for (int k2 = 0; k2 < 2; ++k2)
#pragma unroll
        for (int d = 0; d < 4; ++d) sa0[k2][d] = *(const bf16x8*)(sp + (size_t)(16 * d) * 128 + 32 * k2);
    f32x4 O[8][4];
#pragma unroll
    for (int a = 0; a < 8; ++a)
#pragma unroll
        for (int b = 0; b < 4; ++b) O[a][b] = (f32x4){0.f, 0.f, 0.f, 0.f};
#pragma unroll
    for (int s2 = 0; s2 < 2; ++s2)
#pragma unroll
        for (int dh = 0; dh < 2; ++dh) {
            bf16x8 vt[4];
#pragma unroll
            for (int d = 0; d < 4; ++d) { LAS unsigned char* pa = vb + (32 * s2 + 4 * g + r4) * M2_VSTR + 32 * (4 * dh + d) + 8 * c4; vt[d] = tr2(pa, pa + 16 * M2_VSTR); }
#pragma unroll
            for (int it = 2 * s2; it < 4; ++it)
#pragma unroll
                for (int d = 0; d < 4; ++d) O[4 * dh + d][it] = MFMA16(vt[d], PB[it][s2], O[4 * dh + d][it]);
            asm volatile("" ::: "memory");
        }
#pragma unroll
    for (int dh = 0; dh < 2; ++dh)
#pragma unroll
        for (int kp2 = 0; kp2 < 2; ++kp2) {
            bf16x8 qg[2][4], sa[2][4];
#pragma unroll
            for (int k2 = 0; k2 < 2; ++k2) {
#pragma unroll
                for (int t = 0; t < 4; ++t) qg[k2][t] = *(const bf16x8*)(qp + (size_t)(16 * t) * 128 + 32 * (2 * kp2 + k2));
#pragma unroll
                for (int d = 0; d < 4; ++d) sa[k2][d] = (dh == 0 && kp2 == 0) ? sa0[k2][d] : *(const bf16x8*)(sp + (size_t)(16 * (4 * dh + d)) * 128 + 32 * (2 * kp2 + k2));
            }
#pragma unroll
            for (int k2 = 0; k2 < 2; ++k2)
#pragma unroll
                for (int d = 0; d < 4; ++d)
#pragma unroll
                    for (int it = 0; it < 4; ++it) O[4 * dh + d][it] = MFMA16(sa[k2][d], qg[k2][it], O[4 * dh + d][it]);
            asm volatile("" ::: "memory");
        }
    u32x2 gtr[4][8];
#pragma unroll
    for (int it = 0; it < 4; ++it)
#pragma unroll
        for (int d = 0; d < 8; ++d) gtr[it][d] = *(const u32x2*)(GT + pofs(head, r0 + 16 * it + fr) + 4 * g + 16 * d);
    float rs[4];
    LAS float* exch = (LAS float*)(lds + M2_EXCH);
#pragma unroll
    for (int it = 0; it < 4; ++it) {
        float ss = 0.f;
#pragma unroll
        for (int d = 0; d < 8; ++d) ss += (O[d][it][0] * O[d][it][0] + O[d][it][1] * O[d][it][1]) + (O[d][it][2] * O[d][it][2] + O[d][it][3] * O[d][it][3]);
        ss += __shfl_xor(ss, 16); ss += __shfl_xor(ss, 32);
        rs[it] = ss;
        if (mixer && g == 0) exch[(16 * it + fr) * 4 + head] = ss;
    }
    __syncthreads();
#pragma unroll
    for (int it = 0; it < 4; ++it) {
        if (mixer) { const f32x4 e = *(LAS f32x4*)(exch + (16 * it + fr) * 4); rs[it] = 1.0f / sqrtf(((e[0] + e[1]) + (e[2] + e[3])) * (1.0f / 512.0f) + EPS); }
        else rs[it] = 1.0f / sqrtf(rs[it] * (1.0f / 128.0f) + EPS);
    }
#pragma unroll
    for (int it = 0; it < 4; ++it) {
        int rowi = 16 * it + fr; asm volatile("" : "+v"(rowi));
        const size_t row = r0 + rowi;
        bf16_t* mgp = MG + row * DM + mixer * HW + cb + 4 * g;
        const float rsi = rs[it];
#pragma unroll
        for (int d = 0; d < 8; ++d) {
            const f32x4 gn = *(const f32x4*)(gain + 16 * d + 4 * g);
            const u32x2 gt = gtr[it][d];
            const float g0 = silu_f(__uint_as_float(gt.x << 16)), g1 = silu_f(__uint_as_float(gt.x & 0xffff0000u)), g2 = silu_f(__uint_as_float(gt.y << 16)), g3 = silu_f(__uint_as_float(gt.y & 0xffff0000u));
            const f32x4 o = O[d][it] * rsi * gn;
            u32x2 wv; wv.x = cvt_pk_bf16(o[0] * g0, o[1] * g1); wv.y = cvt_pk_bf16(o[2] * g2, o[3] * g3);
            st8b(MG, mgp + 16 * d, wv);
        }
    }
}
__device__ __forceinline__ void phase_normgate_sample(const Args& A, int wave, int lane) {
    unsigned char* ws = A.ws;
    const float* O = A.out + O_Y;
    const bf16_t* GR = (const bf16_t*)(ws + WS_GR); const bf16_t* HGT = (const bf16_t*)(ws + WS_HGT);
    bf16_t* MG = (bf16_t*)(ws + WS_MRG);
    const int gw = blockIdx.x * NWAVES + wave, NGW = gridDim.x * NWAVES;
    const bool hg = lane >= 32; const int c0 = lane * 16;
    const float* gain = hg ? A.in[7] + (c0 - HW) : A.in[6] + c0;
    f32x4 gn[4];
#pragma unroll
    for (int j = 0; j < 4; ++j) gn[j] = *(const f32x4*)(gain + 4 * j);
    for (int m = TP + gw; m < TT; m += NGW) {
        const f32x4* orow = (const f32x4*)(O + (size_t)m * DM + c0);
        f32x4 v[4]; float s = 0.f;
#pragma unroll
        for (int j = 0; j < 4; ++j) { v[j] = orow[j]; s += (v[j][0] * v[j][0] + v[j][1] * v[j][1]) + (v[j][2] * v[j][2] + v[j][3] * v[j][3]); }
        s += __shfl_xor(s, 1); s += __shfl_xor(s, 2); s += __shfl_xor(s, 4);
        float s2 = s; s2 += __shfl_xor(s2, 8); s2 += __shfl_xor(s2, 16);
        const float rs = hg ? 1.0f / sqrtf(s2 * (1.0f / 512.0f) + EPS) : 1.0f / sqrtf(s * (1.0f / 128.0f) + EPS);
        const bf16_t* gp = (hg ? HGT + pofs((c0 - HW) >> 7, m) + ((c0 - HW) & 127) : GR + pofs(c0 >> 7, m) + (c0 & 127));
        const u32x4 ga = *(const u32x4*)gp, gb = *(const u32x4*)(gp + 8);
        const unsigned gw_[8] = {ga.x, ga.y, ga.z, ga.w, gb.x, gb.y, gb.z, gb.w};
        float o[16];
#pragma unroll
        for (int i = 0; i < 8; ++i) { const float g0 = silu_f(__uint_as_float(gw_[i] << 16)), g1 = silu_f(__uint_as_float(gw_[i] & 0xffff0000u));
            o[2 * i] = v[(2 * i) >> 2][(2 * i) & 3] * rs * gn[(2 * i) >> 2][(2 * i) & 3] * g0; o[2 * i + 1] = v[(2 * i + 1) >> 2][(2 * i + 1) & 3] * rs * gn[(2 * i + 1) >> 2][(2 * i + 1) & 3] * g1; }
        u32x4 w0, w1;
        w0.x = cvt_pk_bf16(o[0], o[1]); w0.y = cvt_pk_bf16(o[2], o[3]); w0.z = cvt_pk_bf16(o[4], o[5]); w0.w = cvt_pk_bf16(o[6], o[7]);
        w1.x = cvt_pk_bf16(o[8], o[9]); w1.y = cvt_pk_bf16(o[10], o[11]); w1.z = cvt_pk_bf16(o[12], o[13]); w1.w = cvt_pk_bf16(o[14], o[15]);
        bf16_t* mp = MG + (size_t)m * DM + c0;
        *(u32x4*)mp = w0; *(u32x4*)(mp + 8) = w1;
    }
}

__device__ __forceinline__ void phase_normgate_prompt(const Args& A, int wave, int lane) {
    unsigned char* ws = A.ws;
    const bf16_t* ORAW = (const bf16_t*)(A.out + O_Y);
    const bf16_t* GR = (const bf16_t*)(ws + WS_GR); const bf16_t* HGT = (const bf16_t*)(ws + WS_HGT);
    bf16_t* MG = (bf16_t*)(ws + WS_MRG);
    const int gw = blockIdx.x * NWAVES + wave, NGW = gridDim.x * NWAVES;
    const bool hg = lane >= 32; const int c0 = lane * 16;
    const float* gain = hg ? A.in[7] + (c0 - HW) : A.in[6] + c0;
    f32x4 gn[4];
#pragma unroll
    for (int j = 0; j < 4; ++j) gn[j] = *(const f32x4*)(gain + 4 * j);
    const bf16_t* gbase = hg ? HGT + pofs((c0 - HW) >> 7, 0) + ((c0 - HW) & 127) : GR + pofs(c0 >> 7, 0) + (c0 & 127);
    for (int m0 = 8 * gw; m0 < TP; m0 += 8 * NGW) {
        u32x4 ov[8][2], gv[8][2];
#pragma unroll
        for (int q = 0; q < 8; ++q) { const int m = m0 + q;
            if (m < TP) { const bf16_t* op = ORAW + ((size_t)lane * TP + m) * 16; ov[q][0] = *(const u32x4*)op; ov[q][1] = *(const u32x4*)(op + 8);
                          const bf16_t* gp = gbase + (size_t)m * 128; gv[q][0] = *(const u32x4*)gp; gv[q][1] = *(const u32x4*)(gp + 8); } }
#pragma unroll
        for (int q = 0; q < 8; ++q) { const int m = m0 + q;
            if (m < TP) {
                const unsigned ow[8] = {ov[q][0].x, ov[q][0].y, ov[q][0].z, ov[q][0].w, ov[q][1].x, ov[q][1].y, ov[q][1].z, ov[q][1].w};
                const unsigned gw_[8] = {gv[q][0].x, gv[q][0].y, gv[q][0].z, gv[q][0].w, gv[q][1].x, gv[q][1].y, gv[q][1].z, gv[q][1].w};
                float v[16]; float s = 0.f;
#pragma unroll
                for (int i = 0; i < 8; ++i) { v[2 * i] = __uint_as_float(ow[i] << 16); v[2 * i + 1] = __uint_as_float(ow[i] & 0xffff0000u); s += v[2 * i] * v[2 * i] + v[2 * i + 1] * v[2 * i + 1]; }
                s += __shfl_xor(s, 1); s += __shfl_xor(s, 2); s += __shfl_xor(s, 4);
                float s2 = s; s2 += __shfl_xor(s2, 8); s2 += __shfl_xor(s2, 16);
                const float rs = hg ? 1.0f / sqrtf(s2 * (1.0f / 512.0f) + EPS) : 1.0f / sqrtf(s * (1.0f / 128.0f) + EPS);
                float o[16];
#pragma unroll
                for (int i = 0; i < 8; ++i) { const float g0 = silu_f(__uint_as_float(gw_[i] << 16)), g1 = silu_f(__uint_as_float(gw_[i] & 0xffff0000u));
                    o[2 * i] = v[2 * i] * rs * gn[(2 * i) >> 2][(2 * i) & 3] * g0; o[2 * i + 1] = v[2 * i + 1] * rs * gn[(2 * i + 1) >> 2][(2 * i + 1) & 3] * g1; }
                u32x4 w0, w1;
                w0.x = cvt_pk_bf16(o[0], o[1]); w0.y = cvt_pk_bf16(o[2], o[3]); w0.z = cvt_pk_bf16(o[4], o[5]); w0.w = cvt_pk_bf16(o[6], o[7]);
                w1.x = cvt_pk_bf16(o[8], o[9]); w1.y = cvt_pk_bf16(o[10], o[11]); w1.z = cvt_pk_bf16(o[12], o[13]); w1.w = cvt_pk_bf16(o[14], o[15]);
                bf16_t* mp = MG + (size_t)m * DM + c0;
                *(u32x4*)mp = w0; *(u32x4*)(mp + 8) = w1;
            } }
    }
}
__device__ __forceinline__ void phase_m2(const Args& A, LAS unsigned char* lds, int w, int lane) {
    const int G = gridDim.x;
    const int vcu = (G % 8 == 0) ? (int)(blockIdx.x % 8) * (G / 8) + (int)(blockIdx.x / 8) : (int)blockIdx.x;
    for (int it = vcu; it < 256; it += G) { m2_item(A, it >> 6, it & 63, lds, w, lane); __syncthreads(); }
    phase_normgate_sample(A, w, lane);
}
__device__ __forceinline__ void phase_final(const Args& A, int wave, int lane) {
    const float* SS3 = (const float*)(A.ws + WS_SS3);
    const int gw = blockIdx.x * NWAVES + wave, NGW = gridDim.x * NWAVES;
    f32x4 gn[4];
#pragma unroll
    for (int j = 0; j < 4; ++j) gn[j] = ((const f32x4*)A.in[16])[lane + 64 * j];
    for (int m = gw; m < TP; m += NGW) {
        float p = lane < 16 ? SS3[(size_t)m * 16 + lane] : 0.f;
        p = wave_sum(p);
        const float rs = 1.0f / sqrtf(p * (1.0f / DM) + EPS);
        f32x4* xr = (f32x4*)(A.out + O_Y + (size_t)m * DM) + lane;
#pragma unroll
        for (int j = 0; j < 4; ++j) { f32x4 v = xr[64 * j]; v = v * rs * gn[j]; xr[64 * j] = v; }
    }
}

__global__ void __launch_bounds__(NTHREADS, 2) fwd_kernel(Args args) {
    extern __shared__ __attribute__((aligned(16))) unsigned char lds_raw[];
    LAS unsigned char* lds = (LAS unsigned char*)lds_raw;
    const int tid = threadIdx.x, wave = __builtin_amdgcn_readfirstlane(tid >> 6);
    volatile LAS unsigned* MISC = (volatile LAS unsigned*)(lds + MISC_OFF);
    if (tid < 64) MISC[tid] = 0u;
    __syncthreads();
    unsigned char* ws = args.ws;
    XcdBarrier bar; bar.bar = (unsigned*)(ws + WS_CTL); bar.x = 0; bar.st = nullptr;
    if (N_LAUNCHES == 1) bar = xcd_barrier_post((unsigned*)(ws + WS_CTL), MISC + 8);
    const int lo = args.ph_lo, hi = args.ph_hi;
#define IN(k) (lo <= (k) && (k) < hi)
#define SEAM(k) do { if (IN(k) && IN((k) + 1)) { xcd_barrier(bar); if (PROBE & 256) xcd_barrier(bar); } } while (0)
    const int G = gridDim.x, c = blockIdx.x;

    if (IN(0)) { phase_prep(args, lds, wave, fresh_lane()); if (PROBE & 64) { __syncthreads(); phase_prep(args, lds, wave, fresh_lane()); } } SEAM(0);
    if (IN(1)) {
        pg8::Gemm g{(const bf16_t*)(ws + WS_XB), (const bf16_t*)(ws + WS_WIN), DM}; pg8::StaticOrder S; S.init(64, 16, G, c);
        EpiIn E{ws + WS_PROJ, (float*)(ws + WS_DEC), (float*)(ws + WS_HGFS), (const f32x4*)(ws + WS_ROPE), (const float*)(ws + WS_LB)};
        EpiInT<true> EM{E.proj, E.DEC, E.HGFS, E.rope, E.lb};
        pg8::gemm_phase<EpiInT<true>, false>(lds, g, S, EM);
        pg8::sample_gemm<EpiIn>(lds, g.A + (size_t)TP * DM, g.Bt, DM, 16, 64, E, c, G);
        if (PROBE & 1) pg8::sample_gemm<EpiIn>(lds, g.A + (size_t)TP * DM, g.Bt, DM, 16, 64, E, c, G);
        if (PROBE & 2) { pg8::gemm_phase<EpiInT<true>, false>(lds, g, S, EM); }
    } SEAM(1);
    if (IN(2) && FUSED_MIX) { phase_mix(args, lds, wave, fresh_lane()); }
    if (IN(2) && !FUSED_MIX) { phase_m1(args, lds, wave, fresh_lane()); if (PROBE & (16 | 4096 | 8192)) { __syncthreads(); phase_m1(args, lds, wave, fresh_lane(), true); } } SEAM(2);
    if (IN(3) && FUSED_MIX) { const int ln_ = fresh_lane(); phase_normgate_prompt(args, wave, ln_); phase_normgate_sample(args, wave, ln_); }
    if (IN(3) && !FUSED_MIX) { phase_m2(args, lds, wave, fresh_lane()); if (PROBE & 32) { __syncthreads(); phase_m2(args, lds, wave, fresh_lane()); } } SEAM(3);
    if (IN(4)) {
        { bf16_t* X1B = (bf16_t*)(ws + WS_X1B); const int gt = c * NTHREADS + tid;
          if (gt < 4 * 256) { const int b = gt >> 8, w = gt & 255; ((u32x4*)(X1B + (size_t)(4098 * b) * DM))[w] = (u32x4){0u, 0u, 0u, 0u}; } }
        pg8::Gemm g{(const bf16_t*)(ws + WS_MRG), (const bf16_t*)(ws + WS_WOUT), DM}; pg8::StaticOrder S; S.init(64, 4, G, c);
        EpiOut E{(const bf16_t*)(ws + WS_XB), (const float*)(ws + WS_SS1), args.out + O_Y, (bf16_t*)(ws + WS_X1B), (float*)(ws + WS_SS2)};
        pg8::gemm_phase<EpiOut, false>(lds, g, S, E);
        pg8::sample_gemm16<EpiOut>(lds, g.A + (size_t)TP * DM, g.Bt, DM, 4, 64, E, c, G);
        if (PROBE & 1) pg8::sample_gemm<EpiOut>(lds, g.A + (size_t)TP * DM, g.Bt, DM, 4, 64, E, c, G);
        if (PROBE & 4) { pg8::gemm_phase<EpiOut, false>(lds, g, S, E); }
    } SEAM(4);
    if (IN(5)) {
        pg8::Gemm g{(const bf16_t*)(ws + WS_X1B), (const bf16_t*)(ws + WS_WUP), DM}; pg8::StaticOrder S; S.init(69, 22, G, c);
        EpiUp E{(const float*)(ws + WS_SS2), args.in[13], args.in[14], args.in[4], (bf16_t*)(ws + WS_ACT), args.out + O_CCP, args.out + O_CCS};
        EpiUpMain EM{E.SS2, E.ck, E.cb, E.cache_in, E.ACT, E.ccp, E.ccs};
        pg8::gemm_phase<EpiUpMain, true>(lds, g, S, EM);
        if (PROBE & 8) { pg8::gemm_phase<EpiUpMain, true>(lds, g, S, EM); }
    } SEAM(5);
    if (IN(6)) {
        pg8::Gemm g{(const bf16_t*)(ws + WS_ACT), (const bf16_t*)(ws + WS_WD), DFF}; pg8::StaticOrder S; S.init(64, 4, G, c);
        EpiDownT<true> E{args.out + O_Y, (const bf16_t*)(ws + WS_X1B), (float*)(ws + WS_SS3), args.in[16], (float*)(ws + WS_SS3), (unsigned*)(ws + WS_CTL + 32768), lds + RING_BYTES, false};
        EpiDownT<false> Es{args.out + O_Y, (const bf16_t*)(ws + WS_X1B), (float*)(ws + WS_SS3), args.in[16], nullptr, (unsigned*)(ws + WS_CTL + 32768), lds, G == 256};
        if (PROBE & 2048) { EpiNull En; pg8::gemm_phase<EpiNull, false>(lds, g, S, En); }
        if (G == 256) pg8::gemm_phase<EpiDownT<true>, false>(lds, g, S, E);
        else pg8::gemm_phase<EpiDownT<false>, false>(lds, g, S, Es);
        pg8::sample_gemm16<EpiDownT<false>>(lds, g.A + (size_t)TP * DFF, g.Bt, DFF, 4, 64, Es, c, G);
    }
    if (G != 256) {
        SEAM(6);
        if (IN(7)) { phase_final(args, wave, fresh_lane()); }
    }
#undef IN
#undef SEAM
}

extern "C" void kernel_launch(void* const* d_in, const int* in_sizes, int n_in, void* d_out, int out_size, void* d_ws, size_t ws_size, hipStream_t stream) {
    static int grid = 0;
    if (grid == 0) {
        if (n_in != 17 || ws_size < WS_END) { fprintf(stderr, "kernel_launch: unexpected n_in %d or ws_size %zu (need %zu)\n", n_in, ws_size, (size_t)WS_END); grid = -1; return; }
        int dev = 0, cus = 0, per_cu = 0;
        hipGetDevice(&dev); hipDeviceGetAttribute(&cus, hipDeviceAttributeMultiprocessorCount, dev);
        hipFuncSetAttribute((const void*)fwd_kernel, hipFuncAttributeMaxDynamicSharedMemorySize, LDS_BYTES);
        hipOccupancyMaxActiveBlocksPerMultiprocessor(&per_cu, (const void*)fwd_kernel, NTHREADS, LDS_BYTES);
        if (per_cu < 1) { fprintf(stderr, "kernel_launch: occupancy query says %d blocks per CU\n", per_cu); per_cu = 1; }
        (void)hipGetLastError();
        grid = cus;
        if (grid > 256) grid = 256;
        fprintf(stderr, "kernel_launch: cus %d per_cu %d grid %d ws %zu\n", cus, per_cu, grid, ws_size);
    }
    if (grid < 0) return;
    hipMemsetAsync((char*)d_ws + WS_CTL, 0, 65536, stream);
    Args a{};
    for (int i = 0; i < 17; ++i) a.in[i] = (const float*)d_in[i];
    a.out = (float*)d_out; a.ws = (unsigned char*)d_ws;
    if (N_LAUNCHES == 1) {
        a.ph_lo = 0; a.ph_hi = 8;
        void* kargs[] = {&a};
#if PROBE & 1024
        hipLaunchKernelGGL(fwd_kernel, dim3(grid), dim3(NTHREADS), LDS_BYTES, stream, a); hipError_t e = hipSuccess; (void)kargs;
#else
        hipError_t e = hipLaunchCooperativeKernel((const void*)fwd_kernel, dim3(grid), dim3(NTHREADS), kargs, LDS_BYTES, stream);
#endif
        if (e != hipSuccess) fprintf(stderr, "cooperative launch failed: %s (grid %d)\n", hipGetErrorString(e), grid);
    } else {
        for (int p = 0; p < 8; ++p) { a.ph_lo = p; a.ph_hi = p + 1; hipLaunchKernelGGL(fwd_kernel, dim3(grid), dim3(NTHREADS), LDS_BYTES, stream, a); }
    }
}
```
